# Optimizing an MI355X kernel written in HIP

```python
import jax
import jax.numpy as jnp
from jax import lax
import numpy as np

D_MODEL = 2048
BATCH = 4
SEQ = 8192
DEPTH = 4
DEC_BATCH = 8
DEC_SEQ = 32
PAST_LEN = 2048

CHUNK = 64
D_MIX = D_MODEL
EPS = 1e-6
NEG_INF = -1e30
D_CONV = D_MIX // 4
CONV_W = 31
CONV_GROUPS = 8
D_ATT = D_MIX // 4
N_HEADS = 8
HEAD_DIM = D_ATT // N_HEADS
BAND_CHUNKS = 8
BAND_PAST = BAND_CHUNKS * CHUNK
BAND_LEN = (BAND_CHUNKS + 1) * CHUNK
REL_CLIP = 128
D_POOL = D_MIX // 4
POOL_WINDOWS = (2, 4, 8, 16)
POOL_GROUP = D_POOL // 4
POOL_HIST = 15
D_SG = D_MIX // 4
SG_CHUNK = 128
SG_GROUPS = 4
SG_GROUP = D_SG // SG_GROUPS
D_FF = -(-8 * D_MODEL // (3 * 256)) * 256
D_IN = 2 * D_CONV + 3 * D_ATT + D_POOL + 2 * D_SG
IN_SPLITS = (D_CONV, 2 * D_CONV, 2 * D_CONV + D_ATT, 2 * D_CONV + 2 * D_ATT,
             2 * D_CONV + 3 * D_ATT, 2 * D_CONV + 3 * D_ATT + D_POOL,
             2 * D_CONV + 3 * D_ATT + D_POOL + D_SG)

kernel_name = 'hybrid_streaming_encoder_step'


def rms_norm(x, g):
    xf = x.astype(jnp.float32)
    y = xf * lax.rsqrt(jnp.mean(xf * xf, axis=-1, keepdims=True) + EPS)
    return (y * g).astype(x.dtype)


def group_norm(x, g, b, groups):
    shp = x.shape
    xf = x.astype(jnp.float32).reshape(shp[:-1] + (groups, shp[-1] // groups))
    mu = jnp.mean(xf, axis=-1, keepdims=True)
    var = jnp.mean(jnp.square(xf - mu), axis=-1, keepdims=True)
    y = ((xf - mu) * lax.rsqrt(var + EPS)).reshape(shp)
    return (y * g + b).astype(x.dtype)


def conv_module(za, zg, hist, conv_w, conv_b, gn_g, gn_b, conv_pw):
    u = za * jax.nn.sigmoid(zg)
    ext = jnp.concatenate([hist.astype(u.dtype), u], axis=1)
    y = lax.conv_general_dilated(ext, conv_w[:, None, :], window_strides=(1,), padding='VALID',
                                 dimension_numbers=('NWC', 'WIO', 'NWC'),
                                 feature_group_count=D_CONV) + conv_b
    y = jax.nn.silu(group_norm(y, gn_g, gn_b, CONV_GROUPS)) @ conv_pw
    return y, ext[:, -(CONV_W - 1):]


def band_attn_prompt(q, k, v, rel_bias):
    B, T, H, Dh = q.shape
    nc = T // CHUNK
    qc = q.reshape(B, nc, CHUNK, H, Dh)
    pad = jnp.zeros((B, BAND_PAST, H, Dh), k.dtype)
    kp = jnp.concatenate([pad, k], axis=1).reshape(B, nc + BAND_CHUNKS, CHUNK, H, Dh)
    vp = jnp.concatenate([pad, v], axis=1).reshape(B, nc + BAND_CHUNKS, CHUNK, H, Dh)
    idx = jnp.arange(nc)[:, None] + jnp.arange(BAND_CHUNKS + 1)[None, :]
    kb = kp[:, idx].reshape(B, nc, BAND_LEN, H, Dh)
    vb = vp[:, idx].reshape(B, nc, BAND_LEN, H, Dh)
    j = jnp.arange(BAND_LEN)
    i = jnp.arange(CHUNK)
    rel = jnp.clip(j[None, :] - BAND_PAST - i[:, None], -REL_CLIP, REL_CLIP) + REL_CLIP
    bias = rel_bias[:, rel].astype(jnp.float32)
    valid = j[None, :] >= (BAND_CHUNKS - jnp.arange(nc))[:, None] * CHUNK
    s = jnp.einsum('bnqhd,bnkhd->bnhqk', qc, kb, preferred_element_type=jnp.float32) * (Dh ** -0.5) + bias
    s = jnp.where(valid[None, :, None, None, :], s, NEG_INF)
    p = jax.nn.softmax(s, axis=-1).astype(v.dtype)
    o = jnp.einsum('bnhqk,bnkhd->bnqhd', p, vb)
    return o.reshape(B, T, H * Dh)


def band_attn_sample(q, k, v, k_cache, v_cache, rel_bias):
    B, T, H, Dh = q.shape
    L = k_cache.shape[1]
    kk = jnp.concatenate([k_cache.astype(k.dtype), k], axis=1)
    vv = jnp.concatenate([v_cache.astype(v.dtype), v], axis=1)
    kpos = jnp.arange(L + T) - L
    rel = jnp.clip(kpos[None, :] - jnp.arange(T)[:, None], -REL_CLIP, REL_CLIP) + REL_CLIP
    bias = rel_bias[:, rel].astype(jnp.float32)
    s = jnp.einsum('bqhd,bkhd->bhqk', q, kk, preferred_element_type=jnp.float32) * (Dh ** -0.5) + bias
    p = jax.nn.softmax(s, axis=-1).astype(v.dtype)
    o = jnp.einsum('bhqk,bkhd->bqhd', p, vv)
    return o.reshape(B, T, H * Dh)


def pool_mixer(p, hist, pos0, pool_w, pool_scale):
    B, T, C = p.shape
    ext = jnp.concatenate([hist.astype(p.dtype), p], axis=1)
    extf = ext.astype(jnp.float32)
    cs = jnp.concatenate([jnp.zeros((B, 1, C), jnp.float32), lax.cumsum(extf, axis=1)], axis=1)
    pos = pos0 + jnp.arange(T)
    outs = []
    for gi, w in enumerate(POOL_WINDOWS):
        sl = slice(gi * POOL_GROUP, (gi + 1) * POOL_GROUP)
        win = cs[:, POOL_HIST + 1:POOL_HIST + 1 + T, sl] - cs[:, POOL_HIST + 1 - w:POOL_HIST + 1 - w + T, sl]
        cnt = jnp.minimum(w, pos + 1).astype(jnp.float32)[None, :, None]
        outs.append(win / cnt - extf[:, POOL_HIST:, sl])
    m = jnp.concatenate(outs, axis=-1).reshape(B, T, len(POOL_WINDOWS), POOL_GROUP).astype(p.dtype)
    y = jnp.einsum('btgc,gcd->btgd', m, pool_w).reshape(B, T, C) * pool_scale
    return y, ext[:, -POOL_HIST:]


def spatial_gating(u, v, ln_g, ln_b, sg_w, sg_b):
    B, T, C = v.shape
    vn = group_norm(v, ln_g, ln_b, 1)
    L = min(T, SG_CHUNK)
    n = T // L
    vc = vn.reshape(B, n, L, SG_GROUPS, SG_GROUP)
    w = sg_w[:, :L, :L] * jnp.tril(jnp.ones((L, L), sg_w.dtype))
    s = jnp.einsum('gij,bnjgc->bnigc', w, vc) + sg_b[:, :L].T[None, None, :, :, None]
    return u * s.reshape(B, T, C), vn


def trunk_layer(x, c, lp, conv_hist, pool_hist, k_cache, v_cache, pos0):
    (ada_w, ada_b, n1, n2, w_in, conv_w, conv_b, gn_g, gn_b, conv_pw, rel_bias,
     pool_w, pool_scale, sg_g, sg_bn, sg_w, sg_b, w_out, wg, wu, wd) = lp
    B, T, _ = x.shape
    mod = (jax.nn.silu(c) @ ada_w + ada_b)[:, None, :]
    sh1, sc1, g1, sh2, sc2, g2 = jnp.split(mod, 6, axis=-1)
    h = rms_norm(x, n1) * (1 + sc1) + sh1
    z = h @ w_in
    za, zg, zq, zk, zv, zp, zu, zs = jnp.split(z, IN_SPLITS, axis=-1)
    if conv_hist is None:
        conv_hist = jnp.zeros((B, CONV_W - 1, D_CONV), x.dtype)
        pool_hist = jnp.zeros((B, POOL_HIST, D_POOL), x.dtype)
    ya, conv_state = conv_module(za, zg, conv_hist, conv_w, conv_b, gn_g, gn_b, conv_pw)
    q = zq.reshape(B, T, N_HEADS, HEAD_DIM)
    k = zk.reshape(B, T, N_HEADS, HEAD_DIM)
    v = zv.reshape(B, T, N_HEADS, HEAD_DIM)
    if k_cache is None:
        yb = band_attn_prompt(q, k, v, rel_bias)
        k_rows, v_rows = k[:, -BAND_PAST:], v[:, -BAND_PAST:]
    else:
        yb = band_attn_sample(q, k, v, k_cache, v_cache, rel_bias)
        k_rows, v_rows = k, v
    yc, pool_state = pool_mixer(zp, pool_hist, pos0, pool_w, pool_scale)
    yd, sg_v = spatial_gating(zu, zs, sg_g, sg_bn, sg_w, sg_b)
    mix = jnp.concatenate([ya, yb, yc, yd], axis=-1) @ w_out
    x = x + g1 * mix
    h2 = rms_norm(x, n2) * (1 + sc2) + sh2
    x = x + g2 * ((jax.nn.silu(h2 @ wg) * (h2 @ wu)) @ wd)
    return x, (conv_state, k_rows, v_rows, pool_state, sg_v)


def setup_inputs(seed: int = 0) -> dict:
    key = jax.random.key(seed)
    ks = iter(jax.random.split(key, 40))

    def nrm(shape, s):
        return jax.random.normal(next(ks), shape, jnp.float32) * s

    kv_len = min(BAND_PAST, PAST_LEN)
    return {
        'x_prompt': nrm((BATCH, SEQ, D_MODEL), 1.0),
        'x_sample': nrm((DEC_BATCH, DEC_SEQ, D_MODEL), 1.0),
        'c_prompt': nrm((BATCH, D_MODEL), 1.0),
        'c_sample': nrm((DEC_BATCH, D_MODEL), 1.0),
        'cache_conv': nrm((DEPTH, DEC_BATCH, CONV_W - 1, D_CONV), 0.5),
        'cache_k': nrm((DEPTH, DEC_BATCH, kv_len, N_HEADS, HEAD_DIM), 1.0),
        'cache_v': nrm((DEPTH, DEC_BATCH, kv_len, N_HEADS, HEAD_DIM), 1.0),
        'cache_pool': nrm((DEPTH, DEC_BATCH, POOL_HIST, D_POOL), 1.0),
        'ada_w': nrm((DEPTH, D_MODEL, 6 * D_MODEL), 0.5 * D_MODEL ** -0.5),
        'ada_b': nrm((DEPTH, 6 * D_MODEL), 0.02),
        'norm1_g': 1.0 + nrm((DEPTH, D_MODEL), 0.02),
        'norm2_g': 1.0 + nrm((DEPTH, D_MODEL), 0.02),
        'w_in': nrm((DEPTH, D_MODEL, D_IN), D_MODEL ** -0.5),
        'conv_w': nrm((DEPTH, CONV_W, D_CONV), CONV_W ** -0.5),
        'conv_b': nrm((DEPTH, D_CONV), 0.02),
        'conv_gn_g': 1.0 + nrm((DEPTH, D_CONV), 0.02),
        'conv_gn_b': nrm((DEPTH, D_CONV), 0.02),
        'conv_pw': nrm((DEPTH, D_CONV, D_CONV), D_CONV ** -0.5),
        'rel_bias': nrm((DEPTH, N_HEADS, 2 * REL_CLIP + 1), 0.5),
        'pool_w': nrm((DEPTH, len(POOL_WINDOWS), POOL_GROUP, POOL_GROUP), POOL_GROUP ** -0.5),
        'pool_scale': 1.0 + nrm((DEPTH, D_POOL), 0.1),
        'sg_ln_g': 1.0 + nrm((DEPTH, D_SG), 0.02),
        'sg_ln_b': nrm((DEPTH, D_SG), 0.02),
        'sg_w': nrm((DEPTH, SG_GROUPS, SG_CHUNK, SG_CHUNK), 0.5 * SG_CHUNK ** -0.5),
        'sg_b': 1.0 + nrm((DEPTH, SG_GROUPS, SG_CHUNK), 0.1),
        'w_out': nrm((DEPTH, D_MIX, D_MODEL), D_MIX ** -0.5),
        'ffn_gate': nrm((DEPTH, D_MODEL, D_FF), D_MODEL ** -0.5),
        'ffn_up': nrm((DEPTH, D_MODEL, D_FF), D_MODEL ** -0.5),
        'ffn_down': nrm((DEPTH, D_FF, D_MODEL), D_FF ** -0.5),
        'final_g': 1.0 + nrm((D_MODEL,), 0.02),
    }


def reference(x_prompt, x_sample, c_prompt, c_sample, cache_conv, cache_k, cache_v, cache_pool,
              ada_w, ada_b, norm1_g, norm2_g, w_in, conv_w, conv_b, conv_gn_g, conv_gn_b, conv_pw,
              rel_bias, pool_w, pool_scale, sg_ln_g, sg_ln_b, sg_w, sg_b, w_out,
              ffn_gate, ffn_up, ffn_down, final_g):
    xp, xs = x_prompt, x_sample
    conv_p, conv_s, kp_l, vp_l, ks_l, vs_l, pool_p, pool_s, sgv_s = [], [], [], [], [], [], [], [], []
    for l in range(DEPTH):
        lp = (ada_w[l], ada_b[l], norm1_g[l], norm2_g[l], w_in[l], conv_w[l], conv_b[l],
              conv_gn_g[l], conv_gn_b[l], conv_pw[l], rel_bias[l], pool_w[l], pool_scale[l],
              sg_ln_g[l], sg_ln_b[l], sg_w[l], sg_b[l], w_out[l], ffn_gate[l], ffn_up[l], ffn_down[l])
        xp, (cp, kr, vr, pp, _) = trunk_layer(xp, c_prompt, lp, None, None, None, None, 0)
        xs, (cs_, ksr, vsr, ps, sgv) = trunk_layer(xs, c_sample, lp, cache_conv[l], cache_pool[l],
                                                   cache_k[l], cache_v[l], PAST_LEN)
        conv_p.append(cp)
        kp_l.append(kr)
        vp_l.append(vr)
        pool_p.append(pp)
        conv_s.append(cs_)
        ks_l.append(ksr)
        vs_l.append(vsr)
        pool_s.append(ps)
        sgv_s.append(sgv)
    y_prompt = rms_norm(xp, final_g)
    y_sample = rms_norm(xs, final_g)
    return (y_prompt, y_sample,
            jnp.stack(conv_p), jnp.stack(conv_s),
            jnp.stack(kp_l), jnp.stack(vp_l), jnp.stack(ks_l), jnp.stack(vs_l),
            jnp.stack(pool_p), jnp.stack(pool_s), jnp.stack(sgv_s))
```

```cpp
#include <hip/hip_runtime.h>
#include <cstdio>
#include <cstdint>

#ifndef MK_ONE_LAUNCH
#define MK_ONE_LAUNCH 0
#endif

constexpr int DM = 2048, SEQ = 8192, NBP = 4, MP = NBP * SEQ, NBS = 8, TS = 32, MS = NBS * TS, MT = MP + MS, NPANEL = MT / 256;
constexpr int DIN = 4096, DFF = 5632, DC = 512, NL = 4, NMOD = 6 * DM, NBT = NBP + NBS;
constexpr int ZW = 3584, ZU = 0, ZQ = 512, ZK = 1024, ZV = 1536, ZP = 2048, ZSU = 2560, ZSV = 3072;
constexpr int MIXW = 2048, MIX_A = 0, MIX_B = 512, MIX_C = 1024, MIX_D = 1536;
constexpr float EPS = 1e-6f, LOG2E = 1.4426950408889634f, QSCALE = 0.125f * LOG2E;
constexpr int KSPLIT = 16;
constexpr size_t O_YP = 0, O_YS = O_YP + (size_t)MP * DM, O_CONVP = O_YS + (size_t)MS * DM, O_CONVS = O_CONVP + (size_t)NL * NBP * 30 * DC,
    O_KP = O_CONVS + (size_t)NL * NBS * 30 * DC, O_VP = O_KP + (size_t)NL * NBP * 512 * 512, O_KS = O_VP + (size_t)NL * NBP * 512 * 512,
    O_VS = O_KS + (size_t)NL * NBS * TS * 512, O_POOLP = O_VS + (size_t)NL * NBS * TS * 512, O_POOLS = O_POOLP + (size_t)NL * NBP * 15 * DC,
    O_SGV = O_POOLS + (size_t)NL * NBS * 15 * DC, O_END = O_SGV + (size_t)NL * NBS * TS * DC;
static_assert(O_END == 78700544, "output size");
enum { I_XP = 0, I_XS, I_CP, I_CS, I_CCONV, I_CK, I_CV, I_CPOOL, I_ADAW, I_ADAB, I_N1, I_N2, I_WIN, I_CONVW, I_CONVB, I_GNG, I_GNB, I_CPW, I_RELB,
       I_POOLW, I_POOLS, I_SGG, I_SGB, I_SGW, I_SGBIAS, I_WOUT, I_WG, I_WU, I_WD, I_FING, N_IN };
static_assert(N_IN == 30, "30 inputs");

constexpr size_t MiB = 1u << 20;
constexpr size_t WS_CTL = 0, CTL_ZERO_BYTES = 1 * MiB;
constexpr size_t WS_MOD = 1 * MiB;
constexpr size_t WS_MODP = 4 * MiB;
constexpr size_t WS_W = 40 * MiB;
constexpr size_t LW_WIN = 0, LW_WOUT = 16 * MiB, LW_WGU = 24 * MiB, LW_WD = 68 * MiB, LW_CPW = 90 * MiB, LW_PWD = LW_CPW + 512 * 1024, LW_SGW = 91 * MiB, LW = 91 * MiB + 256 * 1024;
constexpr size_t WS_H = WS_W + NL * LW;
constexpr size_t WS_Z = WS_H + (size_t)MT * DM * 2;
constexpr size_t WS_MIX = WS_Z + (size_t)MT * ZW * 2;
constexpr size_t WS_HID = WS_Z;
constexpr size_t WS_CAPM = WS_MIX + (size_t)MT * MIXW * 2;
constexpr size_t WS_END = WS_CAPM + (size_t)2 * MT * DC * 2;
static_assert(WS_HID + (size_t)MT * DFF * 2 <= WS_CAPM, "HID overlay");
static_assert((size_t)NL * 12 * NMOD * 4 <= 3 * MiB && (size_t)KSPLIT * NL * 12 * NMOD * 4 <= 36 * MiB, "mod buffers");
constexpr int CW_BAR = 4096;

constexpr int RING_BYTES = 131072;
constexpr int LDSCTL_OFF = RING_BYTES, MISC_OFF = LDSCTL_OFF + 320;
constexpr int LDS_BYTES = 147456;
constexpr int NWAVES = 8;

#define GAS __attribute__((address_space(1)))
#define LAS __attribute__((address_space(3)))
typedef unsigned short bf16;
typedef unsigned v4u __attribute__((ext_vector_type(4)));
typedef unsigned v2u __attribute__((ext_vector_type(2)));
typedef float f32x4 __attribute__((ext_vector_type(4)));
typedef float f32x2 __attribute__((ext_vector_type(2)));
typedef float f32x16 __attribute__((ext_vector_type(16)));
typedef short bf16x8 __attribute__((ext_vector_type(8)));
typedef __bf16 bf16x2_t __attribute__((ext_vector_type(2)));
typedef GAS unsigned gu32;
#define RLX_AGENT __ATOMIC_RELAXED, __HIP_MEMORY_SCOPE_AGENT
#define LDS_WAIT() asm volatile("s_waitcnt lgkmcnt(0)" ::: "memory")
#define VM_WAIT() asm volatile("s_waitcnt vmcnt(0)" ::: "memory")

__device__ __forceinline__ unsigned pk2(float lo, float hi) { f32x2 v = {lo, hi}; bf16x2_t b = __builtin_convertvector(v, bf16x2_t); return __builtin_bit_cast(unsigned, b); }
__device__ __forceinline__ float bflo(unsigned u) { return __uint_as_float(u << 16); }
__device__ __forceinline__ float bfhi(unsigned u) { return __uint_as_float(u & 0xffff0000u); }
__device__ __forceinline__ float bf2f(bf16 h) { return __uint_as_float((unsigned)h << 16); }
__device__ __forceinline__ float fast_exp2(float x) { return __builtin_amdgcn_exp2f(x); }
__device__ __forceinline__ float fast_rcp(float x) { return __builtin_amdgcn_rcpf(x); }
__device__ __forceinline__ float sigmoidf_(float x) { return fast_rcp(1.0f + fast_exp2(-x * LOG2E)); }
__device__ __forceinline__ float siluf_(float x) { return x * sigmoidf_(x); }
__device__ __forceinline__ float wave_sum(float v) {
#pragma unroll
    for (int o = 1; o < 64; o <<= 1) v += __shfl_xor(v, o);
    return v;
}
__device__ __forceinline__ int batch_of_row(int row) { return row < MP ? (row >> 13) : NBP + ((row - MP) >> 5); }

namespace pg8 {
#define PG8_LAS __attribute__((address_space(3)))
typedef unsigned short bf16_t;
typedef short bf16x8 __attribute__((ext_vector_type(8)));
typedef float f32x4 __attribute__((ext_vector_type(4)));
typedef unsigned u32x4 __attribute__((ext_vector_type(4)));
constexpr int BM = 256, BK = 64, HALF = 128, HTB = HALF * BK * 2  , STAGE_BYTES = 8 * HTB, NXCD = 8, WGM = 8;

__host__ __device__ __forceinline__ int lds_byte(int r, int c) { const int st = (r >> 4) * 2 + (c >> 5), rr = r & 15, cc = c & 31, ob = rr * 64 + cc * 2; return st * 1024 + (ob ^ (((ob >> 9) & 1) << 5)); }
__host__ __device__ __forceinline__ void stage_rc(int b, int& R, int& C) { const int st = b / 1024, sb = b % 1024, swz = sb ^ (((sb >> 9) & 1) << 5); R = (st >> 1) * 16 + swz / 64; C = (st & 1) * 32 + (swz % 64) / 2; }
__host__ __device__ __forceinline__ int perm32(int rho) { const int n = rho >> 4, i = rho & 15; return 8 * (i >> 2) + 4 * n + (i & 3); }

struct Unit { int pm, pn; };
struct Gemm { const bf16_t* A; const bf16_t* Bt; int M, N, K; };

struct StaticOrder {
    int nM, nN, nwg, G, c;
    __host__ __device__ void init(int M, int N, int G_, int c_) { nM = M / BM; nN = N / BM; nwg = nM * nN; G = G_; c = c_; }
    __host__ __device__ bool next(int i, Unit& u) const {
        const long L = (long)i * G + c; if (L >= nwg) return false;
        int wgid = (int)L; { const int q = nwg / NXCD, r = nwg % NXCD, xcd = wgid % NXCD, off = wgid / NXCD; wgid = (xcd < r ? xcd * (q + 1) : r * (q + 1) + (xcd - r) * q) + off; }
        const int nig = WGM * nN, gid = wgid / nig, fm = gid * WGM, gsz = (nM - fm) < WGM ? (nM - fm) : WGM;
        u.pm = fm + ((wgid % nig) % gsz); u.pn = (wgid % nig) / gsz; return true;
    }
    __device__ __forceinline__ void a_ready(const Unit&) const {}
    __device__ __forceinline__ void done(const Unit&) const {}
};
__device__ __forceinline__ unsigned cvt_pk_bf16(float lo, float hi) { return ::pk2(lo, hi); }
struct EpiZ {
    static constexpr bool PERM = true, AFTER_DRAIN = false;
    bf16_t* Z;
    __device__ __forceinline__ void operator()(const f32x4 (&acc)[2][2][4][2], const Unit& u, int wr, int wc, int fr, int fq) const {
        const int row0 = u.pm * BM + wr * 64 + fr;
        if (u.pn < 4) {
            const int col0 = 128 * u.pn + wc * 32 + 8 * fq;
#pragma unroll
            for (int ai = 0; ai < 2; ++ai)
#pragma unroll
                for (int m = 0; m < 4; ++m) { bf16_t* rowp = Z + (size_t)(row0 + ai * HALF + m * 16) * ::ZW + col0;
                    const f32x4 a0 = acc[ai][0][m][0], a1 = acc[ai][0][m][1], g0 = acc[ai][1][m][0], g1 = acc[ai][1][m][1];
                    u32x4 w; w.x = cvt_pk_bf16(a0[0] * ::sigmoidf_(g0[0]), a0[1] * ::sigmoidf_(g0[1])); w.y = cvt_pk_bf16(a0[2] * ::sigmoidf_(g0[2]), a0[3] * ::sigmoidf_(g0[3]));
                    w.z = cvt_pk_bf16(a1[0] * ::sigmoidf_(g1[0]), a1[1] * ::sigmoidf_(g1[1])); w.w = cvt_pk_bf16(a1[2] * ::sigmoidf_(g1[2]), a1[3] * ::sigmoidf_(g1[3]));
                    *(u32x4*)rowp = w; }
        } else {
            const float sc = (u.pn < 6) ? ::QSCALE : 1.0f;
            const int col0 = 512 + 256 * (u.pn - 4) + wc * 32 + 8 * fq;
#pragma unroll
            for (int ai = 0; ai < 2; ++ai)
#pragma unroll
                for (int m = 0; m < 4; ++m) { bf16_t* rowp = Z + (size_t)(row0 + ai * HALF + m * 16) * ::ZW + col0;
#pragma unroll
                    for (int bj = 0; bj < 2; ++bj) { const f32x4 v0 = acc[ai][bj][m][0] * sc, v1 = acc[ai][bj][m][1] * sc;
                        u32x4 w; w.x = cvt_pk_bf16(v0[0], v0[1]); w.y = cvt_pk_bf16(v0[2], v0[3]); w.z = cvt_pk_bf16(v1[0], v1[1]); w.w = cvt_pk_bf16(v1[2], v1[3]);
                        *(u32x4*)(rowp + bj * HALF) = w; } }
        }
    }
};
struct EpiMix2 {
    static constexpr bool PERM = true, AFTER_DRAIN = false;
    bf16_t* MIX;
    __device__ __forceinline__ void operator()(const f32x4 (&acc)[2][2][4][2], const Unit& u, int wr, int wc, int fr, int fq) const {
        const int which = u.pn >> 1, pm = u.pm - which * ::NPANEL;
        const int row0 = pm * BM + wr * 64 + fr, col0 = which * 1024 + (u.pn & 1) * 256 + wc * 32 + 8 * fq;
#pragma unroll
        for (int ai = 0; ai < 2; ++ai)
#pragma unroll
            for (int m = 0; m < 4; ++m) { bf16_t* rowp = MIX + (size_t)(row0 + ai * HALF + m * 16) * ::MIXW + col0;
#pragma unroll
                for (int bj = 0; bj < 2; ++bj) { const f32x4 v0 = acc[ai][bj][m][0], v1 = acc[ai][bj][m][1];
                    u32x4 w; w.x = cvt_pk_bf16(v0[0], v0[1]); w.y = cvt_pk_bf16(v0[2], v0[3]); w.z = cvt_pk_bf16(v1[0], v1[1]); w.w = cvt_pk_bf16(v1[2], v1[3]);
                    *(u32x4*)(rowp + bj * HALF) = w; } }
    }
};
struct EpiRes {
    static constexpr bool PERM = false, AFTER_DRAIN = false;
    float* X; const float* gate;
    __device__ __forceinline__ void operator()(const f32x4 (&acc)[2][2][4][2], const Unit& u, int wr, int wc, int fr, int fq) const {
        const int col0 = u.pn * BM + wc * 32 + 4 * fq;
#pragma unroll
        for (int ai = 0; ai < 2; ++ai)
#pragma unroll
            for (int m = 0; m < 4; ++m) { const int row = u.pm * BM + ai * HALF + wr * 64 + m * 16 + fr;
                const float* gp = gate + (size_t)::batch_of_row(row) * ::NMOD + col0; float* xp = X + (size_t)row * ::DM + col0;
#pragma unroll
                for (int bj = 0; bj < 2; ++bj)
#pragma unroll
                    for (int n = 0; n < 2; ++n) { const f32x4 g = *(const f32x4*)(gp + bj * HALF + n * 16); f32x4 x = *(const f32x4*)(xp + bj * HALF + n * 16);
                        x = x + g * acc[ai][bj][m][n]; *(f32x4*)(xp + bj * HALF + n * 16) = x; } }
    }
};
struct EpiSwi {
    static constexpr bool PERM = true, AFTER_DRAIN = false;
    bf16_t* HID;
    __device__ __forceinline__ void operator()(const f32x4 (&acc)[2][2][4][2], const Unit& u, int wr, int wc, int fr, int fq) const {
        const int row0 = u.pm * BM + wr * 64 + fr, col0 = 128 * u.pn + wc * 32 + 8 * fq;
#pragma unroll
        for (int ai = 0; ai < 2; ++ai)
#pragma unroll
            for (int m = 0; m < 4; ++m) { bf16_t* rowp = HID + (size_t)(row0 + ai * HALF + m * 16) * ::DFF + col0;
                const f32x4 g0 = acc[ai][0][m][0], g1 = acc[ai][0][m][1], u0 = acc[ai][1][m][0], u1 = acc[ai][1][m][1];
                u32x4 w; w.x = cvt_pk_bf16(::siluf_(g0[0]) * u0[0], ::siluf_(g0[1]) * u0[1]); w.y = cvt_pk_bf16(::siluf_(g0[2]) * u0[2], ::siluf_(g0[3]) * u0[3]);
                w.z = cvt_pk_bf16(::siluf_(g1[0]) * u1[0], ::siluf_(g1[1]) * u1[1]); w.w = cvt_pk_bf16(::siluf_(g1[2]) * u1[2], ::siluf_(g1[3]) * u1[3]);
                *(u32x4*)rowp = w; }
    }
};
struct Mix2Order {
    int G, c;
    __device__ __forceinline__ bool next(int i, Unit& u) const {
        const int L = i * G + c; if (L >= 4 * ::NPANEL) return false;
        const int which = L / (2 * ::NPANEL), rem = L % (2 * ::NPANEL);
        u.pm = which * ::NPANEL + (rem >> 1); u.pn = which * 2 + (rem & 1); return true;
    }
    __device__ __forceinline__ void a_ready(const Unit&) const {}
    __device__ __forceinline__ void done(const Unit&) const {}
};

template <class Epi, class Sched, bool ALIGN_EPI = false, bool SP2 = false>
__device__ __forceinline__ void gemm_phase(PG8_LAS unsigned char* lds, const Gemm g, const Sched& S, const Epi& E) {
    int tid_ = threadIdx.x; asm volatile("" : "+v"(tid_));
    const int tid = tid_, wid = __builtin_amdgcn_readfirstlane(tid >> 6), lane = tid & 63, wr = wid >> 2, wc = wid & 3, fr = lane & 15, fq = lane >> 4;
    const int K = g.K, nt = K / BK;
    unsigned voffA[2], voffB[2];
#pragma unroll
    for (int i = 0; i < 2; ++i) { int R, C; stage_rc(tid * 16 + i * 8192, R, C); const int Rb = Epi::PERM ? ((R & ~31) + perm32(R & 31)) : R;
        voffA[i] = (unsigned)(R * K + C) * 2u; voffB[i] = (unsigned)(Rb * K + C) * 2u; }
    const size_t kstep = (size_t)(BK * 2);
    const size_t hstep = (size_t)HALF * K * 2;
    const size_t tstep = 2 * hstep;
    const unsigned ldsw = (unsigned)wid * 1024u;
    const int aoff = lds_byte(wr * 64 + fr, fq * 8), boff = lds_byte(wc * 32 + fr, fq * 8);
#define PG8_SA(b, h) (((b) * 2 + (h)) * HTB)
#define PG8_SB(b, h) ((4 + (b) * 2 + (h)) * HTB)
#define PG8_STAGE(bufoff, gbase, voff) do { _Pragma("unroll") for (int _i = 0; _i < 2; ++_i) \
        __builtin_amdgcn_global_load_lds((const unsigned*)((const char*)(gbase) + (voff)[_i]), (PG8_LAS unsigned*)(lds + (bufoff) + ldsw + _i * 8192), 16, 0, 0); } while (0)
#define PG8_LDA(dst, b, h) do { _Pragma("unroll") for (int m = 0; m < 4; ++m) _Pragma("unroll") for (int k = 0; k < 2; ++k) dst[m][k] = *(const PG8_LAS bf16x8*)(lds + PG8_SA(b, h) + aoff + m * 2048 + k * 1024); } while (0)
#define PG8_LDB(dst, b, h) do { _Pragma("unroll") for (int n = 0; n < 2; ++n) _Pragma("unroll") for (int k = 0; k < 2; ++k) dst[n][k] = *(const PG8_LAS bf16x8*)(lds + PG8_SB(b, h) + boff + n * 2048 + k * 1024); } while (0)
#define PG8_MMA(ai, bj, At, Bt) do { __builtin_amdgcn_s_setprio(1); _Pragma("unroll") for (int m = 0; m < 4; ++m) _Pragma("unroll") for (int n = 0; n < 2; ++n) _Pragma("unroll") for (int k = 0; k < 2; ++k) \
        acc[ai][bj][m][n] = __builtin_amdgcn_mfma_f32_16x16x32_bf16(Bt[n][k], At[m][k], acc[ai][bj][m][n], 0, 0, 0); __builtin_amdgcn_s_setprio(0); } while (0)
#define PG8_WAIT_V(n) asm volatile("s_waitcnt vmcnt(" #n ")" ::: "memory")
#define PG8_WAIT_L(n) asm volatile("s_waitcnt lgkmcnt(" #n ")" ::: "memory")
#define PG8_BAR __builtin_amdgcn_s_barrier()
#define PG8_SCHED __builtin_amdgcn_sched_barrier(0)
    Unit cur, nxt; int ui = 0;
    if (!S.next(0, cur)) return;
    f32x4 acc[2][2][4][2];
#pragma unroll
    for (int a = 0; a < 2; ++a)
#pragma unroll
        for (int b = 0; b < 2; ++b)
#pragma unroll
            for (int m = 0; m < 4; ++m)
#pragma unroll
                for (int n = 0; n < 2; ++n) acc[a][b][m][n] = (f32x4){0.f, 0.f, 0.f, 0.f};
    bf16x8 At[4][2], B0[2][2], B1[2][2];
    const char* cA = (const char*)g.A + (size_t)cur.pm * tstep; const char* cB = (const char*)g.Bt + (size_t)cur.pn * tstep;
    S.a_ready(cur);
    if constexpr (SP2) {
        PG8_STAGE(PG8_SB(0, 0), cB, voffB); PG8_STAGE(PG8_SB(0, 1), cB + hstep, voffB); PG8_STAGE(PG8_SA(0, 0), cA, voffA); PG8_STAGE(PG8_SA(0, 1), cA + hstep, voffA);
        if (wr == 1) PG8_BAR;
        PG8_WAIT_V(2); PG8_BAR;
        PG8_STAGE(PG8_SB(1, 0), cB + kstep, voffB); PG8_STAGE(PG8_SA(1, 0), cA + kstep, voffA); PG8_STAGE(PG8_SB(1, 1), cB + hstep + kstep, voffB);
        PG8_WAIT_V(6); PG8_BAR;
    } else {
        PG8_STAGE(PG8_SB(0, 0), cB, voffB); PG8_STAGE(PG8_SA(0, 0), cA, voffA); PG8_STAGE(PG8_SB(0, 1), cB + hstep, voffB); PG8_STAGE(PG8_SA(0, 1), cA + hstep, voffA);
        if (wr == 1) PG8_BAR;
        PG8_WAIT_V(4); PG8_BAR;
        PG8_STAGE(PG8_SB(1, 0), cB + kstep, voffB); PG8_STAGE(PG8_SA(1, 0), cA + kstep, voffA); PG8_STAGE(PG8_SB(1, 1), cB + hstep + kstep, voffB);
        PG8_WAIT_V(6); PG8_BAR;
    }
    for (;;) {
        const bool has_next = S.next(ui + 1, nxt);
        const char* nA = has_next ? (const char*)g.A + (size_t)nxt.pm * tstep : cA; const char* nB = has_next ? (const char*)g.Bt + (size_t)nxt.pn * tstep : cB;
        for (int t = 0; t < nt; t += 2) {
            const bool last = (t == nt - 2);
            const char* a1 = cA + (size_t)(t + 1) * kstep;
            const char* a2 = last ? nA : cA + (size_t)(t + 2) * kstep; const char* b2 = last ? nB : cB + (size_t)(t + 2) * kstep;
            const char* a3 = a2 + kstep; const char* b3 = b2 + kstep;
            if (last && has_next) S.a_ready(nxt);
            if constexpr (SP2) {
            PG8_LDB(B0, 0, 0); PG8_LDB(B1, 0, 1); PG8_SCHED; PG8_LDA(At, 0, 0); PG8_STAGE(PG8_SA(1, 1), a1 + hstep, voffA);
            PG8_WAIT_V(8); PG8_WAIT_L(0); PG8_BAR; PG8_MMA(0, 0, At, B0); PG8_MMA(0, 1, At, B1); PG8_BAR; PG8_SCHED;
            PG8_LDA(At, 0, 1); PG8_STAGE(PG8_SB(0, 0), b2, voffB); PG8_STAGE(PG8_SB(0, 1), b2 + hstep, voffB); PG8_STAGE(PG8_SA(0, 0), a2, voffA);
            PG8_WAIT_V(8); PG8_WAIT_L(0); PG8_BAR; PG8_MMA(1, 0, At, B0); PG8_MMA(1, 1, At, B1); PG8_BAR; PG8_SCHED;
            PG8_LDB(B0, 1, 0); PG8_LDB(B1, 1, 1); PG8_SCHED; PG8_LDA(At, 1, 0); PG8_STAGE(PG8_SA(0, 1), a2 + hstep, voffA);
            PG8_WAIT_V(8); PG8_WAIT_L(0); PG8_BAR; PG8_MMA(0, 0, At, B0); PG8_MMA(0, 1, At, B1); PG8_BAR; PG8_SCHED;
            PG8_LDA(At, 1, 1); PG8_STAGE(PG8_SB(1, 0), b3, voffB); PG8_STAGE(PG8_SB(1, 1), b3 + hstep, voffB); PG8_STAGE(PG8_SA(1, 0), a3, voffA);
            PG8_WAIT_V(8); PG8_WAIT_L(0); PG8_BAR; PG8_MMA(1, 0, At, B0); PG8_MMA(1, 1, At, B1); PG8_BAR; PG8_SCHED;
            } else {
            PG8_LDB(B0, 0, 0); PG8_SCHED; PG8_LDA(At, 0, 0); PG8_STAGE(PG8_SA(1, 1), a1 + hstep, voffA);
            PG8_WAIT_L(8); PG8_BAR; PG8_WAIT_L(0); PG8_MMA(0, 0, At, B0); PG8_BAR; PG8_SCHED;
            PG8_LDB(B1, 0, 1); PG8_STAGE(PG8_SB(0, 0), b2, voffB);
            PG8_BAR; PG8_WAIT_L(0); PG8_MMA(0, 1, At, B1); PG8_BAR;
            PG8_LDA(At, 0, 1); PG8_STAGE(PG8_SA(0, 0), a2, voffA);
            PG8_BAR; PG8_WAIT_L(0); PG8_MMA(1, 0, At, B0); PG8_BAR; PG8_SCHED;
            PG8_STAGE(PG8_SB(0, 1), b2 + hstep, voffB);
            PG8_WAIT_V(6); PG8_BAR; PG8_MMA(1, 1, At, B1); PG8_BAR;
            PG8_LDB(B0, 1, 0); PG8_SCHED; PG8_LDA(At, 1, 0); PG8_STAGE(PG8_SA(0, 1), a2 + hstep, voffA);
            PG8_WAIT_L(8); PG8_BAR; PG8_WAIT_L(0); PG8_MMA(0, 0, At, B0); PG8_BAR; PG8_SCHED;
            PG8_LDB(B1, 1, 1); PG8_STAGE(PG8_SB(1, 0), b3, voffB);
            PG8_BAR; PG8_WAIT_L(0); PG8_MMA(0, 1, At, B1); PG8_BAR;
            PG8_LDA(At, 1, 1); PG8_STAGE(PG8_SA(1, 0), a3, voffA);
            PG8_BAR; PG8_WAIT_L(0); PG8_MMA(1, 0, At, B0); PG8_BAR; PG8_SCHED;
            PG8_STAGE(PG8_SB(1, 1), b3 + hstep, voffB);
            PG8_WAIT_V(6); PG8_BAR; PG8_MMA(1, 1, At, B1); PG8_BAR;
            }
        }
        if constexpr (ALIGN_EPI) { if (wr == 0) PG8_BAR; }
        if constexpr (!Epi::AFTER_DRAIN) { E(acc, cur, wr, wc, fr, fq); S.done(cur); }
        if (!has_next) break;
#pragma unroll
        for (int a = 0; a < 2; ++a)
#pragma unroll
            for (int b = 0; b < 2; ++b)
#pragma unroll
                for (int m = 0; m < 4; ++m)
#pragma unroll
                    for (int n = 0; n < 2; ++n) acc[a][b][m][n] = (f32x4){0.f, 0.f, 0.f, 0.f};
        cur = nxt; cA = nA; cB = nB; ++ui;
        if constexpr (ALIGN_EPI) { if (wr == 1) PG8_BAR; }
    }
    PG8_WAIT_V(0);
    if constexpr (!ALIGN_EPI) { if (wr == 0) PG8_BAR; }
    PG8_BAR;
    if constexpr (Epi::AFTER_DRAIN) { E.fused(acc, cur, wr, wc, fr, fq, lds, wid, lane); S.done(cur); }
#undef PG8_SA
#undef PG8_SB
#undef PG8_STAGE
#undef PG8_LDA
#undef PG8_LDB
#undef PG8_MMA
#undef PG8_WAIT_V
#undef PG8_WAIT_L
#undef PG8_BAR
#undef PG8_SCHED
}
}
#define XB_TMO      128
#define XB_XCNT(j)  (256  + 64 * (j))
#define XB_XSUB(j)  (1280 + 64 * (j))
#define XB_XGEN(j)  (2304 + 64 * (j))
#define XB_TOP      3328
#define XB_TOPGEN   3392
#define XCD_BAR_WORDS 3456
#define XB_SPIN_CAP (1u << 18)

__device__ __forceinline__ unsigned xb_ld(unsigned* p)              { return __hip_atomic_load(p, __ATOMIC_RELAXED, __HIP_MEMORY_SCOPE_AGENT); }
__device__ __forceinline__ unsigned xb_add(unsigned* p, unsigned v) { return __hip_atomic_fetch_add(p, v, __ATOMIC_RELAXED, __HIP_MEMORY_SCOPE_AGENT); }
__device__ __forceinline__ unsigned xb_xcc_id() { return (unsigned)__builtin_amdgcn_s_getreg((3 << 11) | 20) & 0xFu; }
#define XB_SPIN(cond, bar) do { unsigned _sp = 0; while (cond) { __builtin_amdgcn_s_sleep(1); \
    if ((++_sp & 255u) == 0u) { if (xb_ld(&(bar)[XB_TMO])) break; if (_sp > XB_SPIN_CAP) { atomicAdd(&(bar)[XB_TMO], 1u); break; } } } } while (0)

struct XcdBarrier {
    unsigned* bar; unsigned x;
    volatile LAS unsigned* st;
};

__device__ __forceinline__ XcdBarrier xcd_barrier_post(unsigned* bar, volatile LAS unsigned* st) {
    XcdBarrier b; b.bar = bar; b.x = xb_xcc_id(); b.st = st;
    if (threadIdx.x == 0) (void)xb_add(&bar[XB_XCNT(b.x)], 1u);
    return b;
}
__device__ __forceinline__ void xcd_barrier_complete(unsigned* bar, unsigned x, unsigned& nloc, unsigned& nx) {
    const unsigned G = gridDim.x * gridDim.y * gridDim.z;
    unsigned sum, cnt, mine, sp = 0u;
    for (;;) {
        sum = 0u; cnt = 0u; mine = 0u;
#pragma unroll
        for (unsigned j = 0; j < 16; ++j) { const unsigned c = xb_ld(&bar[XB_XCNT(j)]); sum += c; cnt += (c > 0u) ? 1u : 0u; mine = (j == x) ? c : mine; }
        if (sum == G) break;
        __builtin_amdgcn_s_sleep(1);
        if ((++sp & 255u) == 0u) { if (xb_ld(&bar[XB_TMO])) break; if (sp > XB_SPIN_CAP) { atomicAdd(&bar[XB_TMO], 1u); break; } }
    }
    nloc = mine > 0u ? mine : 1u; nx = cnt > 0u ? cnt : 1u;
}

__device__ __forceinline__ void xcd_barrier(const XcdBarrier& b) {
    asm volatile("s_waitcnt vmcnt(0)" ::: "memory");
    __syncthreads();
    if (threadIdx.x == 0) {
        unsigned* bar = b.bar;
        __builtin_amdgcn_s_waitcnt(0);
        unsigned nloc = b.st[0], nx = b.st[1];
        if (nloc == 0u) { xcd_barrier_complete(bar, b.x, nloc, nx); b.st[0] = nloc; b.st[1] = nx; }
        const unsigned old = xb_add(&bar[XB_XSUB(b.x)], 1u);
        const unsigned gen = old / nloc;
        if (old + 1u == (gen + 1u) * nloc) {
            __builtin_amdgcn_fence(__ATOMIC_RELEASE, "agent");
            asm volatile("s_waitcnt vmcnt(0)" ::: "memory");
            const unsigned og = xb_add(&bar[XB_TOP], 1u);
            const unsigned tg = og / nx;
            if (og + 1u == (tg + 1u) * nx) xb_add(&bar[XB_TOPGEN], 1u);
            else XB_SPIN(xb_ld(&bar[XB_TOPGEN]) == tg, bar);
            __builtin_amdgcn_fence(__ATOMIC_ACQUIRE, "agent");
            xb_add(&bar[XB_XGEN(b.x)], 1u);
            asm volatile("s_waitcnt vmcnt(0)" ::: "memory");
        } else {
            XB_SPIN(xb_ld(&bar[XB_XGEN(b.x)]) == gen, bar);
            __builtin_amdgcn_fence(__ATOMIC_ACQUIRE, "agent");
            asm volatile("s_waitcnt vmcnt(0)" ::: "memory");
        }
    }
    __syncthreads();
}
struct Args { const float* in[N_IN]; float* out; unsigned char* ws; int ph_lo, ph_hi, pad0, pad1; };
static_assert(sizeof(Args) == (N_IN + 2) * 8 + 16, "Args has no padding");
struct DevArgs { const GAS float* in[N_IN]; GAS float* out; GAS unsigned char* ws; int ph_lo, ph_hi, pad0, pad1; };
static_assert(sizeof(DevArgs) == sizeof(Args), "DevArgs mirrors Args");
typedef const __attribute__((address_space(4))) DevArgs* KArgs;
#define INP(i) ((const float*)F.ka->in[i])
struct Frame {
    LAS unsigned char* lds;
    int tid, lane, wave, vcu, G;
    KArgs ka;
    float* out; unsigned char* ws;
};
__device__ __forceinline__ const float* modp(const Frame& F, int layer) { return (const float*)(F.ws + WS_MOD) + (size_t)layer * 12 * NMOD; }
__device__ __forceinline__ unsigned char* lw(const Frame& F, int layer) { return F.ws + WS_W + (size_t)layer * LW; }

__device__ __forceinline__ void transpose_item(const float* W, int K, int N, bf16* WT, int k0, int n0, int orow0, LAS float* scr, int lane) {
#pragma unroll 8
    for (int i = 0; i < 32; ++i) { const int kk = 2 * i + (lane >> 5); scr[kk * 33 + (lane & 31)] = W[(size_t)(k0 + kk) * N + n0 + (lane & 31)]; }
    LDS_WAIT(); asm volatile("" ::: "memory");
    const int c = lane & 7;
#pragma unroll
    for (int j = 0; j < 4; ++j) { const int n = (lane >> 3) + 8 * j; const LAS float* s = scr + (8 * c) * 33 + n;
        v4u o; o.x = pk2(s[0 * 33], s[1 * 33]); o.y = pk2(s[2 * 33], s[3 * 33]); o.z = pk2(s[4 * 33], s[5 * 33]); o.w = pk2(s[6 * 33], s[7 * 33]);
        *(GAS v4u*)(WT + (size_t)(orow0 + n) * K + k0 + 8 * c) = o; }
    LDS_WAIT(); asm volatile("" ::: "memory");
}
__device__ __forceinline__ void p0a_phase(Frame& F) {
    const int gw = F.vcu * NWAVES + F.wave, NGW = F.G * NWAVES, gt = F.vcu * (NWAVES * 64) + F.tid, NGT = F.G * NWAVES * 64;
    {
        LAS float* sil = (LAS float*)F.lds;
        for (int i = F.tid; i < 12 * DM; i += NWAVES * 64) { const int b = i / DM, k = i % DM;
            const float c = b < NBP ? INP(I_CP)[b * DM + k] : INP(I_CS)[(b - NBP) * DM + k]; sil[k * 12 + b] = siluf_(c); }
        __syncthreads();
        constexpr int KC = DM / KSPLIT, NCB = NMOD / 256;
        float* part = (float*)(F.ws + WS_MODP);
        for (int it = gw; it < NL * KSPLIT * NCB; it += NGW) {
            const int l = it / (KSPLIT * NCB), ks = (it / NCB) % KSPLIT, cb = it % NCB, col = cb * 256 + 4 * F.lane;
            const GAS f32x4* wp = (const GAS f32x4*)(INP(I_ADAW) + ((size_t)l * DM + ks * KC) * NMOD + col);
            f32x4 acc[12];
#pragma unroll
            for (int b = 0; b < 12; ++b) acc[b] = (f32x4){0.f, 0.f, 0.f, 0.f};
#pragma unroll 4
            for (int k = 0; k < KC; ++k) { const f32x4 wv = wp[(size_t)k * (NMOD / 4)];
                const LAS f32x4* sp = (const LAS f32x4*)(sil + (ks * KC + k) * 12); const f32x4 s0 = sp[0], s1 = sp[1], s2 = sp[2];
                acc[0] += wv * s0[0]; acc[1] += wv * s0[1]; acc[2] += wv * s0[2]; acc[3] += wv * s0[3];
                acc[4] += wv * s1[0]; acc[5] += wv * s1[1]; acc[6] += wv * s1[2]; acc[7] += wv * s1[3];
                acc[8] += wv * s2[0]; acc[9] += wv * s2[1]; acc[10] += wv * s2[2]; acc[11] += wv * s2[3]; }
#pragma unroll
            for (int b = 0; b < 12; ++b) *(GAS f32x4*)(part + (((size_t)ks * NL + l) * 12 + b) * NMOD + col) = acc[b];
        }
        __syncthreads();
    }
    {
        LAS float* scr = (LAS float*)(F.lds + F.wave * 16384);
        constexpr int I_IN = (DM / 64) * (DIN / 32), I_OUT = (DM / 64) * (DM / 32), I_G = (DM / 64) * (DFF / 32), I_D = (DFF / 64) * (DM / 32), I_C = (DC / 64) * (DC / 32);
        constexpr int PER_L = I_IN + I_OUT + 2 * I_G + I_D + I_C;
        for (int it = gw; it < NL * PER_L; it += NGW) {
            const int l = it / PER_L; int r = it % PER_L; unsigned char* wl = lw(F, l);
            if (r < I_IN) { const int nblk = DIN / 32, k0 = 64 * (r / nblk), n0 = 32 * (r % nblk);
                int orow0 = n0; if (n0 < 512) orow0 = 256 * (n0 >> 7) + (n0 & 127); else if (n0 < 1024) orow0 = 256 * ((n0 - 512) >> 7) + 128 + (n0 & 127);
                transpose_item(INP(I_WIN) + (size_t)l * DM * DIN, DM, DIN, (bf16*)(wl + LW_WIN), k0, n0, orow0, scr, F.lane); continue; } r -= I_IN;
            if (r < I_OUT) { const int nblk = DM / 32, k0 = 64 * (r / nblk), n0 = 32 * (r % nblk);
                transpose_item(INP(I_WOUT) + (size_t)l * DM * DM, DM, DM, (bf16*)(wl + LW_WOUT), k0, n0, n0, scr, F.lane); continue; } r -= I_OUT;
            if (r < 2 * I_G) { const int up = r >= I_G; if (up) r -= I_G; const int nblk = DFF / 32, k0 = 64 * (r / nblk), n0 = 32 * (r % nblk);
                const int orow0 = 256 * (n0 >> 7) + 128 * up + (n0 & 127);
                transpose_item(INP(up ? I_WU : I_WG) + (size_t)l * DM * DFF, DM, DFF, (bf16*)(wl + LW_WGU), k0, n0, orow0, scr, F.lane); continue; } r -= 2 * I_G;
            if (r < I_D) { const int nblk = DM / 32, k0 = 64 * (r / nblk), n0 = 32 * (r % nblk);
                transpose_item(INP(I_WD) + (size_t)l * DFF * DM, DFF, DM, (bf16*)(wl + LW_WD), k0, n0, n0, scr, F.lane); continue; } r -= I_D;
            { const int nblk = DC / 32, k0 = 64 * (r / nblk), n0 = 32 * (r % nblk);
                transpose_item(INP(I_CPW) + (size_t)l * DC * DC, DC, DC, (bf16*)(wl + LW_CPW), k0, n0, n0, scr, F.lane); }
        }
        for (int i = gt; i < NL * DC * DC; i += NGT) { const int l = i / (DC * DC), n = (i / DC) % DC, k = i % DC; float v = 0.f;
            if ((n >> 7) == (k >> 7)) v = INP(I_POOLW)[(((size_t)l * 4 + (n >> 7)) * 128 + (k & 127)) * 128 + (n & 127)] * INP(I_POOLS)[l * DC + n];
            ((bf16*)(lw(F, l) + LW_PWD))[n * DC + k] = (bf16)(pk2(v, 0.f) & 0xffffu); }
        for (int i = gt; i < NL * 4 * 128 * 128; i += NGT) { const int l = i / 65536, r = i % 65536, ii = (r >> 7) & 127, jj = r & 127;
            const float v = (jj <= ii) ? INP(I_SGW)[i] : 0.f; ((bf16*)(lw(F, l) + LW_SGW))[r] = (bf16)(pk2(v, 0.f) & 0xffffu); }
    }
}
__device__ __forceinline__ void p0b_phase(Frame& F) {
    const int gt = F.vcu * (NWAVES * 64) + F.tid, NGT = F.G * NWAVES * 64;
    const float* part = (const float*)(F.ws + WS_MODP); float* mod = (float*)(F.ws + WS_MOD);
    for (int i = gt; i < NL * 12 * NMOD; i += NGT) { const int l = i / (12 * NMOD), n = i % NMOD; float s = INP(I_ADAB)[l * NMOD + n];
#pragma unroll
        for (int ks = 0; ks < KSPLIT; ++ks) s += part[(size_t)ks * NL * 12 * NMOD + i];
        mod[i] = s; }
}
template <bool COPY>
__device__ __forceinline__ void norm_phase(Frame& F, const float* gain, const float* mod_l, int sh_idx, bf16* H) {
    const int gw = F.vcu * NWAVES + F.wave, NGW = F.G * NWAVES;
    float* X = F.out;
    for (int m = gw; m < MT; m += NGW) {
        const float* src = COPY ? (m < MP ? INP(I_XP) + (size_t)m * DM : INP(I_XS) + (size_t)(m - MP) * DM) : X + (size_t)m * DM;
        const GAS f32x4* xr = (const GAS f32x4*)src + F.lane;
        f32x4 v[8]; float s = 0.f;
#pragma unroll
        for (int j = 0; j < 8; ++j) { v[j] = xr[64 * j]; s += (v[j].x * v[j].x + v[j].y * v[j].y) + (v[j].z * v[j].z + v[j].w * v[j].w); }
        if (COPY) { GAS f32x4* xo = (GAS f32x4*)(X + (size_t)m * DM) + F.lane;
#pragma unroll
            for (int j = 0; j < 8; ++j) xo[64 * j] = v[j]; }
        const float rstd = 1.0f / sqrtf(wave_sum(s) * (1.0f / DM) + EPS);
        const float* mb = mod_l + (size_t)batch_of_row(m) * NMOD;
        const GAS f32x4* shp = (const GAS f32x4*)(mb + sh_idx * DM) + F.lane; const GAS f32x4* scp = (const GAS f32x4*)(mb + (sh_idx + 1) * DM) + F.lane;
        const GAS f32x4* gp = (const GAS f32x4*)gain + F.lane;
        GAS v2u* o8 = (GAS v2u*)(H + (size_t)m * DM) + F.lane;
#pragma unroll
        for (int j = 0; j < 8; ++j) { const f32x4 g = gp[64 * j], sc = scp[64 * j], sh = shp[64 * j];
            const f32x4 y = v[j] * rstd * g * (sc + 1.0f) + sh; v2u w; w.x = pk2(y.x, y.y); w.y = pk2(y.z, y.w); o8[64 * j] = w; }
    }
}
__device__ __forceinline__ void final_norm_phase(Frame& F) {
    const int gw = F.vcu * NWAVES + F.wave, NGW = F.G * NWAVES;
    for (int m = gw; m < MT; m += NGW) {
        GAS f32x4* xr = (GAS f32x4*)(F.out + (size_t)m * DM) + F.lane;
        f32x4 v[8]; float s = 0.f;
#pragma unroll
        for (int j = 0; j < 8; ++j) { v[j] = xr[64 * j]; s += (v[j].x * v[j].x + v[j].y * v[j].y) + (v[j].z * v[j].z + v[j].w * v[j].w); }
        const float rstd = 1.0f / sqrtf(wave_sum(s) * (1.0f / DM) + EPS);
        const GAS f32x4* gp = (const GAS f32x4*)INP(I_FING) + F.lane;
#pragma unroll
        for (int j = 0; j < 8; ++j) xr[64 * j] = v[j] * rstd * gp[64 * j];
    }
}

__device__ __forceinline__ int crow(int r, int hi) { return (r & 3) + 8 * (r >> 2) + 4 * hi; }
#define MFMA32(a, b, c) __builtin_amdgcn_mfma_f32_32x32x16_bf16((a), (b), (c), 0, 0, 0)
constexpr int AT_KS = 0, AT_VT = 9216, AT_BT = 18432, AT_PITCH = 144;
__device__ __forceinline__ void attn_unit(Frame& F, int layer, bool sample, int b, int h, int qg, const bf16* Z, bf16* MIX) {
    const int tid = F.tid, lane = F.lane, w = F.wave, l31 = lane & 31, hh = lane >> 5;
    LAS unsigned char* Ks = F.lds + AT_KS; LAS unsigned char* VTs = F.lds + AT_VT; LAS float* bt = (LAS float*)(F.lds + AT_BT);
    if (tid < 257) bt[tid] = INP(I_RELB)[((size_t)layer * 8 + h) * 257 + tid] * LOG2E;
    const bool wave_on = sample ? (w == 0) : true;
    const int qpos = sample ? l31 : 256 * qg + 32 * w + l31;
    const int qrow = sample ? MP + 32 * b + l31 : b * SEQ + qpos;
    bf16x8 qr[4];
#pragma unroll
    for (int d0 = 0; d0 < 4; ++d0) qr[d0] = *(const GAS bf16x8*)(Z + (size_t)qrow * ZW + ZQ + 64 * h + 16 * d0 + 8 * hh);
    f32x16 o0, o1;
#pragma unroll
    for (int r = 0; r < 16; ++r) { o0[r] = 0.f; o1[r] = 0.f; }
    float mrun = -1e30f, lrun = 0.f;
    const int ntile = sample ? 9 : 12, qc = 4 * qg + (w >> 1);
    const int sr = tid >> 3, sch = tid & 7;
    const float* ck = INP(I_CK) + ((size_t)layer * NBS + b) * 512 * 512; const float* cv = INP(I_CV) + ((size_t)layer * NBS + b) * 512 * 512;
    v4u kreg = (v4u){0u, 0u, 0u, 0u}, vreg = (v4u){0u, 0u, 0u, 0u};
#define AT_LOAD(j) do { \
        if (!sample) { const int kc_ = 4 * qg - 8 + (j); if (kc_ >= 0) { const bf16* zr_ = Z + (size_t)(b * SEQ + 64 * kc_ + sr) * ZW + 64 * h + 8 * sch; \
                kreg = *(const GAS v4u*)(zr_ + ZK); vreg = *(const GAS v4u*)(zr_ + ZV); } } \
        else if ((j) < 8) { const size_t o_ = ((size_t)(64 * (j) + sr) * 8 + h) * 64 + 8 * sch; \
                const f32x4 k0_ = *(const GAS f32x4*)(ck + o_), k1_ = *(const GAS f32x4*)(ck + o_ + 4), v0_ = *(const GAS f32x4*)(cv + o_), v1_ = *(const GAS f32x4*)(cv + o_ + 4); \
                kreg = (v4u){pk2(k0_.x, k0_.y), pk2(k0_.z, k0_.w), pk2(k1_.x, k1_.y), pk2(k1_.z, k1_.w)}; vreg = (v4u){pk2(v0_.x, v0_.y), pk2(v0_.z, v0_.w), pk2(v1_.x, v1_.y), pk2(v1_.z, v1_.w)}; } \
        else if (sr < 32) { const bf16* zr_ = Z + (size_t)(MP + 32 * b + sr) * ZW + 64 * h + 8 * sch; kreg = *(const GAS v4u*)(zr_ + ZK); vreg = *(const GAS v4u*)(zr_ + ZV); } \
        else { kreg = (v4u){0u, 0u, 0u, 0u}; vreg = (v4u){0u, 0u, 0u, 0u}; } } while (0)
    AT_LOAD(0);
    for (int j = 0; j < ntile; ++j) {
        const int kc = 4 * qg - 8 + j;
        if (!sample && kc < 0) { AT_LOAD(j + 1); continue; }
        *(LAS v4u*)(Ks + sr * AT_PITCH + sch * 16) = kreg;
        { LAS bf16* vt = (LAS bf16*)VTs + (8 * sch) * (AT_PITCH / 2) + sr;
          vt[0 * (AT_PITCH / 2)] = (bf16)(vreg.x & 0xffffu); vt[1 * (AT_PITCH / 2)] = (bf16)(vreg.x >> 16); vt[2 * (AT_PITCH / 2)] = (bf16)(vreg.y & 0xffffu); vt[3 * (AT_PITCH / 2)] = (bf16)(vreg.y >> 16);
          vt[4 * (AT_PITCH / 2)] = (bf16)(vreg.z & 0xffffu); vt[5 * (AT_PITCH / 2)] = (bf16)(vreg.z >> 16); vt[6 * (AT_PITCH / 2)] = (bf16)(vreg.w & 0xffffu); vt[7 * (AT_PITCH / 2)] = (bf16)(vreg.w >> 16); }
        __syncthreads();
        if (j + 1 < ntile) AT_LOAD(j + 1);
        const bool active = sample ? (w == 0) : (kc >= qc - 8 && kc <= qc);
        if (active) {
            f32x16 p0, p1;
#pragma unroll
            for (int r = 0; r < 16; ++r) { p0[r] = 0.f; p1[r] = 0.f; }
#pragma unroll
            for (int d0 = 0; d0 < 4; ++d0) {
                const bf16x8 a0 = *(const LAS bf16x8*)(Ks + l31 * AT_PITCH + (16 * d0 + 8 * hh) * 2);
                const bf16x8 a1 = *(const LAS bf16x8*)(Ks + (32 + l31) * AT_PITCH + (16 * d0 + 8 * hh) * 2);
                p0 = MFMA32(a0, qr[d0], p0); p1 = MFMA32(a1, qr[d0], p1);
            }
            const int kbase = sample ? 64 * j - 512 : 64 * kc;
            const int relb = kbase - qpos;
            const int qmin = sample ? 0 : 256 * qg + 32 * w;
            if (kbase + 63 - qmin <= -128) { const float b0 = bt[0];
#pragma unroll
                for (int r = 0; r < 16; ++r) { p0[r] += b0; p1[r] += b0; }
            } else {
#pragma unroll
                for (int r = 0; r < 16; ++r) { const int kv = crow(r, hh); int i0 = relb + kv, i1 = i0 + 32;
                    i0 = (i0 < -128 ? -128 : (i0 > 128 ? 128 : i0)) + 128; i1 = (i1 < -128 ? -128 : (i1 > 128 ? 128 : i1)) + 128;
                    p0[r] += bt[i0]; p1[r] += bt[i1]; }
            }
            if (sample && j == 8) {
#pragma unroll
                for (int r = 0; r < 16; ++r) p1[r] = -1e30f;
            }
            float mx = p0[0];
#pragma unroll
            for (int r = 1; r < 16; ++r) mx = fmaxf(mx, p0[r]);
#pragma unroll
            for (int r = 0; r < 16; ++r) mx = fmaxf(mx, p1[r]);
            mx = fmaxf(mx, __shfl_xor(mx, 32));
            const float mn = fmaxf(mrun, mx), alpha = fast_exp2(mrun - mn); mrun = mn;
            float rs = 0.f;
#pragma unroll
            for (int r = 0; r < 16; ++r) { p0[r] = fast_exp2(p0[r] - mn); p1[r] = fast_exp2(p1[r] - mn); rs += p0[r] + p1[r]; }
            rs += __shfl_xor(rs, 32);
            lrun = lrun * alpha + rs;
#pragma unroll
            for (int r = 0; r < 16; ++r) { o0[r] *= alpha; o1[r] *= alpha; }
            bf16x8 pf[4];
            { v4u t;
              t = (v4u){pk2(p0[0], p0[1]), pk2(p0[2], p0[3]), pk2(p0[4], p0[5]), pk2(p0[6], p0[7])}; pf[0] = __builtin_bit_cast(bf16x8, t);
              t = (v4u){pk2(p0[8], p0[9]), pk2(p0[10], p0[11]), pk2(p0[12], p0[13]), pk2(p0[14], p0[15])}; pf[1] = __builtin_bit_cast(bf16x8, t);
              t = (v4u){pk2(p1[0], p1[1]), pk2(p1[2], p1[3]), pk2(p1[4], p1[5]), pk2(p1[6], p1[7])}; pf[2] = __builtin_bit_cast(bf16x8, t);
              t = (v4u){pk2(p1[8], p1[9]), pk2(p1[10], p1[11]), pk2(p1[12], p1[13]), pk2(p1[14], p1[15])}; pf[3] = __builtin_bit_cast(bf16x8, t); }
#pragma unroll
            for (int xt = 0; xt < 2; ++xt)
#pragma unroll
                for (int s = 0; s < 2; ++s) { const int kvo = 32 * xt + 16 * s + 4 * hh;
                    const v2u lo0 = *(const LAS v2u*)(VTs + l31 * AT_PITCH + kvo * 2), hi0 = *(const LAS v2u*)(VTs + l31 * AT_PITCH + (kvo + 8) * 2);
                    const v2u lo1 = *(const LAS v2u*)(VTs + (32 + l31) * AT_PITCH + kvo * 2), hi1 = *(const LAS v2u*)(VTs + (32 + l31) * AT_PITCH + (kvo + 8) * 2);
                    const v4u f0 = (v4u){lo0.x, lo0.y, hi0.x, hi0.y}, f1 = (v4u){lo1.x, lo1.y, hi1.x, hi1.y};
                    o0 = MFMA32(__builtin_bit_cast(bf16x8, f0), pf[2 * xt + s], o0); o1 = MFMA32(__builtin_bit_cast(bf16x8, f1), pf[2 * xt + s], o1); }
        }
        __syncthreads();
    }
#undef AT_LOAD
    if (wave_on) {
        const float inv = 1.0f / lrun;
        bf16* orow = MIX + (size_t)qrow * MIXW + MIX_B + 64 * h;
#pragma unroll
        for (int g4 = 0; g4 < 4; ++g4) { const int d = 8 * g4 + 4 * hh;
            v2u w0; w0.x = pk2(o0[4 * g4] * inv, o0[4 * g4 + 1] * inv); w0.y = pk2(o0[4 * g4 + 2] * inv, o0[4 * g4 + 3] * inv); *(GAS v2u*)(orow + d) = w0;
            v2u w1; w1.x = pk2(o1[4 * g4] * inv, o1[4 * g4 + 1] * inv); w1.y = pk2(o1[4 * g4 + 2] * inv, o1[4 * g4 + 3] * inv); *(GAS v2u*)(orow + 32 + d) = w1; }
    }
}
constexpr int SG_PITCH = 272;
__device__ __forceinline__ void sg_unit(Frame& F, int layer, int ci, int g, const bf16* Z, bf16* MIX) {
    const int lane = F.lane, w = F.wave, l31 = lane & 31, hh = lane >> 5;
    const bool sample = ci >= MP / 128; const int L = sample ? 32 : 128, row0 = sample ? MP + 32 * (ci - MP / 128) : 128 * ci;
    LAS unsigned char* VNT = F.lds;
    {
        const int c8 = 8 * lane;
        const GAS f32x4* lgp = (const GAS f32x4*)(INP(I_SGG) + layer * DC + c8); const GAS f32x4* lbp = (const GAS f32x4*)(INP(I_SGB) + layer * DC + c8);
        const f32x4 lg0 = lgp[0], lg1 = lgp[1], lb0 = lbp[0], lb1 = lbp[1];
        const int nrw = L / 8;
        for (int i = 0; i < nrw; ++i) { const int rr = w * nrw + i;
            const v4u zv = *(const GAS v4u*)(Z + (size_t)(row0 + rr) * ZW + ZSV + c8);
            float x[8] = {bflo(zv.x), bfhi(zv.x), bflo(zv.y), bfhi(zv.y), bflo(zv.z), bfhi(zv.z), bflo(zv.w), bfhi(zv.w)};
            float s = ((x[0] + x[1]) + (x[2] + x[3])) + ((x[4] + x[5]) + (x[6] + x[7]));
            const float mean = wave_sum(s) * (1.0f / DC); float q = 0.f;
#pragma unroll
            for (int e = 0; e < 8; ++e) { x[e] -= mean; q += x[e] * x[e]; }
            const float rstd = 1.0f / sqrtf(wave_sum(q) * (1.0f / DC) + EPS);
            float y[8];
            y[0] = x[0] * rstd * lg0.x + lb0.x; y[1] = x[1] * rstd * lg0.y + lb0.y; y[2] = x[2] * rstd * lg0.z + lb0.z; y[3] = x[3] * rstd * lg0.w + lb0.w;
            y[4] = x[4] * rstd * lg1.x + lb1.x; y[5] = x[5] * rstd * lg1.y + lb1.y; y[6] = x[6] * rstd * lg1.z + lb1.z; y[7] = x[7] * rstd * lg1.w + lb1.w;
            if ((lane >> 4) == g) {
                LAS bf16* vt = (LAS bf16*)VNT + (8 * (lane & 15)) * (SG_PITCH / 2) + rr;
#pragma unroll
                for (int e = 0; e < 8; ++e) vt[e * (SG_PITCH / 2)] = (bf16)(pk2(y[e], 0.f) & 0xffffu);
                if (sample) { float* so = F.out + O_SGV + (((size_t)layer * NBS + (ci - MP / 128)) * TS + rr) * DC + c8;
                    *(GAS f32x4*)so = (f32x4){y[0], y[1], y[2], y[3]}; *(GAS f32x4*)(so + 4) = (f32x4){y[4], y[5], y[6], y[7]}; }
            }
        }
    }
    __syncthreads();
    {
        const int cb = w & 3, ih = w >> 2;
        const bf16* Wg = (const bf16*)(lw(F, layer) + LW_SGW) + (size_t)g * 128 * 128;
#pragma unroll
        for (int ibb = 0; ibb < 2; ++ibb) { const int ib = 2 * ih + ibb;
            if (32 * ib < L) {
                const int jmax = (32 * (ib + 1) < L) ? 32 * (ib + 1) : L, nks = jmax / 16;
                f32x16 acc;
#pragma unroll
                for (int r = 0; r < 16; ++r) acc[r] = 0.f;
                for (int s = 0; s < nks; ++s) {
                    const bf16x8 a = *(const LAS bf16x8*)(VNT + (32 * cb + l31) * SG_PITCH + (16 * s + 8 * hh) * 2);
                    const bf16x8 bb = *(const GAS bf16x8*)(Wg + (size_t)(32 * ib + l31) * 128 + 16 * s + 8 * hh);
                    acc = MFMA32(a, bb, acc);
                }
                const int i = 32 * ib + l31, row = row0 + i; const float bias = INP(I_SGBIAS)[((size_t)layer * 4 + g) * 128 + i];
#pragma unroll
                for (int rg = 0; rg < 4; ++rg) { const int c4 = 32 * cb + 8 * rg + 4 * hh;
                    const v2u zu = *(const GAS v2u*)(Z + (size_t)row * ZW + ZSU + 128 * g + c4);
                    v2u o; o.x = pk2(bflo(zu.x) * (acc[4 * rg] + bias), bfhi(zu.x) * (acc[4 * rg + 1] + bias)); o.y = pk2(bflo(zu.y) * (acc[4 * rg + 2] + bias), bfhi(zu.y) * (acc[4 * rg + 3] + bias));
                    *(GAS v2u*)(MIX + (size_t)row * MIXW + MIX_D + 128 * g + c4) = o; }
            }
        }
    }
    __syncthreads();
}
__device__ __forceinline__ void conv_unit(Frame& F, int layer, int tb, int cg, const bf16* Z, bf16* CA) {
    const int c = 64 * cg + F.lane; const bool sample = tb >= MP / 32; const int sb = tb - MP / 32;
    const int r0 = sample ? MP + 32 * sb : 32 * tb; const bool first = !sample && ((r0 & (SEQ - 1)) == 0);
    float wt[31];
#pragma unroll
    for (int j = 0; j < 31; ++j) wt[j] = INP(I_CONVW)[((size_t)layer * 31 + j) * DC + c];
    const float cbias = INP(I_CONVB)[layer * DC + c], gg = INP(I_GNG)[layer * DC + c], gb = INP(I_GNB)[layer * DC + c];
    float acc[32];
#pragma unroll
    for (int t = 0; t < 32; ++t) acc[t] = cbias;
    const float* hist = INP(I_CCONV) + ((size_t)layer * NBS + (sample ? sb : 0)) * 30 * DC + c;
#pragma unroll
    for (int e = 0; e < 62; ++e) {
        float v;
        if (e < 30) { if (sample) v = hist[(size_t)e * DC]; else v = first ? 0.f : bf2f(Z[(size_t)(r0 - 30 + e) * ZW + ZU + c]); }
        else v = bf2f(Z[(size_t)(r0 + e - 30) * ZW + ZU + c]);
#pragma unroll
        for (int t = 0; t < 32; ++t) { if (e - t >= 0 && e - t <= 30) acc[t] += wt[e - t] * v; }
        if (e >= 30) { const int tt = e - 30;
            if (sample) { if (tt >= 2) F.out[O_CONVS + (((size_t)layer * NBS + sb) * 30 + (tt - 2)) * DC + c] = v; }
            else if ((r0 & (SEQ - 1)) == SEQ - 32) { if (tt >= 2) F.out[O_CONVP + (((size_t)layer * NBP + (r0 >> 13)) * 30 + (tt - 2)) * DC + c] = v; } }
    }
#pragma unroll
    for (int t = 0; t < 32; ++t) {
        const float mean = wave_sum(acc[t]) * (1.0f / 64.0f), d = acc[t] - mean;
        const float rstd = 1.0f / sqrtf(wave_sum(d * d) * (1.0f / 64.0f) + EPS);
        const float y = d * rstd * gg + gb;
        CA[(size_t)(r0 + t) * DC + c] = (bf16)(pk2(siluf_(y), 0.f) & 0xffffu);
    }
}
template <int W>
__device__ __forceinline__ void pool_body(Frame& F, int layer, int tb, int cg, const bf16* Z, bf16* PM) {
    const int c = 64 * cg + F.lane; const bool sample = tb >= MP / 32; const int sb = tb - MP / 32;
    const int r0 = sample ? MP + 32 * sb : 32 * tb; const bool first = !sample && ((r0 & (SEQ - 1)) == 0);
    const float* hist = INP(I_CPOOL) + ((size_t)layer * NBS + (sample ? sb : 0)) * 15 * DC + c;
    float ext[47];
#pragma unroll
    for (int e = 0; e < 47; ++e) {
        if (e < 15) { if (sample) ext[e] = hist[(size_t)e * DC]; else ext[e] = first ? 0.f : bf2f(Z[(size_t)(r0 - 15 + e) * ZW + ZP + c]); }
        else ext[e] = bf2f(Z[(size_t)(r0 + e - 15) * ZW + ZP + c]);
    }
#pragma unroll
    for (int t = 0; t < 32; ++t) {
        float win = 0.f;
#pragma unroll
        for (int i = W - 1; i >= 0; --i) win += ext[15 + t - i];
        const int cnt = (first && t + 1 < W) ? t + 1 : W;
        PM[(size_t)(r0 + t) * DC + c] = (bf16)(pk2(win / (float)cnt - ext[15 + t], 0.f) & 0xffffu);
        if (sample) { if (t >= 17) F.out[O_POOLS + (((size_t)layer * NBS + sb) * 15 + (t - 17)) * DC + c] = ext[15 + t]; }
        else if ((r0 & (SEQ - 1)) == SEQ - 32) { if (t >= 17) F.out[O_POOLP + (((size_t)layer * NBP + (r0 >> 13)) * 15 + (t - 17)) * DC + c] = ext[15 + t]; }
    }
}
__device__ __forceinline__ void mixer_phase(Frame& F, int layer) {
    const bf16* Z = (const bf16*)(F.ws + WS_Z); bf16* MIX = (bf16*)(F.ws + WS_MIX); bf16* CA = (bf16*)(F.ws + WS_CAPM); bf16* PM = CA + (size_t)MT * DC;
    for (int id = F.vcu; id < NBP * 8 * 32; id += F.G) attn_unit(F, layer, false, id >> 8, (id >> 5) & 7, id & 31, Z, MIX);
    for (int id = F.vcu; id < NBS * 8; id += F.G) attn_unit(F, layer, true, id >> 3, id & 7, 0, Z, MIX);
    for (int id = F.vcu; id < (MP / 128 + NBS) * 4; id += F.G) sg_unit(F, layer, id >> 2, id & 3, Z, MIX);
    const int gw = F.vcu * NWAVES + F.wave, NGW = F.G * NWAVES;
    for (int id = gw; id < (MT / 32) * 8; id += NGW) conv_unit(F, layer, id >> 3, id & 7, Z, CA);
    for (int id = gw; id < (MT / 32) * 8; id += NGW) { const int tb = id >> 3, cg = id & 7;
        switch (cg >> 1) { case 0: pool_body<2>(F, layer, tb, cg, Z, PM); break; case 1: pool_body<4>(F, layer, tb, cg, Z, PM); break;
                           case 2: pool_body<8>(F, layer, tb, cg, Z, PM); break; default: pool_body<16>(F, layer, tb, cg, Z, PM); break; } }
    const int gt = F.vcu * (NWAVES * 64) + F.tid, NGT = F.G * NWAVES * 64;
    for (int i = gt; i < (NBP * 512 + NBS * TS) * 128; i += NGT) {
        const int rr = i >> 7, kv = (i >> 6) & 1, ch = i & 63;
        int zrow; size_t o;
        if (rr < NBP * 512) { const int b = rr >> 9, t = rr & 511; zrow = b * SEQ + SEQ - 512 + t; o = (kv ? O_VP : O_KP) + (((size_t)layer * NBP + b) * 512 + t) * 512 + 8 * ch; }
        else { const int r2 = rr - NBP * 512, b = r2 >> 5, t = r2 & 31; zrow = MP + r2; o = (kv ? O_VS : O_KS) + (((size_t)layer * NBS + b) * TS + t) * 512 + 8 * ch; }
        const v4u z = *(const GAS v4u*)(Z + (size_t)zrow * ZW + (kv ? ZV : ZK) + 8 * ch);
        *(GAS f32x4*)(F.out + o) = (f32x4){bflo(z.x), bfhi(z.x), bflo(z.y), bfhi(z.y)}; *(GAS f32x4*)(F.out + o + 4) = (f32x4){bflo(z.z), bfhi(z.z), bflo(z.w), bfhi(z.w)};
    }
}

constexpr int N_PHASES = 2 + 8 * NL + 1;

__global__ void __launch_bounds__(NWAVES * 64, 2) enc_fwd(Args args) {
    extern __shared__ __attribute__((aligned(16))) unsigned char lds[];
    Frame F;
    F.lds = (LAS unsigned char*)lds;
    F.tid = threadIdx.x; F.lane = F.tid & 63; F.wave = __builtin_amdgcn_readfirstlane(F.tid >> 6);
    F.G = gridDim.x; { const int bx = blockIdx.x; F.vcu = (F.G % 8 == 0) ? (bx % 8) * (F.G / 8) + bx / 8 : bx; }
    F.ka = (KArgs)__builtin_amdgcn_kernarg_segment_ptr();
    F.out = args.out; F.ws = args.ws;
    volatile LAS unsigned* MISC = (volatile LAS unsigned*)(F.lds + MISC_OFF);
    for (int u = F.tid; u < (LDS_BYTES - LDSCTL_OFF) / 4; u += NWAVES * 64) ((LAS unsigned*)(F.lds + LDSCTL_OFF))[u] = 0u;
    __syncthreads();
    const int lo = args.ph_lo, hi = args.ph_hi;
#define REFRESH() do { int t_ = threadIdx.x; asm volatile("" : "+v"(t_)); F.tid = t_; F.lane = t_ & 63; F.wave = __builtin_amdgcn_readfirstlane(t_ >> 6); \
        unsigned long long w_ = (unsigned long long)args.ws, o_ = (unsigned long long)args.out, k_ = (unsigned long long)__builtin_amdgcn_kernarg_segment_ptr(); \
        asm volatile("" : "+s"(w_), "+s"(o_), "+s"(k_)); F.ws = (unsigned char*)(GAS unsigned char*)w_; F.out = (float*)(GAS float*)o_; F.ka = (KArgs)k_; \
        unsigned l_ = (unsigned)(unsigned long long)(LAS unsigned char*)lds; asm volatile("" : "+s"(l_)); F.lds = (LAS unsigned char*)(unsigned long long)l_; } while (0)
    XcdBarrier bar; bar.bar = (unsigned*)(F.ws + WS_CTL) + CW_BAR; bar.x = 0; bar.st = nullptr;
    if (hi - lo > 1) bar = xcd_barrier_post((unsigned*)(F.ws + WS_CTL) + CW_BAR, MISC + 8);
#ifdef ONLY_PHASE
#define IN(k) ((((k) < 2 || (k) == N_PHASES - 1) ? (k) : 2 + ((k) - 2) % 8) == ONLY_PHASE && lo <= (k) && (k) < hi)
#else
#define IN(k) (lo <= (k) && (k) < hi)
#endif
#define SEAM(k) do { if (IN(k) && IN((k) + 1)) { XcdBarrier b_ = bar; unsigned long long p_ = (unsigned long long)b_.bar; asm volatile("" : "+s"(p_)); b_.bar = (unsigned*)p_; xcd_barrier(b_); } } while (0)

    if (IN(0)) { REFRESH(); p0a_phase(F); } SEAM(0);
    if (IN(1)) { REFRESH(); p0b_phase(F); } SEAM(1);
    for (int l = 0; l < NL; ++l) {
        const int pb = 2 + 8 * l;
        if (IN(pb + 0)) { REFRESH(); bf16* H = (bf16*)(F.ws + WS_H); bf16* Zb = (bf16*)(F.ws + WS_Z); bf16* MIX = (bf16*)(F.ws + WS_MIX); bf16* HID = (bf16*)(F.ws + WS_HID); bf16* CAPM = (bf16*)(F.ws + WS_CAPM); (void)H; (void)Zb; (void)MIX; (void)HID; (void)CAPM; const float* mod_l = modp(F, l); unsigned char* wl = lw(F, l); (void)mod_l; (void)wl; if (l == 0) norm_phase<true>(F, INP(I_N1) + l * DM, mod_l, 0, H); else norm_phase<false>(F, INP(I_N1) + l * DM, mod_l, 0, H); } SEAM(pb + 0);
        if (IN(pb + 1)) { REFRESH(); bf16* H = (bf16*)(F.ws + WS_H); bf16* Zb = (bf16*)(F.ws + WS_Z); bf16* MIX = (bf16*)(F.ws + WS_MIX); bf16* HID = (bf16*)(F.ws + WS_HID); bf16* CAPM = (bf16*)(F.ws + WS_CAPM); (void)H; (void)Zb; (void)MIX; (void)HID; (void)CAPM; const float* mod_l = modp(F, l); unsigned char* wl = lw(F, l); (void)mod_l; (void)wl; pg8::Gemm g{H, (const bf16*)(wl + LW_WIN), MT, DIN, DM}; pg8::StaticOrder S; S.init(MT, DIN, F.G, (int)blockIdx.x); pg8::EpiZ E{Zb};
            pg8::gemm_phase<pg8::EpiZ, pg8::StaticOrder, true, true>(F.lds, g, S, E); } SEAM(pb + 1);
        if (IN(pb + 2)) { REFRESH(); bf16* H = (bf16*)(F.ws + WS_H); bf16* Zb = (bf16*)(F.ws + WS_Z); bf16* MIX = (bf16*)(F.ws + WS_MIX); bf16* HID = (bf16*)(F.ws + WS_HID); bf16* CAPM = (bf16*)(F.ws + WS_CAPM); (void)H; (void)Zb; (void)MIX; (void)HID; (void)CAPM; const float* mod_l = modp(F, l); unsigned char* wl = lw(F, l); (void)mod_l; (void)wl; mixer_phase(F, l); } SEAM(pb + 2);
        if (IN(pb + 3)) { REFRESH(); bf16* H = (bf16*)(F.ws + WS_H); bf16* Zb = (bf16*)(F.ws + WS_Z); bf16* MIX = (bf16*)(F.ws + WS_MIX); bf16* HID = (bf16*)(F.ws + WS_HID); bf16* CAPM = (bf16*)(F.ws + WS_CAPM); (void)H; (void)Zb; (void)MIX; (void)HID; (void)CAPM; const float* mod_l = modp(F, l); unsigned char* wl = lw(F, l); (void)mod_l; (void)wl; pg8::Gemm g{CAPM, (const bf16*)(wl + LW_CPW), 2 * MT, 2 * DC, DC}; pg8::Mix2Order S{F.G, (int)blockIdx.x}; pg8::EpiMix2 E{MIX};
            pg8::gemm_phase<pg8::EpiMix2, pg8::Mix2Order, true, true>(F.lds, g, S, E); } SEAM(pb + 3);
        if (IN(pb + 4)) { REFRESH(); bf16* H = (bf16*)(F.ws + WS_H); bf16* Zb = (bf16*)(F.ws + WS_Z); bf16* MIX = (bf16*)(F.ws + WS_MIX); bf16* HID = (bf16*)(F.ws + WS_HID); bf16* CAPM = (bf16*)(F.ws + WS_CAPM); (void)H; (void)Zb; (void)MIX; (void)HID; (void)CAPM; const float* mod_l = modp(F, l); unsigned char* wl = lw(F, l); (void)mod_l; (void)wl; pg8::Gemm g{MIX, (const bf16*)(wl + LW_WOUT), MT, DM, DM}; pg8::StaticOrder S; S.init(MT, DM, F.G, (int)blockIdx.x); pg8::EpiRes E{F.out, mod_l + 2 * DM};
            pg8::gemm_phase<pg8::EpiRes, pg8::StaticOrder, true, true>(F.lds, g, S, E); } SEAM(pb + 4);
        if (IN(pb + 5)) { REFRESH(); bf16* H = (bf16*)(F.ws + WS_H); bf16* Zb = (bf16*)(F.ws + WS_Z); bf16* MIX = (bf16*)(F.ws + WS_MIX); bf16* HID = (bf16*)(F.ws + WS_HID); bf16* CAPM = (bf16*)(F.ws + WS_CAPM); (void)H; (void)Zb; (void)MIX; (void)HID; (void)CAPM; const float* mod_l = modp(F, l); unsigned char* wl = lw(F, l); (void)mod_l; (void)wl; norm_phase<false>(F, INP(I_N2) + l * DM, mod_l, 3, H); } SEAM(pb + 5);
        if (IN(pb + 6)) { REFRESH(); bf16* H = (bf16*)(F.ws + WS_H); bf16* Zb = (bf16*)(F.ws + WS_Z); bf16* MIX = (bf16*)(F.ws + WS_MIX); bf16* HID = (bf16*)(F.ws + WS_HID); bf16* CAPM = (bf16*)(F.ws + WS_CAPM); (void)H; (void)Zb; (void)MIX; (void)HID; (void)CAPM; const float* mod_l = modp(F, l); unsigned char* wl = lw(F, l); (void)mod_l; (void)wl; pg8::Gemm g{H, (const bf16*)(wl + LW_WGU), MT, 2 * DFF, DM}; pg8::StaticOrder S; S.init(MT, 2 * DFF, F.G, (int)blockIdx.x); pg8::EpiSwi E{HID};
            pg8::gemm_phase<pg8::EpiSwi, pg8::StaticOrder, true, true>(F.lds, g, S, E); } SEAM(pb + 6);
        if (IN(pb + 7)) { REFRESH(); bf16* H = (bf16*)(F.ws + WS_H); bf16* Zb = (bf16*)(F.ws + WS_Z); bf16* MIX = (bf16*)(F.ws + WS_MIX); bf16* HID = (bf16*)(F.ws + WS_HID); bf16* CAPM = (bf16*)(F.ws + WS_CAPM); (void)H; (void)Zb; (void)MIX; (void)HID; (void)CAPM; const float* mod_l = modp(F, l); unsigned char* wl = lw(F, l); (void)mod_l; (void)wl; pg8::Gemm g{HID, (const bf16*)(wl + LW_WD), MT, DM, DFF}; pg8::StaticOrder S; S.init(MT, DM, F.G, (int)blockIdx.x); pg8::EpiRes E{F.out, mod_l + 5 * DM};
            pg8::gemm_phase<pg8::EpiRes, pg8::StaticOrder, true, true>(F.lds, g, S, E); } SEAM(pb + 7);
    }
    if (IN(N_PHASES - 1)) { REFRESH(); final_norm_phase(F); }
#undef IN
#undef SEAM
}

extern "C" void kernel_launch(void* const* d_in, const int* in_sizes, int n_in, void* d_out, int out_size, void* d_ws, size_t ws_size, hipStream_t stream) {
    static int grid = 0;
    if (grid == 0) {
        if (n_in != N_IN || in_sizes[0] != MP * DM || (size_t)out_size != O_END || ws_size < WS_END) {
            fprintf(stderr, "kernel_launch: unexpected shapes: n_in %d in0 %d out %d ws %zu (need %zu); nothing launched\n", n_in, n_in > 0 ? in_sizes[0] : -1, out_size, ws_size, (size_t)WS_END); grid = -1; return; }
        int dev = 0, cus = 0;
        if (hipGetDevice(&dev) != hipSuccess || hipDeviceGetAttribute(&cus, hipDeviceAttributeMultiprocessorCount, dev) != hipSuccess) { grid = -1; return; }
        if (hipFuncSetAttribute((const void*)enc_fwd, hipFuncAttributeMaxDynamicSharedMemorySize, LDS_BYTES) != hipSuccess) { fprintf(stderr, "kernel_launch: hipFuncSetAttribute failed\n"); grid = -1; return; }
        int per_cu = 0;
        if (hipOccupancyMaxActiveBlocksPerMultiprocessor(&per_cu, (const void*)enc_fwd, NWAVES * 64, LDS_BYTES) != hipSuccess || per_cu < 1)
            fprintf(stderr, "kernel_launch: note: occupancy query reports %d workgroups per CU\n", per_cu);
        (void)hipGetLastError();
        grid = cus;
    }
    if (grid < 0) return;
    if (hipMemsetAsync((char*)d_ws + WS_CTL, 0, CTL_ZERO_BYTES, stream) != hipSuccess) return;
    Args a{};
    for (int i = 0; i < N_IN; ++i) a.in[i] = (const float*)d_in[i];
    a.out = (float*)d_out; a.ws = (unsigned char*)d_ws; a.pad0 = 0; a.pad1 = 0;
#if MK_ONE_LAUNCH
    a.ph_lo = 0; a.ph_hi = N_PHASES;
    hipLaunchKernelGGL(enc_fwd, dim3(grid), dim3(NWAVES * 64), LDS_BYTES, stream, a);
#else
    for (int ph = 0; ph < N_PHASES; ++ph) { a.ph_lo = ph; a.ph_hi = ph + 1;
        hipLaunchKernelGGL(enc_fwd, dim3(grid), dim3(NWAVES * 64), LDS_BYTES, stream, a); }
#endif
}
```

```cpp
#include <hip/hip_runtime.h>
#include <cstdio>
#include <cstdint>

#ifndef MK_ONE_LAUNCH
#define MK_ONE_LAUNCH 1
#endif

constexpr int DM = 2048, SEQ = 8192, NBP = 4, MP = NBP * SEQ, NBS = 8, TS = 32, MS = NBS * TS, MT = MP + MS, NPANEL = MT / 256;
constexpr int DIN = 4096, DFF = 5632, DC = 512, NL = 4, NMOD = 6 * DM, NBT = NBP + NBS;
constexpr int ZW = 3584, ZU = 0, ZQ = 512, ZK = 1024, ZV = 1536, ZP = 2048, ZSU = 2560, ZSV = 3072;
constexpr int MIXW = 2048, MIX_A = 0, MIX_B = 512, MIX_C = 1024, MIX_D = 1536;
constexpr float EPS = 1e-6f, LOG2E = 1.4426950408889634f, QSCALE = 0.125f * LOG2E;
constexpr int KSPLIT = 16;
constexpr size_t O_YP = 0, O_YS = O_YP + (size_t)MP * DM, O_CONVP = O_YS + (size_t)MS * DM, O_CONVS = O_CONVP + (size_t)NL * NBP * 30 * DC,
    O_KP = O_CONVS + (size_t)NL * NBS * 30 * DC, O_VP = O_KP + (size_t)NL * NBP * 512 * 512, O_KS = O_VP + (size_t)NL * NBP * 512 * 512,
    O_VS = O_KS + (size_t)NL * NBS * TS * 512, O_POOLP = O_VS + (size_t)NL * NBS * TS * 512, O_POOLS = O_POOLP + (size_t)NL * NBP * 15 * DC,
    O_SGV = O_POOLS + (size_t)NL * NBS * 15 * DC, O_END = O_SGV + (size_t)NL * NBS * TS * DC;
static_assert(O_END == 78700544, "output size");
enum { I_XP = 0, I_XS, I_CP, I_CS, I_CCONV, I_CK, I_CV, I_CPOOL, I_ADAW, I_ADAB, I_N1, I_N2, I_WIN, I_CONVW, I_CONVB, I_GNG, I_GNB, I_CPW, I_RELB,
       I_POOLW, I_POOLS, I_SGG, I_SGB, I_SGW, I_SGBIAS, I_WOUT, I_WG, I_WU, I_WD, I_FING, N_IN };
static_assert(N_IN == 30, "30 inputs");

constexpr size_t MiB = 1u << 20;
constexpr size_t WS_CTL = 0, CTL_ZERO_BYTES = 1 * MiB;
constexpr size_t WS_MOD = 1 * MiB;
constexpr size_t WS_MODP = 4 * MiB;
constexpr size_t WS_W = 40 * MiB;
constexpr size_t LW_WIN = 0, LW_WOUT = 16 * MiB, LW_WGU = 24 * MiB, LW_WD = 68 * MiB, LW_CPW = 90 * MiB, LW_PWD = LW_CPW + 512 * 1024, LW_SGW = 91 * MiB, LW = 91 * MiB + 256 * 1024;
constexpr size_t WS_H = WS_W + NL * LW;
constexpr size_t WS_Z = WS_H + (size_t)MT * DM * 2;
constexpr size_t WS_MIX = WS_Z + (size_t)MT * ZW * 2;
constexpr size_t WS_HID = WS_Z;
constexpr size_t WS_CAPM = WS_MIX + (size_t)MT * MIXW * 2;
constexpr size_t WS_END = WS_CAPM + (size_t)2 * MT * DC * 2;
static_assert(WS_HID + (size_t)MT * DFF * 2 <= WS_CAPM, "HID overlay");
static_assert((size_t)NL * 12 * NMOD * 4 <= 3 * MiB && (size_t)KSPLIT * NL * 12 * NMOD * 4 <= 36 * MiB, "mod buffers");
constexpr int CW_BAR = 4096;

constexpr int RING_BYTES = 131072;
constexpr int LDSCTL_OFF = RING_BYTES, MISC_OFF = LDSCTL_OFF + 320;
constexpr int LDS_BYTES = 147456;
constexpr int NWAVES = 8;

#define GAS __attribute__((address_space(1)))
#define LAS __attribute__((address_space(3)))
typedef unsigned short bf16;
typedef unsigned v4u __attribute__((ext_vector_type(4)));
typedef unsigned v2u __attribute__((ext_vector_type(2)));
typedef float f32x4 __attribute__((ext_vector_type(4)));
typedef float f32x2 __attribute__((ext_vector_type(2)));
typedef float f32x16 __attribute__((ext_vector_type(16)));
typedef short bf16x8 __attribute__((ext_vector_type(8)));
typedef __bf16 bf16x2_t __attribute__((ext_vector_type(2)));
typedef GAS unsigned gu32;
#define RLX_AGENT __ATOMIC_RELAXED, __HIP_MEMORY_SCOPE_AGENT
#define LDS_WAIT() asm volatile("s_waitcnt lgkmcnt(0)" ::: "memory")
#define VM_WAIT() asm volatile("s_waitcnt vmcnt(0)" ::: "memory")

__device__ __forceinline__ unsigned pk2(float lo, float hi) { f32x2 v = {lo, hi}; bf16x2_t b = __builtin_convertvector(v, bf16x2_t); return __builtin_bit_cast(unsigned, b); }
__device__ __forceinline__ float bflo(unsigned u) { return __uint_as_float(u << 16); }
__device__ __forceinline__ float bfhi(unsigned u) { return __uint_as_float(u & 0xffff0000u); }
__device__ __forceinline__ float bf2f(bf16 h) { return __uint_as_float((unsigned)h << 16); }
__device__ __forceinline__ float fast_exp2(float x) { return __builtin_amdgcn_exp2f(x); }
__device__ __forceinline__ float fast_rcp(float x) { return __builtin_amdgcn_rcpf(x); }
__device__ __forceinline__ float sigmoidf_(float x) { return fast_rcp(1.0f + fast_exp2(-x * LOG2E)); }
__device__ __forceinline__ float siluf_(float x) { return x * sigmoidf_(x); }
__device__ __forceinline__ float wave_sum(float v) {
#pragma unroll
    for (int o = 1; o < 64; o <<= 1) v += __shfl_xor(v, o);
    return v;
}
__device__ __forceinline__ int batch_of_row(int row) { return row < MP ? (row >> 13) : NBP + ((row - MP) >> 5); }

namespace pg8 {
#define PG8_LAS __attribute__((address_space(3)))
typedef unsigned short bf16_t;
typedef short bf16x8 __attribute__((ext_vector_type(8)));
typedef float f32x4 __attribute__((ext_vector_type(4)));
typedef unsigned u32x4 __attribute__((ext_vector_type(4)));
constexpr int BM = 256, BK = 64, HALF = 128, HTB = HALF * BK * 2  , STAGE_BYTES = 8 * HTB, NXCD = 8, WGM = 8;

__host__ __device__ __forceinline__ int lds_byte(int r, int c) { const int st = (r >> 4) * 2 + (c >> 5), rr = r & 15, cc = c & 31, ob = rr * 64 + cc * 2; return st * 1024 + (ob ^ (((ob >> 9) & 1) << 5)); }
__host__ __device__ __forceinline__ void stage_rc(int b, int& R, int& C) { const int st = b / 1024, sb = b % 1024, swz = sb ^ (((sb >> 9) & 1) << 5); R = (st >> 1) * 16 + swz / 64; C = (st & 1) * 32 + (swz % 64) / 2; }
__host__ __device__ __forceinline__ int perm32(int rho) { const int n = rho >> 4, i = rho & 15; return 8 * (i >> 2) + 4 * n + (i & 3); }

struct Unit { int pm, pn; };
struct Gemm { const bf16_t* A; const bf16_t* Bt; int M, N, K; };

struct StaticOrder {
    int nM, nN, nwg, G, c;
    __host__ __device__ void init(int M, int N, int G_, int c_) { nM = M / BM; nN = N / BM; nwg = nM * nN; G = G_; c = c_; }
    __host__ __device__ bool next(int i, Unit& u) const {
        const long L = (long)i * G + c; if (L >= nwg) return false;
        int wgid = (int)L; { const int q = nwg / NXCD, r = nwg % NXCD, xcd = wgid % NXCD, off = wgid / NXCD; wgid = (xcd < r ? xcd * (q + 1) : r * (q + 1) + (xcd - r) * q) + off; }
        const int nig = WGM * nN, gid = wgid / nig, fm = gid * WGM, gsz = (nM - fm) < WGM ? (nM - fm) : WGM;
        u.pm = fm + ((wgid % nig) % gsz); u.pn = (wgid % nig) / gsz; return true;
    }
    __device__ __forceinline__ void a_ready(const Unit&) const {}
    __device__ __forceinline__ void done(const Unit&) const {}
};
__device__ __forceinline__ unsigned cvt_pk_bf16(float lo, float hi) { return ::pk2(lo, hi); }
struct EpiZ {
    static constexpr bool PERM = true, AFTER_DRAIN = false;
    bf16_t* Z;
    __device__ __forceinline__ void operator()(const f32x4 (&acc)[2][2][4][2], const Unit& u, int wr, int wc, int fr, int fq) const {
        const int row0 = u.pm * BM + wr * 64 + fr;
        if (u.pn < 4) {
            const int col0 = 128 * u.pn + wc * 32 + 8 * fq;
#pragma unroll
            for (int ai = 0; ai < 2; ++ai)
#pragma unroll
                for (int m = 0; m < 4; ++m) { bf16_t* rowp = Z + (size_t)(row0 + ai * HALF + m * 16) * ::ZW + col0;
                    const f32x4 a0 = acc[ai][0][m][0], a1 = acc[ai][0][m][1], g0 = acc[ai][1][m][0], g1 = acc[ai][1][m][1];
                    u32x4 w; w.x = cvt_pk_bf16(a0[0] * ::sigmoidf_(g0[0]), a0[1] * ::sigmoidf_(g0[1])); w.y = cvt_pk_bf16(a0[2] * ::sigmoidf_(g0[2]), a0[3] * ::sigmoidf_(g0[3]));
                    w.z = cvt_pk_bf16(a1[0] * ::sigmoidf_(g1[0]), a1[1] * ::sigmoidf_(g1[1])); w.w = cvt_pk_bf16(a1[2] * ::sigmoidf_(g1[2]), a1[3] * ::sigmoidf_(g1[3]));
                    *(u32x4*)rowp = w; }
        } else {
            const float sc = (u.pn < 6) ? ::QSCALE : 1.0f;
            const int col0 = 512 + 256 * (u.pn - 4) + wc * 32 + 8 * fq;
#pragma unroll
            for (int ai = 0; ai < 2; ++ai)
#pragma unroll
                for (int m = 0; m < 4; ++m) { bf16_t* rowp = Z + (size_t)(row0 + ai * HALF + m * 16) * ::ZW + col0;
#pragma unroll
                    for (int bj = 0; bj < 2; ++bj) { const f32x4 v0 = acc[ai][bj][m][0] * sc, v1 = acc[ai][bj][m][1] * sc;
                        u32x4 w; w.x = cvt_pk_bf16(v0[0], v0[1]); w.y = cvt_pk_bf16(v0[2], v0[3]); w.z = cvt_pk_bf16(v1[0], v1[1]); w.w = cvt_pk_bf16(v1[2], v1[3]);
                        *(u32x4*)(rowp + bj * HALF) = w; } }
        }
    }
};
struct EpiMix2 {
    static constexpr bool PERM = true, AFTER_DRAIN = false;
    bf16_t* MIX;
    __device__ __forceinline__ void operator()(const f32x4 (&acc)[2][2][4][2], const Unit& u, int wr, int wc, int fr, int fq) const {
        const int which = u.pn >> 1, pm = u.pm - which * ::NPANEL;
        const int row0 = pm * BM + wr * 64 + fr, col0 = which * 1024 + (u.pn & 1) * 256 + wc * 32 + 8 * fq;
#pragma unroll
        for (int ai = 0; ai < 2; ++ai)
#pragma unroll
            for (int m = 0; m < 4; ++m) { bf16_t* rowp = MIX + (size_t)(row0 + ai * HALF + m * 16) * ::MIXW + col0;
#pragma unroll
                for (int bj = 0; bj < 2; ++bj) { const f32x4 v0 = acc[ai][bj][m][0], v1 = acc[ai][bj][m][1];
                    u32x4 w; w.x = cvt_pk_bf16(v0[0], v0[1]); w.y = cvt_pk_bf16(v0[2], v0[3]); w.z = cvt_pk_bf16(v1[0], v1[1]); w.w = cvt_pk_bf16(v1[2], v1[3]);
                    *(u32x4*)(rowp + bj * HALF) = w; } }
    }
};
struct EpiRes {
    static constexpr bool PERM = false, AFTER_DRAIN = false;
    float* X; const float* gate;
    __device__ __forceinline__ void operator()(const f32x4 (&acc)[2][2][4][2], const Unit& u, int wr, int wc, int fr, int fq) const {
        const int col0 = u.pn * BM + wc * 32 + 4 * fq;
#pragma unroll
        for (int ai = 0; ai < 2; ++ai)
#pragma unroll
            for (int m = 0; m < 4; ++m) { const int row = u.pm * BM + ai * HALF + wr * 64 + m * 16 + fr;
                const float* gp = gate + (size_t)::batch_of_row(row) * ::NMOD + col0; float* xp = X + (size_t)row * ::DM + col0;
#pragma unroll
                for (int bj = 0; bj < 2; ++bj)
#pragma unroll
                    for (int n = 0; n < 2; ++n) { const f32x4 g = *(const f32x4*)(gp + bj * HALF + n * 16); f32x4 x = *(const f32x4*)(xp + bj * HALF + n * 16);
                        x = x + g * acc[ai][bj][m][n]; *(f32x4*)(xp + bj * HALF + n * 16) = x; } }
    }
};
struct EpiSwi {
    static constexpr bool PERM = true, AFTER_DRAIN = false;
    bf16_t* HID;
    __device__ __forceinline__ void operator()(const f32x4 (&acc)[2][2][4][2], const Unit& u, int wr, int wc, int fr, int fq) const {
        const int row0 = u.pm * BM + wr * 64 + fr, col0 = 128 * u.pn + wc * 32 + 8 * fq;
#pragma unroll
        for (int ai = 0; ai < 2; ++ai)
#pragma unroll
            for (int m = 0; m < 4; ++m) { bf16_t* rowp = HID + (size_t)(row0 + ai * HALF + m * 16) * ::DFF + col0;
                const f32x4 g0 = acc[ai][0][m][0], g1 = acc[ai][0][m][1], u0 = acc[ai][1][m][0], u1 = acc[ai][1][m][1];
                u32x4 w; w.x = cvt_pk_bf16(::siluf_(g0[0]) * u0[0], ::siluf_(g0[1]) * u0[1]); w.y = cvt_pk_bf16(::siluf_(g0[2]) * u0[2], ::siluf_(g0[3]) * u0[3]);
                w.z = cvt_pk_bf16(::siluf_(g1[0]) * u1[0], ::siluf_(g1[1]) * u1[1]); w.w = cvt_pk_bf16(::siluf_(g1[2]) * u1[2], ::siluf_(g1[3]) * u1[3]);
                *(u32x4*)rowp = w; }
    }
};
struct Mix2Order {
    int G, c;
    __device__ __forceinline__ bool next(int i, Unit& u) const {
        const int L = i * G + c; if (L >= 4 * ::NPANEL) return false;
        const int which = L / (2 * ::NPANEL), rem = L % (2 * ::NPANEL);
        u.pm = which * ::NPANEL + (rem >> 1); u.pn = which * 2 + (rem & 1); return true;
    }
    __device__ __forceinline__ void a_ready(const Unit&) const {}
    __device__ __forceinline__ void done(const Unit&) const {}
};

template <class Epi, class Sched, bool ALIGN_EPI = false, bool SP2 = false>
__device__ __forceinline__ void gemm_phase(PG8_LAS unsigned char* lds, const Gemm g, const Sched& S, const Epi& E) {
    int tid_ = threadIdx.x; asm volatile("" : "+v"(tid_));
    const int tid = tid_, wid = __builtin_amdgcn_readfirstlane(tid >> 6), lane = tid & 63, wr = wid >> 2, wc = wid & 3, fr = lane & 15, fq = lane >> 4;
    const int K = g.K, nt = K / BK;
    unsigned voffA[2], voffB[2];
#pragma unroll
    for (int i = 0; i < 2; ++i) { int R, C; stage_rc(tid * 16 + i * 8192, R, C); const int Rb = Epi::PERM ? ((R & ~31) + perm32(R & 31)) : R;
        voffA[i] = (unsigned)(R * K + C) * 2u; voffB[i] = (unsigned)(Rb * K + C) * 2u; }
    const size_t kstep = (size_t)(BK * 2);
    const size_t hstep = (size_t)HALF * K * 2;
    const size_t tstep = 2 * hstep;
    const unsigned ldsw = (unsigned)wid * 1024u;
    const int aoff = lds_byte(wr * 64 + fr, fq * 8), boff = lds_byte(wc * 32 + fr, fq * 8);
#define PG8_SA(b, h) (((b) * 2 + (h)) * HTB)
#define PG8_SB(b, h) ((4 + (b) * 2 + (h)) * HTB)
#define PG8_STAGE(bufoff, gbase, voff) do { _Pragma("unroll") for (int _i = 0; _i < 2; ++_i) \
        __builtin_amdgcn_global_load_lds((const unsigned*)((const char*)(gbase) + (voff)[_i]), (PG8_LAS unsigned*)(lds + (bufoff) + ldsw + _i * 8192), 16, 0, 0); } while (0)
#define PG8_LDA(dst, b, h) do { _Pragma("unroll") for (int m = 0; m < 4; ++m) _Pragma("unroll") for (int k = 0; k < 2; ++k) dst[m][k] = *(const PG8_LAS bf16x8*)(lds + PG8_SA(b, h) + aoff + m * 2048 + k * 1024); } while (0)
#define PG8_LDB(dst, b, h) do { _Pragma("unroll") for (int n = 0; n < 2; ++n) _Pragma("unroll") for (int k = 0; k < 2; ++k) dst[n][k] = *(const PG8_LAS bf16x8*)(lds + PG8_SB(b, h) + boff + n * 2048 + k * 1024); } while (0)
#define PG8_MMA(ai, bj, At, Bt) do { __builtin_amdgcn_s_setprio(1); _Pragma("unroll") for (int m = 0; m < 4; ++m) _Pragma("unroll") for (int n = 0; n < 2; ++n) _Pragma("unroll") for (int k = 0; k < 2; ++k) \
        acc[ai][bj][m][n] = __builtin_amdgcn_mfma_f32_16x16x32_bf16(Bt[n][k], At[m][k], acc[ai][bj][m][n], 0, 0, 0); __builtin_amdgcn_s_setprio(0); } while (0)
#define PG8_WAIT_V(n) asm volatile("s_waitcnt vmcnt(" #n ")" ::: "memory")
#define PG8_WAIT_L(n) asm volatile("s_waitcnt lgkmcnt(" #n ")" ::: "memory")
#define PG8_BAR __builtin_amdgcn_s_barrier()
#define PG8_SCHED __builtin_amdgcn_sched_barrier(0)
    Unit cur, nxt; int ui = 0;
    if (!S.next(0, cur)) return;
    f32x4 acc[2][2][4][2];
#pragma unroll
    for (int a = 0; a < 2; ++a)
#pragma unroll
        for (int b = 0; b < 2; ++b)
#pragma unroll
            for (int m = 0; m < 4; ++m)
#pragma unroll
                for (int n = 0; n < 2; ++n) acc[a][b][m][n] = (f32x4){0.f, 0.f, 0.f, 0.f};
    bf16x8 At[4][2], B0[2][2], B1[2][2];
    const char* cA = (const char*)g.A + (size_t)cur.pm * tstep; const char* cB = (const char*)g.Bt + (size_t)cur.pn * tstep;
    S.a_ready(cur);
    if constexpr (SP2) {
        PG8_STAGE(PG8_SB(0, 0), cB, voffB); PG8_STAGE(PG8_SB(0, 1), cB + hstep, voffB); PG8_STAGE(PG8_SA(0, 0), cA, voffA); PG8_STAGE(PG8_SA(0, 1), cA + hstep, voffA);
        if (wr == 1) PG8_BAR;
        PG8_WAIT_V(2); PG8_BAR;
        PG8_STAGE(PG8_SB(1, 0), cB + kstep, voffB); PG8_STAGE(PG8_SA(1, 0), cA + kstep, voffA); PG8_STAGE(PG8_SB(1, 1), cB + hstep + kstep, voffB);
        PG8_WAIT_V(6); PG8_BAR;
    } else {
        PG8_STAGE(PG8_SB(0, 0), cB, voffB); PG8_STAGE(PG8_SA(0, 0), cA, voffA); PG8_STAGE(PG8_SB(0, 1), cB + hstep, voffB); PG8_STAGE(PG8_SA(0, 1), cA + hstep, voffA);
        if (wr == 1) PG8_BAR;
        PG8_WAIT_V(4); PG8_BAR;
        PG8_STAGE(PG8_SB(1, 0), cB + kstep, voffB); PG8_STAGE(PG8_SA(1, 0), cA + kstep, voffA); PG8_STAGE(PG8_SB(1, 1), cB + hstep + kstep, voffB);
        PG8_WAIT_V(6); PG8_BAR;
    }
    for (;;) {
        const bool has_next = S.next(ui + 1, nxt);
        const char* nA = has_next ? (const char*)g.A + (size_t)nxt.pm * tstep : cA; const char* nB = has_next ? (const char*)g.Bt + (size_t)nxt.pn * tstep : cB;
        for (int t = 0; t < nt; t += 2) {
            const bool last = (t == nt - 2);
            const char* a1 = cA + (size_t)(t + 1) * kstep;
            const char* a2 = last ? nA : cA + (size_t)(t + 2) * kstep; const char* b2 = last ? nB : cB + (size_t)(t + 2) * kstep;
            const char* a3 = a2 + kstep; const char* b3 = b2 + kstep;
            if (last && has_next) S.a_ready(nxt);
            if constexpr (SP2) {
            PG8_LDB(B0, 0, 0); PG8_LDB(B1, 0, 1); PG8_SCHED; PG8_LDA(At, 0, 0); PG8_STAGE(PG8_SA(1, 1), a1 + hstep, voffA);
            PG8_WAIT_V(8); PG8_WAIT_L(0); PG8_BAR; PG8_MMA(0, 0, At, B0); PG8_MMA(0, 1, At, B1); PG8_BAR; PG8_SCHED;
            PG8_LDA(At, 0, 1); PG8_STAGE(PG8_SB(0, 0), b2, voffB); PG8_STAGE(PG8_SB(0, 1), b2 + hstep, voffB); PG8_STAGE(PG8_SA(0, 0), a2, voffA);
            PG8_WAIT_V(8); PG8_WAIT_L(0); PG8_BAR; PG8_MMA(1, 0, At, B0); PG8_MMA(1, 1, At, B1); PG8_BAR; PG8_SCHED;
            PG8_LDB(B0, 1, 0); PG8_LDB(B1, 1, 1); PG8_SCHED; PG8_LDA(At, 1, 0); PG8_STAGE(PG8_SA(0, 1), a2 + hstep, voffA);
            PG8_WAIT_V(8); PG8_WAIT_L(0); PG8_BAR; PG8_MMA(0, 0, At, B0); PG8_MMA(0, 1, At, B1); PG8_BAR; PG8_SCHED;
            PG8_LDA(At, 1, 1); PG8_STAGE(PG8_SB(1, 0), b3, voffB); PG8_STAGE(PG8_SB(1, 1), b3 + hstep, voffB); PG8_STAGE(PG8_SA(1, 0), a3, voffA);
            PG8_WAIT_V(8); PG8_WAIT_L(0); PG8_BAR; PG8_MMA(1, 0, At, B0); PG8_MMA(1, 1, At, B1); PG8_BAR; PG8_SCHED;
            } else {
            PG8_LDB(B0, 0, 0); PG8_SCHED; PG8_LDA(At, 0, 0); PG8_STAGE(PG8_SA(1, 1), a1 + hstep, voffA);
            PG8_WAIT_L(8); PG8_BAR; PG8_WAIT_L(0); PG8_MMA(0, 0, At, B0); PG8_BAR; PG8_SCHED;
            PG8_LDB(B1, 0, 1); PG8_STAGE(PG8_SB(0, 0), b2, voffB);
            PG8_BAR; PG8_WAIT_L(0); PG8_MMA(0, 1, At, B1); PG8_BAR;
            PG8_LDA(At, 0, 1); PG8_STAGE(PG8_SA(0, 0), a2, voffA);
            PG8_BAR; PG8_WAIT_L(0); PG8_MMA(1, 0, At, B0); PG8_BAR; PG8_SCHED;
            PG8_STAGE(PG8_SB(0, 1), b2 + hstep, voffB);
            PG8_WAIT_V(6); PG8_BAR; PG8_MMA(1, 1, At, B1); PG8_BAR;
            PG8_LDB(B0, 1, 0); PG8_SCHED; PG8_LDA(At, 1, 0); PG8_STAGE(PG8_SA(0, 1), a2 + hstep, voffA);
            PG8_WAIT_L(8); PG8_BAR; PG8_WAIT_L(0); PG8_MMA(0, 0, At, B0); PG8_BAR; PG8_SCHED;
            PG8_LDB(B1, 1, 1); PG8_STAGE(PG8_SB(1, 0), b3, voffB);
            PG8_BAR; PG8_WAIT_L(0); PG8_MMA(0, 1, At, B1); PG8_BAR;
            PG8_LDA(At, 1, 1); PG8_STAGE(PG8_SA(1, 0), a3, voffA);
            PG8_BAR; PG8_WAIT_L(0); PG8_MMA(1, 0, At, B0); PG8_BAR; PG8_SCHED;
            PG8_STAGE(PG8_SB(1, 1), b3 + hstep, voffB);
            PG8_WAIT_V(6); PG8_BAR; PG8_MMA(1, 1, At, B1); PG8_BAR;
            }
        }
        if constexpr (ALIGN_EPI) { if (wr == 0) PG8_BAR; }
        if constexpr (!Epi::AFTER_DRAIN) { E(acc, cur, wr, wc, fr, fq); S.done(cur); }
        if (!has_next) break;
#pragma unroll
        for (int a = 0; a < 2; ++a)
#pragma unroll
            for (int b = 0; b < 2; ++b)
#pragma unroll
                for (int m = 0; m < 4; ++m)
#pragma unroll
                    for (int n = 0; n < 2; ++n) acc[a][b][m][n] = (f32x4){0.f, 0.f, 0.f, 0.f};
        cur = nxt; cA = nA; cB = nB; ++ui;
        if constexpr (ALIGN_EPI) { if (wr == 1) PG8_BAR; }
    }
    PG8_WAIT_V(0);
    if constexpr (!ALIGN_EPI) { if (wr == 0) PG8_BAR; }
    PG8_BAR;
    if constexpr (Epi::AFTER_DRAIN) { E.fused(acc, cur, wr, wc, fr, fq, lds, wid, lane); S.done(cur); }
#undef PG8_SA
#undef PG8_SB
#undef PG8_STAGE
#undef PG8_LDA
#undef PG8_LDB
#undef PG8_MMA
#undef PG8_WAIT_V
#undef PG8_WAIT_L
#undef PG8_BAR
#undef PG8_SCHED
}
}
#define XB_TMO      128
#define XB_XCNT(j)  (256  + 64 * (j))
#define XB_XSUB(j)  (1280 + 64 * (j))
#define XB_XGEN(j)  (2304 + 64 * (j))
#define XB_TOP      3328
#define XB_TOPGEN   3392
#define XCD_BAR_WORDS 3456
#define XB_SPIN_CAP (1u << 18)

__device__ __forceinline__ unsigned xb_ld(unsigned* p)              { return __hip_atomic_load(p, __ATOMIC_RELAXED, __HIP_MEMORY_SCOPE_AGENT); }
__device__ __forceinline__ unsigned xb_add(unsigned* p, unsigned v) { return __hip_atomic_fetch_add(p, v, __ATOMIC_RELAXED, __HIP_MEMORY_SCOPE_AGENT); }
__device__ __forceinline__ unsigned xb_xcc_id() { return (unsigned)__builtin_amdgcn_s_getreg((3 << 11) | 20) & 0xFu; }
#define XB_SPIN(cond, bar) do { unsigned _sp = 0; while (cond) { __builtin_amdgcn_s_sleep(1); \
    if ((++_sp & 255u) == 0u) { if (xb_ld(&(bar)[XB_TMO])) break; if (_sp > XB_SPIN_CAP) { atomicAdd(&(bar)[XB_TMO], 1u); break; } } } } while (0)

struct XcdBarrier {
    unsigned* bar; unsigned x;
    volatile LAS unsigned* st;
};

__device__ __forceinline__ XcdBarrier xcd_barrier_post(unsigned* bar, volatile LAS unsigned* st) {
    XcdBarrier b; b.bar = bar; b.x = xb_xcc_id(); b.st = st;
    if (threadIdx.x == 0) (void)xb_add(&bar[XB_XCNT(b.x)], 1u);
    return b;
}
__device__ __forceinline__ void xcd_barrier_complete(unsigned* bar, unsigned x, unsigned& nloc, unsigned& nx) {
    const unsigned G = gridDim.x * gridDim.y * gridDim.z;
    unsigned sum, cnt, mine, sp = 0u;
    for (;;) {
        sum = 0u; cnt = 0u; mine = 0u;
#pragma unroll
        for (unsigned j = 0; j < 16; ++j) { const unsigned c = xb_ld(&bar[XB_XCNT(j)]); sum += c; cnt += (c > 0u) ? 1u : 0u; mine = (j == x) ? c : mine; }
        if (sum == G) break;
        __builtin_amdgcn_s_sleep(1);
        if ((++sp & 255u) == 0u) { if (xb_ld(&bar[XB_TMO])) break; if (sp > XB_SPIN_CAP) { atomicAdd(&bar[XB_TMO], 1u); break; } }
    }
    nloc = mine > 0u ? mine : 1u; nx = cnt > 0u ? cnt : 1u;
}

__device__ __forceinline__ void xcd_barrier(const XcdBarrier& b) {
    asm volatile("s_waitcnt vmcnt(0)" ::: "memory");
    __syncthreads();
    if (threadIdx.x == 0) {
        unsigned* bar = b.bar;
        __builtin_amdgcn_s_waitcnt(0);
        unsigned nloc = b.st[0], nx = b.st[1];
        if (nloc == 0u) { xcd_barrier_complete(bar, b.x, nloc, nx); b.st[0] = nloc; b.st[1] = nx; }
        const unsigned old = xb_add(&bar[XB_XSUB(b.x)], 1u);
        const unsigned gen = old / nloc;
        if (old + 1u == (gen + 1u) * nloc) {
            __builtin_amdgcn_fence(__ATOMIC_RELEASE, "agent");
            asm volatile("s_waitcnt vmcnt(0)" ::: "memory");
            const unsigned og = xb_add(&bar[XB_TOP], 1u);
            const unsigned tg = og / nx;
            if (og + 1u == (tg + 1u) * nx) xb_add(&bar[XB_TOPGEN], 1u);
            else XB_SPIN(xb_ld(&bar[XB_TOPGEN]) == tg, bar);
            __builtin_amdgcn_fence(__ATOMIC_ACQUIRE, "agent");
            xb_add(&bar[XB_XGEN(b.x)], 1u);
            asm volatile("s_waitcnt vmcnt(0)" ::: "memory");
        } else {
            XB_SPIN(xb_ld(&bar[XB_XGEN(b.x)]) == gen, bar);
            __builtin_amdgcn_fence(__ATOMIC_ACQUIRE, "agent");
            asm volatile("s_waitcnt vmcnt(0)" ::: "memory");
        }
    }
    __syncthreads();
}
struct Args { const float* in[N_IN]; float* out; unsigned char* ws; int ph_lo, ph_hi, pad0, pad1; };
static_assert(sizeof(Args) == (N_IN + 2) * 8 + 16, "Args has no padding");
struct DevArgs { const GAS float* in[N_IN]; GAS float* out; GAS unsigned char* ws; int ph_lo, ph_hi, pad0, pad1; };
static_assert(sizeof(DevArgs) == sizeof(Args), "DevArgs mirrors Args");
typedef const __attribute__((address_space(4))) DevArgs* KArgs;
#define INP(i) ((const float*)F.ka->in[i])
struct Frame {
    LAS unsigned char* lds;
    int tid, lane, wave, vcu, G;
    KArgs ka;
    float* out; unsigned char* ws;
};
__device__ __forceinline__ const float* modp(const Frame& F, int layer) { return (const float*)(F.ws + WS_MOD) + (size_t)layer * 12 * NMOD; }
__device__ __forceinline__ unsigned char* lw(const Frame& F, int layer) { return F.ws + WS_W + (size_t)layer * LW; }

__device__ __forceinline__ void transpose_item(const float* W, int K, int N, bf16* WT, int k0, int n0, int orow0, LAS float* scr, int lane) {
#pragma unroll 8
    for (int i = 0; i < 32; ++i) { const int kk = 2 * i + (lane >> 5); scr[kk * 33 + (lane & 31)] = W[(size_t)(k0 + kk) * N + n0 + (lane & 31)]; }
    LDS_WAIT(); asm volatile("" ::: "memory");
    const int c = lane & 7;
#pragma unroll
    for (int j = 0; j < 4; ++j) { const int n = (lane >> 3) + 8 * j; const LAS float* s = scr + (8 * c) * 33 + n;
        v4u o; o.x = pk2(s[0 * 33], s[1 * 33]); o.y = pk2(s[2 * 33], s[3 * 33]); o.z = pk2(s[4 * 33], s[5 * 33]); o.w = pk2(s[6 * 33], s[7 * 33]);
        *(GAS v4u*)(WT + (size_t)(orow0 + n) * K + k0 + 8 * c) = o; }
    LDS_WAIT(); asm volatile("" ::: "memory");
}
__device__ __forceinline__ void p0a_phase(Frame& F) {
    const int gw = F.vcu * NWAVES + F.wave, NGW = F.G * NWAVES, gt = F.vcu * (NWAVES * 64) + F.tid, NGT = F.G * NWAVES * 64;
    {
        LAS float* sil = (LAS float*)F.lds;
        for (int i = F.tid; i < 12 * DM; i += NWAVES * 64) { const int b = i / DM, k = i % DM;
            const float c = b < NBP ? INP(I_CP)[b * DM + k] : INP(I_CS)[(b - NBP) * DM + k]; sil[k * 12 + b] = siluf_(c); }
        __syncthreads();
        constexpr int KC = DM / KSPLIT, NCB = NMOD / 256;
        float* part = (float*)(F.ws + WS_MODP);
        for (int it = gw; it < NL * KSPLIT * NCB; it += NGW) {
            const int l = it / (KSPLIT * NCB), ks = (it / NCB) % KSPLIT, cb = it % NCB, col = cb * 256 + 4 * F.lane;
            const GAS f32x4* wp = (const GAS f32x4*)(INP(I_ADAW) + ((size_t)l * DM + ks * KC) * NMOD + col);
            f32x4 acc[12];
#pragma unroll
            for (int b = 0; b < 12; ++b) acc[b] = (f32x4){0.f, 0.f, 0.f, 0.f};
#pragma unroll 4
            for (int k = 0; k < KC; ++k) { const f32x4 wv = wp[(size_t)k * (NMOD / 4)];
                const LAS f32x4* sp = (const LAS f32x4*)(sil + (ks * KC + k) * 12); const f32x4 s0 = sp[0], s1 = sp[1], s2 = sp[2];
                acc[0] += wv * s0[0]; acc[1] += wv * s0[1]; acc[2] += wv * s0[2]; acc[3] += wv * s0[3];
                acc[4] += wv * s1[0]; acc[5] += wv * s1[1]; acc[6] += wv * s1[2]; acc[7] += wv * s1[3];
                acc[8] += wv * s2[0]; acc[9] += wv * s2[1]; acc[10] += wv * s2[2]; acc[11] += wv * s2[3]; }
#pragma unroll
            for (int b = 0; b < 12; ++b) *(GAS f32x4*)(part + (((size_t)ks * NL + l) * 12 + b) * NMOD + col) = acc[b];
        }
        __syncthreads();
    }
    {
        LAS float* scr = (LAS float*)(F.lds + F.wave * 16384);
        constexpr int I_IN = (DM / 64) * (DIN / 32), I_OUT = (DM / 64) * (DM / 32), I_G = (DM / 64) * (DFF / 32), I_D = (DFF / 64) * (DM / 32), I_C = (DC / 64) * (DC / 32);
        constexpr int PER_L = I_IN + I_OUT + 2 * I_G + I_D + I_C;
        for (int it = gw; it < NL * PER_L; it += NGW) {
            const int l = it / PER_L; int r = it % PER_L; unsigned char* wl = lw(F, l);
            if (r < I_IN) { const int nblk = DIN / 32, k0 = 64 * (r / nblk), n0 = 32 * (r % nblk);
                int orow0 = n0; if (n0 < 512) orow0 = 256 * (n0 >> 7) + (n0 & 127); else if (n0 < 1024) orow0 = 256 * ((n0 - 512) >> 7) + 128 + (n0 & 127);
                transpose_item(INP(I_WIN) + (size_t)l * DM * DIN, DM, DIN, (bf16*)(wl + LW_WIN), k0, n0, orow0, scr, F.lane); continue; } r -= I_IN;
            if (r < I_OUT) { const int nblk = DM / 32, k0 = 64 * (r / nblk), n0 = 32 * (r % nblk);
                transpose_item(INP(I_WOUT) + (size_t)l * DM * DM, DM, DM, (bf16*)(wl + LW_WOUT), k0, n0, n0, scr, F.lane); continue; } r -= I_OUT;
            if (r < 2 * I_G) { const int up = r >= I_G; if (up) r -= I_G; const int nblk = DFF / 32, k0 = 64 * (r / nblk), n0 = 32 * (r % nblk);
                const int orow0 = 256 * (n0 >> 7) + 128 * up + (n0 & 127);
                transpose_item(INP(up ? I_WU : I_WG) + (size_t)l * DM * DFF, DM, DFF, (bf16*)(wl + LW_WGU), k0, n0, orow0, scr, F.lane); continue; } r -= 2 * I_G;
            if (r < I_D) { const int nblk = DM / 32, k0 = 64 * (r / nblk), n0 = 32 * (r % nblk);
                transpose_item(INP(I_WD) + (size_t)l * DFF * DM, DFF, DM, (bf16*)(wl + LW_WD), k0, n0, n0, scr, F.lane); continue; } r -= I_D;
            { const int nblk = DC / 32, k0 = 64 * (r / nblk), n0 = 32 * (r % nblk);
                transpose_item(INP(I_CPW) + (size_t)l * DC * DC, DC, DC, (bf16*)(wl + LW_CPW), k0, n0, n0, scr, F.lane); }
        }
        for (int i = gt; i < NL * DC * DC; i += NGT) { const int l = i / (DC * DC), n = (i / DC) % DC, k = i % DC; float v = 0.f;
            if ((n >> 7) == (k >> 7)) v = INP(I_POOLW)[(((size_t)l * 4 + (n >> 7)) * 128 + (k & 127)) * 128 + (n & 127)] * INP(I_POOLS)[l * DC + n];
            ((bf16*)(lw(F, l) + LW_PWD))[n * DC + k] = (bf16)(pk2(v, 0.f) & 0xffffu); }
        for (int i = gt; i < NL * 4 * 128 * 128; i += NGT) { const int l = i / 65536, r = i % 65536, ii = (r >> 7) & 127, jj = r & 127;
            const float v = (jj <= ii) ? INP(I_SGW)[i] : 0.f; ((bf16*)(lw(F, l) + LW_SGW))[r] = (bf16)(pk2(v, 0.f) & 0xffffu); }
    }
}
__device__ __forceinline__ void p0b_phase(Frame& F) {
    const int gt = F.vcu * (NWAVES * 64) + F.tid, NGT = F.G * NWAVES * 64;
    const float* part = (const float*)(F.ws + WS_MODP); float* mod = (float*)(F.ws + WS_MOD);
    for (int i = gt; i < NL * 12 * NMOD; i += NGT) { const int l = i / (12 * NMOD), n = i % NMOD; float s = INP(I_ADAB)[l * NMOD + n];
#pragma unroll
        for (int ks = 0; ks < KSPLIT; ++ks) s += part[(size_t)ks * NL * 12 * NMOD + i];
        mod[i] = s; }
}
template <bool COPY>
__device__ __forceinline__ void norm_phase(Frame& F, const float* gain, const float* mod_l, int sh_idx, bf16* H) {
    const int gw = F.vcu * NWAVES + F.wave, NGW = F.G * NWAVES;
    float* X = F.out;
    for (int m = gw; m < MT; m += NGW) {
        const float* src = COPY ? (m < MP ? INP(I_XP) + (size_t)m * DM : INP(I_XS) + (size_t)(m - MP) * DM) : X + (size_t)m * DM;
        const GAS f32x4* xr = (const GAS f32x4*)src + F.lane;
        f32x4 v[8]; float s = 0.f;
#pragma unroll
        for (int j = 0; j < 8; ++j) { v[j] = xr[64 * j]; s += (v[j].x * v[j].x + v[j].y * v[j].y) + (v[j].z * v[j].z + v[j].w * v[j].w); }
        if (COPY) { GAS f32x4* xo = (GAS f32x4*)(X + (size_t)m * DM) + F.lane;
#pragma unroll
            for (int j = 0; j < 8; ++j) xo[64 * j] = v[j]; }
        const float rstd = 1.0f / sqrtf(wave_sum(s) * (1.0f / DM) + EPS);
        const float* mb = mod_l + (size_t)batch_of_row(m) * NMOD;
        const GAS f32x4* shp = (const GAS f32x4*)(mb + sh_idx * DM) + F.lane; const GAS f32x4* scp = (const GAS f32x4*)(mb + (sh_idx + 1) * DM) + F.lane;
        const GAS f32x4* gp = (const GAS f32x4*)gain + F.lane;
        GAS v2u* o8 = (GAS v2u*)(H + (size_t)m * DM) + F.lane;
#pragma unroll
        for (int j = 0; j < 8; ++j) { const f32x4 g = gp[64 * j], sc = scp[64 * j], sh = shp[64 * j];
            const f32x4 y = v[j] * rstd * g * (sc + 1.0f) + sh; v2u w; w.x = pk2(y.x, y.y); w.y = pk2(y.z, y.w); o8[64 * j] = w; }
    }
}
__device__ __forceinline__ void final_norm_phase(Frame& F) {
    const int gw = F.vcu * NWAVES + F.wave, NGW = F.G * NWAVES;
    for (int m = gw; m < MT; m += NGW) {
        GAS f32x4* xr = (GAS f32x4*)(F.out + (size_t)m * DM) + F.lane;
        f32x4 v[8]; float s = 0.f;
#pragma unroll
        for (int j = 0; j < 8; ++j) { v[j] = xr[64 * j]; s += (v[j].x * v[j].x + v[j].y * v[j].y) + (v[j].z * v[j].z + v[j].w * v[j].w); }
        const float rstd = 1.0f / sqrtf(wave_sum(s) * (1.0f / DM) + EPS);
        const GAS f32x4* gp = (const GAS f32x4*)INP(I_FING) + F.lane;
#pragma unroll
        for (int j = 0; j < 8; ++j) xr[64 * j] = v[j] * rstd * gp[64 * j];
    }
}

__device__ __forceinline__ int crow(int r, int hi) { return (r & 3) + 8 * (r >> 2) + 4 * hi; }
#define MFMA32(a, b, c) __builtin_amdgcn_mfma_f32_32x32x16_bf16((a), (b), (c), 0, 0, 0)
constexpr int AT_KS = 0, AT_VT = 9216, AT_BT = 18432, AT_PITCH = 144;
__device__ __forceinline__ void attn_unit(Frame& F, int layer, bool sample, int b, int h, int qg, const bf16* Z, bf16* MIX) {
    const int tid = F.tid, lane = F.lane, w = F.wave, l31 = lane & 31, hh = lane >> 5;
    LAS unsigned char* Ks = F.lds + AT_KS; LAS unsigned char* VTs = F.lds + AT_VT; LAS float* bt = (LAS float*)(F.lds + AT_BT);
    if (tid < 257) bt[tid] = INP(I_RELB)[((size_t)layer * 8 + h) * 257 + tid] * LOG2E;
    const bool wave_on = sample ? (w == 0) : true;
    const int qpos = sample ? l31 : 256 * qg + 32 * w + l31;
    const int qrow = sample ? MP + 32 * b + l31 : b * SEQ + qpos;
    bf16x8 qr[4];
#pragma unroll
    for (int d0 = 0; d0 < 4; ++d0) qr[d0] = *(const GAS bf16x8*)(Z + (size_t)qrow * ZW + ZQ + 64 * h + 16 * d0 + 8 * hh);
    f32x16 o0, o1;
#pragma unroll
    for (int r = 0; r < 16; ++r) { o0[r] = 0.f; o1[r] = 0.f; }
    float mrun = -1e30f, lrun = 0.f;
    const int ntile = sample ? 9 : 12, qc = 4 * qg + (w >> 1);
    const int sr = tid >> 3, sch = tid & 7;
    const float* ck = INP(I_CK) + ((size_t)layer * NBS + b) * 512 * 512; const float* cv = INP(I_CV) + ((size_t)layer * NBS + b) * 512 * 512;
    v4u kreg = (v4u){0u, 0u, 0u, 0u}, vreg = (v4u){0u, 0u, 0u, 0u};
#define AT_LOAD(j) do { \
        if (!sample) { const int kc_ = 4 * qg - 8 + (j); if (kc_ >= 0) { const bf16* zr_ = Z + (size_t)(b * SEQ + 64 * kc_ + sr) * ZW + 64 * h + 8 * sch; \
                kreg = *(const GAS v4u*)(zr_ + ZK); vreg = *(const GAS v4u*)(zr_ + ZV); } } \
        else if ((j) < 8) { const size_t o_ = ((size_t)(64 * (j) + sr) * 8 + h) * 64 + 8 * sch; \
                const f32x4 k0_ = *(const GAS f32x4*)(ck + o_), k1_ = *(const GAS f32x4*)(ck + o_ + 4), v0_ = *(const GAS f32x4*)(cv + o_), v1_ = *(const GAS f32x4*)(cv + o_ + 4); \
                kreg = (v4u){pk2(k0_.x, k0_.y), pk2(k0_.z, k0_.w), pk2(k1_.x, k1_.y), pk2(k1_.z, k1_.w)}; vreg = (v4u){pk2(v0_.x, v0_.y), pk2(v0_.z, v0_.w), pk2(v1_.x, v1_.y), pk2(v1_.z, v1_.w)}; } \
        else if (sr < 32) { const bf16* zr_ = Z + (size_t)(MP + 32 * b + sr) * ZW + 64 * h + 8 * sch; kreg = *(const GAS v4u*)(zr_ + ZK); vreg = *(const GAS v4u*)(zr_ + ZV); } \
        else { kreg = (v4u){0u, 0u, 0u, 0u}; vreg = (v4u){0u, 0u, 0u, 0u}; } } while (0)
    AT_LOAD(0);
    for (int j = 0; j < ntile; ++j) {
        const int kc = 4 * qg - 8 + j;
        if (!sample && kc < 0) { AT_LOAD(j + 1); continue; }
        *(LAS v4u*)(Ks + sr * AT_PITCH + sch * 16) = kreg;
        { LAS bf16* vt = (LAS bf16*)VTs + (8 * sch) * (AT_PITCH / 2) + sr;
          vt[0 * (AT_PITCH / 2)] = (bf16)(vreg.x & 0xffffu); vt[1 * (AT_PITCH / 2)] = (bf16)(vreg.x >> 16); vt[2 * (AT_PITCH / 2)] = (bf16)(vreg.y & 0xffffu); vt[3 * (AT_PITCH / 2)] = (bf16)(vreg.y >> 16);
          vt[4 * (AT_PITCH / 2)] = (bf16)(vreg.z & 0xffffu); vt[5 * (AT_PITCH / 2)] = (bf16)(vreg.z >> 16); vt[6 * (AT_PITCH / 2)] = (bf16)(vreg.w & 0xffffu); vt[7 * (AT_PITCH / 2)] = (bf16)(vreg.w >> 16); }
        __syncthreads();
        if (j + 1 < ntile) AT_LOAD(j + 1);
        const bool active = sample ? (w == 0) : (kc >= qc - 8 && kc <= qc);
        if (active) {
            f32x16 p0, p1;
#pragma unroll
            for (int r = 0; r < 16; ++r) { p0[r] = 0.f; p1[r] = 0.f; }
#pragma unroll
            for (int d0 = 0; d0 < 4; ++d0) {
                const bf16x8 a0 = *(const LAS bf16x8*)(Ks + l31 * AT_PITCH + (16 * d0 + 8 * hh) * 2);
                const bf16x8 a1 = *(const LAS bf16x8*)(Ks + (32 + l31) * AT_PITCH + (16 * d0 + 8 * hh) * 2);
                p0 = MFMA32(a0, qr[d0], p0); p1 = MFMA32(a1, qr[d0], p1);
            }
            const int kbase = sample ? 64 * j - 512 : 64 * kc;
            const int relb = kbase - qpos;
            const int qmin = sample ? 0 : 256 * qg + 32 * w;
            if (kbase + 63 - qmin <= -128) { const float b0 = bt[0];
#pragma unroll
                for (int r = 0; r < 16; ++r) { p0[r] += b0; p1[r] += b0; }
            } else {
#pragma unroll
                for (int r = 0; r < 16; ++r) { const int kv = crow(r, hh); int i0 = relb + kv, i1 = i0 + 32;
                    i0 = (i0 < -128 ? -128 : (i0 > 128 ? 128 : i0)) + 128; i1 = (i1 < -128 ? -128 : (i1 > 128 ? 128 : i1)) + 128;
                    p0[r] += bt[i0]; p1[r] += bt[i1]; }
            }
            if (sample && j == 8) {
#pragma unroll
                for (int r = 0; r < 16; ++r) p1[r] = -1e30f;
            }
            float mx = p0[0];
#pragma unroll
            for (int r = 1; r < 16; ++r) mx = fmaxf(mx, p0[r]);
#pragma unroll
            for (int r = 0; r < 16; ++r) mx = fmaxf(mx, p1[r]);
            mx = fmaxf(mx, __shfl_xor(mx, 32));
            const float mn = fmaxf(mrun, mx), alpha = fast_exp2(mrun - mn); mrun = mn;
            float rs = 0.f;
#pragma unroll
            for (int r = 0; r < 16; ++r) { p0[r] = fast_exp2(p0[r] - mn); p1[r] = fast_exp2(p1[r] - mn); rs += p0[r] + p1[r]; }
            rs += __shfl_xor(rs, 32);
            lrun = lrun * alpha + rs;
#pragma unroll
            for (int r = 0; r < 16; ++r) { o0[r] *= alpha; o1[r] *= alpha; }
            bf16x8 pf[4];
            { v4u t;
              t = (v4u){pk2(p0[0], p0[1]), pk2(p0[2], p0[3]), pk2(p0[4], p0[5]), pk2(p0[6], p0[7])}; pf[0] = __builtin_bit_cast(bf16x8, t);
              t = (v4u){pk2(p0[8], p0[9]), pk2(p0[10], p0[11]), pk2(p0[12], p0[13]), pk2(p0[14], p0[15])}; pf[1] = __builtin_bit_cast(bf16x8, t);
              t = (v4u){pk2(p1[0], p1[1]), pk2(p1[2], p1[3]), pk2(p1[4], p1[5]), pk2(p1[6], p1[7])}; pf[2] = __builtin_bit_cast(bf16x8, t);
              t = (v4u){pk2(p1[8], p1[9]), pk2(p1[10], p1[11]), pk2(p1[12], p1[13]), pk2(p1[14], p1[15])}; pf[3] = __builtin_bit_cast(bf16x8, t); }
#pragma unroll
            for (int xt = 0; xt < 2; ++xt)
#pragma unroll
                for (int s = 0; s < 2; ++s) { const int kvo = 32 * xt + 16 * s + 4 * hh;
                    const v2u lo0 = *(const LAS v2u*)(VTs + l31 * AT_PITCH + kvo * 2), hi0 = *(const LAS v2u*)(VTs + l31 * AT_PITCH + (kvo + 8) * 2);
                    const v2u lo1 = *(const LAS v2u*)(VTs + (32 + l31) * AT_PITCH + kvo * 2), hi1 = *(const LAS v2u*)(VTs + (32 + l31) * AT_PITCH + (kvo + 8) * 2);
                    const v4u f0 = (v4u){lo0.x, lo0.y, hi0.x, hi0.y}, f1 = (v4u){lo1.x, lo1.y, hi1.x, hi1.y};
                    o0 = MFMA32(__builtin_bit_cast(bf16x8, f0), pf[2 * xt + s], o0); o1 = MFMA32(__builtin_bit_cast(bf16x8, f1), pf[2 * xt + s], o1); }
        }
        __syncthreads();
    }
#undef AT_LOAD
    if (wave_on) {
        const float inv = 1.0f / lrun;
        bf16* orow = MIX + (size_t)qrow * MIXW + MIX_B + 64 * h;
#pragma unroll
        for (int g4 = 0; g4 < 4; ++g4) { const int d = 8 * g4 + 4 * hh;
            v2u w0; w0.x = pk2(o0[4 * g4] * inv, o0[4 * g4 + 1] * inv); w0.y = pk2(o0[4 * g4 + 2] * inv, o0[4 * g4 + 3] * inv); *(GAS v2u*)(orow + d) = w0;
            v2u w1; w1.x = pk2(o1[4 * g4] * inv, o1[4 * g4 + 1] * inv); w1.y = pk2(o1[4 * g4 + 2] * inv, o1[4 * g4 + 3] * inv); *(GAS v2u*)(orow + 32 + d) = w1; }
    }
}
constexpr int SG_PITCH = 272;
__device__ __forceinline__ void sg_unit(Frame& F, int layer, int ci, int g, const bf16* Z, bf16* MIX) {
    const int lane = F.lane, w = F.wave, l31 = lane & 31, hh = lane >> 5;
    const bool sample = ci >= MP / 128; const int L = sample ? 32 : 128, row0 = sample ? MP + 32 * (ci - MP / 128) : 128 * ci;
    LAS unsigned char* VNT = F.lds;
    {
        const int c8 = 8 * lane;
        const GAS f32x4* lgp = (const GAS f32x4*)(INP(I_SGG) + layer * DC + c8); const GAS f32x4* lbp = (const GAS f32x4*)(INP(I_SGB) + layer * DC + c8);
        const f32x4 lg0 = lgp[0], lg1 = lgp[1], lb0 = lbp[0], lb1 = lbp[1];
        const int nrw = L / 8;
        for (int i = 0; i < nrw; ++i) { const int rr = w * nrw + i;
            const v4u zv = *(const GAS v4u*)(Z + (size_t)(row0 + rr) * ZW + ZSV + c8);
            float x[8] = {bflo(zv.x), bfhi(zv.x), bflo(zv.y), bfhi(zv.y), bflo(zv.z), bfhi(zv.z), bflo(zv.w), bfhi(zv.w)};
            float s = ((x[0] + x[1]) + (x[2] + x[3])) + ((x[4] + x[5]) + (x[6] + x[7]));
            const float mean = wave_sum(s) * (1.0f / DC); float q = 0.f;
#pragma unroll
            for (int e = 0; e < 8; ++e) { x[e] -= mean; q += x[e] * x[e]; }
            const float rstd = 1.0f / sqrtf(wave_sum(q) * (1.0f / DC) + EPS);
            float y[8];
            y[0] = x[0] * rstd * lg0.x + lb0.x; y[1] = x[1] * rstd * lg0.y + lb0.y; y[2] = x[2] * rstd * lg0.z + lb0.z; y[3] = x[3] * rstd * lg0.w + lb0.w;
            y[4] = x[4] * rstd * lg1.x + lb1.x; y[5] = x[5] * rstd * lg1.y + lb1.y; y[6] = x[6] * rstd * lg1.z + lb1.z; y[7] = x[7] * rstd * lg1.w + lb1.w;
            if ((lane >> 4) == g) {
                LAS bf16* vt = (LAS bf16*)VNT + (8 * (lane & 15)) * (SG_PITCH / 2) + rr;
#pragma unroll
                for (int e = 0; e < 8; ++e) vt[e * (SG_PITCH / 2)] = (bf16)(pk2(y[e], 0.f) & 0xffffu);
                if (sample) { float* so = F.out + O_SGV + (((size_t)layer * NBS + (ci - MP / 128)) * TS + rr) * DC + c8;
                    *(GAS f32x4*)so = (f32x4){y[0], y[1], y[2], y[3]}; *(GAS f32x4*)(so + 4) = (f32x4){y[4], y[5], y[6], y[7]}; }
            }
        }
    }
    __syncthreads();
    {
        const int cb = w & 3, ih = w >> 2;
        const bf16* Wg = (const bf16*)(lw(F, layer) + LW_SGW) + (size_t)g * 128 * 128;
#pragma unroll
        for (int ibb = 0; ibb < 2; ++ibb) { const int ib = 2 * ih + ibb;
            if (32 * ib < L) {
                const int jmax = (32 * (ib + 1) < L) ? 32 * (ib + 1) : L, nks = jmax / 16;
                f32x16 acc;
#pragma unroll
                for (int r = 0; r < 16; ++r) acc[r] = 0.f;
                for (int s = 0; s < nks; ++s) {
                    const bf16x8 a = *(const LAS bf16x8*)(VNT + (32 * cb + l31) * SG_PITCH + (16 * s + 8 * hh) * 2);
                    const bf16x8 bb = *(const GAS bf16x8*)(Wg + (size_t)(32 * ib + l31) * 128 + 16 * s + 8 * hh);
                    acc = MFMA32(a, bb, acc);
                }
                const int i = 32 * ib + l31, row = row0 + i; const float bias = INP(I_SGBIAS)[((size_t)layer * 4 + g) * 128 + i];
#pragma unroll
                for (int rg = 0; rg < 4; ++rg) { const int c4 = 32 * cb + 8 * rg + 4 * hh;
                    const v2u zu = *(const GAS v2u*)(Z + (size_t)row * ZW + ZSU + 128 * g + c4);
                    v2u o; o.x = pk2(bflo(zu.x) * (acc[4 * rg] + bias), bfhi(zu.x) * (acc[4 * rg + 1] + bias)); o.y = pk2(bflo(zu.y) * (acc[4 * rg + 2] + bias), bfhi(zu.y) * (acc[4 * rg + 3] + bias));
                    *(GAS v2u*)(MIX + (size_t)row * MIXW + MIX_D + 128 * g + c4) = o; }
            }
        }
    }
    __syncthreads();
}
__device__ __forceinline__ void conv_unit(Frame& F, int layer, int tb, int cg, const bf16* Z, bf16* CA) {
    const int c = 64 * cg + F.lane; const bool sample = tb >= MP / 32; const int sb = tb - MP / 32;
    const int r0 = sample ? MP + 32 * sb : 32 * tb; const bool first = !sample && ((r0 & (SEQ - 1)) == 0);
    float wt[31];
#pragma unroll
    for (int j = 0; j < 31; ++j) wt[j] = INP(I_CONVW)[((size_t)layer * 31 + j) * DC + c];
    const float cbias = INP(I_CONVB)[layer * DC + c], gg = INP(I_GNG)[layer * DC + c], gb = INP(I_GNB)[layer * DC + c];
    float acc[32];
#pragma unroll
    for (int t = 0; t < 32; ++t) acc[t] = cbias;
    const float* hist = INP(I_CCONV) + ((size_t)layer * NBS + (sample ? sb : 0)) * 30 * DC + c;
#pragma unroll
    for (int e = 0; e < 62; ++e) {
        float v;
        if (e < 30) { if (sample) v = hist[(size_t)e * DC]; else v = first ? 0.f : bf2f(Z[(size_t)(r0 - 30 + e) * ZW + ZU + c]); }
        else v = bf2f(Z[(size_t)(r0 + e - 30) * ZW + ZU + c]);
#pragma unroll
        for (int t = 0; t < 32; ++t) { if (e - t >= 0 && e - t <= 30) acc[t] += wt[e - t] * v; }
        if (e >= 30) { const int tt = e - 30;
            if (sample) { if (tt >= 2) F.out[O_CONVS + (((size_t)layer * NBS + sb) * 30 + (tt - 2)) * DC + c] = v; }
            else if ((r0 & (SEQ - 1)) == SEQ - 32) { if (tt >= 2) F.out[O_CONVP + (((size_t)layer * NBP + (r0 >> 13)) * 30 + (tt - 2)) * DC + c] = v; } }
    }
#pragma unroll
    for (int t = 0; t < 32; ++t) {
        const float mean = wave_sum(acc[t]) * (1.0f / 64.0f), d = acc[t] - mean;
        const float rstd = 1.0f / sqrtf(wave_sum(d * d) * (1.0f / 64.0f) + EPS);
        const float y = d * rstd * gg + gb;
        CA[(size_t)(r0 + t) * DC + c] = (bf16)(pk2(siluf_(y), 0.f) & 0xffffu);
    }
}
template <int W>
__device__ __forceinline__ void pool_body(Frame& F, int layer, int tb, int cg, const bf16* Z, bf16* PM) {
    const int c = 64 * cg + F.lane; const bool sample = tb >= MP / 32; const int sb = tb - MP / 32;
    const int r0 = sample ? MP + 32 * sb : 32 * tb; const bool first = !sample && ((r0 & (SEQ - 1)) == 0);
    const float* hist = INP(I_CPOOL) + ((size_t)layer * NBS + (sample ? sb : 0)) * 15 * DC + c;
    float ext[47];
#pragma unroll
    for (int e = 0; e < 47; ++e) {
        if (e < 15) { if (sample) ext[e] = hist[(size_t)e * DC]; else ext[e] = first ? 0.f : bf2f(Z[(size_t)(r0 - 15 + e) * ZW + ZP + c]); }
        else ext[e] = bf2f(Z[(size_t)(r0 + e - 15) * ZW + ZP + c]);
    }
#pragma unroll
    for (int t = 0; t < 32; ++t) {
        float win = 0.f;
#pragma unroll
        for (int i = W - 1; i >= 0; --i) win += ext[15 + t - i];
        const int cnt = (first && t + 1 < W) ? t + 1 : W;
        PM[(size_t)(r0 + t) * DC + c] = (bf16)(pk2(win / (float)cnt - ext[15 + t], 0.f) & 0xffffu);
        if (sample) { if (t >= 17) F.out[O_POOLS + (((size_t)layer * NBS + sb) * 15 + (t - 17)) * DC + c] = ext[15 + t]; }
        else if ((r0 & (SEQ - 1)) == SEQ - 32) { if (t >= 17) F.out[O_POOLP + (((size_t)layer * NBP + (r0 >> 13)) * 15 + (t - 17)) * DC + c] = ext[15 + t]; }
    }
}
__device__ __forceinline__ void mixer_phase(Frame& F, int layer) {
    const bf16* Z = (const bf16*)(F.ws + WS_Z); bf16* MIX = (bf16*)(F.ws + WS_MIX); bf16* CA = (bf16*)(F.ws + WS_CAPM); bf16* PM = CA + (size_t)MT * DC;
    for (int id = F.vcu; id < NBP * 8 * 32; id += F.G) attn_unit(F, layer, false, id >> 8, (id >> 5) & 7, id & 31, Z, MIX);
    for (int id = F.vcu; id < NBS * 8; id += F.G) attn_unit(F, layer, true, id >> 3, id & 7, 0, Z, MIX);
    for (int id = F.vcu; id < (MP / 128 + NBS) * 4; id += F.G) sg_unit(F, layer, id >> 2, id & 3, Z, MIX);
    const int gw = F.vcu * NWAVES + F.wave, NGW = F.G * NWAVES;
    for (int id = gw; id < (MT / 32) * 8; id += NGW) conv_unit(F, layer, id >> 3, id & 7, Z, CA);
    for (int id = gw; id < (MT / 32) * 8; id += NGW) { const int tb = id >> 3, cg = id & 7;
        switch (cg >> 1) { case 0: pool_body<2>(F, layer, tb, cg, Z, PM); break; case 1: pool_body<4>(F, layer, tb, cg, Z, PM); break;
                           case 2: pool_body<8>(F, layer, tb, cg, Z, PM); break; default: pool_body<16>(F, layer, tb, cg, Z, PM); break; } }
    const int gt = F.vcu * (NWAVES * 64) + F.tid, NGT = F.G * NWAVES * 64;
    for (int i = gt; i < (NBP * 512 + NBS * TS) * 128; i += NGT) {
        const int rr = i >> 7, kv = (i >> 6) & 1, ch = i & 63;
        int zrow; size_t o;
        if (rr < NBP * 512) { const int b = rr >> 9, t = rr & 511; zrow = b * SEQ + SEQ - 512 + t; o = (kv ? O_VP : O_KP) + (((size_t)layer * NBP + b) * 512 + t) * 512 + 8 * ch; }
        else { const int r2 = rr - NBP * 512, b = r2 >> 5, t = r2 & 31; zrow = MP + r2; o = (kv ? O_VS : O_KS) + (((size_t)layer * NBS + b) * TS + t) * 512 + 8 * ch; }
        const v4u z = *(const GAS v4u*)(Z + (size_t)zrow * ZW + (kv ? ZV : ZK) + 8 * ch);
        *(GAS f32x4*)(F.out + o) = (f32x4){bflo(z.x), bfhi(z.x), bflo(z.y), bfhi(z.y)}; *(GAS f32x4*)(F.out + o + 4) = (f32x4){bflo(z.z), bfhi(z.z), bflo(z.w), bfhi(z.w)};
    }
}

constexpr int N_PHASES = 2 + 8 * NL + 1;

__global__ void __launch_bounds__(NWAVES * 64, 2) enc_fwd(Args args) {
    extern __shared__ __attribute__((aligned(16))) unsigned char lds[];
    Frame F;
    F.lds = (LAS unsigned char*)lds;
    F.tid = threadIdx.x; F.lane = F.tid & 63; F.wave = __builtin_amdgcn_readfirstlane(F.tid >> 6);
    F.G = gridDim.x; { const int bx = blockIdx.x; F.vcu = (F.G % 8 == 0) ? (bx % 8) * (F.G / 8) + bx / 8 : bx; }
    F.ka = (KArgs)__builtin_amdgcn_kernarg_segment_ptr();
    F.out = args.out; F.ws = args.ws;
    volatile LAS unsigned* MISC = (volatile LAS unsigned*)(F.lds + MISC_OFF);
    for (int u = F.tid; u < (LDS_BYTES - LDSCTL_OFF) / 4; u += NWAVES * 64) ((LAS unsigned*)(F.lds + LDSCTL_OFF))[u] = 0u;
    __syncthreads();
    const int lo = args.ph_lo, hi = args.ph_hi;
#define REFRESH() do { int t_ = threadIdx.x; asm volatile("" : "+v"(t_)); F.tid = t_; F.lane = t_ & 63; F.wave = __builtin_amdgcn_readfirstlane(t_ >> 6); \
        unsigned long long w_ = (unsigned long long)args.ws, o_ = (unsigned long long)args.out, k_ = (unsigned long long)__builtin_amdgcn_kernarg_segment_ptr(); \
        asm volatile("" : "+s"(w_), "+s"(o_), "+s"(k_)); F.ws = (unsigned char*)(GAS unsigned char*)w_; F.out = (float*)(GAS float*)o_; F.ka = (KArgs)k_; \
        unsigned l_ = (unsigned)(unsigned long long)(LAS unsigned char*)lds; asm volatile("" : "+s"(l_)); F.lds = (LAS unsigned char*)(unsigned long long)l_; } while (0)
    XcdBarrier bar; bar.bar = (unsigned*)(F.ws + WS_CTL) + CW_BAR; bar.x = 0; bar.st = nullptr;
    if (hi - lo > 1) bar = xcd_barrier_post((unsigned*)(F.ws + WS_CTL) + CW_BAR, MISC + 8);
#ifdef ONLY_PHASE
#define IN(k) ((((k) < 2 || (k) == N_PHASES - 1) ? (k) : 2 + ((k) - 2) % 8) == ONLY_PHASE && lo <= (k) && (k) < hi)
#else
#define IN(k) (lo <= (k) && (k) < hi)
#endif
#define SEAM(k) do { if (IN(k) && IN((k) + 1)) { XcdBarrier b_ = bar; unsigned long long p_ = (unsigned long long)b_.bar; asm volatile("" : "+s"(p_)); b_.bar = (unsigned*)p_; xcd_barrier(b_); } } while (0)

    if (IN(0)) { REFRESH(); p0a_phase(F); } SEAM(0);
    if (IN(1)) { REFRESH(); p0b_phase(F); } SEAM(1);
    for (int l = 0; l < NL; ++l) {
        const int pb = 2 + 8 * l;
        if (IN(pb + 0)) { REFRESH(); bf16* H = (bf16*)(F.ws + WS_H); bf16* Zb = (bf16*)(F.ws + WS_Z); bf16* MIX = (bf16*)(F.ws + WS_MIX); bf16* HID = (bf16*)(F.ws + WS_HID); bf16* CAPM = (bf16*)(F.ws + WS_CAPM); (void)H; (void)Zb; (void)MIX; (void)HID; (void)CAPM; const float* mod_l = modp(F, l); unsigned char* wl = lw(F, l); (void)mod_l; (void)wl; if (l == 0) norm_phase<true>(F, INP(I_N1) + l * DM, mod_l, 0, H); else norm_phase<false>(F, INP(I_N1) + l * DM, mod_l, 0, H); } SEAM(pb + 0);
        if (IN(pb + 1)) { REFRESH(); bf16* H = (bf16*)(F.ws + WS_H); bf16* Zb = (bf16*)(F.ws + WS_Z); bf16* MIX = (bf16*)(F.ws + WS_MIX); bf16* HID = (bf16*)(F.ws + WS_HID); bf16* CAPM = (bf16*)(F.ws + WS_CAPM); (void)H; (void)Zb; (void)MIX; (void)HID; (void)CAPM; const float* mod_l = modp(F, l); unsigned char* wl = lw(F, l); (void)mod_l; (void)wl; pg8::Gemm g{H, (const bf16*)(wl + LW_WIN), MT, DIN, DM}; pg8::StaticOrder S; S.init(MT, DIN, F.G, (int)blockIdx.x); pg8::EpiZ E{Zb};
            pg8::gemm_phase<pg8::EpiZ, pg8::StaticOrder, true, true>(F.lds, g, S, E); } SEAM(pb + 1);
        if (IN(pb + 2)) { REFRESH(); bf16* H = (bf16*)(F.ws + WS_H); bf16* Zb = (bf16*)(F.ws + WS_Z); bf16* MIX = (bf16*)(F.ws + WS_MIX); bf16* HID = (bf16*)(F.ws + WS_HID); bf16* CAPM = (bf16*)(F.ws + WS_CAPM); (void)H; (void)Zb; (void)MIX; (void)HID; (void)CAPM; const float* mod_l = modp(F, l); unsigned char* wl = lw(F, l); (void)mod_l; (void)wl; mixer_phase(F, l); } SEAM(pb + 2);
        if (IN(pb + 3)) { REFRESH(); bf16* H = (bf16*)(F.ws + WS_H); bf16* Zb = (bf16*)(F.ws + WS_Z); bf16* MIX = (bf16*)(F.ws + WS_MIX); bf16* HID = (bf16*)(F.ws + WS_HID); bf16* CAPM = (bf16*)(F.ws + WS_CAPM); (void)H; (void)Zb; (void)MIX; (void)HID; (void)CAPM; const float* mod_l = modp(F, l); unsigned char* wl = lw(F, l); (void)mod_l; (void)wl; pg8::Gemm g{CAPM, (const bf16*)(wl + LW_CPW), 2 * MT, 2 * DC, DC}; pg8::Mix2Order S{F.G, (int)blockIdx.x}; pg8::EpiMix2 E{MIX};
            pg8::gemm_phase<pg8::EpiMix2, pg8::Mix2Order, true, true>(F.lds, g, S, E); } SEAM(pb + 3);
        if (IN(pb + 4)) { REFRESH(); bf16* H = (bf16*)(F.ws + WS_H); bf16* Zb = (bf16*)(F.ws + WS_Z); bf16* MIX = (bf16*)(F.ws + WS_MIX); bf16* HID = (bf16*)(F.ws + WS_HID); bf16* CAPM = (bf16*)(F.ws + WS_CAPM); (void)H; (void)Zb; (void)MIX; (void)HID; (void)CAPM; const float* mod_l = modp(F, l); unsigned char* wl = lw(F, l); (void)mod_l; (void)wl; pg8::Gemm g{MIX, (const bf16*)(wl + LW_WOUT), MT, DM, DM}; pg8::StaticOrder S; S.init(MT, DM, F.G, (int)blockIdx.x); pg8::EpiRes E{F.out, mod_l + 2 * DM};
            pg8::gemm_phase<pg8::EpiRes, pg8::StaticOrder, true, true>(F.lds, g, S, E); } SEAM(pb + 4);
        if (IN(pb + 5)) { REFRESH(); bf16* H = (bf16*)(F.ws + WS_H); bf16* Zb = (bf16*)(F.ws + WS_Z); bf16* MIX = (bf16*)(F.ws + WS_MIX); bf16* HID = (bf16*)(F.ws + WS_HID); bf16* CAPM = (bf16*)(F.ws + WS_CAPM); (void)H; (void)Zb; (void)MIX; (void)HID; (void)CAPM; const float* mod_l = modp(F, l); unsigned char* wl = lw(F, l); (void)mod_l; (void)wl; norm_phase<false>(F, INP(I_N2) + l * DM, mod_l, 3, H); } SEAM(pb + 5);
        if (IN(pb + 6)) { REFRESH(); bf16* H = (bf16*)(F.ws + WS_H); bf16* Zb = (bf16*)(F.ws + WS_Z); bf16* MIX = (bf16*)(F.ws + WS_MIX); bf16* HID = (bf16*)(F.ws + WS_HID); bf16* CAPM = (bf16*)(F.ws + WS_CAPM); (void)H; (void)Zb; (void)MIX; (void)HID; (void)CAPM; const float* mod_l = modp(F, l); unsigned char* wl = lw(F, l); (void)mod_l; (void)wl; pg8::Gemm g{H, (const bf16*)(wl + LW_WGU), MT, 2 * DFF, DM}; pg8::StaticOrder S; S.init(MT, 2 * DFF, F.G, (int)blockIdx.x); pg8::EpiSwi E{HID};
            pg8::gemm_phase<pg8::EpiSwi, pg8::StaticOrder, true, true>(F.lds, g, S, E); } SEAM(pb + 6);
        if (IN(pb + 7)) { REFRESH(); bf16* H = (bf16*)(F.ws + WS_H); bf16* Zb = (bf16*)(F.ws + WS_Z); bf16* MIX = (bf16*)(F.ws + WS_MIX); bf16* HID = (bf16*)(F.ws + WS_HID); bf16* CAPM = (bf16*)(F.ws + WS_CAPM); (void)H; (void)Zb; (void)MIX; (void)HID; (void)CAPM; const float* mod_l = modp(F, l); unsigned char* wl = lw(F, l); (void)mod_l; (void)wl; pg8::Gemm g{HID, (const bf16*)(wl + LW_WD), MT, DM, DFF}; pg8::StaticOrder S; S.init(MT, DM, F.G, (int)blockIdx.x); pg8::EpiRes E{F.out, mod_l + 5 * DM};
            pg8::gemm_phase<pg8::EpiRes, pg8::StaticOrder, true, true>(F.lds, g, S, E); } SEAM(pb + 7);
    }
    if (IN(N_PHASES - 1)) { REFRESH(); final_norm_phase(F); }
#undef IN
#undef SEAM
}

extern "C" void kernel_launch(void* const* d_in, const int* in_sizes, int n_in, void* d_out, int out_size, void* d_ws, size_t ws_size, hipStream_t stream) {
    static int grid = 0;
    if (grid == 0) {
        if (n_in != N_IN || in_sizes[0] != MP * DM || (size_t)out_size != O_END || ws_size < WS_END) {
            fprintf(stderr, "kernel_launch: unexpected shapes: n_in %d in0 %d out %d ws %zu (need %zu); nothing launched\n", n_in, n_in > 0 ? in_sizes[0] : -1, out_size, ws_size, (size_t)WS_END); grid = -1; return; }
        int dev = 0, cus = 0;
        if (hipGetDevice(&dev) != hipSuccess || hipDeviceGetAttribute(&cus, hipDeviceAttributeMultiprocessorCount, dev) != hipSuccess) { grid = -1; return; }
        if (hipFuncSetAttribute((const void*)enc_fwd, hipFuncAttributeMaxDynamicSharedMemorySize, LDS_BYTES) != hipSuccess) { fprintf(stderr, "kernel_launch: hipFuncSetAttribute failed\n"); grid = -1; return; }
        int per_cu = 0;
        if (hipOccupancyMaxActiveBlocksPerMultiprocessor(&per_cu, (const void*)enc_fwd, NWAVES * 64, LDS_BYTES) != hipSuccess || per_cu < 1)
            fprintf(stderr, "kernel_launch: note: occupancy query reports %d workgroups per CU\n", per_cu);
        (void)hipGetLastError();
        grid = cus;
    }
    if (grid < 0) return;
    if (hipMemsetAsync((char*)d_ws + WS_CTL, 0, CTL_ZERO_BYTES, stream) != hipSuccess) return;
    Args a{};
    for (int i = 0; i < N_IN; ++i) a.in[i] = (const float*)d_in[i];
    a.out = (float*)d_out; a.ws = (unsigned char*)d_ws; a.pad0 = 0; a.pad1 = 0;
#if MK_ONE_LAUNCH
    a.ph_lo = 0; a.ph_hi = N_PHASES;
    hipLaunchKernelGGL(enc_fwd, dim3(grid), dim3(NWAVES * 64), LDS_BYTES, stream, a);
#else
    for (int ph = 0; ph < N_PHASES; ++ph) { a.ph_lo = ph; a.ph_hi = ph + 1;
        hipLaunchKernelGGL(enc_fwd, dim3(grid), dim3(NWAVES * 64), LDS_BYTES, stream, a); }
#endif
}
```

```cpp
#include <hip/hip_runtime.h>
#include <cstdio>
#include <cstdint>
#include <utility>

#ifndef MK_ONE_LAUNCH
#define MK_ONE_LAUNCH 1
#endif
#ifndef PROBE_DUP
#define PROBE_DUP 0
#endif
#ifndef PROBE_MIX
#define PROBE_MIX 0
#endif

constexpr int DM = 2048, SEQ = 8192, NBP = 4, MP = NBP * SEQ, NBS = 8, TS = 32, MS = NBS * TS, MT = MP + MS, NPANEL = MT / 256;
constexpr int DIN = 4096, DFF = 5632, DC = 512, NL = 4, NMOD = 6 * DM, NBT = NBP + NBS;
constexpr int ZW = 3584, ZU = 0, ZQ = 512, ZK = 1024, ZV = 1536, ZP = 2048, ZSU = 2560, ZSV = 3072;
constexpr int MIXW = 2048, MIX_A = 0, MIX_B = 512, MIX_C = 1024, MIX_D = 1536;
constexpr float EPS = 1e-6f, LOG2E = 1.4426950408889634f, QSCALE = 0.125f * LOG2E;
constexpr int KSPLIT = 16;
constexpr size_t O_YP = 0, O_YS = O_YP + (size_t)MP * DM, O_CONVP = O_YS + (size_t)MS * DM, O_CONVS = O_CONVP + (size_t)NL * NBP * 30 * DC,
    O_KP = O_CONVS + (size_t)NL * NBS * 30 * DC, O_VP = O_KP + (size_t)NL * NBP * 512 * 512, O_KS = O_VP + (size_t)NL * NBP * 512 * 512,
    O_VS = O_KS + (size_t)NL * NBS * TS * 512, O_POOLP = O_VS + (size_t)NL * NBS * TS * 512, O_POOLS = O_POOLP + (size_t)NL * NBP * 15 * DC,
    O_SGV = O_POOLS + (size_t)NL * NBS * 15 * DC, O_END = O_SGV + (size_t)NL * NBS * TS * DC;
static_assert(O_END == 78700544, "output size");
enum { I_XP = 0, I_XS, I_CP, I_CS, I_CCONV, I_CK, I_CV, I_CPOOL, I_ADAW, I_ADAB, I_N1, I_N2, I_WIN, I_CONVW, I_CONVB, I_GNG, I_GNB, I_CPW, I_RELB,
       I_POOLW, I_POOLS, I_SGG, I_SGB, I_SGW, I_SGBIAS, I_WOUT, I_WG, I_WU, I_WD, I_FING, N_IN };
static_assert(N_IN == 30, "30 inputs");

constexpr size_t MiB = 1u << 20;
constexpr size_t WS_CTL = 0, CTL_ZERO_BYTES = 1 * MiB;
constexpr size_t WS_MOD = 1 * MiB;
constexpr size_t WS_MODP = 4 * MiB;
constexpr size_t WS_W = 40 * MiB;
constexpr size_t LW_WIN = 0, LW_WOUT = 16 * MiB, LW_WGU = 24 * MiB, LW_WD = 68 * MiB, LW_CPW = 90 * MiB, LW_PWD = LW_CPW + 512 * 1024, LW_SGW = 91 * MiB, LW = 91 * MiB + 256 * 1024;
constexpr size_t WS_H = WS_W + NL * LW;
constexpr size_t WS_Z = WS_H + (size_t)MT * DM * 2;
constexpr size_t WS_MIX = WS_Z + (size_t)MT * ZW * 2;
constexpr size_t WS_HID = WS_Z;
constexpr size_t WS_CAPM = WS_MIX + (size_t)MT * MIXW * 2;
constexpr size_t WS_END = WS_CAPM + (size_t)2 * MT * DC * 2;
static_assert(WS_HID + (size_t)MT * DFF * 2 <= WS_CAPM, "HID overlay");
static_assert((size_t)NL * 12 * NMOD * 4 <= 3 * MiB && (size_t)KSPLIT * NL * 12 * NMOD * 4 <= 36 * MiB, "mod buffers");
constexpr int CW_BAR = 4096;

constexpr int RING_BYTES = 131072;
constexpr int LDSCTL_OFF = RING_BYTES, MISC_OFF = LDSCTL_OFF + 320;
constexpr int LDS_BYTES = 147456;
constexpr int NWAVES = 8;

#define GAS __attribute__((address_space(1)))
#define LAS __attribute__((address_space(3)))
typedef unsigned short bf16;
typedef unsigned v4u __attribute__((ext_vector_type(4)));
typedef unsigned v2u __attribute__((ext_vector_type(2)));
typedef float f32x4 __attribute__((ext_vector_type(4)));
typedef float f32x2 __attribute__((ext_vector_type(2)));
typedef float f32x16 __attribute__((ext_vector_type(16)));
typedef short bf16x8 __attribute__((ext_vector_type(8)));
typedef __bf16 bf16x2_t __attribute__((ext_vector_type(2)));
typedef GAS unsigned gu32;
#define RLX_AGENT __ATOMIC_RELAXED, __HIP_MEMORY_SCOPE_AGENT
#define LDS_WAIT() asm volatile("s_waitcnt lgkmcnt(0)" ::: "memory")
#define VM_WAIT() asm volatile("s_waitcnt vmcnt(0)" ::: "memory")

__device__ __forceinline__ unsigned pk2(float lo, float hi) { f32x2 v = {lo, hi}; bf16x2_t b = __builtin_convertvector(v, bf16x2_t); return __builtin_bit_cast(unsigned, b); }
__device__ __forceinline__ float bflo(unsigned u) { return __uint_as_float(u << 16); }
__device__ __forceinline__ float bfhi(unsigned u) { return __uint_as_float(u & 0xffff0000u); }
__device__ __forceinline__ float bf2f(bf16 h) { return __uint_as_float((unsigned)h << 16); }
__device__ __forceinline__ float fast_exp2(float x) { return __builtin_amdgcn_exp2f(x); }
__device__ __forceinline__ float fast_rcp(float x) { return __builtin_amdgcn_rcpf(x); }
__device__ __forceinline__ float sigmoidf_(float x) { return fast_rcp(1.0f + fast_exp2(-x * LOG2E)); }
__device__ __forceinline__ float siluf_(float x) { return x * sigmoidf_(x); }
template <int CTRL> __device__ __forceinline__ float dpp_f(float v) { return __int_as_float(__builtin_amdgcn_update_dpp(0, __float_as_int(v), CTRL, 0xF, 0xF, true)); }
__device__ __forceinline__ float row16_sum(float v) { v += dpp_f<0xB1>(v); v += dpp_f<0x4E>(v); v += dpp_f<0x141>(v); v += dpp_f<0x140>(v); return v; }
__device__ __forceinline__ float half32_sum(float v) { v = row16_sum(v); v += __int_as_float(__builtin_amdgcn_ds_swizzle(__float_as_int(v), 0x401F)); return v; }
__device__ __forceinline__ float wave_sum(float v) { v = half32_sum(v);
    return __int_as_float(__builtin_amdgcn_readlane(__float_as_int(v), 0)) + __int_as_float(__builtin_amdgcn_readlane(__float_as_int(v), 32)); }
__device__ __forceinline__ int batch_of_row(int row) { return row < MP ? (row >> 13) : NBP + ((row - MP) >> 5); }

namespace pg8 {
#define PG8_LAS __attribute__((address_space(3)))
typedef unsigned short bf16_t;
typedef short bf16x8 __attribute__((ext_vector_type(8)));
typedef float f32x4 __attribute__((ext_vector_type(4)));
typedef unsigned u32x4 __attribute__((ext_vector_type(4)));
constexpr int BM = 256, BK = 64, HALF = 128, HTB = HALF * BK * 2  , STAGE_BYTES = 8 * HTB, NXCD = 8, WGM = 8;

__host__ __device__ __forceinline__ int lds_byte(int r, int c) { const int st = (r >> 4) * 2 + (c >> 5), rr = r & 15, cc = c & 31, ob = rr * 64 + cc * 2; return st * 1024 + (ob ^ (((ob >> 9) & 1) << 5)); }
__host__ __device__ __forceinline__ void stage_rc(int b, int& R, int& C) { const int st = b / 1024, sb = b % 1024, swz = sb ^ (((sb >> 9) & 1) << 5); R = (st >> 1) * 16 + swz / 64; C = (st & 1) * 32 + (swz % 64) / 2; }
__host__ __device__ __forceinline__ int perm32(int rho) { const int n = rho >> 4, i = rho & 15; return 8 * (i >> 2) + 4 * n + (i & 3); }

struct Unit { int pm, pn; };
struct Gemm { const bf16_t* A; const bf16_t* Bt; int M, N, K; };

struct StaticOrder {
    int nM, nN, nwg, G, c;
    __host__ __device__ void init(int M, int N, int G_, int c_) { nM = M / BM; nN = N / BM; nwg = nM * nN; G = G_; c = c_; }
    __host__ __device__ bool next(int i, Unit& u) const {
        const long L = (long)i * G + c; if (L >= nwg) return false;
        int wgid = (int)L; { const int q = nwg / NXCD, r = nwg % NXCD, xcd = wgid % NXCD, off = wgid / NXCD; wgid = (xcd < r ? xcd * (q + 1) : r * (q + 1) + (xcd - r) * q) + off; }
        const int nig = WGM * nN, gid = wgid / nig, fm = gid * WGM, gsz = (nM - fm) < WGM ? (nM - fm) : WGM;
        u.pm = fm + ((wgid % nig) % gsz); u.pn = (wgid % nig) / gsz; return true;
    }
    __device__ __forceinline__ void a_ready(const Unit&) const {}
    __device__ __forceinline__ void done(const Unit&) const {}
};
__device__ __forceinline__ unsigned cvt_pk_bf16(float lo, float hi) { return ::pk2(lo, hi); }
struct EpiZ {
    static constexpr bool PERM = true, AFTER_DRAIN = false;
    bf16_t* Z;
    __device__ __forceinline__ void operator()(const f32x4 (&acc)[2][2][4][2], const Unit& u, int wr, int wc, int fr, int fq) const {
        const int row0 = u.pm * BM + wr * 64 + fr;
        if (u.pn < 4) {
            const int col0 = 128 * u.pn + wc * 32 + 8 * fq;
#pragma unroll
            for (int ai = 0; ai < 2; ++ai)
#pragma unroll
                for (int m = 0; m < 4; ++m) { bf16_t* rowp = Z + (size_t)(row0 + ai * HALF + m * 16) * ::ZW + col0;
                    const f32x4 a0 = acc[ai][0][m][0], a1 = acc[ai][0][m][1], g0 = acc[ai][1][m][0], g1 = acc[ai][1][m][1];
                    u32x4 w; w.x = cvt_pk_bf16(a0[0] * ::sigmoidf_(g0[0]), a0[1] * ::sigmoidf_(g0[1])); w.y = cvt_pk_bf16(a0[2] * ::sigmoidf_(g0[2]), a0[3] * ::sigmoidf_(g0[3]));
                    w.z = cvt_pk_bf16(a1[0] * ::sigmoidf_(g1[0]), a1[1] * ::sigmoidf_(g1[1])); w.w = cvt_pk_bf16(a1[2] * ::sigmoidf_(g1[2]), a1[3] * ::sigmoidf_(g1[3]));
                    *(u32x4*)rowp = w; }
        } else {
            const float sc = (u.pn < 6) ? ::QSCALE : 1.0f;
            const int col0 = 512 + 256 * (u.pn - 4) + wc * 32 + 8 * fq;
#pragma unroll
            for (int ai = 0; ai < 2; ++ai)
#pragma unroll
                for (int m = 0; m < 4; ++m) { bf16_t* rowp = Z + (size_t)(row0 + ai * HALF + m * 16) * ::ZW + col0;
#pragma unroll
                    for (int bj = 0; bj < 2; ++bj) { const f32x4 v0 = acc[ai][bj][m][0] * sc, v1 = acc[ai][bj][m][1] * sc;
                        u32x4 w; w.x = cvt_pk_bf16(v0[0], v0[1]); w.y = cvt_pk_bf16(v0[2], v0[3]); w.z = cvt_pk_bf16(v1[0], v1[1]); w.w = cvt_pk_bf16(v1[2], v1[3]);
                        *(u32x4*)(rowp + bj * HALF) = w; } }
        }
    }
};
struct EpiMix2 {
    static constexpr bool PERM = true, AFTER_DRAIN = false;
    bf16_t* MIX;
    __device__ __forceinline__ void operator()(const f32x4 (&acc)[2][2][4][2], const Unit& u, int wr, int wc, int fr, int fq) const {
        const int which = u.pn >> 1, pm = u.pm - which * ::NPANEL;
        const int row0 = pm * BM + wr * 64 + fr, col0 = which * 1024 + (u.pn & 1) * 256 + wc * 32 + 8 * fq;
#pragma unroll
        for (int ai = 0; ai < 2; ++ai)
#pragma unroll
            for (int m = 0; m < 4; ++m) { bf16_t* rowp = MIX + (size_t)(row0 + ai * HALF + m * 16) * ::MIXW + col0;
#pragma unroll
                for (int bj = 0; bj < 2; ++bj) { const f32x4 v0 = acc[ai][bj][m][0], v1 = acc[ai][bj][m][1];
                    u32x4 w; w.x = cvt_pk_bf16(v0[0], v0[1]); w.y = cvt_pk_bf16(v0[2], v0[3]); w.z = cvt_pk_bf16(v1[0], v1[1]); w.w = cvt_pk_bf16(v1[2], v1[3]);
                    *(u32x4*)(rowp + bj * HALF) = w; } }
    }
};
struct EpiRes {
    static constexpr bool PERM = false, AFTER_DRAIN = false;
    float* X; const float* gate;
    __device__ __forceinline__ void operator()(const f32x4 (&acc)[2][2][4][2], const Unit& u, int wr, int wc, int fr, int fq) const {
        const int col0 = u.pn * BM + wc * 32 + 4 * fq;
#pragma unroll
        for (int ai = 0; ai < 2; ++ai)
#pragma unroll
            for (int m = 0; m < 4; ++m) { const int row = u.pm * BM + ai * HALF + wr * 64 + m * 16 + fr;
                const float* gp = gate + (size_t)::batch_of_row(row) * ::NMOD + col0; float* xp = X + (size_t)row * ::DM + col0;
#pragma unroll
                for (int bj = 0; bj < 2; ++bj)
#pragma unroll
                    for (int n = 0; n < 2; ++n) { const f32x4 g = *(const f32x4*)(gp + bj * HALF + n * 16); f32x4 x = *(const f32x4*)(xp + bj * HALF + n * 16);
                        x = x + g * acc[ai][bj][m][n]; *(f32x4*)(xp + bj * HALF + n * 16) = x; } }
    }
};
struct EpiSwi {
    static constexpr bool PERM = true, AFTER_DRAIN = false;
    bf16_t* HID;
    __device__ __forceinline__ void operator()(const f32x4 (&acc)[2][2][4][2], const Unit& u, int wr, int wc, int fr, int fq) const {
        const int row0 = u.pm * BM + wr * 64 + fr, col0 = 128 * u.pn + wc * 32 + 8 * fq;
#pragma unroll
        for (int ai = 0; ai < 2; ++ai)
#pragma unroll
            for (int m = 0; m < 4; ++m) { bf16_t* rowp = HID + (size_t)(row0 + ai * HALF + m * 16) * ::DFF + col0;
                const f32x4 g0 = acc[ai][0][m][0], g1 = acc[ai][0][m][1], u0 = acc[ai][1][m][0], u1 = acc[ai][1][m][1];
                u32x4 w; w.x = cvt_pk_bf16(::siluf_(g0[0]) * u0[0], ::siluf_(g0[1]) * u0[1]); w.y = cvt_pk_bf16(::siluf_(g0[2]) * u0[2], ::siluf_(g0[3]) * u0[3]);
                w.z = cvt_pk_bf16(::siluf_(g1[0]) * u1[0], ::siluf_(g1[1]) * u1[1]); w.w = cvt_pk_bf16(::siluf_(g1[2]) * u1[2], ::siluf_(g1[3]) * u1[3]);
                *(u32x4*)rowp = w; }
    }
};
struct Mix2Order {
    int G, c;
    __device__ __forceinline__ bool next(int i, Unit& u) const {
        const int L = i * G + c; if (L >= 4 * ::NPANEL) return false;
        const int which = L / (2 * ::NPANEL), rem = L % (2 * ::NPANEL);
        u.pm = which * ::NPANEL + (rem >> 1); u.pn = which * 2 + (rem & 1); return true;
    }
    __device__ __forceinline__ void a_ready(const Unit&) const {}
    __device__ __forceinline__ void done(const Unit&) const {}
};

template <class Epi, class Sched, bool ALIGN_EPI = false, bool SP2 = false>
__device__ __forceinline__ void gemm_phase(PG8_LAS unsigned char* lds, const Gemm g, const Sched& S, const Epi& E) {
    int tid_ = threadIdx.x; asm volatile("" : "+v"(tid_));
    const int tid = tid_, wid = __builtin_amdgcn_readfirstlane(tid >> 6), lane = tid & 63, wr = wid >> 2, wc = wid & 3, fr = lane & 15, fq = lane >> 4;
    const int K = g.K, nt = K / BK;
    unsigned voffA[2], voffB[2];
#pragma unroll
    for (int i = 0; i < 2; ++i) { int R, C; stage_rc(tid * 16 + i * 8192, R, C); const int Rb = Epi::PERM ? ((R & ~31) + perm32(R & 31)) : R;
        voffA[i] = (unsigned)(R * K + C) * 2u; voffB[i] = (unsigned)(Rb * K + C) * 2u; }
    const size_t kstep = (size_t)(BK * 2);
    const size_t hstep = (size_t)HALF * K * 2;
    const size_t tstep = 2 * hstep;
    const unsigned ldsw = (unsigned)wid * 1024u;
    const int aoff = lds_byte(wr * 64 + fr, fq * 8), boff = lds_byte(wc * 32 + fr, fq * 8);
#define PG8_SA(b, h) (((b) * 2 + (h)) * HTB)
#define PG8_SB(b, h) ((4 + (b) * 2 + (h)) * HTB)
#define PG8_STAGE(bufoff, gbase, voff) do { _Pragma("unroll") for (int _i = 0; _i < 2; ++_i) \
        __builtin_amdgcn_global_load_lds((const unsigned*)((const char*)(gbase) + (voff)[_i]), (PG8_LAS unsigned*)(lds + (bufoff) + ldsw + _i * 8192), 16, 0, 0); } while (0)
#define PG8_LDA(dst, b, h) do { _Pragma("unroll") for (int m = 0; m < 4; ++m) _Pragma("unroll") for (int k = 0; k < 2; ++k) dst[m][k] = *(const PG8_LAS bf16x8*)(lds + PG8_SA(b, h) + aoff + m * 2048 + k * 1024); } while (0)
#define PG8_LDB(dst, b, h) do { _Pragma("unroll") for (int n = 0; n < 2; ++n) _Pragma("unroll") for (int k = 0; k < 2; ++k) dst[n][k] = *(const PG8_LAS bf16x8*)(lds + PG8_SB(b, h) + boff + n * 2048 + k * 1024); } while (0)
#define PG8_MMA(ai, bj, At, Bt) do { __builtin_amdgcn_s_setprio(1); _Pragma("unroll") for (int m = 0; m < 4; ++m) _Pragma("unroll") for (int n = 0; n < 2; ++n) _Pragma("unroll") for (int k = 0; k < 2; ++k) \
        acc[ai][bj][m][n] = __builtin_amdgcn_mfma_f32_16x16x32_bf16(Bt[n][k], At[m][k], acc[ai][bj][m][n], 0, 0, 0); __builtin_amdgcn_s_setprio(0); } while (0)
#define PG8_WAIT_V(n) asm volatile("s_waitcnt vmcnt(" #n ")" ::: "memory")
#define PG8_WAIT_L(n) asm volatile("s_waitcnt lgkmcnt(" #n ")" ::: "memory")
#define PG8_BAR __builtin_amdgcn_s_barrier()
#define PG8_SCHED __builtin_amdgcn_sched_barrier(0)
    Unit cur, nxt; int ui = 0;
    if (!S.next(0, cur)) return;
    f32x4 acc[2][2][4][2];
#pragma unroll
    for (int a = 0; a < 2; ++a)
#pragma unroll
        for (int b = 0; b < 2; ++b)
#pragma unroll
            for (int m = 0; m < 4; ++m)
#pragma unroll
                for (int n = 0; n < 2; ++n) acc[a][b][m][n] = (f32x4){0.f, 0.f, 0.f, 0.f};
    bf16x8 At[4][2], B0[2][2], B1[2][2];
    const char* cA = (const char*)g.A + (size_t)cur.pm * tstep; const char* cB = (const char*)g.Bt + (size_t)cur.pn * tstep;
    S.a_ready(cur);
    if constexpr (SP2) {
        PG8_STAGE(PG8_SB(0, 0), cB, voffB); PG8_STAGE(PG8_SB(0, 1), cB + hstep, voffB); PG8_STAGE(PG8_SA(0, 0), cA, voffA); PG8_STAGE(PG8_SA(0, 1), cA + hstep, voffA);
        if (wr == 1) PG8_BAR;
        PG8_WAIT_V(2); PG8_BAR;
        PG8_STAGE(PG8_SB(1, 0), cB + kstep, voffB); PG8_STAGE(PG8_SA(1, 0), cA + kstep, voffA); PG8_STAGE(PG8_SB(1, 1), cB + hstep + kstep, voffB);
        PG8_WAIT_V(6); PG8_BAR;
    } else {
        PG8_STAGE(PG8_SB(0, 0), cB, voffB); PG8_STAGE(PG8_SA(0, 0), cA, voffA); PG8_STAGE(PG8_SB(0, 1), cB + hstep, voffB); PG8_STAGE(PG8_SA(0, 1), cA + hstep, voffA);
        if (wr == 1) PG8_BAR;
        PG8_WAIT_V(4); PG8_BAR;
        PG8_STAGE(PG8_SB(1, 0), cB + kstep, voffB); PG8_STAGE(PG8_SA(1, 0), cA + kstep, voffA); PG8_STAGE(PG8_SB(1, 1), cB + hstep + kstep, voffB);
        PG8_WAIT_V(6); PG8_BAR;
    }
    for (;;) {
        const bool has_next = S.next(ui + 1, nxt);
        const char* nA = has_next ? (const char*)g.A + (size_t)nxt.pm * tstep : cA; const char* nB = has_next ? (const char*)g.Bt + (size_t)nxt.pn * tstep : cB;
        for (int t = 0; t < nt; t += 2) {
            const bool last = (t == nt - 2);
            const char* a1 = cA + (size_t)(t + 1) * kstep;
            const char* a2 = last ? nA : cA + (size_t)(t + 2) * kstep; const char* b2 = last ? nB : cB + (size_t)(t + 2) * kstep;
            const char* a3 = a2 + kstep; const char* b3 = b2 + kstep;
            if (last && has_next) S.a_ready(nxt);
            if constexpr (SP2) {
            PG8_LDB(B0, 0, 0); PG8_LDB(B1, 0, 1); PG8_SCHED; PG8_LDA(At, 0, 0); PG8_STAGE(PG8_SA(1, 1), a1 + hstep, voffA);
            PG8_WAIT_V(8); PG8_WAIT_L(0); PG8_BAR; PG8_MMA(0, 0, At, B0); PG8_MMA(0, 1, At, B1); PG8_BAR; PG8_SCHED;
            PG8_LDA(At, 0, 1); PG8_STAGE(PG8_SB(0, 0), b2, voffB); PG8_STAGE(PG8_SB(0, 1), b2 + hstep, voffB); PG8_STAGE(PG8_SA(0, 0), a2, voffA);
            PG8_WAIT_V(8); PG8_WAIT_L(0); PG8_BAR; PG8_MMA(1, 0, At, B0); PG8_MMA(1, 1, At, B1); PG8_BAR; PG8_SCHED;
            PG8_LDB(B0, 1, 0); PG8_LDB(B1, 1, 1); PG8_SCHED; PG8_LDA(At, 1, 0); PG8_STAGE(PG8_SA(0, 1), a2 + hstep, voffA);
            PG8_WAIT_V(8); PG8_WAIT_L(0); PG8_BAR; PG8_MMA(0, 0, At, B0); PG8_MMA(0, 1, At, B1); PG8_BAR; PG8_SCHED;
            PG8_LDA(At, 1, 1); PG8_STAGE(PG8_SB(1, 0), b3, voffB); PG8_STAGE(PG8_SB(1, 1), b3 + hstep, voffB); PG8_STAGE(PG8_SA(1, 0), a3, voffA);
            PG8_WAIT_V(8); PG8_WAIT_L(0); PG8_BAR; PG8_MMA(1, 0, At, B0); PG8_MMA(1, 1, At, B1); PG8_BAR; PG8_SCHED;
            } else {
            PG8_LDB(B0, 0, 0); PG8_SCHED; PG8_LDA(At, 0, 0); PG8_STAGE(PG8_SA(1, 1), a1 + hstep, voffA);
            PG8_WAIT_L(8); PG8_BAR; PG8_WAIT_L(0); PG8_MMA(0, 0, At, B0); PG8_BAR; PG8_SCHED;
            PG8_LDB(B1, 0, 1); PG8_STAGE(PG8_SB(0, 0), b2, voffB);
            PG8_BAR; PG8_WAIT_L(0); PG8_MMA(0, 1, At, B1); PG8_BAR;
            PG8_LDA(At, 0, 1); PG8_STAGE(PG8_SA(0, 0), a2, voffA);
            PG8_BAR; PG8_WAIT_L(0); PG8_MMA(1, 0, At, B0); PG8_BAR; PG8_SCHED;
            PG8_STAGE(PG8_SB(0, 1), b2 + hstep, voffB);
            PG8_WAIT_V(6); PG8_BAR; PG8_MMA(1, 1, At, B1); PG8_BAR;
            PG8_LDB(B0, 1, 0); PG8_SCHED; PG8_LDA(At, 1, 0); PG8_STAGE(PG8_SA(0, 1), a2 + hstep, voffA);
            PG8_WAIT_L(8); PG8_BAR; PG8_WAIT_L(0); PG8_MMA(0, 0, At, B0); PG8_BAR; PG8_SCHED;
            PG8_LDB(B1, 1, 1); PG8_STAGE(PG8_SB(1, 0), b3, voffB);
            PG8_BAR; PG8_WAIT_L(0); PG8_MMA(0, 1, At, B1); PG8_BAR;
            PG8_LDA(At, 1, 1); PG8_STAGE(PG8_SA(1, 0), a3, voffA);
            PG8_BAR; PG8_WAIT_L(0); PG8_MMA(1, 0, At, B0); PG8_BAR; PG8_SCHED;
            PG8_STAGE(PG8_SB(1, 1), b3 + hstep, voffB);
            PG8_WAIT_V(6); PG8_BAR; PG8_MMA(1, 1, At, B1); PG8_BAR;
            }
        }
        if constexpr (ALIGN_EPI) { if (wr == 0) PG8_BAR; }
        if constexpr (!Epi::AFTER_DRAIN) { E(acc, cur, wr, wc, fr, fq); S.done(cur); }
        if (!has_next) break;
#pragma unroll
        for (int a = 0; a < 2; ++a)
#pragma unroll
            for (int b = 0; b < 2; ++b)
#pragma unroll
                for (int m = 0; m < 4; ++m)
#pragma unroll
                    for (int n = 0; n < 2; ++n) acc[a][b][m][n] = (f32x4){0.f, 0.f, 0.f, 0.f};
        cur = nxt; cA = nA; cB = nB; ++ui;
        if constexpr (ALIGN_EPI) { if (wr == 1) PG8_BAR; }
    }
    PG8_WAIT_V(0);
    if constexpr (!ALIGN_EPI) { if (wr == 0) PG8_BAR; }
    PG8_BAR;
    if constexpr (Epi::AFTER_DRAIN) { E.fused(acc, cur, wr, wc, fr, fq, lds, wid, lane); S.done(cur); }
#undef PG8_SA
#undef PG8_SB
#undef PG8_STAGE
#undef PG8_LDA
#undef PG8_LDB
#undef PG8_MMA
#undef PG8_WAIT_V
#undef PG8_WAIT_L
#undef PG8_BAR
#undef PG8_SCHED
}
}
#define XB_TMO      128
#define XB_XCNT(j)  (256  + 64 * (j))
#define XB_XSUB(j)  (1280 + 64 * (j))
#define XB_XGEN(j)  (2304 + 64 * (j))
#define XB_TOP      3328
#define XB_TOPGEN   3392
#define XCD_BAR_WORDS 3456
#define XB_SPIN_CAP (1u << 18)

__device__ __forceinline__ unsigned xb_ld(unsigned* p)              { return __hip_atomic_load(p, __ATOMIC_RELAXED, __HIP_MEMORY_SCOPE_AGENT); }
__device__ __forceinline__ unsigned xb_add(unsigned* p, unsigned v) { return __hip_atomic_fetch_add(p, v, __ATOMIC_RELAXED, __HIP_MEMORY_SCOPE_AGENT); }
__device__ __forceinline__ unsigned xb_xcc_id() { return (unsigned)__builtin_amdgcn_s_getreg((3 << 11) | 20) & 0xFu; }
#define XB_SPIN(cond, bar) do { unsigned _sp = 0; while (cond) { __builtin_amdgcn_s_sleep(1); \
    if ((++_sp & 255u) == 0u) { if (xb_ld(&(bar)[XB_TMO])) break; if (_sp > XB_SPIN_CAP) { atomicAdd(&(bar)[XB_TMO], 1u); break; } } } } while (0)

struct XcdBarrier {
    unsigned* bar; unsigned x;
    volatile LAS unsigned* st;
};

__device__ __forceinline__ XcdBarrier xcd_barrier_post(unsigned* bar, volatile LAS unsigned* st) {
    XcdBarrier b; b.bar = bar; b.x = xb_xcc_id(); b.st = st;
    if (threadIdx.x == 0) (void)xb_add(&bar[XB_XCNT(b.x)], 1u);
    return b;
}
__device__ __forceinline__ void xcd_barrier_complete(unsigned* bar, unsigned x, unsigned& nloc, unsigned& nx) {
    const unsigned G = gridDim.x * gridDim.y * gridDim.z;
    unsigned sum, cnt, mine, sp = 0u;
    for (;;) {
        sum = 0u; cnt = 0u; mine = 0u;
#pragma unroll
        for (unsigned j = 0; j < 16; ++j) { const unsigned c = xb_ld(&bar[XB_XCNT(j)]); sum += c; cnt += (c > 0u) ? 1u : 0u; mine = (j == x) ? c : mine; }
        if (sum == G) break;
        __builtin_amdgcn_s_sleep(1);
        if ((++sp & 255u) == 0u) { if (xb_ld(&bar[XB_TMO])) break; if (sp > XB_SPIN_CAP) { atomicAdd(&bar[XB_TMO], 1u); break; } }
    }
    nloc = mine > 0u ? mine : 1u; nx = cnt > 0u ? cnt : 1u;
}

__device__ __forceinline__ void xcd_barrier(const XcdBarrier& b) {
    asm volatile("s_waitcnt vmcnt(0)" ::: "memory");
    __syncthreads();
    if (threadIdx.x == 0) {
        unsigned* bar = b.bar;
        __builtin_amdgcn_s_waitcnt(0);
        unsigned nloc = b.st[0], nx = b.st[1];
        if (nloc == 0u) { xcd_barrier_complete(bar, b.x, nloc, nx); b.st[0] = nloc; b.st[1] = nx; }
        const unsigned old = xb_add(&bar[XB_XSUB(b.x)], 1u);
        const unsigned gen = old / nloc;
        if (old + 1u == (gen + 1u) * nloc) {
            __builtin_amdgcn_fence(__ATOMIC_RELEASE, "agent");
            asm volatile("s_waitcnt vmcnt(0)" ::: "memory");
            const unsigned og = xb_add(&bar[XB_TOP], 1u);
            const unsigned tg = og / nx;
            if (og + 1u == (tg + 1u) * nx) xb_add(&bar[XB_TOPGEN], 1u);
            else XB_SPIN(xb_ld(&bar[XB_TOPGEN]) == tg, bar);
            __builtin_amdgcn_fence(__ATOMIC_ACQUIRE, "agent");
            xb_add(&bar[XB_XGEN(b.x)], 1u);
            asm volatile("s_waitcnt vmcnt(0)" ::: "memory");
        } else {
            XB_SPIN(xb_ld(&bar[XB_XGEN(b.x)]) == gen, bar);
            __builtin_amdgcn_fence(__ATOMIC_ACQUIRE, "agent");
            asm volatile("s_waitcnt vmcnt(0)" ::: "memory");
        }
    }
    __syncthreads();
}
struct Args { const float* in[N_IN]; float* out; unsigned char* ws; int ph_lo, ph_hi, pad0, pad1; };
static_assert(sizeof(Args) == (N_IN + 2) * 8 + 16, "Args has no padding");
struct DevArgs { const GAS float* in[N_IN]; GAS float* out; GAS unsigned char* ws; int ph_lo, ph_hi, pad0, pad1; };
static_assert(sizeof(DevArgs) == sizeof(Args), "DevArgs mirrors Args");
typedef const __attribute__((address_space(4))) DevArgs* KArgs;
#define INP(i) ((const float*)F.ka->in[i])
struct Frame {
    LAS unsigned char* lds;
    int tid, lane, wave, vcu, G;
    KArgs ka;
    float* out; unsigned char* ws;
};
__device__ __forceinline__ const float* modp(const Frame& F, int layer) { return (const float*)(F.ws + WS_MOD) + (size_t)layer * 12 * NMOD; }
__device__ __forceinline__ unsigned char* lw(const Frame& F, int layer) { return F.ws + WS_W + (size_t)layer * LW; }

__device__ __forceinline__ void transpose_item(const float* W, int K, int N, bf16* WT, int k0, int n0, int orow0, LAS float* scr, int lane) {
#pragma unroll 8
    for (int i = 0; i < 32; ++i) { const int kk = 2 * i + (lane >> 5); scr[kk * 33 + (lane & 31)] = W[(size_t)(k0 + kk) * N + n0 + (lane & 31)]; }
    LDS_WAIT(); asm volatile("" ::: "memory");
    const int c = lane & 7;
#pragma unroll
    for (int j = 0; j < 4; ++j) { const int n = (lane >> 3) + 8 * j; const LAS float* s = scr + (8 * c) * 33 + n;
        v4u o; o.x = pk2(s[0 * 33], s[1 * 33]); o.y = pk2(s[2 * 33], s[3 * 33]); o.z = pk2(s[4 * 33], s[5 * 33]); o.w = pk2(s[6 * 33], s[7 * 33]);
        *(GAS v4u*)(WT + (size_t)(orow0 + n) * K + k0 + 8 * c) = o; }
    LDS_WAIT(); asm volatile("" ::: "memory");
}
__device__ __forceinline__ void p0a_phase(Frame& F) {
    const int gw = F.vcu * NWAVES + F.wave, NGW = F.G * NWAVES, gt = F.vcu * (NWAVES * 64) + F.tid, NGT = F.G * NWAVES * 64;
    {
        LAS float* sil = (LAS float*)F.lds;
        for (int i = F.tid; i < 12 * DM; i += NWAVES * 64) { const int b = i / DM, k = i % DM;
            const float c = b < NBP ? INP(I_CP)[b * DM + k] : INP(I_CS)[(b - NBP) * DM + k]; sil[k * 12 + b] = siluf_(c); }
        __syncthreads();
        constexpr int KC = DM / KSPLIT, NCB = NMOD / 256;
        float* part = (float*)(F.ws + WS_MODP);
        for (int it = gw; it < NL * KSPLIT * NCB; it += NGW) {
            const int l = it / (KSPLIT * NCB), ks = (it / NCB) % KSPLIT, cb = it % NCB, col = cb * 256 + 4 * F.lane;
            const GAS f32x4* wp = (const GAS f32x4*)(INP(I_ADAW) + ((size_t)l * DM + ks * KC) * NMOD + col);
            f32x4 acc[12];
#pragma unroll
            for (int b = 0; b < 12; ++b) acc[b] = (f32x4){0.f, 0.f, 0.f, 0.f};
#pragma unroll 4
            for (int k = 0; k < KC; ++k) { const f32x4 wv = wp[(size_t)k * (NMOD / 4)];
                const LAS f32x4* sp = (const LAS f32x4*)(sil + (ks * KC + k) * 12); const f32x4 s0 = sp[0], s1 = sp[1], s2 = sp[2];
                acc[0] += wv * s0[0]; acc[1] += wv * s0[1]; acc[2] += wv * s0[2]; acc[3] += wv * s0[3];
                acc[4] += wv * s1[0]; acc[5] += wv * s1[1]; acc[6] += wv * s1[2]; acc[7] += wv * s1[3];
                acc[8] += wv * s2[0]; acc[9] += wv * s2[1]; acc[10] += wv * s2[2]; acc[11] += wv * s2[3]; }
#pragma unroll
            for (int b = 0; b < 12; ++b) *(GAS f32x4*)(part + (((size_t)ks * NL + l) * 12 + b) * NMOD + col) = acc[b];
        }
        __syncthreads();
    }
    {
        LAS float* scr = (LAS float*)(F.lds + F.wave * 16384);
        constexpr int I_IN = (DM / 64) * (DIN / 32), I_OUT = (DM / 64) * (DM / 32), I_G = (DM / 64) * (DFF / 32), I_D = (DFF / 64) * (DM / 32), I_C = (DC / 64) * (DC / 32);
        constexpr int PER_L = I_IN + I_OUT + 2 * I_G + I_D + I_C;
        for (int it = gw; it < NL * PER_L; it += NGW) {
            const int l = it / PER_L; int r = it % PER_L; unsigned char* wl = lw(F, l);
            if (r < I_IN) { const int nblk = DIN / 32, k0 = 64 * (r / nblk), n0 = 32 * (r % nblk);
                int orow0 = n0; if (n0 < 512) orow0 = 256 * (n0 >> 7) + (n0 & 127); else if (n0 < 1024) orow0 = 256 * ((n0 - 512) >> 7) + 128 + (n0 & 127);
                transpose_item(INP(I_WIN) + (size_t)l * DM * DIN, DM, DIN, (bf16*)(wl + LW_WIN), k0, n0, orow0, scr, F.lane); continue; } r -= I_IN;
            if (r < I_OUT) { const int nblk = DM / 32, k0 = 64 * (r / nblk), n0 = 32 * (r % nblk);
                transpose_item(INP(I_WOUT) + (size_t)l * DM * DM, DM, DM, (bf16*)(wl + LW_WOUT), k0, n0, n0, scr, F.lane); continue; } r -= I_OUT;
            if (r < 2 * I_G) { const int up = r >= I_G; if (up) r -= I_G; const int nblk = DFF / 32, k0 = 64 * (r / nblk), n0 = 32 * (r % nblk);
                const int orow0 = 256 * (n0 >> 7) + 128 * up + (n0 & 127);
                transpose_item(INP(up ? I_WU : I_WG) + (size_t)l * DM * DFF, DM, DFF, (bf16*)(wl + LW_WGU), k0, n0, orow0, scr, F.lane); continue; } r -= 2 * I_G;
            if (r < I_D) { const int nblk = DM / 32, k0 = 64 * (r / nblk), n0 = 32 * (r % nblk);
                transpose_item(INP(I_WD) + (size_t)l * DFF * DM, DFF, DM, (bf16*)(wl + LW_WD), k0, n0, n0, scr, F.lane); continue; } r -= I_D;
            { const int nblk = DC / 32, k0 = 64 * (r / nblk), n0 = 32 * (r % nblk);
                transpose_item(INP(I_CPW) + (size_t)l * DC * DC, DC, DC, (bf16*)(wl + LW_CPW), k0, n0, n0, scr, F.lane); }
        }
        for (int i = gt; i < NL * DC * DC; i += NGT) { const int l = i / (DC * DC), n = (i / DC) % DC, k = i % DC; float v = 0.f;
            if ((n >> 7) == (k >> 7)) v = INP(I_POOLW)[(((size_t)l * 4 + (n >> 7)) * 128 + (k & 127)) * 128 + (n & 127)] * INP(I_POOLS)[l * DC + n];
            ((bf16*)(lw(F, l) + LW_PWD))[n * DC + k] = (bf16)(pk2(v, 0.f) & 0xffffu); }
        for (int i = gt; i < NL * 4 * 128 * 128; i += NGT) { const int l = i / 65536, r = i % 65536, ii = (r >> 7) & 127, jj = r & 127;
            const float v = (jj <= ii) ? INP(I_SGW)[i] : 0.f; ((bf16*)(lw(F, l) + LW_SGW))[r] = (bf16)(pk2(v, 0.f) & 0xffffu); }
    }
    __syncthreads();
}
__device__ __forceinline__ void p0b_phase(Frame& F) {
    const int gt = F.vcu * (NWAVES * 64) + F.tid, NGT = F.G * NWAVES * 64;
    const float* part = (const float*)(F.ws + WS_MODP); float* mod = (float*)(F.ws + WS_MOD);
    for (int i = gt; i < NL * 12 * NMOD; i += NGT) { const int l = i / (12 * NMOD), n = i % NMOD; float s = INP(I_ADAB)[l * NMOD + n];
#pragma unroll
        for (int ks = 0; ks < KSPLIT; ++ks) s += part[(size_t)ks * NL * 12 * NMOD + i];
        mod[i] = s; }
}
template <bool COPY>
__device__ __forceinline__ void norm_phase(Frame& F, const float* gain, const float* mod_l, int sh_idx, bf16* H) {
    const int gw = F.vcu * NWAVES + F.wave, NGW = F.G * NWAVES;
    float* X = F.out;
    for (int m = gw; m < MT; m += NGW) {
        const float* src = COPY ? (m < MP ? INP(I_XP) + (size_t)m * DM : INP(I_XS) + (size_t)(m - MP) * DM) : X + (size_t)m * DM;
        const GAS f32x4* xr = (const GAS f32x4*)src + F.lane;
        f32x4 v[8]; float s = 0.f;
#pragma unroll
        for (int j = 0; j < 8; ++j) { v[j] = xr[64 * j]; s += (v[j].x * v[j].x + v[j].y * v[j].y) + (v[j].z * v[j].z + v[j].w * v[j].w); }
        if (COPY) { GAS f32x4* xo = (GAS f32x4*)(X + (size_t)m * DM) + F.lane;
#pragma unroll
            for (int j = 0; j < 8; ++j) xo[64 * j] = v[j]; }
        const float rstd = 1.0f / sqrtf(wave_sum(s) * (1.0f / DM) + EPS);
        const float* mb = mod_l + (size_t)batch_of_row(m) * NMOD;
        const GAS f32x4* shp = (const GAS f32x4*)(mb + sh_idx * DM) + F.lane; const GAS f32x4* scp = (const GAS f32x4*)(mb + (sh_idx + 1) * DM) + F.lane;
        const GAS f32x4* gp = (const GAS f32x4*)gain + F.lane;
        GAS v2u* o8 = (GAS v2u*)(H + (size_t)m * DM) + F.lane;
#pragma unroll
        for (int j = 0; j < 8; ++j) { const f32x4 g = gp[64 * j], sc = scp[64 * j], sh = shp[64 * j];
            const f32x4 y = v[j] * rstd * g * (sc + 1.0f) + sh; v2u w; w.x = pk2(y.x, y.y); w.y = pk2(y.z, y.w); o8[64 * j] = w; }
    }
}
__device__ __forceinline__ void final_norm_phase(Frame& F) {
    const int gw = F.vcu * NWAVES + F.wave, NGW = F.G * NWAVES;
    for (int m = gw; m < MT; m += NGW) {
        GAS f32x4* xr = (GAS f32x4*)(F.out + (size_t)m * DM) + F.lane;
        f32x4 v[8]; float s = 0.f;
#pragma unroll
        for (int j = 0; j < 8; ++j) { v[j] = xr[64 * j]; s += (v[j].x * v[j].x + v[j].y * v[j].y) + (v[j].z * v[j].z + v[j].w * v[j].w); }
        const float rstd = 1.0f / sqrtf(wave_sum(s) * (1.0f / DM) + EPS);
        const GAS f32x4* gp = (const GAS f32x4*)INP(I_FING) + F.lane;
#pragma unroll
        for (int j = 0; j < 8; ++j) xr[64 * j] = v[j] * rstd * gp[64 * j];
    }
}

__device__ __forceinline__ int crow(int r, int hi) { return (r & 3) + 8 * (r >> 2) + 4 * hi; }
#define MFMA32(a, b, c) __builtin_amdgcn_mfma_f32_32x32x16_bf16((a), (b), (c), 0, 0, 0)
constexpr int AT_KS = 0, AT_VT = 9216, AT_BT = 18432, AT_PITCH = 144;
__device__ __forceinline__ void attn_unit(Frame& F, int layer, bool sample, int b, int h, int qg, const bf16* Z, bf16* MIX) {
    const int tid = F.tid, lane = F.lane, w = F.wave, l31 = lane & 31, hh = lane >> 5;
    LAS unsigned char* Ks = F.lds + AT_KS; LAS unsigned char* VTs = F.lds + AT_VT; LAS float* bt = (LAS float*)(F.lds + AT_BT);
    if (tid < 257) bt[tid] = INP(I_RELB)[((size_t)layer * 8 + h) * 257 + tid] * LOG2E;
    const bool wave_on = sample ? (w == 0) : true;
    const int qpos = sample ? l31 : 256 * qg + 32 * w + l31;
    const int qrow = sample ? MP + 32 * b + l31 : b * SEQ + qpos;
    bf16x8 qr[4];
#pragma unroll
    for (int d0 = 0; d0 < 4; ++d0) qr[d0] = *(const GAS bf16x8*)(Z + (size_t)qrow * ZW + ZQ + 64 * h + 16 * d0 + 8 * hh);
    f32x16 o0, o1;
#pragma unroll
    for (int r = 0; r < 16; ++r) { o0[r] = 0.f; o1[r] = 0.f; }
    float mrun = -1e30f, lrun = 0.f;
    const int ntile = sample ? 9 : 12, qc = 4 * qg + (w >> 1);
    const int sr = tid >> 3, sch = tid & 7;
    const float* ck = INP(I_CK) + ((size_t)layer * NBS + b) * 512 * 512; const float* cv = INP(I_CV) + ((size_t)layer * NBS + b) * 512 * 512;
    v4u kreg = (v4u){0u, 0u, 0u, 0u}, vreg = (v4u){0u, 0u, 0u, 0u};
#define AT_LOAD(j) do { \
        if (!sample) { const int kc_ = 4 * qg - 8 + (j); if (kc_ >= 0) { const bf16* zr_ = Z + (size_t)(b * SEQ + 64 * kc_ + sr) * ZW + 64 * h + 8 * sch; \
                kreg = *(const GAS v4u*)(zr_ + ZK); vreg = *(const GAS v4u*)(zr_ + ZV); } } \
        else if ((j) < 8) { const size_t o_ = ((size_t)(64 * (j) + sr) * 8 + h) * 64 + 8 * sch; \
                const f32x4 k0_ = *(const GAS f32x4*)(ck + o_), k1_ = *(const GAS f32x4*)(ck + o_ + 4), v0_ = *(const GAS f32x4*)(cv + o_), v1_ = *(const GAS f32x4*)(cv + o_ + 4); \
                kreg = (v4u){pk2(k0_.x, k0_.y), pk2(k0_.z, k0_.w), pk2(k1_.x, k1_.y), pk2(k1_.z, k1_.w)}; vreg = (v4u){pk2(v0_.x, v0_.y), pk2(v0_.z, v0_.w), pk2(v1_.x, v1_.y), pk2(v1_.z, v1_.w)}; } \
        else if (sr < 32) { const bf16* zr_ = Z + (size_t)(MP + 32 * b + sr) * ZW + 64 * h + 8 * sch; kreg = *(const GAS v4u*)(zr_ + ZK); vreg = *(const GAS v4u*)(zr_ + ZV); } \
        else { kreg = (v4u){0u, 0u, 0u, 0u}; vreg = (v4u){0u, 0u, 0u, 0u}; } } while (0)
    AT_LOAD(0);
    for (int j = 0; j < ntile; ++j) {
        const int kc = 4 * qg - 8 + j;
        if (!sample && kc < 0) { AT_LOAD(j + 1); continue; }
        *(LAS v4u*)(Ks + sr * AT_PITCH + sch * 16) = kreg;
        { LAS bf16* vt = (LAS bf16*)VTs + (8 * sch) * (AT_PITCH / 2) + sr;
          vt[0 * (AT_PITCH / 2)] = (bf16)(vreg.x & 0xffffu); vt[1 * (AT_PITCH / 2)] = (bf16)(vreg.x >> 16); vt[2 * (AT_PITCH / 2)] = (bf16)(vreg.y & 0xffffu); vt[3 * (AT_PITCH / 2)] = (bf16)(vreg.y >> 16);
          vt[4 * (AT_PITCH / 2)] = (bf16)(vreg.z & 0xffffu); vt[5 * (AT_PITCH / 2)] = (bf16)(vreg.z >> 16); vt[6 * (AT_PITCH / 2)] = (bf16)(vreg.w & 0xffffu); vt[7 * (AT_PITCH / 2)] = (bf16)(vreg.w >> 16); }
        __syncthreads();
        if (j + 1 < ntile) AT_LOAD(j + 1);
        const bool active = sample ? (w == 0) : (kc >= qc - 8 && kc <= qc);
        if (active) {
            f32x16 p0, p1;
#pragma unroll
            for (int r = 0; r < 16; ++r) { p0[r] = 0.f; p1[r] = 0.f; }
#pragma unroll
            for (int d0 = 0; d0 < 4; ++d0) {
                const bf16x8 a0 = *(const LAS bf16x8*)(Ks + l31 * AT_PITCH + (16 * d0 + 8 * hh) * 2);
                const bf16x8 a1 = *(const LAS bf16x8*)(Ks + (32 + l31) * AT_PITCH + (16 * d0 + 8 * hh) * 2);
                p0 = MFMA32(a0, qr[d0], p0); p1 = MFMA32(a1, qr[d0], p1);
            }
            const int kbase = sample ? 64 * j - 512 : 64 * kc;
            const int relb = kbase - qpos;
            const int qmin = sample ? 0 : 256 * qg + 32 * w;
            if (kbase + 63 - qmin <= -128) { const float b0 = bt[0];
#pragma unroll
                for (int r = 0; r < 16; ++r) { p0[r] += b0; p1[r] += b0; }
            } else {
#pragma unroll
                for (int r = 0; r < 16; ++r) { const int kv = crow(r, hh); int i0 = relb + kv, i1 = i0 + 32;
                    i0 = (i0 < -128 ? -128 : (i0 > 128 ? 128 : i0)) + 128; i1 = (i1 < -128 ? -128 : (i1 > 128 ? 128 : i1)) + 128;
                    p0[r] += bt[i0]; p1[r] += bt[i1]; }
            }
            if (sample && j == 8) {
#pragma unroll
                for (int r = 0; r < 16; ++r) p1[r] = -1e30f;
            }
            float mx = p0[0];
#pragma unroll
            for (int r = 1; r < 16; ++r) mx = fmaxf(mx, p0[r]);
#pragma unroll
            for (int r = 0; r < 16; ++r) mx = fmaxf(mx, p1[r]);
            mx = fmaxf(mx, __shfl_xor(mx, 32));
            const float mn = fmaxf(mrun, mx), alpha = fast_exp2(mrun - mn); mrun = mn;
            float rs = 0.f;
#pragma unroll
            for (int r = 0; r < 16; ++r) { p0[r] = fast_exp2(p0[r] - mn); p1[r] = fast_exp2(p1[r] - mn); rs += p0[r] + p1[r]; }
            rs += __shfl_xor(rs, 32);
            lrun = lrun * alpha + rs;
#pragma unroll
            for (int r = 0; r < 16; ++r) { o0[r] *= alpha; o1[r] *= alpha; }
            bf16x8 pf[4];
            { v4u t;
              t = (v4u){pk2(p0[0], p0[1]), pk2(p0[2], p0[3]), pk2(p0[4], p0[5]), pk2(p0[6], p0[7])}; pf[0] = __builtin_bit_cast(bf16x8, t);
              t = (v4u){pk2(p0[8], p0[9]), pk2(p0[10], p0[11]), pk2(p0[12], p0[13]), pk2(p0[14], p0[15])}; pf[1] = __builtin_bit_cast(bf16x8, t);
              t = (v4u){pk2(p1[0], p1[1]), pk2(p1[2], p1[3]), pk2(p1[4], p1[5]), pk2(p1[6], p1[7])}; pf[2] = __builtin_bit_cast(bf16x8, t);
              t = (v4u){pk2(p1[8], p1[9]), pk2(p1[10], p1[11]), pk2(p1[12], p1[13]), pk2(p1[14], p1[15])}; pf[3] = __builtin_bit_cast(bf16x8, t); }
#pragma unroll
            for (int xt = 0; xt < 2; ++xt)
#pragma unroll
                for (int s = 0; s < 2; ++s) { const int kvo = 32 * xt + 16 * s + 4 * hh;
                    const v2u lo0 = *(const LAS v2u*)(VTs + l31 * AT_PITCH + kvo * 2), hi0 = *(const LAS v2u*)(VTs + l31 * AT_PITCH + (kvo + 8) * 2);
                    const v2u lo1 = *(const LAS v2u*)(VTs + (32 + l31) * AT_PITCH + kvo * 2), hi1 = *(const LAS v2u*)(VTs + (32 + l31) * AT_PITCH + (kvo + 8) * 2);
                    const v4u f0 = (v4u){lo0.x, lo0.y, hi0.x, hi0.y}, f1 = (v4u){lo1.x, lo1.y, hi1.x, hi1.y};
                    o0 = MFMA32(__builtin_bit_cast(bf16x8, f0), pf[2 * xt + s], o0); o1 = MFMA32(__builtin_bit_cast(bf16x8, f1), pf[2 * xt + s], o1); }
        }
        __syncthreads();
    }
#undef AT_LOAD
    if (wave_on) {
        const float inv = 1.0f / lrun;
        bf16* orow = MIX + (size_t)qrow * MIXW + MIX_B + 64 * h;
#pragma unroll
        for (int g4 = 0; g4 < 4; ++g4) { const int d = 8 * g4 + 4 * hh;
            v2u w0; w0.x = pk2(o0[4 * g4] * inv, o0[4 * g4 + 1] * inv); w0.y = pk2(o0[4 * g4 + 2] * inv, o0[4 * g4 + 3] * inv); *(GAS v2u*)(orow + d) = w0;
            v2u w1; w1.x = pk2(o1[4 * g4] * inv, o1[4 * g4 + 1] * inv); w1.y = pk2(o1[4 * g4 + 2] * inv, o1[4 * g4 + 3] * inv); *(GAS v2u*)(orow + 32 + d) = w1; }
    }
}
__device__ __forceinline__ unsigned sg_off(unsigned row, unsigned ch) { return 256u * row + 16u * (ch ^ (((row & 3u) << 2) | ((row >> 2) & 3u))); }
typedef short v4i16_t __attribute__((ext_vector_type(4)));
__device__ __forceinline__ v2u lds_tr_read(LAS unsigned char* p) { const v4i16_t r = __builtin_amdgcn_ds_read_tr16_b64_v4i16((LAS v4i16_t*)p); return __builtin_bit_cast(v2u, r); }
__device__ __forceinline__ void sg_unit(Frame& F, int layer, int ci, const bf16* Z, bf16* MIX) {
    const int lane = F.lane, w = F.wave, l31 = lane & 31, hh = lane >> 5;
    const bool sample = ci >= MP / 128; const int L = sample ? 32 : 128, row0 = sample ? MP + 32 * (ci - MP / 128) : 128 * ci;
    LAS unsigned char* VN = F.lds;
    {
        const int c8 = 8 * lane;
        const GAS f32x4* lgp = (const GAS f32x4*)(INP(I_SGG) + layer * DC + c8); const GAS f32x4* lbp = (const GAS f32x4*)(INP(I_SGB) + layer * DC + c8);
        const f32x4 lg0 = lgp[0], lg1 = lgp[1], lb0 = lbp[0], lb1 = lbp[1];
        const int nrw = L / 8;
        LAS unsigned char* vbase = VN + (lane >> 4) * 32768;
        for (int i = 0; i < nrw; ++i) { const int rr = w * nrw + i;
            const v4u zv = *(const GAS v4u*)(Z + (size_t)(row0 + rr) * ZW + ZSV + c8);
            float x[8] = {bflo(zv.x), bfhi(zv.x), bflo(zv.y), bfhi(zv.y), bflo(zv.z), bfhi(zv.z), bflo(zv.w), bfhi(zv.w)};
            const float s = ((x[0] + x[1]) + (x[2] + x[3])) + ((x[4] + x[5]) + (x[6] + x[7]));
            const float mean = wave_sum(s) * (1.0f / DC); float q = 0.f;
#pragma unroll
            for (int e = 0; e < 8; ++e) { x[e] -= mean; q += x[e] * x[e]; }
            const float rstd = 1.0f / sqrtf(wave_sum(q) * (1.0f / DC) + EPS);
            float y[8];
            y[0] = x[0] * rstd * lg0.x + lb0.x; y[1] = x[1] * rstd * lg0.y + lb0.y; y[2] = x[2] * rstd * lg0.z + lb0.z; y[3] = x[3] * rstd * lg0.w + lb0.w;
            y[4] = x[4] * rstd * lg1.x + lb1.x; y[5] = x[5] * rstd * lg1.y + lb1.y; y[6] = x[6] * rstd * lg1.z + lb1.z; y[7] = x[7] * rstd * lg1.w + lb1.w;
            *(LAS v4u*)(vbase + sg_off((unsigned)rr, (unsigned)(lane & 15))) = (v4u){pk2(y[0], y[1]), pk2(y[2], y[3]), pk2(y[4], y[5]), pk2(y[6], y[7])};
            if (sample) { float* so = F.out + O_SGV + (((size_t)layer * NBS + (ci - MP / 128)) * TS + rr) * DC + c8;
                *(GAS f32x4*)so = (f32x4){y[0], y[1], y[2], y[3]}; *(GAS f32x4*)(so + 4) = (f32x4){y[4], y[5], y[6], y[7]}; }
        }
    }
    __syncthreads();
    {
        const int g = w >> 1;
        const bf16* Wg = (const bf16*)(lw(F, layer) + LW_SGW) + (size_t)g * 128 * 128;
        LAS unsigned char* vg = VN + g * 32768;
        const int nib = L / 32;
        const unsigned blk = (lane >> 4) & 1, q = (lane & 15) >> 2, p4 = lane & 3;
#pragma unroll
        for (int cbb = 0; cbb < 2; ++cbb) { const int cb = 2 * (w & 1) + cbb;
            f32x16 acc[4];
#pragma unroll
            for (int ib = 0; ib < 4; ++ib)
#pragma unroll
                for (int r = 0; r < 16; ++r) acc[ib][r] = 0.f;
            for (int s = 0; s < 2 * nib; ++s) {
                const v2u a0 = lds_tr_read(vg + sg_off(16u * s + 8u * hh + q, 4u * cb + 2u * blk + (p4 >> 1)) + 8u * (p4 & 1));
                const v2u a1 = lds_tr_read(vg + sg_off(16u * s + 8u * hh + 4u + q, 4u * cb + 2u * blk + (p4 >> 1)) + 8u * (p4 & 1));
                const v4u af = (v4u){a0.x, a0.y, a1.x, a1.y};
#pragma unroll
                for (int ib = 0; ib < 4; ++ib) { if (ib < nib && s < 2 * (ib + 1)) {
                        const bf16x8 bb = *(const GAS bf16x8*)(Wg + (size_t)(32 * ib + l31) * 128 + 16 * s + 8 * hh);
                        acc[ib] = MFMA32(__builtin_bit_cast(bf16x8, af), bb, acc[ib]); } }
            }
#pragma unroll
            for (int ib = 0; ib < 4; ++ib) { if (ib < nib) {
                    const int i = 32 * ib + l31, row = row0 + i; const float bias = INP(I_SGBIAS)[((size_t)layer * 4 + g) * 128 + i];
#pragma unroll
                    for (int rg = 0; rg < 4; ++rg) { const int c4 = 32 * cb + 8 * rg + 4 * hh;
                        const v2u zu = *(const GAS v2u*)(Z + (size_t)row * ZW + ZSU + 128 * g + c4);
                        v2u o; o.x = pk2(bflo(zu.x) * (acc[ib][4 * rg] + bias), bfhi(zu.x) * (acc[ib][4 * rg + 1] + bias)); o.y = pk2(bflo(zu.y) * (acc[ib][4 * rg + 2] + bias), bfhi(zu.y) * (acc[ib][4 * rg + 3] + bias));
                        *(GAS v2u*)(MIX + (size_t)row * MIXW + MIX_D + 128 * g + c4) = o; } } }
        }
    }
    __syncthreads();
}
struct ConvCtx { const GAS unsigned char* zb; const GAS unsigned char* hist; GAS unsigned char* cst; bool sample, first, keep; };
template <int E> __device__ __forceinline__ void conv_row(f32x2 (&acc)[32], const f32x2 (&wt)[31], const ConvCtx& X) {
    f32x2 v;
    if constexpr (E < 30) { if (X.sample) v = *(const GAS f32x2*)(X.hist + (size_t)E * DC * 4);
                            else if (X.first) v = (f32x2){0.f, 0.f};
                            else { const unsigned u = *(const GAS unsigned*)(X.zb + (size_t)E * ZW * 2); v = (f32x2){bflo(u), bfhi(u)}; } }
    else { const unsigned u = *(const GAS unsigned*)(X.zb + (size_t)E * ZW * 2); v = (f32x2){bflo(u), bfhi(u)}; }
    constexpr int T0 = E > 30 ? E - 30 : 0, T1 = E < 31 ? E : 31;
#pragma unroll
    for (int t = T0; t <= T1; ++t) acc[t] = wt[E - t] * v + acc[t];
    if constexpr (E >= 32) { if (X.keep) *(GAS f32x2*)(X.cst + (size_t)(E - 32) * DC * 4) = v; }
}
template <int... Es> __device__ __forceinline__ void conv_rows(f32x2 (&acc)[32], const f32x2 (&wt)[31], const ConvCtx& X, std::integer_sequence<int, Es...>) { (conv_row<Es>(acc, wt, X), ...); }
__device__ __forceinline__ void conv_unit(Frame& F, int layer, int tb, int cq, const bf16* Z, bf16* CA, int ca_pitch) {
    const int c = 128 * cq + 2 * F.lane; const bool sample = tb >= MP / 32; const int sb = tb - MP / 32;
    const int r0 = sample ? MP + 32 * sb : 32 * tb; const bool first = !sample && ((r0 & (SEQ - 1)) == 0);
    ConvCtx X; X.sample = sample; X.first = first; X.keep = sample || ((r0 & (SEQ - 1)) == SEQ - 32);
    X.zb = (const GAS unsigned char*)(Z + ((long)r0 - 30) * ZW + ZU + c); asm volatile("" : "+v"(X.zb));
    const GAS unsigned char* wb = (const GAS unsigned char*)(INP(I_CONVW) + (size_t)layer * 31 * DC + c); asm volatile("" : "+v"(wb));
    f32x2 wt[31];
#pragma unroll
    for (int j = 0; j < 31; ++j) wt[j] = *(const GAS f32x2*)(wb + (size_t)j * DC * 4);
    const f32x2 cbias = *(const GAS f32x2*)(INP(I_CONVB) + layer * DC + c), gg = *(const GAS f32x2*)(INP(I_GNG) + layer * DC + c), gb = *(const GAS f32x2*)(INP(I_GNB) + layer * DC + c);
    f32x2 acc[32];
#pragma unroll
    for (int t = 0; t < 32; ++t) acc[t] = cbias;
    X.hist = (const GAS unsigned char*)(INP(I_CCONV) + ((size_t)layer * NBS + (sample ? sb : 0)) * 30 * DC + c); asm volatile("" : "+v"(X.hist));
    X.cst = (GAS unsigned char*)(sample ? F.out + O_CONVS + ((size_t)layer * NBS + sb) * 30 * DC + c : F.out + O_CONVP + ((size_t)layer * NBP + (r0 >> 13)) * 30 * DC + c); asm volatile("" : "+v"(X.cst));
    GAS unsigned char* cab = (GAS unsigned char*)(CA + (size_t)r0 * ca_pitch + c); asm volatile("" : "+v"(cab));
    conv_rows(acc, wt, X, std::make_integer_sequence<int, 62>{});
#pragma unroll
    for (int t = 0; t < 32; ++t) {
        const f32x2 y = acc[t];
        const float s = half32_sum(y.x + y.y), q = half32_sum(y.x * y.x + y.y * y.y);
        const float mean = s * (1.0f / 64.0f), var = fmaxf(q * (1.0f / 64.0f) - mean * mean, 0.f), rstd = 1.0f / sqrtf(var + EPS);
        const f32x2 n = (y - mean) * rstd * gg + gb;
        *(GAS unsigned*)(cab + (size_t)t * ca_pitch * 2) = pk2(siluf_(n.x), siluf_(n.y));
    }
}
template <int W>
__device__ __forceinline__ void pool_body(Frame& F, int layer, int tb, int cq, const bf16* Z, bf16* PM, int pm_pitch) {
    const int c = 128 * cq + 2 * F.lane; const bool sample = tb >= MP / 32; const int sb = tb - MP / 32;
    const int r0 = sample ? MP + 32 * sb : 32 * tb; const bool first = !sample && ((r0 & (SEQ - 1)) == 0);
    const GAS unsigned char* hist = (const GAS unsigned char*)(INP(I_CPOOL) + ((size_t)layer * NBS + (sample ? sb : 0)) * 15 * DC + c); asm volatile("" : "+v"(hist));
    const bool last_blk = !sample && ((r0 & (SEQ - 1)) == SEQ - 32);
    GAS unsigned char* pst = (GAS unsigned char*)(sample ? F.out + O_POOLS + ((size_t)layer * NBS + sb) * 15 * DC + c : F.out + O_POOLP + ((size_t)layer * NBP + (r0 >> 13)) * 15 * DC + c); asm volatile("" : "+v"(pst));
    const GAS unsigned char* zb = (const GAS unsigned char*)(Z + ((long)r0 - 15) * ZW + ZP + c); asm volatile("" : "+v"(zb));
    GAS unsigned char* pmb = (GAS unsigned char*)(PM + (size_t)r0 * pm_pitch + c); asm volatile("" : "+v"(pmb));
    f32x2 ext[47];
#pragma unroll
    for (int e = 0; e < 47; ++e) {
        if (e < 15) { if (sample) ext[e] = *(const GAS f32x2*)(hist + (size_t)e * DC * 4);
                      else if (first) ext[e] = (f32x2){0.f, 0.f};
                      else { const unsigned u = *(const GAS unsigned*)(zb + (size_t)e * ZW * 2); ext[e] = (f32x2){bflo(u), bfhi(u)}; } }
        else { const unsigned u = *(const GAS unsigned*)(zb + (size_t)e * ZW * 2); ext[e] = (f32x2){bflo(u), bfhi(u)}; }
    }
#pragma unroll
    for (int t = 0; t < 32; ++t) {
        f32x2 win = (f32x2){0.f, 0.f};
#pragma unroll
        for (int i = W - 1; i >= 0; --i) win += ext[15 + t - i];
        const float rc = 1.0f / (float)((first && t + 1 < W) ? t + 1 : W);
        const f32x2 m = win * rc - ext[15 + t];
        *(GAS unsigned*)(pmb + (size_t)t * pm_pitch * 2) = pk2(m.x, m.y);
        if (t >= 17 && (sample || last_blk)) *(GAS f32x2*)(pst + (size_t)(t - 17) * DC * 4) = ext[15 + t];
    }
}
__device__ __forceinline__ void mixer_phase(Frame& F, int layer) {
    const bf16* Z = (const bf16*)(F.ws + WS_Z); bf16* MIX = (bf16*)(F.ws + WS_MIX); bf16* CA = (bf16*)(F.ws + WS_CAPM); bf16* PM = CA + (size_t)MT * DC;
#ifndef PROBE_MIX
#define PROBE_MIX 0
#endif
#define MDUP(k) _Pragma("unroll") for (int mrep_ = 0; mrep_ < 1 + ((PROBE_MIX >> (k)) & 1); ++mrep_)
    MDUP(0) { for (int id = F.vcu; id < NBP * 8 * 32; id += F.G) attn_unit(F, layer, false, id >> 8, (id >> 5) & 7, id & 31, Z, MIX);
    for (int id = F.vcu; id < NBS * 8; id += F.G) attn_unit(F, layer, true, id >> 3, id & 7, 0, Z, MIX); }
    MDUP(1) for (int id = F.vcu; id < MP / 128 + NBS; id += F.G) sg_unit(F, layer, id, Z, MIX);
    const int gw = F.vcu * NWAVES + F.wave, NGW = F.G * NWAVES;
    MDUP(2) for (int id = gw; id < (MT / 32) * 4; id += NGW) conv_unit(F, layer, id >> 2, id & 3, Z, CA, DC);
    MDUP(3) for (int id = gw; id < (MT / 32) * 4; id += NGW) { const int tb = id >> 2, cq = id & 3;
        switch (cq) { case 0: pool_body<2>(F, layer, tb, cq, Z, PM, DC); break; case 1: pool_body<4>(F, layer, tb, cq, Z, PM, DC); break;
                      case 2: pool_body<8>(F, layer, tb, cq, Z, PM, DC); break; default: pool_body<16>(F, layer, tb, cq, Z, PM, DC); break; } }
    const int gt = F.vcu * (NWAVES * 64) + F.tid, NGT = F.G * NWAVES * 64;
    for (int i = gt; i < (NBP * 512 + NBS * TS) * 128; i += NGT) {
        const int rr = i >> 7, kv = (i >> 6) & 1, ch = i & 63;
        int zrow; size_t o;
        if (rr < NBP * 512) { const int b = rr >> 9, t = rr & 511; zrow = b * SEQ + SEQ - 512 + t; o = (kv ? O_VP : O_KP) + (((size_t)layer * NBP + b) * 512 + t) * 512 + 8 * ch; }
        else { const int r2 = rr - NBP * 512, b = r2 >> 5, t = r2 & 31; zrow = MP + r2; o = (kv ? O_VS : O_KS) + (((size_t)layer * NBS + b) * TS + t) * 512 + 8 * ch; }
        const v4u z = *(const GAS v4u*)(Z + (size_t)zrow * ZW + (kv ? ZV : ZK) + 8 * ch);
        *(GAS f32x4*)(F.out + o) = (f32x4){bflo(z.x), bfhi(z.x), bflo(z.y), bfhi(z.y)}; *(GAS f32x4*)(F.out + o + 4) = (f32x4){bflo(z.z), bfhi(z.z), bflo(z.w), bfhi(z.w)};
    }
}

constexpr int N_PHASES = 2 + 8 * NL + 1;

__global__ void __launch_bounds__(NWAVES * 64, 2) enc_fwd(Args args) {
    extern __shared__ __attribute__((aligned(16))) unsigned char lds[];
    Frame F;
    F.lds = (LAS unsigned char*)lds;
    F.tid = threadIdx.x; F.lane = F.tid & 63; F.wave = __builtin_amdgcn_readfirstlane(F.tid >> 6);
    F.G = gridDim.x; { const int bx = blockIdx.x; F.vcu = (F.G % 8 == 0) ? (bx % 8) * (F.G / 8) + bx / 8 : bx; }
    F.ka = (KArgs)__builtin_amdgcn_kernarg_segment_ptr();
    F.out = args.out; F.ws = args.ws;
    volatile LAS unsigned* MISC = (volatile LAS unsigned*)(F.lds + MISC_OFF);
    for (int u = F.tid; u < (LDS_BYTES - LDSCTL_OFF) / 4; u += NWAVES * 64) ((LAS unsigned*)(F.lds + LDSCTL_OFF))[u] = 0u;
    __syncthreads();
    const int lo = args.ph_lo, hi = args.ph_hi;
#define REFRESH() do { int t_ = threadIdx.x; asm volatile("" : "+v"(t_)); F.tid = t_; F.lane = t_ & 63; F.wave = __builtin_amdgcn_readfirstlane(t_ >> 6); \
        unsigned long long w_ = (unsigned long long)args.ws, o_ = (unsigned long long)args.out, k_ = (unsigned long long)__builtin_amdgcn_kernarg_segment_ptr(); \
        asm volatile("" : "+s"(w_), "+s"(o_), "+s"(k_)); F.ws = (unsigned char*)(GAS unsigned char*)w_; F.out = (float*)(GAS float*)o_; F.ka = (KArgs)k_; \
        unsigned l_ = (unsigned)(unsigned long long)(LAS unsigned char*)lds; asm volatile("" : "+s"(l_)); F.lds = (LAS unsigned char*)(unsigned long long)l_; } while (0)
    XcdBarrier bar; bar.bar = (unsigned*)(F.ws + WS_CTL) + CW_BAR; bar.x = 0; bar.st = nullptr;
    if (hi - lo > 1) bar = xcd_barrier_post((unsigned*)(F.ws + WS_CTL) + CW_BAR, MISC + 8);
#ifdef ONLY_PHASE
#define IN(k) ((((k) < 2 || (k) == N_PHASES - 1) ? (k) : 2 + ((k) - 2) % 8) == ONLY_PHASE && lo <= (k) && (k) < hi)
#else
#define IN(k) (lo <= (k) && (k) < hi)
#endif
#ifndef PROBE_DUP
#define PROBE_DUP 0
#endif
#define DUP(k) _Pragma("unroll") for (int rep_ = 0; rep_ < 1 + ((PROBE_DUP >> (k)) & 1); ++rep_)
#define SEAM(k) do { if (IN(k) && IN((k) + 1)) { XcdBarrier b_ = bar; unsigned long long p_ = (unsigned long long)b_.bar; asm volatile("" : "+s"(p_)); b_.bar = (unsigned*)p_; xcd_barrier(b_); } } while (0)

    if (IN(0)) DUP(8) { REFRESH(); p0a_phase(F); } SEAM(0);
    if (IN(1)) { REFRESH(); p0b_phase(F); } SEAM(1);
    for (int l = 0; l < NL; ++l) {
        const int pb = 2 + 8 * l;
        if (IN(pb + 0)) DUP(0) { REFRESH(); bf16* H = (bf16*)(F.ws + WS_H); bf16* Zb = (bf16*)(F.ws + WS_Z); bf16* MIX = (bf16*)(F.ws + WS_MIX); bf16* HID = (bf16*)(F.ws + WS_HID); bf16* CAPM = (bf16*)(F.ws + WS_CAPM); (void)H; (void)Zb; (void)MIX; (void)HID; (void)CAPM; const float* mod_l = modp(F, l); unsigned char* wl = lw(F, l); (void)mod_l; (void)wl; if (l == 0) norm_phase<true>(F, INP(I_N1) + l * DM, mod_l, 0, H); else norm_phase<false>(F, INP(I_N1) + l * DM, mod_l, 0, H); } SEAM(pb + 0);
        if (IN(pb + 1)) DUP(1) { REFRESH(); bf16* H = (bf16*)(F.ws + WS_H); bf16* Zb = (bf16*)(F.ws + WS_Z); bf16* MIX = (bf16*)(F.ws + WS_MIX); bf16* HID = (bf16*)(F.ws + WS_HID); bf16* CAPM = (bf16*)(F.ws + WS_CAPM); (void)H; (void)Zb; (void)MIX; (void)HID; (void)CAPM; const float* mod_l = modp(F, l); unsigned char* wl = lw(F, l); (void)mod_l; (void)wl; pg8::Gemm g{H, (const bf16*)(wl + LW_WIN), MT, DIN, DM}; pg8::StaticOrder S; S.init(MT, DIN, F.G, (int)blockIdx.x); pg8::EpiZ E{Zb};
            pg8::gemm_phase<pg8::EpiZ, pg8::StaticOrder, true, true>(F.lds, g, S, E); } SEAM(pb + 1);
        if (IN(pb + 2)) DUP(2) { REFRESH(); bf16* H = (bf16*)(F.ws + WS_H); bf16* Zb = (bf16*)(F.ws + WS_Z); bf16* MIX = (bf16*)(F.ws + WS_MIX); bf16* HID = (bf16*)(F.ws + WS_HID); bf16* CAPM = (bf16*)(F.ws + WS_CAPM); (void)H; (void)Zb; (void)MIX; (void)HID; (void)CAPM; const float* mod_l = modp(F, l); unsigned char* wl = lw(F, l); (void)mod_l; (void)wl; mixer_phase(F, l); } SEAM(pb + 2);
        if (IN(pb + 3)) DUP(3) { REFRESH(); bf16* H = (bf16*)(F.ws + WS_H); bf16* Zb = (bf16*)(F.ws + WS_Z); bf16* MIX = (bf16*)(F.ws + WS_MIX); bf16* HID = (bf16*)(F.ws + WS_HID); bf16* CAPM = (bf16*)(F.ws + WS_CAPM); (void)H; (void)Zb; (void)MIX; (void)HID; (void)CAPM; const float* mod_l = modp(F, l); unsigned char* wl = lw(F, l); (void)mod_l; (void)wl; pg8::Gemm g{CAPM, (const bf16*)(wl + LW_CPW), 2 * MT, 2 * DC, DC}; pg8::Mix2Order S{F.G, (int)blockIdx.x}; pg8::EpiMix2 E{MIX};
            pg8::gemm_phase<pg8::EpiMix2, pg8::Mix2Order, true, true>(F.lds, g, S, E); } SEAM(pb + 3);
        if (IN(pb + 4)) DUP(4) { REFRESH(); bf16* H = (bf16*)(F.ws + WS_H); bf16* Zb = (bf16*)(F.ws + WS_Z); bf16* MIX = (bf16*)(F.ws + WS_MIX); bf16* HID = (bf16*)(F.ws + WS_HID); bf16* CAPM = (bf16*)(F.ws + WS_CAPM); (void)H; (void)Zb; (void)MIX; (void)HID; (void)CAPM; const float* mod_l = modp(F, l); unsigned char* wl = lw(F, l); (void)mod_l; (void)wl; pg8::Gemm g{MIX, (const bf16*)(wl + LW_WOUT), MT, DM, DM}; pg8::StaticOrder S; S.init(MT, DM, F.G, (int)blockIdx.x); pg8::EpiRes E{F.out, mod_l + 2 * DM};
            pg8::gemm_phase<pg8::EpiRes, pg8::StaticOrder, true, true>(F.lds, g, S, E); } SEAM(pb + 4);
        if (IN(pb + 5)) DUP(5) { REFRESH(); bf16* H = (bf16*)(F.ws + WS_H); bf16* Zb = (bf16*)(F.ws + WS_Z); bf16* MIX = (bf16*)(F.ws + WS_MIX); bf16* HID = (bf16*)(F.ws + WS_HID); bf16* CAPM = (bf16*)(F.ws + WS_CAPM); (void)H; (void)Zb; (void)MIX; (void)HID; (void)CAPM; const float* mod_l = modp(F, l); unsigned char* wl = lw(F, l); (void)mod_l; (void)wl; norm_phase<false>(F, INP(I_N2) + l * DM, mod_l, 3, H); } SEAM(pb + 5);
        if (IN(pb + 6)) DUP(6) { REFRESH(); bf16* H = (bf16*)(F.ws + WS_H); bf16* Zb = (bf16*)(F.ws + WS_Z); bf16* MIX = (bf16*)(F.ws + WS_MIX); bf16* HID = (bf16*)(F.ws + WS_HID); bf16* CAPM = (bf16*)(F.ws + WS_CAPM); (void)H; (void)Zb; (void)MIX; (void)HID; (void)CAPM; const float* mod_l = modp(F, l); unsigned char* wl = lw(F, l); (void)mod_l; (void)wl; pg8::Gemm g{H, (const bf16*)(wl + LW_WGU), MT, 2 * DFF, DM}; pg8::StaticOrder S; S.init(MT, 2 * DFF, F.G, (int)blockIdx.x); pg8::EpiSwi E{HID};
            pg8::gemm_phase<pg8::EpiSwi, pg8::StaticOrder, true, true>(F.lds, g, S, E); } SEAM(pb + 6);
        if (IN(pb + 7)) DUP(7) { REFRESH(); bf16* H = (bf16*)(F.ws + WS_H); bf16* Zb = (bf16*)(F.ws + WS_Z); bf16* MIX = (bf16*)(F.ws + WS_MIX); bf16* HID = (bf16*)(F.ws + WS_HID); bf16* CAPM = (bf16*)(F.ws + WS_CAPM); (void)H; (void)Zb; (void)MIX; (void)HID; (void)CAPM; const float* mod_l = modp(F, l); unsigned char* wl = lw(F, l); (void)mod_l; (void)wl; pg8::Gemm g{HID, (const bf16*)(wl + LW_WD), MT, DM, DFF}; pg8::StaticOrder S; S.init(MT, DM, F.G, (int)blockIdx.x); pg8::EpiRes E{F.out, mod_l + 5 * DM};
            pg8::gemm_phase<pg8::EpiRes, pg8::StaticOrder, true, true>(F.lds, g, S, E); } SEAM(pb + 7);
    }
    if (IN(N_PHASES - 1)) { REFRESH(); final_norm_phase(F); }
#undef IN
#undef SEAM
}

extern "C" void kernel_launch(void* const* d_in, const int* in_sizes, int n_in, void* d_out, int out_size, void* d_ws, size_t ws_size, hipStream_t stream) {
    static int grid = 0;
    if (grid == 0) {
        if (n_in != N_IN || in_sizes[0] != MP * DM || (size_t)out_size != O_END || ws_size < WS_END) {
            fprintf(stderr, "kernel_launch: unexpected shapes: n_in %d in0 %d out %d ws %zu (need %zu); nothing launched\n", n_in, n_in > 0 ? in_sizes[0] : -1, out_size, ws_size, (size_t)WS_END); grid = -1; return; }
        int dev = 0, cus = 0;
        if (hipGetDevice(&dev) != hipSuccess || hipDeviceGetAttribute(&cus, hipDeviceAttributeMultiprocessorCount, dev) != hipSuccess) { grid = -1; return; }
        if (hipFuncSetAttribute((const void*)enc_fwd, hipFuncAttributeMaxDynamicSharedMemorySize, LDS_BYTES) != hipSuccess) { fprintf(stderr, "kernel_launch: hipFuncSetAttribute failed\n"); grid = -1; return; }
        int per_cu = 0;
        if (hipOccupancyMaxActiveBlocksPerMultiprocessor(&per_cu, (const void*)enc_fwd, NWAVES * 64, LDS_BYTES) != hipSuccess || per_cu < 1)
            fprintf(stderr, "kernel_launch: note: occupancy query reports %d workgroups per CU\n", per_cu);
        (void)hipGetLastError();
        grid = cus;
    }
    if (grid < 0) return;
    if (hipMemsetAsync((char*)d_ws + WS_CTL, 0, CTL_ZERO_BYTES, stream) != hipSuccess) return;
    Args a{};
    for (int i = 0; i < N_IN; ++i) a.in[i] = (const float*)d_in[i];
    a.out = (float*)d_out; a.ws = (unsigned char*)d_ws; a.pad0 = 0; a.pad1 = 0;
#if MK_ONE_LAUNCH
    a.ph_lo = 0; a.ph_hi = N_PHASES;
    hipLaunchKernelGGL(enc_fwd, dim3(grid), dim3(NWAVES * 64), LDS_BYTES, stream, a);
#else
    for (int ph = 0; ph < N_PHASES; ++ph) { a.ph_lo = ph; a.ph_hi = ph + 1;
        hipLaunchKernelGGL(enc_fwd, dim3(grid), dim3(NWAVES * 64), LDS_BYTES, stream, a); }
#endif
}
```

```cpp
#include <hip/hip_runtime.h>
#include <cstdio>
#include <cstdint>
#include <utility>

#ifndef MK_ONE_LAUNCH
#define MK_ONE_LAUNCH 1
#endif
#ifndef PROBE_DUP
#define PROBE_DUP 0
#endif
#ifndef PROBE_MIX
#define PROBE_MIX 0
#endif
#ifndef PROBE_EPI2
#define PROBE_EPI2 0
#endif
#ifndef STAGGER_TICKS
#define STAGGER_TICKS 0
#endif

constexpr int DM = 2048, SEQ = 8192, NBP = 4, MP = NBP * SEQ, NBS = 8, TS = 32, MS = NBS * TS, MT = MP + MS, NPANEL = MT / 256;
constexpr int DIN = 4096, DFF = 5632, DC = 512, NL = 4, NMOD = 6 * DM, NBT = NBP + NBS;
constexpr int ZW = 3584, ZU = 0, ZQ = 512, ZK = 1024, ZV = 1536, ZP = 2048, ZSU = 2560, ZSV = 3072;
constexpr int MIXW = 2048, MIX_A = 0, MIX_B = 512, MIX_C = 1024, MIX_D = 1536;
constexpr float EPS = 1e-6f, LOG2E = 1.4426950408889634f, QSCALE = 0.125f * LOG2E;
constexpr int KSPLIT = 16;
constexpr size_t O_YP = 0, O_YS = O_YP + (size_t)MP * DM, O_CONVP = O_YS + (size_t)MS * DM, O_CONVS = O_CONVP + (size_t)NL * NBP * 30 * DC,
    O_KP = O_CONVS + (size_t)NL * NBS * 30 * DC, O_VP = O_KP + (size_t)NL * NBP * 512 * 512, O_KS = O_VP + (size_t)NL * NBP * 512 * 512,
    O_VS = O_KS + (size_t)NL * NBS * TS * 512, O_POOLP = O_VS + (size_t)NL * NBS * TS * 512, O_POOLS = O_POOLP + (size_t)NL * NBP * 15 * DC,
    O_SGV = O_POOLS + (size_t)NL * NBS * 15 * DC, O_END = O_SGV + (size_t)NL * NBS * TS * DC;
static_assert(O_END == 78700544, "output size");
enum { I_XP = 0, I_XS, I_CP, I_CS, I_CCONV, I_CK, I_CV, I_CPOOL, I_ADAW, I_ADAB, I_N1, I_N2, I_WIN, I_CONVW, I_CONVB, I_GNG, I_GNB, I_CPW, I_RELB,
       I_POOLW, I_POOLS, I_SGG, I_SGB, I_SGW, I_SGBIAS, I_WOUT, I_WG, I_WU, I_WD, I_FING, N_IN };
static_assert(N_IN == 30, "30 inputs");

constexpr size_t MiB = 1u << 20;
constexpr size_t WS_CTL = 0, CTL_ZERO_BYTES = 1 * MiB;
constexpr size_t WS_MOD = 1 * MiB;
constexpr size_t WS_MODP = 4 * MiB;
constexpr size_t WS_W = 40 * MiB;
constexpr size_t LW_WIN = 0, LW_WOUT = 16 * MiB, LW_WGU = 24 * MiB, LW_WD = 68 * MiB, LW_CPW = 90 * MiB, LW_PWD = LW_CPW + 512 * 1024, LW_SGW = 91 * MiB, LW = 91 * MiB + 256 * 1024;
constexpr size_t WS_H = WS_W + NL * LW;
constexpr size_t WS_Z = WS_H + (size_t)MT * DM * 2;
constexpr size_t WS_MIX = WS_Z + (size_t)MT * ZW * 2;
constexpr size_t WS_HID = WS_Z;
constexpr size_t WS_CAPM = WS_MIX + (size_t)MT * MIXW * 2;
constexpr size_t WS_END = WS_CAPM + (size_t)2 * MT * DC * 2;
static_assert(WS_HID + (size_t)MT * DFF * 2 <= WS_CAPM, "HID overlay");
static_assert((size_t)NL * 12 * NMOD * 4 <= 3 * MiB && (size_t)KSPLIT * NL * 12 * NMOD * 4 <= 36 * MiB, "mod buffers");
constexpr int CW_BAR = 4096;

constexpr int RING_BYTES = 131072;
constexpr int LDSCTL_OFF = RING_BYTES, MISC_OFF = LDSCTL_OFF + 320;
constexpr int LDS_BYTES = 147456;
constexpr int NWAVES = 8;

#define GAS __attribute__((address_space(1)))
#define LAS __attribute__((address_space(3)))
typedef unsigned short bf16;
typedef unsigned v4u __attribute__((ext_vector_type(4)));
typedef unsigned v2u __attribute__((ext_vector_type(2)));
typedef float f32x4 __attribute__((ext_vector_type(4)));
typedef float f32x2 __attribute__((ext_vector_type(2)));
typedef float f32x16 __attribute__((ext_vector_type(16)));
typedef short bf16x8 __attribute__((ext_vector_type(8)));
typedef __bf16 bf16x2_t __attribute__((ext_vector_type(2)));
typedef GAS unsigned gu32;
#define RLX_AGENT __ATOMIC_RELAXED, __HIP_MEMORY_SCOPE_AGENT
#define LDS_WAIT() asm volatile("s_waitcnt lgkmcnt(0)" ::: "memory")
#define VM_WAIT() asm volatile("s_waitcnt vmcnt(0)" ::: "memory")

__device__ __forceinline__ unsigned pk2(float lo, float hi) { f32x2 v = {lo, hi}; bf16x2_t b = __builtin_convertvector(v, bf16x2_t); return __builtin_bit_cast(unsigned, b); }
__device__ __forceinline__ float bflo(unsigned u) { return __uint_as_float(u << 16); }
__device__ __forceinline__ float bfhi(unsigned u) { return __uint_as_float(u & 0xffff0000u); }
__device__ __forceinline__ float bf2f(bf16 h) { return __uint_as_float((unsigned)h << 16); }
__device__ __forceinline__ float fast_exp2(float x) { return __builtin_amdgcn_exp2f(x); }
__device__ __forceinline__ float fast_rcp(float x) { return __builtin_amdgcn_rcpf(x); }
__device__ __forceinline__ float sigmoidf_(float x) { return fast_rcp(1.0f + fast_exp2(-x * LOG2E)); }
__device__ __forceinline__ float siluf_(float x) { return x * sigmoidf_(x); }
template <int CTRL> __device__ __forceinline__ float dpp_f(float v) { return __int_as_float(__builtin_amdgcn_update_dpp(0, __float_as_int(v), CTRL, 0xF, 0xF, true)); }
__device__ __forceinline__ float row16_sum(float v) { v += dpp_f<0xB1>(v); v += dpp_f<0x4E>(v); v += dpp_f<0x141>(v); v += dpp_f<0x140>(v); return v; }
__device__ __forceinline__ float half32_sum(float v) { v = row16_sum(v); v += __int_as_float(__builtin_amdgcn_ds_swizzle(__float_as_int(v), 0x401F)); return v; }
__device__ __forceinline__ float wave_sum(float v) { v = half32_sum(v);
    return __int_as_float(__builtin_amdgcn_readlane(__float_as_int(v), 0)) + __int_as_float(__builtin_amdgcn_readlane(__float_as_int(v), 32)); }
__device__ __forceinline__ int batch_of_row(int row) { return row < MP ? (row >> 13) : NBP + ((row - MP) >> 5); }

namespace pg8 {
#define PG8_LAS __attribute__((address_space(3)))
typedef unsigned short bf16_t;
typedef short bf16x8 __attribute__((ext_vector_type(8)));
typedef float f32x4 __attribute__((ext_vector_type(4)));
typedef unsigned u32x4 __attribute__((ext_vector_type(4)));
constexpr int BM = 256, BK = 64, HALF = 128, HTB = HALF * BK * 2  , STAGE_BYTES = 8 * HTB, NXCD = 8, WGM = 8;

__host__ __device__ __forceinline__ int lds_byte(int r, int c) { const int st = (r >> 4) * 2 + (c >> 5), rr = r & 15, cc = c & 31, ob = rr * 64 + cc * 2; return st * 1024 + (ob ^ (((ob >> 9) & 1) << 5)); }
__host__ __device__ __forceinline__ void stage_rc(int b, int& R, int& C) { const int st = b / 1024, sb = b % 1024, swz = sb ^ (((sb >> 9) & 1) << 5); R = (st >> 1) * 16 + swz / 64; C = (st & 1) * 32 + (swz % 64) / 2; }
__host__ __device__ __forceinline__ int perm32(int rho) { const int n = rho >> 4, i = rho & 15; return 8 * (i >> 2) + 4 * n + (i & 3); }

struct Unit { int pm, pn; };
struct Gemm { const bf16_t* A; const bf16_t* Bt; int M, N, K; };

struct StaticOrder {
    int nM, nN, nwg, G, c;
    __host__ __device__ void init(int M, int N, int G_, int c_) { nM = M / BM; nN = N / BM; nwg = nM * nN; G = G_; c = c_; }
    __host__ __device__ bool next(int i, Unit& u) const {
        const long L = (long)i * G + c; if (L >= nwg) return false;
        int wgid = (int)L; { const int q = nwg / NXCD, r = nwg % NXCD, xcd = wgid % NXCD, off = wgid / NXCD; wgid = (xcd < r ? xcd * (q + 1) : r * (q + 1) + (xcd - r) * q) + off; }
        const int nig = WGM * nN, gid = wgid / nig, fm = gid * WGM, gsz = (nM - fm) < WGM ? (nM - fm) : WGM;
        u.pm = fm + ((wgid % nig) % gsz); u.pn = (wgid % nig) / gsz; return true;
    }
    __device__ __forceinline__ void a_ready(const Unit&) const {}
    __device__ __forceinline__ void done(const Unit&) const {}
};
__device__ __forceinline__ unsigned cvt_pk_bf16(float lo, float hi) { return ::pk2(lo, hi); }
struct EpiZ {
    static constexpr bool PERM = true, AFTER_DRAIN = false;
    bf16_t* Z;
    __device__ __forceinline__ void operator()(const f32x4 (&acc)[2][2][4][2], const Unit& u, int wr, int wc, int fr, int fq) const {
        const int row0 = u.pm * BM + wr * 64 + fr;
        if (u.pn < 4) {
            const int col0 = 128 * u.pn + wc * 32 + 8 * fq;
#pragma unroll
            for (int ai = 0; ai < 2; ++ai)
#pragma unroll
                for (int m = 0; m < 4; ++m) { bf16_t* rowp = Z + (size_t)(row0 + ai * HALF + m * 16) * ::ZW + col0;
                    const f32x4 a0 = acc[ai][0][m][0], a1 = acc[ai][0][m][1], g0 = acc[ai][1][m][0], g1 = acc[ai][1][m][1];
                    u32x4 w; w.x = cvt_pk_bf16(a0[0] * ::sigmoidf_(g0[0]), a0[1] * ::sigmoidf_(g0[1])); w.y = cvt_pk_bf16(a0[2] * ::sigmoidf_(g0[2]), a0[3] * ::sigmoidf_(g0[3]));
                    w.z = cvt_pk_bf16(a1[0] * ::sigmoidf_(g1[0]), a1[1] * ::sigmoidf_(g1[1])); w.w = cvt_pk_bf16(a1[2] * ::sigmoidf_(g1[2]), a1[3] * ::sigmoidf_(g1[3]));
                    *(u32x4*)rowp = w; }
        } else {
            const float sc = (u.pn < 6) ? ::QSCALE : 1.0f;
            const int col0 = 512 + 256 * (u.pn - 4) + wc * 32 + 8 * fq;
#pragma unroll
            for (int ai = 0; ai < 2; ++ai)
#pragma unroll
                for (int m = 0; m < 4; ++m) { bf16_t* rowp = Z + (size_t)(row0 + ai * HALF + m * 16) * ::ZW + col0;
#pragma unroll
                    for (int bj = 0; bj < 2; ++bj) { const f32x4 v0 = acc[ai][bj][m][0] * sc, v1 = acc[ai][bj][m][1] * sc;
                        u32x4 w; w.x = cvt_pk_bf16(v0[0], v0[1]); w.y = cvt_pk_bf16(v0[2], v0[3]); w.z = cvt_pk_bf16(v1[0], v1[1]); w.w = cvt_pk_bf16(v1[2], v1[3]);
                        *(u32x4*)(rowp + bj * HALF) = w; } }
        }
    }
};
struct EpiMix2 {
    static constexpr bool PERM = true, AFTER_DRAIN = false;
    bf16_t* MIX;
    __device__ __forceinline__ void operator()(const f32x4 (&acc)[2][2][4][2], const Unit& u, int wr, int wc, int fr, int fq) const {
        const int which = u.pn >> 1, pm = u.pm - which * ::NPANEL;
        const int row0 = pm * BM + wr * 64 + fr, col0 = which * 1024 + (u.pn & 1) * 256 + wc * 32 + 8 * fq;
#pragma unroll
        for (int ai = 0; ai < 2; ++ai)
#pragma unroll
            for (int m = 0; m < 4; ++m) { bf16_t* rowp = MIX + (size_t)(row0 + ai * HALF + m * 16) * ::MIXW + col0;
#pragma unroll
                for (int bj = 0; bj < 2; ++bj) { const f32x4 v0 = acc[ai][bj][m][0], v1 = acc[ai][bj][m][1];
                    u32x4 w; w.x = cvt_pk_bf16(v0[0], v0[1]); w.y = cvt_pk_bf16(v0[2], v0[3]); w.z = cvt_pk_bf16(v1[0], v1[1]); w.w = cvt_pk_bf16(v1[2], v1[3]);
                    *(u32x4*)(rowp + bj * HALF) = w; } }
    }
};
struct EpiRes {
    static constexpr bool PERM = false, AFTER_DRAIN = false;
    float* X; const float* gate;
    __device__ __forceinline__ void operator()(const f32x4 (&acc)[2][2][4][2], const Unit& u, int wr, int wc, int fr, int fq) const {
        const int col0 = u.pn * BM + wc * 32 + 4 * fq;
#pragma unroll
        for (int ai = 0; ai < 2; ++ai)
#pragma unroll
            for (int m = 0; m < 4; ++m) { const int row = u.pm * BM + ai * HALF + wr * 64 + m * 16 + fr;
                const float* gp = gate + (size_t)::batch_of_row(row) * ::NMOD + col0; float* xp = X + (size_t)row * ::DM + col0;
#pragma unroll
                for (int bj = 0; bj < 2; ++bj)
#pragma unroll
                    for (int n = 0; n < 2; ++n) { const f32x4 g = *(const f32x4*)(gp + bj * HALF + n * 16); f32x4 x = *(const f32x4*)(xp + bj * HALF + n * 16);
                        x = x + g * acc[ai][bj][m][n]; *(f32x4*)(xp + bj * HALF + n * 16) = x; } }
    }
};
struct EpiSwi {
    static constexpr bool PERM = true, AFTER_DRAIN = false;
    bf16_t* HID;
    __device__ __forceinline__ void operator()(const f32x4 (&acc)[2][2][4][2], const Unit& u, int wr, int wc, int fr, int fq) const {
        const int row0 = u.pm * BM + wr * 64 + fr, col0 = 128 * u.pn + wc * 32 + 8 * fq;
#pragma unroll
        for (int ai = 0; ai < 2; ++ai)
#pragma unroll
            for (int m = 0; m < 4; ++m) { bf16_t* rowp = HID + (size_t)(row0 + ai * HALF + m * 16) * ::DFF + col0;
                const f32x4 g0 = acc[ai][0][m][0], g1 = acc[ai][0][m][1], u0 = acc[ai][1][m][0], u1 = acc[ai][1][m][1];
                u32x4 w; w.x = cvt_pk_bf16(::siluf_(g0[0]) * u0[0], ::siluf_(g0[1]) * u0[1]); w.y = cvt_pk_bf16(::siluf_(g0[2]) * u0[2], ::siluf_(g0[3]) * u0[3]);
                w.z = cvt_pk_bf16(::siluf_(g1[0]) * u1[0], ::siluf_(g1[1]) * u1[1]); w.w = cvt_pk_bf16(::siluf_(g1[2]) * u1[2], ::siluf_(g1[3]) * u1[3]);
                *(u32x4*)rowp = w; }
    }
};
struct Mix2Order {
    int G, c;
    __device__ __forceinline__ bool next(int i, Unit& u) const {
        const int L = i * G + c; if (L >= 4 * (::MP / 256)) return false;
        const int which = L / (2 * (::MP / 256)), rem = L % (2 * (::MP / 256));
        u.pm = which * ::NPANEL + (rem >> 1); u.pn = which * 2 + (rem & 1); return true;
    }
    __device__ __forceinline__ void a_ready(const Unit&) const {}
    __device__ __forceinline__ void done(const Unit&) const {}
};

template <class Epi, class Sched, bool ALIGN_EPI = false, bool SP2 = false>
__device__ __forceinline__ void gemm_phase(PG8_LAS unsigned char* lds, const Gemm g, const Sched& S, const Epi& E) {
    int tid_ = threadIdx.x; asm volatile("" : "+v"(tid_));
    const int tid = tid_, wid = __builtin_amdgcn_readfirstlane(tid >> 6), lane = tid & 63, wr = wid >> 2, wc = wid & 3, fr = lane & 15, fq = lane >> 4;
    const int K = g.K, nt = K / BK;
    unsigned voffA[2], voffB[2];
#pragma unroll
    for (int i = 0; i < 2; ++i) { int R, C; stage_rc(tid * 16 + i * 8192, R, C); const int Rb = Epi::PERM ? ((R & ~31) + perm32(R & 31)) : R;
        voffA[i] = (unsigned)(R * K + C) * 2u; voffB[i] = (unsigned)(Rb * K + C) * 2u; }
    const size_t kstep = (size_t)(BK * 2);
    const size_t hstep = (size_t)HALF * K * 2;
    const size_t tstep = 2 * hstep;
    const unsigned ldsw = (unsigned)wid * 1024u;
    const int aoff = lds_byte(wr * 64 + fr, fq * 8), boff = lds_byte(wc * 32 + fr, fq * 8);
#define PG8_SA(b, h) (((b) * 2 + (h)) * HTB)
#define PG8_SB(b, h) ((4 + (b) * 2 + (h)) * HTB)
#define PG8_STAGE(bufoff, gbase, voff) do { _Pragma("unroll") for (int _i = 0; _i < 2; ++_i) \
        __builtin_amdgcn_global_load_lds((const unsigned*)((const char*)(gbase) + (voff)[_i]), (PG8_LAS unsigned*)(lds + (bufoff) + ldsw + _i * 8192), 16, 0, 0); } while (0)
#define PG8_LDA(dst, b, h) do { _Pragma("unroll") for (int m = 0; m < 4; ++m) _Pragma("unroll") for (int k = 0; k < 2; ++k) dst[m][k] = *(const PG8_LAS bf16x8*)(lds + PG8_SA(b, h) + aoff + m * 2048 + k * 1024); } while (0)
#define PG8_LDB(dst, b, h) do { _Pragma("unroll") for (int n = 0; n < 2; ++n) _Pragma("unroll") for (int k = 0; k < 2; ++k) dst[n][k] = *(const PG8_LAS bf16x8*)(lds + PG8_SB(b, h) + boff + n * 2048 + k * 1024); } while (0)
#define PG8_MMA(ai, bj, At, Bt) do { __builtin_amdgcn_s_setprio(1); _Pragma("unroll") for (int m = 0; m < 4; ++m) _Pragma("unroll") for (int n = 0; n < 2; ++n) _Pragma("unroll") for (int k = 0; k < 2; ++k) \
        acc[ai][bj][m][n] = __builtin_amdgcn_mfma_f32_16x16x32_bf16(Bt[n][k], At[m][k], acc[ai][bj][m][n], 0, 0, 0); __builtin_amdgcn_s_setprio(0); } while (0)
#define PG8_WAIT_V(n) asm volatile("s_waitcnt vmcnt(" #n ")" ::: "memory")
#define PG8_WAIT_L(n) asm volatile("s_waitcnt lgkmcnt(" #n ")" ::: "memory")
#define PG8_BAR __builtin_amdgcn_s_barrier()
#define PG8_SCHED __builtin_amdgcn_sched_barrier(0)
    Unit cur, nxt; int ui = 0;
    if (!S.next(0, cur)) return;
    f32x4 acc[2][2][4][2];
#pragma unroll
    for (int a = 0; a < 2; ++a)
#pragma unroll
        for (int b = 0; b < 2; ++b)
#pragma unroll
            for (int m = 0; m < 4; ++m)
#pragma unroll
                for (int n = 0; n < 2; ++n) acc[a][b][m][n] = (f32x4){0.f, 0.f, 0.f, 0.f};
    bf16x8 At[4][2], B0[2][2], B1[2][2];
    const char* cA = (const char*)g.A + (size_t)cur.pm * tstep; const char* cB = (const char*)g.Bt + (size_t)cur.pn * tstep;
    S.a_ready(cur);
    if constexpr (SP2) {
        PG8_STAGE(PG8_SB(0, 0), cB, voffB); PG8_STAGE(PG8_SB(0, 1), cB + hstep, voffB); PG8_STAGE(PG8_SA(0, 0), cA, voffA); PG8_STAGE(PG8_SA(0, 1), cA + hstep, voffA);
        if (wr == 1) PG8_BAR;
        PG8_WAIT_V(2); PG8_BAR;
        PG8_STAGE(PG8_SB(1, 0), cB + kstep, voffB); PG8_STAGE(PG8_SA(1, 0), cA + kstep, voffA); PG8_STAGE(PG8_SB(1, 1), cB + hstep + kstep, voffB);
        PG8_WAIT_V(6); PG8_BAR;
    } else {
        PG8_STAGE(PG8_SB(0, 0), cB, voffB); PG8_STAGE(PG8_SA(0, 0), cA, voffA); PG8_STAGE(PG8_SB(0, 1), cB + hstep, voffB); PG8_STAGE(PG8_SA(0, 1), cA + hstep, voffA);
        if (wr == 1) PG8_BAR;
        PG8_WAIT_V(4); PG8_BAR;
        PG8_STAGE(PG8_SB(1, 0), cB + kstep, voffB); PG8_STAGE(PG8_SA(1, 0), cA + kstep, voffA); PG8_STAGE(PG8_SB(1, 1), cB + hstep + kstep, voffB);
        PG8_WAIT_V(6); PG8_BAR;
    }
    for (;;) {
        const bool has_next = S.next(ui + 1, nxt);
        const char* nA = has_next ? (const char*)g.A + (size_t)nxt.pm * tstep : cA; const char* nB = has_next ? (const char*)g.Bt + (size_t)nxt.pn * tstep : cB;
        for (int t = 0; t < nt; t += 2) {
            const bool last = (t == nt - 2);
            const char* a1 = cA + (size_t)(t + 1) * kstep;
            const char* a2 = last ? nA : cA + (size_t)(t + 2) * kstep; const char* b2 = last ? nB : cB + (size_t)(t + 2) * kstep;
            const char* a3 = a2 + kstep; const char* b3 = b2 + kstep;
            if (last && has_next) S.a_ready(nxt);
            if constexpr (SP2) {
            PG8_LDB(B0, 0, 0); PG8_LDB(B1, 0, 1); PG8_SCHED; PG8_LDA(At, 0, 0); PG8_STAGE(PG8_SA(1, 1), a1 + hstep, voffA);
            PG8_WAIT_V(8); PG8_WAIT_L(0); PG8_BAR; PG8_MMA(0, 0, At, B0); PG8_MMA(0, 1, At, B1); PG8_BAR; PG8_SCHED;
            PG8_LDA(At, 0, 1); PG8_STAGE(PG8_SB(0, 0), b2, voffB); PG8_STAGE(PG8_SB(0, 1), b2 + hstep, voffB); PG8_STAGE(PG8_SA(0, 0), a2, voffA);
            PG8_WAIT_V(8); PG8_WAIT_L(0); PG8_BAR; PG8_MMA(1, 0, At, B0); PG8_MMA(1, 1, At, B1); PG8_BAR; PG8_SCHED;
            PG8_LDB(B0, 1, 0); PG8_LDB(B1, 1, 1); PG8_SCHED; PG8_LDA(At, 1, 0); PG8_STAGE(PG8_SA(0, 1), a2 + hstep, voffA);
            PG8_WAIT_V(8); PG8_WAIT_L(0); PG8_BAR; PG8_MMA(0, 0, At, B0); PG8_MMA(0, 1, At, B1); PG8_BAR; PG8_SCHED;
            PG8_LDA(At, 1, 1); PG8_STAGE(PG8_SB(1, 0), b3, voffB); PG8_STAGE(PG8_SB(1, 1), b3 + hstep, voffB); PG8_STAGE(PG8_SA(1, 0), a3, voffA);
            PG8_WAIT_V(8); PG8_WAIT_L(0); PG8_BAR; PG8_MMA(1, 0, At, B0); PG8_MMA(1, 1, At, B1); PG8_BAR; PG8_SCHED;
            } else {
            PG8_LDB(B0, 0, 0); PG8_SCHED; PG8_LDA(At, 0, 0); PG8_STAGE(PG8_SA(1, 1), a1 + hstep, voffA);
            PG8_WAIT_L(8); PG8_BAR; PG8_WAIT_L(0); PG8_MMA(0, 0, At, B0); PG8_BAR; PG8_SCHED;
            PG8_LDB(B1, 0, 1); PG8_STAGE(PG8_SB(0, 0), b2, voffB);
            PG8_BAR; PG8_WAIT_L(0); PG8_MMA(0, 1, At, B1); PG8_BAR;
            PG8_LDA(At, 0, 1); PG8_STAGE(PG8_SA(0, 0), a2, voffA);
            PG8_BAR; PG8_WAIT_L(0); PG8_MMA(1, 0, At, B0); PG8_BAR; PG8_SCHED;
            PG8_STAGE(PG8_SB(0, 1), b2 + hstep, voffB);
            PG8_WAIT_V(6); PG8_BAR; PG8_MMA(1, 1, At, B1); PG8_BAR;
            PG8_LDB(B0, 1, 0); PG8_SCHED; PG8_LDA(At, 1, 0); PG8_STAGE(PG8_SA(0, 1), a2 + hstep, voffA);
            PG8_WAIT_L(8); PG8_BAR; PG8_WAIT_L(0); PG8_MMA(0, 0, At, B0); PG8_BAR; PG8_SCHED;
            PG8_LDB(B1, 1, 1); PG8_STAGE(PG8_SB(1, 0), b3, voffB);
            PG8_BAR; PG8_WAIT_L(0); PG8_MMA(0, 1, At, B1); PG8_BAR;
            PG8_LDA(At, 1, 1); PG8_STAGE(PG8_SA(1, 0), a3, voffA);
            PG8_BAR; PG8_WAIT_L(0); PG8_MMA(1, 0, At, B0); PG8_BAR; PG8_SCHED;
            PG8_STAGE(PG8_SB(1, 1), b3 + hstep, voffB);
            PG8_WAIT_V(6); PG8_BAR; PG8_MMA(1, 1, At, B1); PG8_BAR;
            }
        }
        if constexpr (ALIGN_EPI) { if (wr == 0) PG8_BAR; }
        if constexpr (!Epi::AFTER_DRAIN) { E(acc, cur, wr, wc, fr, fq);
#if PROBE_EPI2
            if constexpr (Epi::PERM) { asm volatile("" ::: "memory"); E(acc, cur, wr, wc, fr, fq); }
#endif
            S.done(cur); }
        if (!has_next) break;
#pragma unroll
        for (int a = 0; a < 2; ++a)
#pragma unroll
            for (int b = 0; b < 2; ++b)
#pragma unroll
                for (int m = 0; m < 4; ++m)
#pragma unroll
                    for (int n = 0; n < 2; ++n) acc[a][b][m][n] = (f32x4){0.f, 0.f, 0.f, 0.f};
        cur = nxt; cA = nA; cB = nB; ++ui;
        if constexpr (ALIGN_EPI) { if (wr == 1) PG8_BAR; }
    }
    PG8_WAIT_V(0);
    if constexpr (!ALIGN_EPI) { if (wr == 0) PG8_BAR; }
    PG8_BAR;
    if constexpr (Epi::AFTER_DRAIN) { E.fused(acc, cur, wr, wc, fr, fq, lds, wid, lane); S.done(cur); }
#undef PG8_SA
#undef PG8_SB
#undef PG8_STAGE
#undef PG8_LDA
#undef PG8_LDB
#undef PG8_MMA
#undef PG8_WAIT_V
#undef PG8_WAIT_L
#undef PG8_BAR
#undef PG8_SCHED
}
}
#define XB_TMO      128
#define XB_XCNT(j)  (256  + 64 * (j))
#define XB_XSUB(j)  (1280 + 64 * (j))
#define XB_XGEN(j)  (2304 + 64 * (j))
#define XB_TOP      3328
#define XB_TOPGEN   3392
#define XCD_BAR_WORDS 3456
#define XB_SPIN_CAP (1u << 18)

__device__ __forceinline__ unsigned xb_ld(unsigned* p)              { return __hip_atomic_load(p, __ATOMIC_RELAXED, __HIP_MEMORY_SCOPE_AGENT); }
__device__ __forceinline__ unsigned xb_add(unsigned* p, unsigned v) { return __hip_atomic_fetch_add(p, v, __ATOMIC_RELAXED, __HIP_MEMORY_SCOPE_AGENT); }
__device__ __forceinline__ unsigned xb_xcc_id() { return (unsigned)__builtin_amdgcn_s_getreg((3 << 11) | 20) & 0xFu; }
#define XB_SPIN(cond, bar) do { unsigned _sp = 0; while (cond) { __builtin_amdgcn_s_sleep(1); \
    if ((++_sp & 255u) == 0u) { if (xb_ld(&(bar)[XB_TMO])) break; if (_sp > XB_SPIN_CAP) { atomicAdd(&(bar)[XB_TMO], 1u); break; } } } } while (0)

struct XcdBarrier {
    unsigned* bar; unsigned x;
    volatile LAS unsigned* st;
};

__device__ __forceinline__ XcdBarrier xcd_barrier_post(unsigned* bar, volatile LAS unsigned* st) {
    XcdBarrier b; b.bar = bar; b.x = xb_xcc_id(); b.st = st;
    if (threadIdx.x == 0) (void)xb_add(&bar[XB_XCNT(b.x)], 1u);
    return b;
}
__device__ __forceinline__ void xcd_barrier_complete(unsigned* bar, unsigned x, unsigned& nloc, unsigned& nx) {
    const unsigned G = gridDim.x * gridDim.y * gridDim.z;
    unsigned sum, cnt, mine, sp = 0u;
    for (;;) {
        sum = 0u; cnt = 0u; mine = 0u;
#pragma unroll
        for (unsigned j = 0; j < 16; ++j) { const unsigned c = xb_ld(&bar[XB_XCNT(j)]); sum += c; cnt += (c > 0u) ? 1u : 0u; mine = (j == x) ? c : mine; }
        if (sum == G) break;
        __builtin_amdgcn_s_sleep(1);
        if ((++sp & 255u) == 0u) { if (xb_ld(&bar[XB_TMO])) break; if (sp > XB_SPIN_CAP) { atomicAdd(&bar[XB_TMO], 1u); break; } }
    }
    nloc = mine > 0u ? mine : 1u; nx = cnt > 0u ? cnt : 1u;
}

__device__ __forceinline__ void xcd_barrier(const XcdBarrier& b) {
    asm volatile("s_waitcnt vmcnt(0)" ::: "memory");
    __syncthreads();
    if (threadIdx.x == 0) {
        unsigned* bar = b.bar;
        __builtin_amdgcn_s_waitcnt(0);
        unsigned nloc = b.st[0], nx = b.st[1];
        if (nloc == 0u) { xcd_barrier_complete(bar, b.x, nloc, nx); b.st[0] = nloc; b.st[1] = nx; }
        const unsigned old = xb_add(&bar[XB_XSUB(b.x)], 1u);
        const unsigned gen = old / nloc;
        if (old + 1u == (gen + 1u) * nloc) {
            __builtin_amdgcn_fence(__ATOMIC_RELEASE, "agent");
            asm volatile("s_waitcnt vmcnt(0)" ::: "memory");
            const unsigned og = xb_add(&bar[XB_TOP], 1u);
            const unsigned tg = og / nx;
            if (og + 1u == (tg + 1u) * nx) xb_add(&bar[XB_TOPGEN], 1u);
            else XB_SPIN(xb_ld(&bar[XB_TOPGEN]) == tg, bar);
            __builtin_amdgcn_fence(__ATOMIC_ACQUIRE, "agent");
            xb_add(&bar[XB_XGEN(b.x)], 1u);
            asm volatile("s_waitcnt vmcnt(0)" ::: "memory");
        } else {
            XB_SPIN(xb_ld(&bar[XB_XGEN(b.x)]) == gen, bar);
            __builtin_amdgcn_fence(__ATOMIC_ACQUIRE, "agent");
            asm volatile("s_waitcnt vmcnt(0)" ::: "memory");
        }
    }
    __syncthreads();
}
struct Args { const float* in[N_IN]; float* out; unsigned char* ws; int ph_lo, ph_hi, pad0, pad1; };
static_assert(sizeof(Args) == (N_IN + 2) * 8 + 16, "Args has no padding");
struct DevArgs { const GAS float* in[N_IN]; GAS float* out; GAS unsigned char* ws; int ph_lo, ph_hi, pad0, pad1; };
static_assert(sizeof(DevArgs) == sizeof(Args), "DevArgs mirrors Args");
typedef const __attribute__((address_space(4))) DevArgs* KArgs;
#define INP(i) ((const float*)F.ka->in[i])
struct Frame {
    LAS unsigned char* lds;
    int tid, lane, wave, vcu, G;
    KArgs ka;
    float* out; unsigned char* ws;
};
__device__ __forceinline__ const float* modp(const Frame& F, int layer) { return (const float*)(F.ws + WS_MOD) + (size_t)layer * 12 * NMOD; }
__device__ __forceinline__ unsigned char* lw(const Frame& F, int layer) { return F.ws + WS_W + (size_t)layer * LW; }

__device__ __forceinline__ void transpose_item(const float* W, int K, int N, bf16* WT, int k0, int n0, int orow0, LAS float* scr, int lane) {
#pragma unroll 8
    for (int i = 0; i < 32; ++i) { const int kk = 2 * i + (lane >> 5); scr[kk * 33 + (lane & 31)] = W[(size_t)(k0 + kk) * N + n0 + (lane & 31)]; }
    LDS_WAIT(); asm volatile("" ::: "memory");
    const int c = lane & 7;
#pragma unroll
    for (int j = 0; j < 4; ++j) { const int n = (lane >> 3) + 8 * j; const LAS float* s = scr + (8 * c) * 33 + n;
        v4u o; o.x = pk2(s[0 * 33], s[1 * 33]); o.y = pk2(s[2 * 33], s[3 * 33]); o.z = pk2(s[4 * 33], s[5 * 33]); o.w = pk2(s[6 * 33], s[7 * 33]);
        *(GAS v4u*)(WT + (size_t)(orow0 + n) * K + k0 + 8 * c) = o; }
    LDS_WAIT(); asm volatile("" ::: "memory");
}
__device__ __forceinline__ void p0a_phase(Frame& F) {
    const int gw = F.vcu * NWAVES + F.wave, NGW = F.G * NWAVES, gt = F.vcu * (NWAVES * 64) + F.tid, NGT = F.G * NWAVES * 64;
    {
        LAS float* sil = (LAS float*)F.lds;
        for (int i = F.tid; i < 12 * DM; i += NWAVES * 64) { const int b = i / DM, k = i % DM;
            const float c = b < NBP ? INP(I_CP)[b * DM + k] : INP(I_CS)[(b - NBP) * DM + k]; sil[k * 12 + b] = siluf_(c); }
        __syncthreads();
        constexpr int KC = DM / KSPLIT, NCB = NMOD / 256;
        float* part = (float*)(F.ws + WS_MODP);
        for (int it = gw; it < NL * KSPLIT * NCB; it += NGW) {
            const int l = it / (KSPLIT * NCB), ks = (it / NCB) % KSPLIT, cb = it % NCB, col = cb * 256 + 4 * F.lane;
            const GAS f32x4* wp = (const GAS f32x4*)(INP(I_ADAW) + ((size_t)l * DM + ks * KC) * NMOD + col);
            f32x4 acc[12];
#pragma unroll
            for (int b = 0; b < 12; ++b) acc[b] = (f32x4){0.f, 0.f, 0.f, 0.f};
#pragma unroll 4
            for (int k = 0; k < KC; ++k) { const f32x4 wv = wp[(size_t)k * (NMOD / 4)];
                const LAS f32x4* sp = (const LAS f32x4*)(sil + (ks * KC + k) * 12); const f32x4 s0 = sp[0], s1 = sp[1], s2 = sp[2];
                acc[0] += wv * s0[0]; acc[1] += wv * s0[1]; acc[2] += wv * s0[2]; acc[3] += wv * s0[3];
                acc[4] += wv * s1[0]; acc[5] += wv * s1[1]; acc[6] += wv * s1[2]; acc[7] += wv * s1[3];
                acc[8] += wv * s2[0]; acc[9] += wv * s2[1]; acc[10] += wv * s2[2]; acc[11] += wv * s2[3]; }
#pragma unroll
            for (int b = 0; b < 12; ++b) *(GAS f32x4*)(part + (((size_t)ks * NL + l) * 12 + b) * NMOD + col) = acc[b];
        }
        __syncthreads();
    }
    {
        LAS float* scr = (LAS float*)(F.lds + F.wave * 16384);
        constexpr int I_IN = (DM / 64) * (DIN / 32), I_OUT = (DM / 64) * (DM / 32), I_G = (DM / 64) * (DFF / 32), I_D = (DFF / 64) * (DM / 32), I_C = (DC / 64) * (DC / 32);
        constexpr int PER_L = I_IN + I_OUT + 2 * I_G + I_D + I_C;
        for (int it = gw; it < NL * PER_L; it += NGW) {
            const int l = it / PER_L; int r = it % PER_L; unsigned char* wl = lw(F, l);
            if (r < I_IN) { const int nblk = DIN / 32, k0 = 64 * (r / nblk), n0 = 32 * (r % nblk);
                int orow0 = n0; if (n0 < 512) orow0 = 256 * (n0 >> 7) + (n0 & 127); else if (n0 < 1024) orow0 = 256 * ((n0 - 512) >> 7) + 128 + (n0 & 127);
                transpose_item(INP(I_WIN) + (size_t)l * DM * DIN, DM, DIN, (bf16*)(wl + LW_WIN), k0, n0, orow0, scr, F.lane); continue; } r -= I_IN;
            if (r < I_OUT) { const int nblk = DM / 32, k0 = 64 * (r / nblk), n0 = 32 * (r % nblk);
                transpose_item(INP(I_WOUT) + (size_t)l * DM * DM, DM, DM, (bf16*)(wl + LW_WOUT), k0, n0, n0, scr, F.lane); continue; } r -= I_OUT;
            if (r < 2 * I_G) { const int up = r >= I_G; if (up) r -= I_G; const int nblk = DFF / 32, k0 = 64 * (r / nblk), n0 = 32 * (r % nblk);
                const int orow0 = 256 * (n0 >> 7) + 128 * up + (n0 & 127);
                transpose_item(INP(up ? I_WU : I_WG) + (size_t)l * DM * DFF, DM, DFF, (bf16*)(wl + LW_WGU), k0, n0, orow0, scr, F.lane); continue; } r -= 2 * I_G;
            if (r < I_D) { const int nblk = DM / 32, k0 = 64 * (r / nblk), n0 = 32 * (r % nblk);
                transpose_item(INP(I_WD) + (size_t)l * DFF * DM, DFF, DM, (bf16*)(wl + LW_WD), k0, n0, n0, scr, F.lane); continue; } r -= I_D;
            { const int nblk = DC / 32, k0 = 64 * (r / nblk), n0 = 32 * (r % nblk);
                transpose_item(INP(I_CPW) + (size_t)l * DC * DC, DC, DC, (bf16*)(wl + LW_CPW), k0, n0, n0, scr, F.lane); }
        }
        for (int i = gt; i < NL * DC * DC; i += NGT) { const int l = i / (DC * DC), n = (i / DC) % DC, k = i % DC; float v = 0.f;
            if ((n >> 7) == (k >> 7)) v = INP(I_POOLW)[(((size_t)l * 4 + (n >> 7)) * 128 + (k & 127)) * 128 + (n & 127)] * INP(I_POOLS)[l * DC + n];
            ((bf16*)(lw(F, l) + LW_PWD))[n * DC + k] = (bf16)(pk2(v, 0.f) & 0xffffu); }
        for (int i = gt; i < NL * 4 * 128 * 128; i += NGT) { const int l = i / 65536, r = i % 65536, ii = (r >> 7) & 127, jj = r & 127;
            const float v = (jj <= ii) ? INP(I_SGW)[i] : 0.f; ((bf16*)(lw(F, l) + LW_SGW))[r] = (bf16)(pk2(v, 0.f) & 0xffffu); }
    }
    __syncthreads();
}
__device__ __forceinline__ void p0b_phase(Frame& F) {
    const int gt = F.vcu * (NWAVES * 64) + F.tid, NGT = F.G * NWAVES * 64;
    const float* part = (const float*)(F.ws + WS_MODP); float* mod = (float*)(F.ws + WS_MOD);
    for (int i = gt; i < NL * 12 * NMOD; i += NGT) { const int l = i / (12 * NMOD), n = i % NMOD; float s = INP(I_ADAB)[l * NMOD + n];
#pragma unroll
        for (int ks = 0; ks < KSPLIT; ++ks) s += part[(size_t)ks * NL * 12 * NMOD + i];
        mod[i] = s; }
}
template <bool COPY>
__device__ __forceinline__ void norm_phase(Frame& F, const float* gain, const float* mod_l, int sh_idx, bf16* H) {
    const int gw = F.vcu * NWAVES + F.wave, NGW = F.G * NWAVES;
    float* X = F.out;
    for (int m = gw; m < MT; m += NGW) {
        const float* src = COPY ? (m < MP ? INP(I_XP) + (size_t)m * DM : INP(I_XS) + (size_t)(m - MP) * DM) : X + (size_t)m * DM;
        const GAS f32x4* xr = (const GAS f32x4*)src + F.lane;
        f32x4 v[8]; float s = 0.f;
#pragma unroll
        for (int j = 0; j < 8; ++j) { v[j] = xr[64 * j]; s += (v[j].x * v[j].x + v[j].y * v[j].y) + (v[j].z * v[j].z + v[j].w * v[j].w); }
        if (COPY) { GAS f32x4* xo = (GAS f32x4*)(X + (size_t)m * DM) + F.lane;
#pragma unroll
            for (int j = 0; j < 8; ++j) xo[64 * j] = v[j]; }
        const float rstd = 1.0f / sqrtf(wave_sum(s) * (1.0f / DM) + EPS);
        const float* mb = mod_l + (size_t)batch_of_row(m) * NMOD;
        const GAS f32x4* shp = (const GAS f32x4*)(mb + sh_idx * DM) + F.lane; const GAS f32x4* scp = (const GAS f32x4*)(mb + (sh_idx + 1) * DM) + F.lane;
        const GAS f32x4* gp = (const GAS f32x4*)gain + F.lane;
        GAS v2u* o8 = (GAS v2u*)(H + (size_t)m * DM) + F.lane;
#pragma unroll
        for (int j = 0; j < 8; ++j) { const f32x4 g = gp[64 * j], sc = scp[64 * j], sh = shp[64 * j];
            const f32x4 y = v[j] * rstd * g * (sc + 1.0f) + sh; v2u w; w.x = pk2(y.x, y.y); w.y = pk2(y.z, y.w); o8[64 * j] = w; }
    }
}
__device__ __forceinline__ void final_norm_phase(Frame& F) {
    const int gw = F.vcu * NWAVES + F.wave, NGW = F.G * NWAVES;
    for (int m = gw; m < MT; m += NGW) {
        GAS f32x4* xr = (GAS f32x4*)(F.out + (size_t)m * DM) + F.lane;
        f32x4 v[8]; float s = 0.f;
#pragma unroll
        for (int j = 0; j < 8; ++j) { v[j] = xr[64 * j]; s += (v[j].x * v[j].x + v[j].y * v[j].y) + (v[j].z * v[j].z + v[j].w * v[j].w); }
        const float rstd = 1.0f / sqrtf(wave_sum(s) * (1.0f / DM) + EPS);
        const GAS f32x4* gp = (const GAS f32x4*)INP(I_FING) + F.lane;
#pragma unroll
        for (int j = 0; j < 8; ++j) xr[64 * j] = v[j] * rstd * gp[64 * j];
    }
}

__device__ __forceinline__ int crow(int r, int hi) { return (r & 3) + 8 * (r >> 2) + 4 * hi; }
#define MFMA32(a, b, c) __builtin_amdgcn_mfma_f32_32x32x16_bf16((a), (b), (c), 0, 0, 0)
constexpr int AT_KS = 0, AT_VT = 9216, AT_BT = 18432, AT_PITCH = 144;
__device__ __forceinline__ void attn_unit(Frame& F, int layer, bool sample, int b, int h, int qg, const bf16* Z, bf16* MIX) {
    const int tid = F.tid, lane = F.lane, w = F.wave, l31 = lane & 31, hh = lane >> 5;
    LAS unsigned char* Ks = F.lds + AT_KS; LAS unsigned char* VTs = F.lds + AT_VT; LAS float* bt = (LAS float*)(F.lds + AT_BT);
    if (tid < 257) bt[tid] = INP(I_RELB)[((size_t)layer * 8 + h) * 257 + tid] * LOG2E;
    const bool wave_on = sample ? (w == 0) : true;
    const int qpos = sample ? l31 : 256 * qg + 32 * w + l31;
    const int qrow = sample ? MP + 32 * b + l31 : b * SEQ + qpos;
    bf16x8 qr[4];
#pragma unroll
    for (int d0 = 0; d0 < 4; ++d0) qr[d0] = *(const GAS bf16x8*)(Z + (size_t)qrow * ZW + ZQ + 64 * h + 16 * d0 + 8 * hh);
    f32x16 o0, o1;
#pragma unroll
    for (int r = 0; r < 16; ++r) { o0[r] = 0.f; o1[r] = 0.f; }
    float mrun = -1e30f, lrun = 0.f;
    const int ntile = sample ? 9 : 12, qc = 4 * qg + (w >> 1);
    const int sr = tid >> 3, sch = tid & 7;
    const float* ck = INP(I_CK) + ((size_t)layer * NBS + b) * 512 * 512; const float* cv = INP(I_CV) + ((size_t)layer * NBS + b) * 512 * 512;
    v4u kreg = (v4u){0u, 0u, 0u, 0u}, vreg = (v4u){0u, 0u, 0u, 0u};
#define AT_LOAD(j) do { \
        if (!sample) { const int kc_ = 4 * qg - 8 + (j); if (kc_ >= 0) { const bf16* zr_ = Z + (size_t)(b * SEQ + 64 * kc_ + sr) * ZW + 64 * h + 8 * sch; \
                kreg = *(const GAS v4u*)(zr_ + ZK); vreg = *(const GAS v4u*)(zr_ + ZV); } } \
        else if ((j) < 8) { const size_t o_ = ((size_t)(64 * (j) + sr) * 8 + h) * 64 + 8 * sch; \
                const f32x4 k0_ = *(const GAS f32x4*)(ck + o_), k1_ = *(const GAS f32x4*)(ck + o_ + 4), v0_ = *(const GAS f32x4*)(cv + o_), v1_ = *(const GAS f32x4*)(cv + o_ + 4); \
                kreg = (v4u){pk2(k0_.x, k0_.y), pk2(k0_.z, k0_.w), pk2(k1_.x, k1_.y), pk2(k1_.z, k1_.w)}; vreg = (v4u){pk2(v0_.x, v0_.y), pk2(v0_.z, v0_.w), pk2(v1_.x, v1_.y), pk2(v1_.z, v1_.w)}; } \
        else if (sr < 32) { const bf16* zr_ = Z + (size_t)(MP + 32 * b + sr) * ZW + 64 * h + 8 * sch; kreg = *(const GAS v4u*)(zr_ + ZK); vreg = *(const GAS v4u*)(zr_ + ZV); } \
        else { kreg = (v4u){0u, 0u, 0u, 0u}; vreg = (v4u){0u, 0u, 0u, 0u}; } } while (0)
    AT_LOAD(0);
    for (int j = 0; j < ntile; ++j) {
        const int kc = 4 * qg - 8 + j;
        if (!sample && kc < 0) { AT_LOAD(j + 1); continue; }
        *(LAS v4u*)(Ks + sr * AT_PITCH + sch * 16) = kreg;
        { LAS bf16* vt = (LAS bf16*)VTs + (8 * sch) * (AT_PITCH / 2) + sr;
          vt[0 * (AT_PITCH / 2)] = (bf16)(vreg.x & 0xffffu); vt[1 * (AT_PITCH / 2)] = (bf16)(vreg.x >> 16); vt[2 * (AT_PITCH / 2)] = (bf16)(vreg.y & 0xffffu); vt[3 * (AT_PITCH / 2)] = (bf16)(vreg.y >> 16);
          vt[4 * (AT_PITCH / 2)] = (bf16)(vreg.z & 0xffffu); vt[5 * (AT_PITCH / 2)] = (bf16)(vreg.z >> 16); vt[6 * (AT_PITCH / 2)] = (bf16)(vreg.w & 0xffffu); vt[7 * (AT_PITCH / 2)] = (bf16)(vreg.w >> 16); }
        __syncthreads();
        if (j + 1 < ntile) AT_LOAD(j + 1);
        const bool active = sample ? (w == 0) : (kc >= qc - 8 && kc <= qc);
        if (active) {
            f32x16 p0, p1;
#pragma unroll
            for (int r = 0; r < 16; ++r) { p0[r] = 0.f; p1[r] = 0.f; }
#pragma unroll
            for (int d0 = 0; d0 < 4; ++d0) {
                const bf16x8 a0 = *(const LAS bf16x8*)(Ks + l31 * AT_PITCH + (16 * d0 + 8 * hh) * 2);
                const bf16x8 a1 = *(const LAS bf16x8*)(Ks + (32 + l31) * AT_PITCH + (16 * d0 + 8 * hh) * 2);
                p0 = MFMA32(a0, qr[d0], p0); p1 = MFMA32(a1, qr[d0], p1);
            }
            const int kbase = sample ? 64 * j - 512 : 64 * kc;
            const int relb = kbase - qpos;
            const int qmin = sample ? 0 : 256 * qg + 32 * w;
            if (kbase + 63 - qmin <= -128) { const float b0 = bt[0];
#pragma unroll
                for (int r = 0; r < 16; ++r) { p0[r] += b0; p1[r] += b0; }
            } else {
#pragma unroll
                for (int r = 0; r < 16; ++r) { const int kv = crow(r, hh); int i0 = relb + kv, i1 = i0 + 32;
                    i0 = (i0 < -128 ? -128 : (i0 > 128 ? 128 : i0)) + 128; i1 = (i1 < -128 ? -128 : (i1 > 128 ? 128 : i1)) + 128;
                    p0[r] += bt[i0]; p1[r] += bt[i1]; }
            }
            if (sample && j == 8) {
#pragma unroll
                for (int r = 0; r < 16; ++r) p1[r] = -1e30f;
            }
            float mx = p0[0];
#pragma unroll
            for (int r = 1; r < 16; ++r) mx = fmaxf(mx, p0[r]);
#pragma unroll
            for (int r = 0; r < 16; ++r) mx = fmaxf(mx, p1[r]);
            mx = fmaxf(mx, __shfl_xor(mx, 32));
            const float mn = fmaxf(mrun, mx), alpha = fast_exp2(mrun - mn); mrun = mn;
            float rs = 0.f;
#pragma unroll
            for (int r = 0; r < 16; ++r) { p0[r] = fast_exp2(p0[r] - mn); p1[r] = fast_exp2(p1[r] - mn); rs += p0[r] + p1[r]; }
            rs += __shfl_xor(rs, 32);
            lrun = lrun * alpha + rs;
#pragma unroll
            for (int r = 0; r < 16; ++r) { o0[r] *= alpha; o1[r] *= alpha; }
            bf16x8 pf[4];
            { v4u t;
              t = (v4u){pk2(p0[0], p0[1]), pk2(p0[2], p0[3]), pk2(p0[4], p0[5]), pk2(p0[6], p0[7])}; pf[0] = __builtin_bit_cast(bf16x8, t);
              t = (v4u){pk2(p0[8], p0[9]), pk2(p0[10], p0[11]), pk2(p0[12], p0[13]), pk2(p0[14], p0[15])}; pf[1] = __builtin_bit_cast(bf16x8, t);
              t = (v4u){pk2(p1[0], p1[1]), pk2(p1[2], p1[3]), pk2(p1[4], p1[5]), pk2(p1[6], p1[7])}; pf[2] = __builtin_bit_cast(bf16x8, t);
              t = (v4u){pk2(p1[8], p1[9]), pk2(p1[10], p1[11]), pk2(p1[12], p1[13]), pk2(p1[14], p1[15])}; pf[3] = __builtin_bit_cast(bf16x8, t); }
#pragma unroll
            for (int xt = 0; xt < 2; ++xt)
#pragma unroll
                for (int s = 0; s < 2; ++s) { const int kvo = 32 * xt + 16 * s + 4 * hh;
                    const v2u lo0 = *(const LAS v2u*)(VTs + l31 * AT_PITCH + kvo * 2), hi0 = *(const LAS v2u*)(VTs + l31 * AT_PITCH + (kvo + 8) * 2);
                    const v2u lo1 = *(const LAS v2u*)(VTs + (32 + l31) * AT_PITCH + kvo * 2), hi1 = *(const LAS v2u*)(VTs + (32 + l31) * AT_PITCH + (kvo + 8) * 2);
                    const v4u f0 = (v4u){lo0.x, lo0.y, hi0.x, hi0.y}, f1 = (v4u){lo1.x, lo1.y, hi1.x, hi1.y};
                    o0 = MFMA32(__builtin_bit_cast(bf16x8, f0), pf[2 * xt + s], o0); o1 = MFMA32(__builtin_bit_cast(bf16x8, f1), pf[2 * xt + s], o1); }
        }
        __syncthreads();
    }
#undef AT_LOAD
    if (wave_on) {
        const float inv = 1.0f / lrun;
        bf16* orow = MIX + (size_t)qrow * MIXW + MIX_B + 64 * h;
#pragma unroll
        for (int g4 = 0; g4 < 4; ++g4) { const int d = 8 * g4 + 4 * hh;
            v2u w0; w0.x = pk2(o0[4 * g4] * inv, o0[4 * g4 + 1] * inv); w0.y = pk2(o0[4 * g4 + 2] * inv, o0[4 * g4 + 3] * inv); *(GAS v2u*)(orow + d) = w0;
            v2u w1; w1.x = pk2(o1[4 * g4] * inv, o1[4 * g4 + 1] * inv); w1.y = pk2(o1[4 * g4 + 2] * inv, o1[4 * g4 + 3] * inv); *(GAS v2u*)(orow + 32 + d) = w1; }
    }
}
__device__ __forceinline__ unsigned sg_off(unsigned row, unsigned ch) { return 256u * row + 16u * (ch ^ (((row & 3u) << 2) | ((row >> 2) & 3u))); }
typedef short v4i16_t __attribute__((ext_vector_type(4)));
__device__ __forceinline__ v2u lds_tr_read(LAS unsigned char* p) { const v4i16_t r = __builtin_amdgcn_ds_read_tr16_b64_v4i16((LAS v4i16_t*)p); return __builtin_bit_cast(v2u, r); }
__device__ __forceinline__ void sg_unit(Frame& F, int layer, int ci, const bf16* Z, bf16* MIX) {
    const int lane = F.lane, w = F.wave, l31 = lane & 31, hh = lane >> 5;
    const bool sample = ci >= MP / 128; const int L = sample ? 32 : 128, row0 = sample ? MP + 32 * (ci - MP / 128) : 128 * ci;
    LAS unsigned char* VN = F.lds;
    {
        const int c8 = 8 * lane;
        const GAS f32x4* lgp = (const GAS f32x4*)(INP(I_SGG) + layer * DC + c8); const GAS f32x4* lbp = (const GAS f32x4*)(INP(I_SGB) + layer * DC + c8);
        const f32x4 lg0 = lgp[0], lg1 = lgp[1], lb0 = lbp[0], lb1 = lbp[1];
        const int nrw = L / 8;
        LAS unsigned char* vbase = VN + (lane >> 4) * 32768;
        for (int i = 0; i < nrw; ++i) { const int rr = w * nrw + i;
            const v4u zv = *(const GAS v4u*)(Z + (size_t)(row0 + rr) * ZW + ZSV + c8);
            float x[8] = {bflo(zv.x), bfhi(zv.x), bflo(zv.y), bfhi(zv.y), bflo(zv.z), bfhi(zv.z), bflo(zv.w), bfhi(zv.w)};
            const float s = ((x[0] + x[1]) + (x[2] + x[3])) + ((x[4] + x[5]) + (x[6] + x[7]));
            const float mean = wave_sum(s) * (1.0f / DC); float q = 0.f;
#pragma unroll
            for (int e = 0; e < 8; ++e) { x[e] -= mean; q += x[e] * x[e]; }
            const float rstd = 1.0f / sqrtf(wave_sum(q) * (1.0f / DC) + EPS);
            float y[8];
            y[0] = x[0] * rstd * lg0.x + lb0.x; y[1] = x[1] * rstd * lg0.y + lb0.y; y[2] = x[2] * rstd * lg0.z + lb0.z; y[3] = x[3] * rstd * lg0.w + lb0.w;
            y[4] = x[4] * rstd * lg1.x + lb1.x; y[5] = x[5] * rstd * lg1.y + lb1.y; y[6] = x[6] * rstd * lg1.z + lb1.z; y[7] = x[7] * rstd * lg1.w + lb1.w;
            *(LAS v4u*)(vbase + sg_off((unsigned)rr, (unsigned)(lane & 15))) = (v4u){pk2(y[0], y[1]), pk2(y[2], y[3]), pk2(y[4], y[5]), pk2(y[6], y[7])};
            if (sample) { float* so = F.out + O_SGV + (((size_t)layer * NBS + (ci - MP / 128)) * TS + rr) * DC + c8;
                *(GAS f32x4*)so = (f32x4){y[0], y[1], y[2], y[3]}; *(GAS f32x4*)(so + 4) = (f32x4){y[4], y[5], y[6], y[7]}; }
        }
    }
    __syncthreads();
    {
        const int g = w >> 1;
        const bf16* Wg = (const bf16*)(lw(F, layer) + LW_SGW) + (size_t)g * 128 * 128;
        LAS unsigned char* vg = VN + g * 32768;
        const int nib = L / 32;
        const unsigned blk = (lane >> 4) & 1, q = (lane & 15) >> 2, p4 = lane & 3;
#pragma unroll
        for (int cbb = 0; cbb < 2; ++cbb) { const int cb = 2 * (w & 1) + cbb;
            f32x16 acc[4];
#pragma unroll
            for (int ib = 0; ib < 4; ++ib)
#pragma unroll
                for (int r = 0; r < 16; ++r) acc[ib][r] = 0.f;
            for (int s = 0; s < 2 * nib; ++s) {
                const v2u a0 = lds_tr_read(vg + sg_off(16u * s + 8u * hh + q, 4u * cb + 2u * blk + (p4 >> 1)) + 8u * (p4 & 1));
                const v2u a1 = lds_tr_read(vg + sg_off(16u * s + 8u * hh + 4u + q, 4u * cb + 2u * blk + (p4 >> 1)) + 8u * (p4 & 1));
                const v4u af = (v4u){a0.x, a0.y, a1.x, a1.y};
#pragma unroll
                for (int ib = 0; ib < 4; ++ib) { if (ib < nib && s < 2 * (ib + 1)) {
                        const bf16x8 bb = *(const GAS bf16x8*)(Wg + (size_t)(32 * ib + l31) * 128 + 16 * s + 8 * hh);
                        acc[ib] = MFMA32(__builtin_bit_cast(bf16x8, af), bb, acc[ib]); } }
            }
#pragma unroll
            for (int ib = 0; ib < 4; ++ib) { if (ib < nib) {
                    const int i = 32 * ib + l31, row = row0 + i; const float bias = INP(I_SGBIAS)[((size_t)layer * 4 + g) * 128 + i];
#pragma unroll
                    for (int rg = 0; rg < 4; ++rg) { const int c4 = 32 * cb + 8 * rg + 4 * hh;
                        const v2u zu = *(const GAS v2u*)(Z + (size_t)row * ZW + ZSU + 128 * g + c4);
                        v2u o; o.x = pk2(bflo(zu.x) * (acc[ib][4 * rg] + bias), bfhi(zu.x) * (acc[ib][4 * rg + 1] + bias)); o.y = pk2(bflo(zu.y) * (acc[ib][4 * rg + 2] + bias), bfhi(zu.y) * (acc[ib][4 * rg + 3] + bias));
                        *(GAS v2u*)(MIX + (size_t)row * MIXW + MIX_D + 128 * g + c4) = o; } } }
        }
    }
    __syncthreads();
}
struct ConvCtx { const GAS unsigned char* zb; const GAS unsigned char* hist; GAS unsigned char* cst; bool sample, first, keep; };
template <int E> __device__ __forceinline__ void conv_row(f32x2 (&acc)[32], const f32x2 (&wt)[31], const ConvCtx& X) {
    f32x2 v;
    if constexpr (E < 30) { if (X.sample) v = *(const GAS f32x2*)(X.hist + (size_t)E * DC * 4);
                            else if (X.first) v = (f32x2){0.f, 0.f};
                            else { const unsigned u = *(const GAS unsigned*)(X.zb + (size_t)E * ZW * 2); v = (f32x2){bflo(u), bfhi(u)}; } }
    else { const unsigned u = *(const GAS unsigned*)(X.zb + (size_t)E * ZW * 2); v = (f32x2){bflo(u), bfhi(u)}; }
    constexpr int T0 = E > 30 ? E - 30 : 0, T1 = E < 31 ? E : 31;
#pragma unroll
    for (int t = T0; t <= T1; ++t) acc[t] = wt[E - t] * v + acc[t];
    if constexpr (E >= 32) { if (X.keep) *(GAS f32x2*)(X.cst + (size_t)(E - 32) * DC * 4) = v; }
}
template <int... Es> __device__ __forceinline__ void conv_rows(f32x2 (&acc)[32], const f32x2 (&wt)[31], const ConvCtx& X, std::integer_sequence<int, Es...>) { (conv_row<Es>(acc, wt, X), ...); }
__device__ __forceinline__ void conv_unit(Frame& F, int layer, int tb, int cq, const bf16* Z, bf16* CA, int ca_pitch) {
    const int c = 128 * cq + 2 * F.lane; const bool sample = tb >= MP / 32; const int sb = tb - MP / 32;
    const int r0 = sample ? MP + 32 * sb : 32 * tb; const bool first = !sample && ((r0 & (SEQ - 1)) == 0);
    ConvCtx X; X.sample = sample; X.first = first; X.keep = sample || ((r0 & (SEQ - 1)) == SEQ - 32);
    X.zb = (const GAS unsigned char*)(Z + ((long)r0 - 30) * ZW + ZU + c); asm volatile("" : "+v"(X.zb));
    const GAS unsigned char* wb = (const GAS unsigned char*)(INP(I_CONVW) + (size_t)layer * 31 * DC + c); asm volatile("" : "+v"(wb));
    f32x2 wt[31];
#pragma unroll
    for (int j = 0; j < 31; ++j) wt[j] = *(const GAS f32x2*)(wb + (size_t)j * DC * 4);
    const f32x2 cbias = *(const GAS f32x2*)(INP(I_CONVB) + layer * DC + c), gg = *(const GAS f32x2*)(INP(I_GNG) + layer * DC + c), gb = *(const GAS f32x2*)(INP(I_GNB) + layer * DC + c);
    f32x2 acc[32];
#pragma unroll
    for (int t = 0; t < 32; ++t) acc[t] = cbias;
    X.hist = (const GAS unsigned char*)(INP(I_CCONV) + ((size_t)layer * NBS + (sample ? sb : 0)) * 30 * DC + c); asm volatile("" : "+v"(X.hist));
    X.cst = (GAS unsigned char*)(sample ? F.out + O_CONVS + ((size_t)layer * NBS + sb) * 30 * DC + c : F.out + O_CONVP + ((size_t)layer * NBP + (r0 >> 13)) * 30 * DC + c); asm volatile("" : "+v"(X.cst));
    GAS unsigned char* cab = (GAS unsigned char*)(CA + (size_t)r0 * ca_pitch + c); asm volatile("" : "+v"(cab));
    conv_rows(acc, wt, X, std::make_integer_sequence<int, 62>{});
#pragma unroll
    for (int t = 0; t < 32; ++t) {
        const f32x2 y = acc[t];
        const float s = half32_sum(y.x + y.y), q = half32_sum(y.x * y.x + y.y * y.y);
        const float mean = s * (1.0f / 64.0f), var = fmaxf(q * (1.0f / 64.0f) - mean * mean, 0.f), rstd = 1.0f / sqrtf(var + EPS);
        const f32x2 n = (y - mean) * rstd * gg + gb;
        *(GAS unsigned*)(cab + (size_t)t * ca_pitch * 2) = pk2(siluf_(n.x), siluf_(n.y));
    }
}
template <int W>
__device__ __forceinline__ void pool_body(Frame& F, int layer, int tb, int cq, const bf16* Z, bf16* PM, int pm_pitch) {
    const int c = 128 * cq + 2 * F.lane; const bool sample = tb >= MP / 32; const int sb = tb - MP / 32;
    const int r0 = sample ? MP + 32 * sb : 32 * tb; const bool first = !sample && ((r0 & (SEQ - 1)) == 0);
    const GAS unsigned char* hist = (const GAS unsigned char*)(INP(I_CPOOL) + ((size_t)layer * NBS + (sample ? sb : 0)) * 15 * DC + c); asm volatile("" : "+v"(hist));
    const bool last_blk = !sample && ((r0 & (SEQ - 1)) == SEQ - 32);
    GAS unsigned char* pst = (GAS unsigned char*)(sample ? F.out + O_POOLS + ((size_t)layer * NBS + sb) * 15 * DC + c : F.out + O_POOLP + ((size_t)layer * NBP + (r0 >> 13)) * 15 * DC + c); asm volatile("" : "+v"(pst));
    const GAS unsigned char* zb = (const GAS unsigned char*)(Z + ((long)r0 - 15) * ZW + ZP + c); asm volatile("" : "+v"(zb));
    GAS unsigned char* pmb = (GAS unsigned char*)(PM + (size_t)r0 * pm_pitch + c); asm volatile("" : "+v"(pmb));
    f32x2 ext[47];
#pragma unroll
    for (int e = 0; e < 47; ++e) {
        if (e < 15) { if (sample) ext[e] = *(const GAS f32x2*)(hist + (size_t)e * DC * 4);
                      else if (first) ext[e] = (f32x2){0.f, 0.f};
                      else { const unsigned u = *(const GAS unsigned*)(zb + (size_t)e * ZW * 2); ext[e] = (f32x2){bflo(u), bfhi(u)}; } }
        else { const unsigned u = *(const GAS unsigned*)(zb + (size_t)e * ZW * 2); ext[e] = (f32x2){bflo(u), bfhi(u)}; }
    }
#pragma unroll
    for (int t = 0; t < 32; ++t) {
        f32x2 win = (f32x2){0.f, 0.f};
#pragma unroll
        for (int i = W - 1; i >= 0; --i) win += ext[15 + t - i];
        const float rc = 1.0f / (float)((first && t + 1 < W) ? t + 1 : W);
        const f32x2 m = win * rc - ext[15 + t];
        *(GAS unsigned*)(pmb + (size_t)t * pm_pitch * 2) = pk2(m.x, m.y);
        if (t >= 17 && (sample || last_blk)) *(GAS f32x2*)(pst + (size_t)(t - 17) * DC * 4) = ext[15 + t];
    }
}
__device__ __forceinline__ void mixer_phase(Frame& F, int layer) {
    const bf16* Z = (const bf16*)(F.ws + WS_Z); bf16* MIX = (bf16*)(F.ws + WS_MIX); bf16* CA = (bf16*)(F.ws + WS_CAPM); bf16* PM = CA + (size_t)MT * DC;
#ifndef PROBE_MIX
#define PROBE_MIX 0
#endif
#define MDUP(k) _Pragma("unroll") for (int mrep_ = 0; mrep_ < 1 + ((PROBE_MIX >> (k)) & 1); ++mrep_)
    MDUP(0) { for (int id = F.vcu; id < NBP * 8 * 32; id += F.G) attn_unit(F, layer, false, id >> 8, (id >> 5) & 7, id & 31, Z, MIX);
    for (int id = F.vcu; id < NBS * 8; id += F.G) attn_unit(F, layer, true, id >> 3, id & 7, 0, Z, MIX); }
    MDUP(1) for (int id = F.vcu; id < MP / 128 + NBS; id += F.G) sg_unit(F, layer, id, Z, MIX);
    const int gw = F.vcu * NWAVES + F.wave, NGW = F.G * NWAVES;
    MDUP(2) for (int id = gw; id < (MT / 32) * 4; id += NGW) conv_unit(F, layer, id >> 2, id & 3, Z, CA, DC);
    MDUP(3) for (int id = gw; id < (MT / 32) * 4; id += NGW) { const int tb = id >> 2, cq = id & 3;
        switch (cq) { case 0: pool_body<2>(F, layer, tb, cq, Z, PM, DC); break; case 1: pool_body<4>(F, layer, tb, cq, Z, PM, DC); break;
                      case 2: pool_body<8>(F, layer, tb, cq, Z, PM, DC); break; default: pool_body<16>(F, layer, tb, cq, Z, PM, DC); break; } }
    const int gt = F.vcu * (NWAVES * 64) + F.tid, NGT = F.G * NWAVES * 64;
    for (int i = gt; i < (NBP * 512 + NBS * TS) * 128; i += NGT) {
        const int rr = i >> 7, kv = (i >> 6) & 1, ch = i & 63;
        int zrow; size_t o;
        if (rr < NBP * 512) { const int b = rr >> 9, t = rr & 511; zrow = b * SEQ + SEQ - 512 + t; o = (kv ? O_VP : O_KP) + (((size_t)layer * NBP + b) * 512 + t) * 512 + 8 * ch; }
        else { const int r2 = rr - NBP * 512, b = r2 >> 5, t = r2 & 31; zrow = MP + r2; o = (kv ? O_VS : O_KS) + (((size_t)layer * NBS + b) * TS + t) * 512 + 8 * ch; }
        const v4u z = *(const GAS v4u*)(Z + (size_t)zrow * ZW + (kv ? ZV : ZK) + 8 * ch);
        *(GAS f32x4*)(F.out + o) = (f32x4){bflo(z.x), bfhi(z.x), bflo(z.y), bfhi(z.y)}; *(GAS f32x4*)(F.out + o + 4) = (f32x4){bflo(z.z), bfhi(z.z), bflo(z.w), bfhi(z.w)};
    }
}

enum { SK_Z = 0, SK_MIX2 = 1, SK_RES = 2, SK_SWI = 3 };
struct SkUnit { int row0, nb0, nb1, ocol0, ocol1; bool pair; float scale; };
template <int KIND, int NTB, int U>
__device__ __forceinline__ void sk_unit(Frame& F, const bf16* A, const bf16* Bt, int K, const SkUnit& u, bf16* obf, int opitch, float* X, const float* gate) {
    const int lane = F.lane, w = F.wave, l31 = lane & 31, hh = lane >> 5;
    const int kw = K >> 3, nks = kw >> 4;
    const GAS bf16x8* xa[NTB]; const GAS bf16x8* wb[2];
#pragma unroll
    for (int tb = 0; tb < NTB; ++tb) xa[tb] = (const GAS bf16x8*)(A + (size_t)(u.row0 + 32 * tb + l31) * K + w * kw + 8 * hh);
    wb[0] = (const GAS bf16x8*)(Bt + (size_t)(u.nb0 + l31) * K + w * kw + 8 * hh); wb[1] = (const GAS bf16x8*)(Bt + (size_t)(u.nb1 + l31) * K + w * kw + 8 * hh);
    f32x16 acc[NTB][2];
#pragma unroll
    for (int tb = 0; tb < NTB; ++tb)
#pragma unroll
        for (int c = 0; c < 2; ++c)
#pragma unroll
            for (int r = 0; r < 16; ++r) acc[tb][c][r] = 0.f;
    for (int s0 = 0; s0 < nks; s0 += U) {
        bf16x8 xf[NTB][U], wf[2][U];
#pragma unroll
        for (int i = 0; i < U; ++i) {
#pragma unroll
            for (int tb = 0; tb < NTB; ++tb) xf[tb][i] = xa[tb][2 * (s0 + i)];
            wf[0][i] = wb[0][2 * (s0 + i)]; wf[1][i] = wb[1][2 * (s0 + i)]; }
#pragma unroll
        for (int i = 0; i < U; ++i)
#pragma unroll
            for (int tb = 0; tb < NTB; ++tb) { acc[tb][0] = MFMA32(wf[0][i], xf[tb][i], acc[tb][0]); acc[tb][1] = MFMA32(wf[1][i], xf[tb][i], acc[tb][1]); }
    }
    LAS f32x4* red = (LAS f32x4*)F.lds;
#pragma unroll
    for (int tb = 0; tb < NTB; ++tb)
#pragma unroll
        for (int c = 0; c < 2; ++c)
#pragma unroll
            for (int rg = 0; rg < 4; ++rg) red[((((w * NTB + tb) * 2 + c) * 4 + rg) << 6) + lane] = (f32x4){acc[tb][c][4 * rg], acc[tb][c][4 * rg + 1], acc[tb][c][4 * rg + 2], acc[tb][c][4 * rg + 3]};
    __syncthreads();
    {
        const int rg = w & 3, tb = (NTB == 2) ? (w >> 2) : 0, c_lo = (NTB == 2) ? 0 : (w >> 2), c_hi = (NTB == 2) ? 2 : (w >> 2) + 1;
        f32x4 v[2] = {(f32x4){0.f, 0.f, 0.f, 0.f}, (f32x4){0.f, 0.f, 0.f, 0.f}};
#pragma unroll
        for (int c = 0; c < 2; ++c) { if (c >= c_lo && c < c_hi) {
#pragma unroll
                for (int w2 = 0; w2 < 8; ++w2) v[c] += red[((((w2 * NTB + tb) * 2 + c) * 4 + rg) << 6) + lane]; } }
        const int row = u.row0 + 32 * tb + l31, co = 8 * rg + 4 * hh;
        if (KIND == SK_Z) {
            if (u.pair) { v2u o; o.x = pk2(v[0][0] * sigmoidf_(v[1][0]), v[0][1] * sigmoidf_(v[1][1])); o.y = pk2(v[0][2] * sigmoidf_(v[1][2]), v[0][3] * sigmoidf_(v[1][3]));
                *(GAS v2u*)(obf + (size_t)row * opitch + u.ocol0 + co) = o; }
            else {
#pragma unroll
                for (int c = 0; c < 2; ++c) { const f32x4 y = v[c] * u.scale; v2u o; o.x = pk2(y[0], y[1]); o.y = pk2(y[2], y[3]); *(GAS v2u*)(obf + (size_t)row * opitch + (c ? u.ocol1 : u.ocol0) + co) = o; } }
        } else if (KIND == SK_MIX2) {
#pragma unroll
            for (int c = 0; c < 2; ++c) { v2u o; o.x = pk2(v[c][0], v[c][1]); o.y = pk2(v[c][2], v[c][3]); *(GAS v2u*)(obf + (size_t)row * opitch + (c ? u.ocol1 : u.ocol0) + co) = o; }
        } else if (KIND == SK_SWI) {
            v2u o; o.x = pk2(siluf_(v[0][0]) * v[1][0], siluf_(v[0][1]) * v[1][1]); o.y = pk2(siluf_(v[0][2]) * v[1][2], siluf_(v[0][3]) * v[1][3]);
            *(GAS v2u*)(obf + (size_t)row * opitch + u.ocol0 + co) = o;
        } else {
            const int c = w >> 2, col = (c ? u.ocol1 : u.ocol0) + co;
            const f32x4 g = *(const GAS f32x4*)(gate + (size_t)batch_of_row(row) * NMOD + col); GAS f32x4* xp = (GAS f32x4*)(X + (size_t)row * DM + col);
            *xp = *xp + g * v[c];
        }
    }
    __syncthreads();
}
constexpr int N_PHASES = 2 + 8 * NL + 1;

__global__ void __launch_bounds__(NWAVES * 64, 2) enc_fwd(Args args) {
    extern __shared__ __attribute__((aligned(16))) unsigned char lds[];
    Frame F;
    F.lds = (LAS unsigned char*)lds;
    F.tid = threadIdx.x; F.lane = F.tid & 63; F.wave = __builtin_amdgcn_readfirstlane(F.tid >> 6);
    F.G = gridDim.x; { const int bx = blockIdx.x; F.vcu = (F.G % 8 == 0) ? (bx % 8) * (F.G / 8) + bx / 8 : bx; }
    F.ka = (KArgs)__builtin_amdgcn_kernarg_segment_ptr();
    F.out = args.out; F.ws = args.ws;
    volatile LAS unsigned* MISC = (volatile LAS unsigned*)(F.lds + MISC_OFF);
    for (int u = F.tid; u < (LDS_BYTES - LDSCTL_OFF) / 4; u += NWAVES * 64) ((LAS unsigned*)(F.lds + LDSCTL_OFF))[u] = 0u;
    __syncthreads();
    const int lo = args.ph_lo, hi = args.ph_hi;
#define REFRESH() do { int t_ = threadIdx.x; asm volatile("" : "+v"(t_)); F.tid = t_; F.lane = t_ & 63; F.wave = __builtin_amdgcn_readfirstlane(t_ >> 6); \
        unsigned long long w_ = (unsigned long long)args.ws, o_ = (unsigned long long)args.out, k_ = (unsigned long long)__builtin_amdgcn_kernarg_segment_ptr(); \
        asm volatile("" : "+s"(w_), "+s"(o_), "+s"(k_)); F.ws = (unsigned char*)(GAS unsigned char*)w_; F.out = (float*)(GAS float*)o_; F.ka = (KArgs)k_; \
        unsigned l_ = (unsigned)(unsigned long long)(LAS unsigned char*)lds; asm volatile("" : "+s"(l_)); F.lds = (LAS unsigned char*)(unsigned long long)l_; } while (0)
    XcdBarrier bar; bar.bar = (unsigned*)(F.ws + WS_CTL) + CW_BAR; bar.x = 0; bar.st = nullptr;
    if (hi - lo > 1) bar = xcd_barrier_post((unsigned*)(F.ws + WS_CTL) + CW_BAR, MISC + 8);
#ifdef ONLY_PHASE
#define IN(k) ((((k) < 2 || (k) == N_PHASES - 1) ? (k) : 2 + ((k) - 2) % 8) == ONLY_PHASE && lo <= (k) && (k) < hi)
#else
#define IN(k) (lo <= (k) && (k) < hi)
#endif
#ifndef PROBE_DUP
#define PROBE_DUP 0
#endif
#define DUP(k) _Pragma("unroll") for (int rep_ = 0; rep_ < 1 + ((PROBE_DUP >> (k)) & 1); ++rep_)
#ifndef STAGGER_TICKS
#define STAGGER_TICKS 0
#endif
#define STAGGER() do { if (STAGGER_TICKS > 0 && (blockIdx.x & 8)) { const unsigned long long t0_ = __builtin_amdgcn_s_memrealtime(); while (__builtin_amdgcn_s_memrealtime() - t0_ < (unsigned long long)STAGGER_TICKS) __builtin_amdgcn_s_sleep(8); } } while (0)
#define SEAM(k) do { if (IN(k) && IN((k) + 1)) { XcdBarrier b_ = bar; unsigned long long p_ = (unsigned long long)b_.bar; asm volatile("" : "+s"(p_)); b_.bar = (unsigned*)p_; xcd_barrier(b_); } } while (0)

    if (IN(0)) DUP(8) { REFRESH(); p0a_phase(F); } SEAM(0);
    if (IN(1)) { REFRESH(); p0b_phase(F); } SEAM(1);
    for (int l = 0; l < NL; ++l) {
        const int pb = 2 + 8 * l;
        if (IN(pb + 0)) DUP(0) { REFRESH(); bf16* H = (bf16*)(F.ws + WS_H); bf16* Zb = (bf16*)(F.ws + WS_Z); bf16* MIX = (bf16*)(F.ws + WS_MIX); bf16* HID = (bf16*)(F.ws + WS_HID); bf16* CAPM = (bf16*)(F.ws + WS_CAPM); (void)H; (void)Zb; (void)MIX; (void)HID; (void)CAPM; const float* mod_l = modp(F, l); unsigned char* wl = lw(F, l); (void)mod_l; (void)wl; if (l == 0) norm_phase<true>(F, INP(I_N1) + l * DM, mod_l, 0, H); else norm_phase<false>(F, INP(I_N1) + l * DM, mod_l, 0, H); } SEAM(pb + 0);
        if (IN(pb + 1)) DUP(1) { REFRESH(); bf16* H = (bf16*)(F.ws + WS_H); bf16* Zb = (bf16*)(F.ws + WS_Z); bf16* MIX = (bf16*)(F.ws + WS_MIX); bf16* HID = (bf16*)(F.ws + WS_HID); bf16* CAPM = (bf16*)(F.ws + WS_CAPM); (void)H; (void)Zb; (void)MIX; (void)HID; (void)CAPM; const float* mod_l = modp(F, l); unsigned char* wl = lw(F, l); (void)mod_l; (void)wl; pg8::Gemm g{H, (const bf16*)(wl + LW_WIN), MP, DIN, DM}; pg8::StaticOrder S; S.init(MP, DIN, F.G, (int)blockIdx.x); pg8::EpiZ E{Zb};
            pg8::gemm_phase<pg8::EpiZ, pg8::StaticOrder, true, true>(F.lds, g, S, E);
            for (int su = F.vcu; su < 4 * 64; su += F.G) { const int rt = su & 3, cb = su >> 2; SkUnit u; u.row0 = MP + 64 * rt;
                if (cb < 16) { const int tt = cb >> 2, x0 = 32 * (cb & 3); u.nb0 = 256 * tt + x0; u.nb1 = u.nb0 + 128; u.ocol0 = 128 * tt + x0; u.ocol1 = 0; u.pair = true; u.scale = 1.f; }
                else { const int pbk = cb - 16; u.nb0 = 1024 + 64 * pbk; u.nb1 = u.nb0 + 32; u.ocol0 = 512 + 64 * pbk; u.ocol1 = u.ocol0 + 32; u.pair = false; u.scale = (u.nb0 < 1536) ? QSCALE : 1.f; }
                sk_unit<SK_Z, 2, 8>(F, H, (const bf16*)(wl + LW_WIN), DM, u, Zb, ZW, nullptr, nullptr); } } SEAM(pb + 1);
        if (IN(pb + 2)) DUP(2) { REFRESH(); bf16* H = (bf16*)(F.ws + WS_H); bf16* Zb = (bf16*)(F.ws + WS_Z); bf16* MIX = (bf16*)(F.ws + WS_MIX); bf16* HID = (bf16*)(F.ws + WS_HID); bf16* CAPM = (bf16*)(F.ws + WS_CAPM); (void)H; (void)Zb; (void)MIX; (void)HID; (void)CAPM; const float* mod_l = modp(F, l); unsigned char* wl = lw(F, l); (void)mod_l; (void)wl; mixer_phase(F, l); } SEAM(pb + 2);
        if (IN(pb + 3)) DUP(3) { REFRESH(); bf16* H = (bf16*)(F.ws + WS_H); bf16* Zb = (bf16*)(F.ws + WS_Z); bf16* MIX = (bf16*)(F.ws + WS_MIX); bf16* HID = (bf16*)(F.ws + WS_HID); bf16* CAPM = (bf16*)(F.ws + WS_CAPM); (void)H; (void)Zb; (void)MIX; (void)HID; (void)CAPM; const float* mod_l = modp(F, l); unsigned char* wl = lw(F, l); (void)mod_l; (void)wl; pg8::Gemm g{CAPM, (const bf16*)(wl + LW_CPW), 2 * MT, 2 * DC, DC}; pg8::Mix2Order S{F.G, (int)blockIdx.x}; pg8::EpiMix2 E{MIX};
            pg8::gemm_phase<pg8::EpiMix2, pg8::Mix2Order, true, true>(F.lds, g, S, E);
            for (int su = F.vcu; su < 2 * 4 * 8; su += F.G) { const int which = su >> 5, rt = su & 3, cb = (su >> 2) & 7; SkUnit u; u.row0 = MP + 64 * rt; u.nb0 = 64 * cb; u.nb1 = u.nb0 + 32;
                u.ocol0 = which * 1024 + 64 * cb; u.ocol1 = u.ocol0 + 32; u.pair = false; u.scale = 1.f;
                sk_unit<SK_MIX2, 2, 4>(F, CAPM + (size_t)which * MT * DC, (const bf16*)(wl + LW_CPW) + (size_t)which * DC * DC, DC, u, MIX, MIXW, nullptr, nullptr); } } SEAM(pb + 3);
        if (IN(pb + 4)) DUP(4) { REFRESH(); bf16* H = (bf16*)(F.ws + WS_H); bf16* Zb = (bf16*)(F.ws + WS_Z); bf16* MIX = (bf16*)(F.ws + WS_MIX); bf16* HID = (bf16*)(F.ws + WS_HID); bf16* CAPM = (bf16*)(F.ws + WS_CAPM); (void)H; (void)Zb; (void)MIX; (void)HID; (void)CAPM; const float* mod_l = modp(F, l); unsigned char* wl = lw(F, l); (void)mod_l; (void)wl; pg8::Gemm g{MIX, (const bf16*)(wl + LW_WOUT), MP, DM, DM}; pg8::StaticOrder S; S.init(MP, DM, F.G, (int)blockIdx.x); pg8::EpiRes E{F.out, mod_l + 2 * DM};
            pg8::gemm_phase<pg8::EpiRes, pg8::StaticOrder, true, true>(F.lds, g, S, E);
            for (int su = F.vcu; su < 8 * 32; su += F.G) { const int rt = su & 7, cb = su >> 3; SkUnit u; u.row0 = MP + 32 * rt; u.nb0 = 64 * cb; u.nb1 = u.nb0 + 32; u.ocol0 = u.nb0; u.ocol1 = u.nb1; u.pair = false; u.scale = 1.f;
                sk_unit<SK_RES, 1, 8>(F, MIX, (const bf16*)(wl + LW_WOUT), DM, u, nullptr, 0, F.out, mod_l + 2 * DM); } } SEAM(pb + 4);
        if (IN(pb + 5)) DUP(5) { REFRESH(); bf16* H = (bf16*)(F.ws + WS_H); bf16* Zb = (bf16*)(F.ws + WS_Z); bf16* MIX = (bf16*)(F.ws + WS_MIX); bf16* HID = (bf16*)(F.ws + WS_HID); bf16* CAPM = (bf16*)(F.ws + WS_CAPM); (void)H; (void)Zb; (void)MIX; (void)HID; (void)CAPM; const float* mod_l = modp(F, l); unsigned char* wl = lw(F, l); (void)mod_l; (void)wl; norm_phase<false>(F, INP(I_N2) + l * DM, mod_l, 3, H); } SEAM(pb + 5);
        if (IN(pb + 6)) DUP(6) { REFRESH(); bf16* H = (bf16*)(F.ws + WS_H); bf16* Zb = (bf16*)(F.ws + WS_Z); bf16* MIX = (bf16*)(F.ws + WS_MIX); bf16* HID = (bf16*)(F.ws + WS_HID); bf16* CAPM = (bf16*)(F.ws + WS_CAPM); (void)H; (void)Zb; (void)MIX; (void)HID; (void)CAPM; const float* mod_l = modp(F, l); unsigned char* wl = lw(F, l); (void)mod_l; (void)wl; STAGGER(); pg8::Gemm g{H, (const bf16*)(wl + LW_WGU), MP, 2 * DFF, DM}; pg8::StaticOrder S; S.init(MP, 2 * DFF, F.G, (int)blockIdx.x); pg8::EpiSwi E{HID};
            pg8::gemm_phase<pg8::EpiSwi, pg8::StaticOrder, true, true>(F.lds, g, S, E);
            for (int su = F.vcu; su < 4 * 176; su += F.G) { const int rt = su & 3, cb = su >> 2, tt = cb >> 2, x0 = 32 * (cb & 3); SkUnit u; u.row0 = MP + 64 * rt; u.nb0 = 256 * tt + x0; u.nb1 = u.nb0 + 128;
                u.ocol0 = 128 * tt + x0; u.ocol1 = 0; u.pair = true; u.scale = 1.f;
                sk_unit<SK_SWI, 2, 8>(F, H, (const bf16*)(wl + LW_WGU), DM, u, HID, DFF, nullptr, nullptr); } } SEAM(pb + 6);
        if (IN(pb + 7)) DUP(7) { REFRESH(); bf16* H = (bf16*)(F.ws + WS_H); bf16* Zb = (bf16*)(F.ws + WS_Z); bf16* MIX = (bf16*)(F.ws + WS_MIX); bf16* HID = (bf16*)(F.ws + WS_HID); bf16* CAPM = (bf16*)(F.ws + WS_CAPM); (void)H; (void)Zb; (void)MIX; (void)HID; (void)CAPM; const float* mod_l = modp(F, l); unsigned char* wl = lw(F, l); (void)mod_l; (void)wl; pg8::Gemm g{HID, (const bf16*)(wl + LW_WD), MP, DM, DFF}; pg8::StaticOrder S; S.init(MP, DM, F.G, (int)blockIdx.x); pg8::EpiRes E{F.out, mod_l + 5 * DM};
            pg8::gemm_phase<pg8::EpiRes, pg8::StaticOrder, true, true>(F.lds, g, S, E);
            for (int su = F.vcu; su < 8 * 32; su += F.G) { const int rt = su & 7, cb = su >> 3; SkUnit u; u.row0 = MP + 32 * rt; u.nb0 = 64 * cb; u.nb1 = u.nb0 + 32; u.ocol0 = u.nb0; u.ocol1 = u.nb1; u.pair = false; u.scale = 1.f;
                sk_unit<SK_RES, 1, 11>(F, HID, (const bf16*)(wl + LW_WD), DFF, u, nullptr, 0, F.out, mod_l + 5 * DM); } } SEAM(pb + 7);
    }
    if (IN(N_PHASES - 1)) { REFRESH(); final_norm_phase(F); }
#undef IN
#undef SEAM
}

extern "C" void kernel_launch(void* const* d_in, const int* in_sizes, int n_in, void* d_out, int out_size, void* d_ws, size_t ws_size, hipStream_t stream) {
    static int grid = 0;
    if (grid == 0) {
        if (n_in != N_IN || in_sizes[0] != MP * DM || (size_t)out_size != O_END || ws_size < WS_END) {
            fprintf(stderr, "kernel_launch: unexpected shapes: n_in %d in0 %d out %d ws %zu (need %zu); nothing launched\n", n_in, n_in > 0 ? in_sizes[0] : -1, out_size, ws_size, (size_t)WS_END); grid = -1; return; }
        int dev = 0, cus = 0;
        if (hipGetDevice(&dev) != hipSuccess || hipDeviceGetAttribute(&cus, hipDeviceAttributeMultiprocessorCount, dev) != hipSuccess) { grid = -1; return; }
        if (hipFuncSetAttribute((const void*)enc_fwd, hipFuncAttributeMaxDynamicSharedMemorySize, LDS_BYTES) != hipSuccess) { fprintf(stderr, "kernel_launch: hipFuncSetAttribute failed\n"); grid = -1; return; }
        int per_cu = 0;
        if (hipOccupancyMaxActiveBlocksPerMultiprocessor(&per_cu, (const void*)enc_fwd, NWAVES * 64, LDS_BYTES) != hipSuccess || per_cu < 1)
            fprintf(stderr, "kernel_launch: note: occupancy query reports %d workgroups per CU\n", per_cu);
        (void)hipGetLastError();
        grid = cus;
    }
    if (grid < 0) return;
    if (hipMemsetAsync((char*)d_ws + WS_CTL, 0, CTL_ZERO_BYTES, stream) != hipSuccess) return;
    Args a{};
    for (int i = 0; i < N_IN; ++i) a.in[i] = (const float*)d_in[i];
    a.out = (float*)d_out; a.ws = (unsigned char*)d_ws; a.pad0 = 0; a.pad1 = 0;
#if MK_ONE_LAUNCH
    a.ph_lo = 0; a.ph_hi = N_PHASES;
    hipLaunchKernelGGL(enc_fwd, dim3(grid), dim3(NWAVES * 64), LDS_BYTES, stream, a);
#else
    for (int ph = 0; ph < N_PHASES; ++ph) { a.ph_lo = ph; a.ph_hi = ph + 1;
        hipLaunchKernelGGL(enc_fwd, dim3(grid), dim3(NWAVES * 64), LDS_BYTES, stream, a); }
#endif
}
```

```cpp
#include <hip/hip_runtime.h>
#include <cstdio>
#include <cstdint>
#include <utility>

#ifndef MK_ONE_LAUNCH
#define MK_ONE_LAUNCH 1
#endif
#ifndef PROBE_DUP
#define PROBE_DUP 0
#endif
#ifndef PROBE_MIX
#define PROBE_MIX 0
#endif
#ifndef PROBE_EPI2
#define PROBE_EPI2 0
#endif
#ifndef STAGGER_TICKS
#define STAGGER_TICKS 0
#endif

constexpr int DM = 2048, SEQ = 8192, NBP = 4, MP = NBP * SEQ, NBS = 8, TS = 32, MS = NBS * TS, MT = MP + MS, NPANEL = MT / 256;
constexpr int DIN = 4096, DFF = 5632, DC = 512, NL = 4, NMOD = 6 * DM, NBT = NBP + NBS;
constexpr int ZW = 3584, ZU = 0, ZQ = 512, ZK = 1024, ZV = 1536, ZP = 2048, ZSU = 2560, ZSV = 3072;
constexpr int MIXW = 2048, MIX_A = 0, MIX_B = 512, MIX_C = 1024, MIX_D = 1536;
constexpr float EPS = 1e-6f, LOG2E = 1.4426950408889634f, QSCALE = 0.125f * LOG2E;
constexpr int KSPLIT = 16;
constexpr size_t O_YP = 0, O_YS = O_YP + (size_t)MP * DM, O_CONVP = O_YS + (size_t)MS * DM, O_CONVS = O_CONVP + (size_t)NL * NBP * 30 * DC,
    O_KP = O_CONVS + (size_t)NL * NBS * 30 * DC, O_VP = O_KP + (size_t)NL * NBP * 512 * 512, O_KS = O_VP + (size_t)NL * NBP * 512 * 512,
    O_VS = O_KS + (size_t)NL * NBS * TS * 512, O_POOLP = O_VS + (size_t)NL * NBS * TS * 512, O_POOLS = O_POOLP + (size_t)NL * NBP * 15 * DC,
    O_SGV = O_POOLS + (size_t)NL * NBS * 15 * DC, O_END = O_SGV + (size_t)NL * NBS * TS * DC;
static_assert(O_END == 78700544, "output size");
enum { I_XP = 0, I_XS, I_CP, I_CS, I_CCONV, I_CK, I_CV, I_CPOOL, I_ADAW, I_ADAB, I_N1, I_N2, I_WIN, I_CONVW, I_CONVB, I_GNG, I_GNB, I_CPW, I_RELB,
       I_POOLW, I_POOLS, I_SGG, I_SGB, I_SGW, I_SGBIAS, I_WOUT, I_WG, I_WU, I_WD, I_FING, N_IN };
static_assert(N_IN == 30, "30 inputs");

constexpr size_t MiB = 1u << 20;
constexpr size_t WS_CTL = 0, CTL_ZERO_BYTES = 1 * MiB;
constexpr size_t WS_MOD = 1 * MiB;
constexpr size_t WS_MODP = 4 * MiB;
constexpr size_t WS_W = 40 * MiB;
constexpr size_t LW_WIN = 0, LW_WOUT = 16 * MiB, LW_WGU = 24 * MiB, LW_WD = 68 * MiB, LW_CPW = 90 * MiB, LW_PWD = LW_CPW + 512 * 1024, LW_SGW = 91 * MiB, LW = 91 * MiB + 256 * 1024;
constexpr size_t WS_H = WS_W + NL * LW;
constexpr size_t WS_Z = WS_H + (size_t)MT * DM * 2;
constexpr size_t WS_MIX = WS_Z + (size_t)MT * ZW * 2;
constexpr size_t WS_HID = WS_Z;
constexpr size_t WS_CAPM = WS_MIX + (size_t)MT * MIXW * 2;
constexpr size_t WS_END = WS_CAPM + (size_t)2 * MT * DC * 2;
static_assert(WS_HID + (size_t)MT * DFF * 2 <= WS_CAPM, "HID overlay");
static_assert((size_t)NL * 12 * NMOD * 4 <= 3 * MiB && (size_t)KSPLIT * NL * 12 * NMOD * 4 <= 36 * MiB, "mod buffers");
constexpr int CW_BAR = 4096;

constexpr int RING_BYTES = 131072;
constexpr int LDSCTL_OFF = RING_BYTES, MISC_OFF = LDSCTL_OFF + 320;
constexpr int LDS_BYTES = 147456;
constexpr int NWAVES = 8;

#define GAS __attribute__((address_space(1)))
#define LAS __attribute__((address_space(3)))
typedef unsigned short bf16;
typedef unsigned v4u __attribute__((ext_vector_type(4)));
typedef unsigned v2u __attribute__((ext_vector_type(2)));
typedef float f32x4 __attribute__((ext_vector_type(4)));
typedef float f32x2 __attribute__((ext_vector_type(2)));
typedef float f32x16 __attribute__((ext_vector_type(16)));
typedef short bf16x8 __attribute__((ext_vector_type(8)));
typedef __bf16 bf16x2_t __attribute__((ext_vector_type(2)));
typedef GAS unsigned gu32;
#define RLX_AGENT __ATOMIC_RELAXED, __HIP_MEMORY_SCOPE_AGENT
#define LDS_WAIT() asm volatile("s_waitcnt lgkmcnt(0)" ::: "memory")
#define VM_WAIT() asm volatile("s_waitcnt vmcnt(0)" ::: "memory")

__device__ __forceinline__ unsigned pk2(float lo, float hi) { f32x2 v = {lo, hi}; bf16x2_t b = __builtin_convertvector(v, bf16x2_t); return __builtin_bit_cast(unsigned, b); }
__device__ __forceinline__ float bflo(unsigned u) { return __uint_as_float(u << 16); }
__device__ __forceinline__ float bfhi(unsigned u) { return __uint_as_float(u & 0xffff0000u); }
__device__ __forceinline__ float bf2f(bf16 h) { return __uint_as_float((unsigned)h << 16); }
__device__ __forceinline__ float fast_exp2(float x) { return __builtin_amdgcn_exp2f(x); }
__device__ __forceinline__ float fast_rcp(float x) { return __builtin_amdgcn_rcpf(x); }
__device__ __forceinline__ float sigmoidf_(float x) { return fast_rcp(1.0f + fast_exp2(-x * LOG2E)); }
__device__ __forceinline__ float siluf_(float x) { return x * sigmoidf_(x); }
template <int CTRL> __device__ __forceinline__ float dpp_f(float v) { return __int_as_float(__builtin_amdgcn_update_dpp(0, __float_as_int(v), CTRL, 0xF, 0xF, true)); }
__device__ __forceinline__ float row16_sum(float v) { v += dpp_f<0xB1>(v); v += dpp_f<0x4E>(v); v += dpp_f<0x141>(v); v += dpp_f<0x140>(v); return v; }
__device__ __forceinline__ float half32_sum(float v) { v = row16_sum(v); v += __int_as_float(__builtin_amdgcn_ds_swizzle(__float_as_int(v), 0x401F)); return v; }
__device__ __forceinline__ float wave_sum(float v) { v = half32_sum(v);
    return __int_as_float(__builtin_amdgcn_readlane(__float_as_int(v), 0)) + __int_as_float(__builtin_amdgcn_readlane(__float_as_int(v), 32)); }
__device__ __forceinline__ int batch_of_row(int row) { return row < MP ? (row >> 13) : NBP + ((row - MP) >> 5); }

namespace pg8 {
#define PG8_LAS __attribute__((address_space(3)))
typedef unsigned short bf16_t;
typedef short bf16x8 __attribute__((ext_vector_type(8)));
typedef float f32x4 __attribute__((ext_vector_type(4)));
typedef unsigned u32x4 __attribute__((ext_vector_type(4)));
constexpr int BM = 256, BK = 64, HALF = 128, HTB = HALF * BK * 2  , STAGE_BYTES = 8 * HTB, NXCD = 8, WGM = 8;

__host__ __device__ __forceinline__ int lds_byte(int r, int c) { const int st = (r >> 4) * 2 + (c >> 5), rr = r & 15, cc = c & 31, ob = rr * 64 + cc * 2; return st * 1024 + (ob ^ (((ob >> 9) & 1) << 5)); }
__host__ __device__ __forceinline__ void stage_rc(int b, int& R, int& C) { const int st = b / 1024, sb = b % 1024, swz = sb ^ (((sb >> 9) & 1) << 5); R = (st >> 1) * 16 + swz / 64; C = (st & 1) * 32 + (swz % 64) / 2; }
__host__ __device__ __forceinline__ int perm32(int rho) { const int n = rho >> 4, i = rho & 15; return 8 * (i >> 2) + 4 * n + (i & 3); }

struct Unit { int pm, pn; };
struct Gemm { const bf16_t* A; const bf16_t* Bt; int M, N, K; };

struct StaticOrder {
    int nM, nN, nwg, G, c;
    __host__ __device__ void init(int M, int N, int G_, int c_) { nM = M / BM; nN = N / BM; nwg = nM * nN; G = G_; c = c_; }
    __host__ __device__ bool next(int i, Unit& u) const {
        const long L = (long)i * G + c; if (L >= nwg) return false;
        int wgid = (int)L; { const int q = nwg / NXCD, r = nwg % NXCD, xcd = wgid % NXCD, off = wgid / NXCD; wgid = (xcd < r ? xcd * (q + 1) : r * (q + 1) + (xcd - r) * q) + off; }
        const int nig = WGM * nN, gid = wgid / nig, fm = gid * WGM, gsz = (nM - fm) < WGM ? (nM - fm) : WGM;
        u.pm = fm + ((wgid % nig) % gsz); u.pn = (wgid % nig) / gsz; return true;
    }
    __device__ __forceinline__ void a_ready(const Unit&) const {}
    __device__ __forceinline__ void done(const Unit&) const {}
};
__device__ __forceinline__ unsigned cvt_pk_bf16(float lo, float hi) { return ::pk2(lo, hi); }
struct EpiZ {
    static constexpr bool PERM = true, AFTER_DRAIN = false;
    bf16_t* Z;
    __device__ __forceinline__ void operator()(const f32x4 (&acc)[2][2][4][2], const Unit& u, int wr, int wc, int fr, int fq) const {
        const int row0 = u.pm * BM + wr * 64 + fr;
        if (u.pn < 4) {
            const int col0 = 128 * u.pn + wc * 32 + 8 * fq;
#pragma unroll
            for (int ai = 0; ai < 2; ++ai)
#pragma unroll
                for (int m = 0; m < 4; ++m) { bf16_t* rowp = Z + (size_t)(row0 + ai * HALF + m * 16) * ::ZW + col0;
                    const f32x4 a0 = acc[ai][0][m][0], a1 = acc[ai][0][m][1], g0 = acc[ai][1][m][0], g1 = acc[ai][1][m][1];
                    u32x4 w; w.x = cvt_pk_bf16(a0[0] * ::sigmoidf_(g0[0]), a0[1] * ::sigmoidf_(g0[1])); w.y = cvt_pk_bf16(a0[2] * ::sigmoidf_(g0[2]), a0[3] * ::sigmoidf_(g0[3]));
                    w.z = cvt_pk_bf16(a1[0] * ::sigmoidf_(g1[0]), a1[1] * ::sigmoidf_(g1[1])); w.w = cvt_pk_bf16(a1[2] * ::sigmoidf_(g1[2]), a1[3] * ::sigmoidf_(g1[3]));
                    *(u32x4*)rowp = w; }
        } else {
            const float sc = (u.pn < 6) ? ::QSCALE : 1.0f;
            const int col0 = 512 + 256 * (u.pn - 4) + wc * 32 + 8 * fq;
#pragma unroll
            for (int ai = 0; ai < 2; ++ai)
#pragma unroll
                for (int m = 0; m < 4; ++m) { bf16_t* rowp = Z + (size_t)(row0 + ai * HALF + m * 16) * ::ZW + col0;
#pragma unroll
                    for (int bj = 0; bj < 2; ++bj) { const f32x4 v0 = acc[ai][bj][m][0] * sc, v1 = acc[ai][bj][m][1] * sc;
                        u32x4 w; w.x = cvt_pk_bf16(v0[0], v0[1]); w.y = cvt_pk_bf16(v0[2], v0[3]); w.z = cvt_pk_bf16(v1[0], v1[1]); w.w = cvt_pk_bf16(v1[2], v1[3]);
                        *(u32x4*)(rowp + bj * HALF) = w; } }
        }
    }
};
struct EpiMix2 {
    static constexpr bool PERM = true, AFTER_DRAIN = false;
    bf16_t* MIX;
    __device__ __forceinline__ void operator()(const f32x4 (&acc)[2][2][4][2], const Unit& u, int wr, int wc, int fr, int fq) const {
        const int which = u.pn >> 1, pm = u.pm - which * ::NPANEL;
        const int row0 = pm * BM + wr * 64 + fr, col0 = which * 1024 + (u.pn & 1) * 256 + wc * 32 + 8 * fq;
#pragma unroll
        for (int ai = 0; ai < 2; ++ai)
#pragma unroll
            for (int m = 0; m < 4; ++m) { bf16_t* rowp = MIX + (size_t)(row0 + ai * HALF + m * 16) * ::MIXW + col0;
#pragma unroll
                for (int bj = 0; bj < 2; ++bj) { const f32x4 v0 = acc[ai][bj][m][0], v1 = acc[ai][bj][m][1];
                    u32x4 w; w.x = cvt_pk_bf16(v0[0], v0[1]); w.y = cvt_pk_bf16(v0[2], v0[3]); w.z = cvt_pk_bf16(v1[0], v1[1]); w.w = cvt_pk_bf16(v1[2], v1[3]);
                    *(u32x4*)(rowp + bj * HALF) = w; } }
    }
};
struct EpiRes {
    static constexpr bool PERM = false, AFTER_DRAIN = false;
    float* X; const float* gate;
    __device__ __forceinline__ void operator()(const f32x4 (&acc)[2][2][4][2], const Unit& u, int wr, int wc, int fr, int fq) const {
        const int col0 = u.pn * BM + wc * 32 + 4 * fq;
#pragma unroll
        for (int ai = 0; ai < 2; ++ai)
#pragma unroll
            for (int m = 0; m < 4; ++m) { const int row = u.pm * BM + ai * HALF + wr * 64 + m * 16 + fr;
                const float* gp = gate + (size_t)::batch_of_row(row) * ::NMOD + col0; float* xp = X + (size_t)row * ::DM + col0;
#pragma unroll
                for (int bj = 0; bj < 2; ++bj)
#pragma unroll
                    for (int n = 0; n < 2; ++n) { const f32x4 g = *(const f32x4*)(gp + bj * HALF + n * 16); f32x4 x = *(const f32x4*)(xp + bj * HALF + n * 16);
                        x = x + g * acc[ai][bj][m][n]; *(f32x4*)(xp + bj * HALF + n * 16) = x; } }
    }
};
struct EpiSwi {
    static constexpr bool PERM = true, AFTER_DRAIN = false;
    bf16_t* HID;
    __device__ __forceinline__ void operator()(const f32x4 (&acc)[2][2][4][2], const Unit& u, int wr, int wc, int fr, int fq) const {
        const int row0 = u.pm * BM + wr * 64 + fr, col0 = 128 * u.pn + wc * 32 + 8 * fq;
#pragma unroll
        for (int ai = 0; ai < 2; ++ai)
#pragma unroll
            for (int m = 0; m < 4; ++m) { bf16_t* rowp = HID + (size_t)(row0 + ai * HALF + m * 16) * ::DFF + col0;
                const f32x4 g0 = acc[ai][0][m][0], g1 = acc[ai][0][m][1], u0 = acc[ai][1][m][0], u1 = acc[ai][1][m][1];
                u32x4 w; w.x = cvt_pk_bf16(::siluf_(g0[0]) * u0[0], ::siluf_(g0[1]) * u0[1]); w.y = cvt_pk_bf16(::siluf_(g0[2]) * u0[2], ::siluf_(g0[3]) * u0[3]);
                w.z = cvt_pk_bf16(::siluf_(g1[0]) * u1[0], ::siluf_(g1[1]) * u1[1]); w.w = cvt_pk_bf16(::siluf_(g1[2]) * u1[2], ::siluf_(g1[3]) * u1[3]);
                *(u32x4*)rowp = w; }
    }
};
struct Mix2Order {
    int G, c;
    __device__ __forceinline__ bool next(int i, Unit& u) const {
        const int L = i * G + c; if (L >= 4 * (::MP / 256)) return false;
        const int which = L / (2 * (::MP / 256)), rem = L % (2 * (::MP / 256));
        u.pm = which * ::NPANEL + (rem >> 1); u.pn = which * 2 + (rem & 1); return true;
    }
    __device__ __forceinline__ void a_ready(const Unit&) const {}
    __device__ __forceinline__ void done(const Unit&) const {}
};

template <class Epi, class Sched, bool ALIGN_EPI = false, bool SP2 = false>
__device__ __forceinline__ void gemm_phase(PG8_LAS unsigned char* lds, const Gemm g, const Sched& S, const Epi& E) {
    int tid_ = threadIdx.x; asm volatile("" : "+v"(tid_));
    const int tid = tid_, wid = __builtin_amdgcn_readfirstlane(tid >> 6), lane = tid & 63, wr = wid >> 2, wc = wid & 3, fr = lane & 15, fq = lane >> 4;
    const int K = g.K, nt = K / BK;
    unsigned voffA[2], voffB[2];
#pragma unroll
    for (int i = 0; i < 2; ++i) { int R, C; stage_rc(tid * 16 + i * 8192, R, C); const int Rb = Epi::PERM ? ((R & ~31) + perm32(R & 31)) : R;
        voffA[i] = (unsigned)(R * K + C) * 2u; voffB[i] = (unsigned)(Rb * K + C) * 2u; }
    const size_t kstep = (size_t)(BK * 2);
    const size_t hstep = (size_t)HALF * K * 2;
    const size_t tstep = 2 * hstep;
    const unsigned ldsw = (unsigned)wid * 1024u;
    const int aoff = lds_byte(wr * 64 + fr, fq * 8), boff = lds_byte(wc * 32 + fr, fq * 8);
#define PG8_SA(b, h) (((b) * 2 + (h)) * HTB)
#define PG8_SB(b, h) ((4 + (b) * 2 + (h)) * HTB)
#define PG8_STAGE(bufoff, gbase, voff) do { _Pragma("unroll") for (int _i = 0; _i < 2; ++_i) \
        __builtin_amdgcn_global_load_lds((const unsigned*)((const char*)(gbase) + (voff)[_i]), (PG8_LAS unsigned*)(lds + (bufoff) + ldsw + _i * 8192), 16, 0, 0); } while (0)
#define PG8_LDA(dst, b, h) do { _Pragma("unroll") for (int m = 0; m < 4; ++m) _Pragma("unroll") for (int k = 0; k < 2; ++k) dst[m][k] = *(const PG8_LAS bf16x8*)(lds + PG8_SA(b, h) + aoff + m * 2048 + k * 1024); } while (0)
#define PG8_LDB(dst, b, h) do { _Pragma("unroll") for (int n = 0; n < 2; ++n) _Pragma("unroll") for (int k = 0; k < 2; ++k) dst[n][k] = *(const PG8_LAS bf16x8*)(lds + PG8_SB(b, h) + boff + n * 2048 + k * 1024); } while (0)
#define PG8_MMA(ai, bj, At, Bt) do { __builtin_amdgcn_s_setprio(1); _Pragma("unroll") for (int m = 0; m < 4; ++m) _Pragma("unroll") for (int n = 0; n < 2; ++n) _Pragma("unroll") for (int k = 0; k < 2; ++k) \
        acc[ai][bj][m][n] = __builtin_amdgcn_mfma_f32_16x16x32_bf16(Bt[n][k], At[m][k], acc[ai][bj][m][n], 0, 0, 0); __builtin_amdgcn_s_setprio(0); } while (0)
#define PG8_WAIT_V(n) asm volatile("s_waitcnt vmcnt(" #n ")" ::: "memory")
#define PG8_WAIT_L(n) asm volatile("s_waitcnt lgkmcnt(" #n ")" ::: "memory")
#define PG8_BAR __builtin_amdgcn_s_barrier()
#define PG8_SCHED __builtin_amdgcn_sched_barrier(0)
    Unit cur, nxt; int ui = 0;
    if (!S.next(0, cur)) return;
    f32x4 acc[2][2][4][2];
#pragma unroll
    for (int a = 0; a < 2; ++a)
#pragma unroll
        for (int b = 0; b < 2; ++b)
#pragma unroll
            for (int m = 0; m < 4; ++m)
#pragma unroll
                for (int n = 0; n < 2; ++n) acc[a][b][m][n] = (f32x4){0.f, 0.f, 0.f, 0.f};
    bf16x8 At[4][2], B0[2][2], B1[2][2];
    const char* cA = (const char*)g.A + (size_t)cur.pm * tstep; const char* cB = (const char*)g.Bt + (size_t)cur.pn * tstep;
    S.a_ready(cur);
    if constexpr (SP2) {
        PG8_STAGE(PG8_SB(0, 0), cB, voffB); PG8_STAGE(PG8_SB(0, 1), cB + hstep, voffB); PG8_STAGE(PG8_SA(0, 0), cA, voffA); PG8_STAGE(PG8_SA(0, 1), cA + hstep, voffA);
        if (wr == 1) PG8_BAR;
        PG8_WAIT_V(2); PG8_BAR;
        PG8_STAGE(PG8_SB(1, 0), cB + kstep, voffB); PG8_STAGE(PG8_SA(1, 0), cA + kstep, voffA); PG8_STAGE(PG8_SB(1, 1), cB + hstep + kstep, voffB);
        PG8_WAIT_V(6); PG8_BAR;
    } else {
        PG8_STAGE(PG8_SB(0, 0), cB, voffB); PG8_STAGE(PG8_SA(0, 0), cA, voffA); PG8_STAGE(PG8_SB(0, 1), cB + hstep, voffB); PG8_STAGE(PG8_SA(0, 1), cA + hstep, voffA);
        if (wr == 1) PG8_BAR;
        PG8_WAIT_V(4); PG8_BAR;
        PG8_STAGE(PG8_SB(1, 0), cB + kstep, voffB); PG8_STAGE(PG8_SA(1, 0), cA + kstep, voffA); PG8_STAGE(PG8_SB(1, 1), cB + hstep + kstep, voffB);
        PG8_WAIT_V(6); PG8_BAR;
    }
    for (;;) {
        const bool has_next = S.next(ui + 1, nxt);
        const char* nA = has_next ? (const char*)g.A + (size_t)nxt.pm * tstep : cA; const char* nB = has_next ? (const char*)g.Bt + (size_t)nxt.pn * tstep : cB;
        for (int t = 0; t < nt; t += 2) {
            const bool last = (t == nt - 2);
            const char* a1 = cA + (size_t)(t + 1) * kstep;
            const char* a2 = last ? nA : cA + (size_t)(t + 2) * kstep; const char* b2 = last ? nB : cB + (size_t)(t + 2) * kstep;
            const char* a3 = a2 + kstep; const char* b3 = b2 + kstep;
            if (last && has_next) S.a_ready(nxt);
            if constexpr (SP2) {
            PG8_LDB(B0, 0, 0); PG8_LDB(B1, 0, 1); PG8_SCHED; PG8_LDA(At, 0, 0); PG8_STAGE(PG8_SA(1, 1), a1 + hstep, voffA);
            PG8_WAIT_V(8); PG8_WAIT_L(0); PG8_BAR; PG8_MMA(0, 0, At, B0); PG8_MMA(0, 1, At, B1); PG8_BAR; PG8_SCHED;
            PG8_LDA(At, 0, 1); PG8_STAGE(PG8_SB(0, 0), b2, voffB); PG8_STAGE(PG8_SB(0, 1), b2 + hstep, voffB); PG8_STAGE(PG8_SA(0, 0), a2, voffA);
            PG8_WAIT_V(8); PG8_WAIT_L(0); PG8_BAR; PG8_MMA(1, 0, At, B0); PG8_MMA(1, 1, At, B1); PG8_BAR; PG8_SCHED;
            PG8_LDB(B0, 1, 0); PG8_LDB(B1, 1, 1); PG8_SCHED; PG8_LDA(At, 1, 0); PG8_STAGE(PG8_SA(0, 1), a2 + hstep, voffA);
            PG8_WAIT_V(8); PG8_WAIT_L(0); PG8_BAR; PG8_MMA(0, 0, At, B0); PG8_MMA(0, 1, At, B1); PG8_BAR; PG8_SCHED;
            PG8_LDA(At, 1, 1); PG8_STAGE(PG8_SB(1, 0), b3, voffB); PG8_STAGE(PG8_SB(1, 1), b3 + hstep, voffB); PG8_STAGE(PG8_SA(1, 0), a3, voffA);
            PG8_WAIT_V(8); PG8_WAIT_L(0); PG8_BAR; PG8_MMA(1, 0, At, B0); PG8_MMA(1, 1, At, B1); PG8_BAR; PG8_SCHED;
            } else {
            PG8_LDB(B0, 0, 0); PG8_SCHED; PG8_LDA(At, 0, 0); PG8_STAGE(PG8_SA(1, 1), a1 + hstep, voffA);
            PG8_WAIT_L(8); PG8_BAR; PG8_WAIT_L(0); PG8_MMA(0, 0, At, B0); PG8_BAR; PG8_SCHED;
            PG8_LDB(B1, 0, 1); PG8_STAGE(PG8_SB(0, 0), b2, voffB);
            PG8_BAR; PG8_WAIT_L(0); PG8_MMA(0, 1, At, B1); PG8_BAR;
            PG8_LDA(At, 0, 1); PG8_STAGE(PG8_SA(0, 0), a2, voffA);
            PG8_BAR; PG8_WAIT_L(0); PG8_MMA(1, 0, At, B0); PG8_BAR; PG8_SCHED;
            PG8_STAGE(PG8_SB(0, 1), b2 + hstep, voffB);
            PG8_WAIT_V(6); PG8_BAR; PG8_MMA(1, 1, At, B1); PG8_BAR;
            PG8_LDB(B0, 1, 0); PG8_SCHED; PG8_LDA(At, 1, 0); PG8_STAGE(PG8_SA(0, 1), a2 + hstep, voffA);
            PG8_WAIT_L(8); PG8_BAR; PG8_WAIT_L(0); PG8_MMA(0, 0, At, B0); PG8_BAR; PG8_SCHED;
            PG8_LDB(B1, 1, 1); PG8_STAGE(PG8_SB(1, 0), b3, voffB);
            PG8_BAR; PG8_WAIT_L(0); PG8_MMA(0, 1, At, B1); PG8_BAR;
            PG8_LDA(At, 1, 1); PG8_STAGE(PG8_SA(1, 0), a3, voffA);
            PG8_BAR; PG8_WAIT_L(0); PG8_MMA(1, 0, At, B0); PG8_BAR; PG8_SCHED;
            PG8_STAGE(PG8_SB(1, 1), b3 + hstep, voffB);
            PG8_WAIT_V(6); PG8_BAR; PG8_MMA(1, 1, At, B1); PG8_BAR;
            }
        }
        if constexpr (ALIGN_EPI) { if (wr == 0) PG8_BAR; }
        if constexpr (!Epi::AFTER_DRAIN) { E(acc, cur, wr, wc, fr, fq);
#if PROBE_EPI2
            if constexpr (Epi::PERM) { asm volatile("" ::: "memory"); E(acc, cur, wr, wc, fr, fq); }
#endif
            S.done(cur); }
        if (!has_next) break;
#pragma unroll
        for (int a = 0; a < 2; ++a)
#pragma unroll
            for (int b = 0; b < 2; ++b)
#pragma unroll
                for (int m = 0; m < 4; ++m)
#pragma unroll
                    for (int n = 0; n < 2; ++n) acc[a][b][m][n] = (f32x4){0.f, 0.f, 0.f, 0.f};
        cur = nxt; cA = nA; cB = nB; ++ui;
        if constexpr (ALIGN_EPI) { if (wr == 1) PG8_BAR; }
    }
    PG8_WAIT_V(0);
    if constexpr (!ALIGN_EPI) { if (wr == 0) PG8_BAR; }
    PG8_BAR;
    if constexpr (Epi::AFTER_DRAIN) { E.fused(acc, cur, wr, wc, fr, fq, lds, wid, lane); S.done(cur); }
#undef PG8_SA
#undef PG8_SB
#undef PG8_STAGE
#undef PG8_LDA
#undef PG8_LDB
#undef PG8_MMA
#undef PG8_WAIT_V
#undef PG8_WAIT_L
#undef PG8_BAR
#undef PG8_SCHED
}
}
#define XB_TMO      128
#define XB_XCNT(j)  (256  + 64 * (j))
#define XB_XSUB(j)  (1280 + 64 * (j))
#define XB_XGEN(j)  (2304 + 64 * (j))
#define XB_TOP      3328
#define XB_TOPGEN   3392
#define XCD_BAR_WORDS 3456
#define XB_SPIN_CAP (1u << 18)

__device__ __forceinline__ unsigned xb_ld(unsigned* p)              { return __hip_atomic_load(p, __ATOMIC_RELAXED, __HIP_MEMORY_SCOPE_AGENT); }
__device__ __forceinline__ unsigned xb_add(unsigned* p, unsigned v) { return __hip_atomic_fetch_add(p, v, __ATOMIC_RELAXED, __HIP_MEMORY_SCOPE_AGENT); }
__device__ __forceinline__ unsigned xb_xcc_id() { return (unsigned)__builtin_amdgcn_s_getreg((3 << 11) | 20) & 0xFu; }
#define XB_SPIN(cond, bar) do { unsigned _sp = 0; while (cond) { __builtin_amdgcn_s_sleep(1); \
    if ((++_sp & 255u) == 0u) { if (xb_ld(&(bar)[XB_TMO])) break; if (_sp > XB_SPIN_CAP) { atomicAdd(&(bar)[XB_TMO], 1u); break; } } } } while (0)

struct XcdBarrier {
    unsigned* bar; unsigned x;
    volatile LAS unsigned* st;
};

__device__ __forceinline__ XcdBarrier xcd_barrier_post(unsigned* bar, volatile LAS unsigned* st) {
    XcdBarrier b; b.bar = bar; b.x = xb_xcc_id(); b.st = st;
    if (threadIdx.x == 0) (void)xb_add(&bar[XB_XCNT(b.x)], 1u);
    return b;
}
__device__ __forceinline__ void xcd_barrier_complete(unsigned* bar, unsigned x, unsigned& nloc, unsigned& nx) {
    const unsigned G = gridDim.x * gridDim.y * gridDim.z;
    unsigned sum, cnt, mine, sp = 0u;
    for (;;) {
        sum = 0u; cnt = 0u; mine = 0u;
#pragma unroll
        for (unsigned j = 0; j < 16; ++j) { const unsigned c = xb_ld(&bar[XB_XCNT(j)]); sum += c; cnt += (c > 0u) ? 1u : 0u; mine = (j == x) ? c : mine; }
        if (sum == G) break;
        __builtin_amdgcn_s_sleep(1);
        if ((++sp & 255u) == 0u) { if (xb_ld(&bar[XB_TMO])) break; if (sp > XB_SPIN_CAP) { atomicAdd(&bar[XB_TMO], 1u); break; } }
    }
    nloc = mine > 0u ? mine : 1u; nx = cnt > 0u ? cnt : 1u;
}

__device__ __forceinline__ void xcd_barrier(const XcdBarrier& b) {
    asm volatile("s_waitcnt vmcnt(0)" ::: "memory");
    __syncthreads();
    if (threadIdx.x == 0) {
        unsigned* bar = b.bar;
        __builtin_amdgcn_s_waitcnt(0);
        unsigned nloc = b.st[0], nx = b.st[1];
        if (nloc == 0u) { xcd_barrier_complete(bar, b.x, nloc, nx); b.st[0] = nloc; b.st[1] = nx; }
        const unsigned old = xb_add(&bar[XB_XSUB(b.x)], 1u);
        const unsigned gen = old / nloc;
        if (old + 1u == (gen + 1u) * nloc) {
            __builtin_amdgcn_fence(__ATOMIC_RELEASE, "agent");
            asm volatile("s_waitcnt vmcnt(0)" ::: "memory");
            const unsigned og = xb_add(&bar[XB_TOP], 1u);
            const unsigned tg = og / nx;
            if (og + 1u == (tg + 1u) * nx) xb_add(&bar[XB_TOPGEN], 1u);
            else XB_SPIN(xb_ld(&bar[XB_TOPGEN]) == tg, bar);
            __builtin_amdgcn_fence(__ATOMIC_ACQUIRE, "agent");
            xb_add(&bar[XB_XGEN(b.x)], 1u);
            asm volatile("s_waitcnt vmcnt(0)" ::: "memory");
        } else {
            XB_SPIN(xb_ld(&bar[XB_XGEN(b.x)]) == gen, bar);
            __builtin_amdgcn_fence(__ATOMIC_ACQUIRE, "agent");
            asm volatile("s_waitcnt vmcnt(0)" ::: "memory");
        }
    }
    __syncthreads();
}
struct Args { const float* in[N_IN]; float* out; unsigned char* ws; int ph_lo, ph_hi, pad0, pad1; };
static_assert(sizeof(Args) == (N_IN + 2) * 8 + 16, "Args has no padding");
struct DevArgs { const GAS float* in[N_IN]; GAS float* out; GAS unsigned char* ws; int ph_lo, ph_hi, pad0, pad1; };
static_assert(sizeof(DevArgs) == sizeof(Args), "DevArgs mirrors Args");
typedef const __attribute__((address_space(4))) DevArgs* KArgs;
#define INP(i) ((const float*)F.ka->in[i])
struct Frame {
    LAS unsigned char* lds;
    int tid, lane, wave, vcu, G;
    KArgs ka;
    float* out; unsigned char* ws;
};
__device__ __forceinline__ const float* modp(const Frame& F, int layer) { return (const float*)(F.ws + WS_MOD) + (size_t)layer * 12 * NMOD; }
__device__ __forceinline__ unsigned char* lw(const Frame& F, int layer) { return F.ws + WS_W + (size_t)layer * LW; }

__device__ __forceinline__ void transpose_item(const float* W, int K, int N, bf16* WT, int k0, int n0, int orow0, LAS float* scr, int lane) {
#pragma unroll 8
    for (int i = 0; i < 32; ++i) { const int kk = 2 * i + (lane >> 5); scr[kk * 33 + (lane & 31)] = W[(size_t)(k0 + kk) * N + n0 + (lane & 31)]; }
    LDS_WAIT(); asm volatile("" ::: "memory");
    const int c = lane & 7;
#pragma unroll
    for (int j = 0; j < 4; ++j) { const int n = (lane >> 3) + 8 * j; const LAS float* s = scr + (8 * c) * 33 + n;
        v4u o; o.x = pk2(s[0 * 33], s[1 * 33]); o.y = pk2(s[2 * 33], s[3 * 33]); o.z = pk2(s[4 * 33], s[5 * 33]); o.w = pk2(s[6 * 33], s[7 * 33]);
        *(GAS v4u*)(WT + (size_t)(orow0 + n) * K + k0 + 8 * c) = o; }
    LDS_WAIT(); asm volatile("" ::: "memory");
}
__device__ __forceinline__ void p0a_phase(Frame& F) {
    const int gw = F.vcu * NWAVES + F.wave, NGW = F.G * NWAVES, gt = F.vcu * (NWAVES * 64) + F.tid, NGT = F.G * NWAVES * 64;
    {
        LAS float* sil = (LAS float*)F.lds;
        for (int i = F.tid; i < 12 * DM; i += NWAVES * 64) { const int b = i / DM, k = i % DM;
            const float c = b < NBP ? INP(I_CP)[b * DM + k] : INP(I_CS)[(b - NBP) * DM + k]; sil[k * 12 + b] = siluf_(c); }
        __syncthreads();
        constexpr int KC = DM / KSPLIT, NCB = NMOD / 256;
        float* part = (float*)(F.ws + WS_MODP);
        for (int it = gw; it < NL * KSPLIT * NCB; it += NGW) {
            const int l = it / (KSPLIT * NCB), ks = (it / NCB) % KSPLIT, cb = it % NCB, col = cb * 256 + 4 * F.lane;
            const GAS f32x4* wp = (const GAS f32x4*)(INP(I_ADAW) + ((size_t)l * DM + ks * KC) * NMOD + col);
            f32x4 acc[12];
#pragma unroll
            for (int b = 0; b < 12; ++b) acc[b] = (f32x4){0.f, 0.f, 0.f, 0.f};
#pragma unroll 4
            for (int k = 0; k < KC; ++k) { const f32x4 wv = wp[(size_t)k * (NMOD / 4)];
                const LAS f32x4* sp = (const LAS f32x4*)(sil + (ks * KC + k) * 12); const f32x4 s0 = sp[0], s1 = sp[1], s2 = sp[2];
                acc[0] += wv * s0[0]; acc[1] += wv * s0[1]; acc[2] += wv * s0[2]; acc[3] += wv * s0[3];
                acc[4] += wv * s1[0]; acc[5] += wv * s1[1]; acc[6] += wv * s1[2]; acc[7] += wv * s1[3];
                acc[8] += wv * s2[0]; acc[9] += wv * s2[1]; acc[10] += wv * s2[2]; acc[11] += wv * s2[3]; }
#pragma unroll
            for (int b = 0; b < 12; ++b) *(GAS f32x4*)(part + (((size_t)ks * NL + l) * 12 + b) * NMOD + col) = acc[b];
        }
        __syncthreads();
    }
    {
        LAS float* scr = (LAS float*)(F.lds + F.wave * 16384);
        constexpr int I_IN = (DM / 64) * (DIN / 32), I_OUT = (DM / 64) * (DM / 32), I_G = (DM / 64) * (DFF / 32), I_D = (DFF / 64) * (DM / 32), I_C = (DC / 64) * (DC / 32);
        constexpr int PER_L = I_IN + I_OUT + 2 * I_G + I_D + I_C;
        for (int it = gw; it < NL * PER_L; it += NGW) {
            const int l = it / PER_L; int r = it % PER_L; unsigned char* wl = lw(F, l);
            if (r < I_IN) { const int nblk = DIN / 32, k0 = 64 * (r / nblk), n0 = 32 * (r % nblk);
                int orow0 = n0; if (n0 < 512) orow0 = 256 * (n0 >> 7) + (n0 & 127); else if (n0 < 1024) orow0 = 256 * ((n0 - 512) >> 7) + 128 + (n0 & 127);
                transpose_item(INP(I_WIN) + (size_t)l * DM * DIN, DM, DIN, (bf16*)(wl + LW_WIN), k0, n0, orow0, scr, F.lane); continue; } r -= I_IN;
            if (r < I_OUT) { const int nblk = DM / 32, k0 = 64 * (r / nblk), n0 = 32 * (r % nblk);
                transpose_item(INP(I_WOUT) + (size_t)l * DM * DM, DM, DM, (bf16*)(wl + LW_WOUT), k0, n0, n0, scr, F.lane); continue; } r -= I_OUT;
            if (r < 2 * I_G) { const int up = r >= I_G; if (up) r -= I_G; const int nblk = DFF / 32, k0 = 64 * (r / nblk), n0 = 32 * (r % nblk);
                const int orow0 = 256 * (n0 >> 7) + 128 * up + (n0 & 127);
                transpose_item(INP(up ? I_WU : I_WG) + (size_t)l * DM * DFF, DM, DFF, (bf16*)(wl + LW_WGU), k0, n0, orow0, scr, F.lane); continue; } r -= 2 * I_G;
            if (r < I_D) { const int nblk = DM / 32, k0 = 64 * (r / nblk), n0 = 32 * (r % nblk);
                transpose_item(INP(I_WD) + (size_t)l * DFF * DM, DFF, DM, (bf16*)(wl + LW_WD), k0, n0, n0, scr, F.lane); continue; } r -= I_D;
            { const int nblk = DC / 32, k0 = 64 * (r / nblk), n0 = 32 * (r % nblk);
                transpose_item(INP(I_CPW) + (size_t)l * DC * DC, DC, DC, (bf16*)(wl + LW_CPW), k0, n0, n0, scr, F.lane); }
        }
        for (int i = gt; i < NL * DC * DC; i += NGT) { const int l = i / (DC * DC), n = (i / DC) % DC, k = i % DC; float v = 0.f;
            if ((n >> 7) == (k >> 7)) v = INP(I_POOLW)[(((size_t)l * 4 + (n >> 7)) * 128 + (k & 127)) * 128 + (n & 127)] * INP(I_POOLS)[l * DC + n];
            ((bf16*)(lw(F, l) + LW_PWD))[n * DC + k] = (bf16)(pk2(v, 0.f) & 0xffffu); }
        for (int i = gt; i < NL * 4 * 128 * 128; i += NGT) { const int l = i / 65536, r = i % 65536, ii = (r >> 7) & 127, jj = r & 127;
            const float v = (jj <= ii) ? INP(I_SGW)[i] : 0.f; ((bf16*)(lw(F, l) + LW_SGW))[r] = (bf16)(pk2(v, 0.f) & 0xffffu); }
    }
    __syncthreads();
}
__device__ __forceinline__ void p0b_phase(Frame& F) {
    const int gt = F.vcu * (NWAVES * 64) + F.tid, NGT = F.G * NWAVES * 64;
    const float* part = (const float*)(F.ws + WS_MODP); float* mod = (float*)(F.ws + WS_MOD);
    for (int i = gt; i < NL * 12 * NMOD; i += NGT) { const int l = i / (12 * NMOD), n = i % NMOD; float s = INP(I_ADAB)[l * NMOD + n];
#pragma unroll
        for (int ks = 0; ks < KSPLIT; ++ks) s += part[(size_t)ks * NL * 12 * NMOD + i];
        mod[i] = s; }
}
template <bool COPY>
__device__ __forceinline__ void norm_phase(Frame& F, const float* gain, const float* mod_l, int sh_idx, bf16* H) {
    const int gw = F.vcu * NWAVES + F.wave, NGW = F.G * NWAVES;
    float* X = F.out;
    for (int m = gw; m < MT; m += NGW) {
        const float* src = COPY ? (m < MP ? INP(I_XP) + (size_t)m * DM : INP(I_XS) + (size_t)(m - MP) * DM) : X + (size_t)m * DM;
        const GAS f32x4* xr = (const GAS f32x4*)src + F.lane;
        f32x4 v[8]; float s = 0.f;
#pragma unroll
        for (int j = 0; j < 8; ++j) { v[j] = xr[64 * j]; s += (v[j].x * v[j].x + v[j].y * v[j].y) + (v[j].z * v[j].z + v[j].w * v[j].w); }
        if (COPY) { GAS f32x4* xo = (GAS f32x4*)(X + (size_t)m * DM) + F.lane;
#pragma unroll
            for (int j = 0; j < 8; ++j) xo[64 * j] = v[j]; }
        const float rstd = 1.0f / sqrtf(wave_sum(s) * (1.0f / DM) + EPS);
        const float* mb = mod_l + (size_t)batch_of_row(m) * NMOD;
        const GAS f32x4* shp = (const GAS f32x4*)(mb + sh_idx * DM) + F.lane; const GAS f32x4* scp = (const GAS f32x4*)(mb + (sh_idx + 1) * DM) + F.lane;
        const GAS f32x4* gp = (const GAS f32x4*)gain + F.lane;
        GAS v2u* o8 = (GAS v2u*)(H + (size_t)m * DM) + F.lane;
#pragma unroll
        for (int j = 0; j < 8; ++j) { const f32x4 g = gp[64 * j], sc = scp[64 * j], sh = shp[64 * j];
            const f32x4 y = v[j] * rstd * g * (sc + 1.0f) + sh; v2u w; w.x = pk2(y.x, y.y); w.y = pk2(y.z, y.w); o8[64 * j] = w; }
    }
}
__device__ __forceinline__ void final_norm_phase(Frame& F) {
    const int gw = F.vcu * NWAVES + F.wave, NGW = F.G * NWAVES;
    for (int m = gw; m < MT; m += NGW) {
        GAS f32x4* xr = (GAS f32x4*)(F.out + (size_t)m * DM) + F.lane;
        f32x4 v[8]; float s = 0.f;
#pragma unroll
        for (int j = 0; j < 8; ++j) { v[j] = xr[64 * j]; s += (v[j].x * v[j].x + v[j].y * v[j].y) + (v[j].z * v[j].z + v[j].w * v[j].w); }
        const float rstd = 1.0f / sqrtf(wave_sum(s) * (1.0f / DM) + EPS);
        const GAS f32x4* gp = (const GAS f32x4*)INP(I_FING) + F.lane;
#pragma unroll
        for (int j = 0; j < 8; ++j) xr[64 * j] = v[j] * rstd * gp[64 * j];
    }
}

__device__ __forceinline__ int crow(int r, int hi) { return (r & 3) + 8 * (r >> 2) + 4 * hi; }
#define MFMA32(a, b, c) __builtin_amdgcn_mfma_f32_32x32x16_bf16((a), (b), (c), 0, 0, 0)
constexpr int AT_KS = 0, AT_VT = 9216, AT_BT = 18432, AT_PITCH = 144;
__device__ __forceinline__ void attn_unit(Frame& F, int layer, bool sample, int b, int h, int qg, const bf16* Z, bf16* MIX) {
    const int tid = F.tid, lane = F.lane, w = F.wave, l31 = lane & 31, hh = lane >> 5;
    LAS unsigned char* Ks = F.lds + AT_KS; LAS unsigned char* VTs = F.lds + AT_VT; LAS float* bt = (LAS float*)(F.lds + AT_BT);
    if (tid < 257) bt[tid] = INP(I_RELB)[((size_t)layer * 8 + h) * 257 + tid] * LOG2E;
    const bool wave_on = sample ? (w == 0) : true;
    const int qpos = sample ? l31 : 256 * qg + 32 * w + l31;
    const int qrow = sample ? MP + 32 * b + l31 : b * SEQ + qpos;
    bf16x8 qr[4];
#pragma unroll
    for (int d0 = 0; d0 < 4; ++d0) qr[d0] = *(const GAS bf16x8*)(Z + (size_t)qrow * ZW + ZQ + 64 * h + 16 * d0 + 8 * hh);
    f32x16 o0, o1;
#pragma unroll
    for (int r = 0; r < 16; ++r) { o0[r] = 0.f; o1[r] = 0.f; }
    float mrun = -1e30f, lrun = 0.f;
    const int ntile = sample ? 9 : 12, qc = 4 * qg + (w >> 1);
    const int sr = tid >> 3, sch = tid & 7;
    const float* ck = INP(I_CK) + ((size_t)layer * NBS + b) * 512 * 512; const float* cv = INP(I_CV) + ((size_t)layer * NBS + b) * 512 * 512;
    v4u kreg = (v4u){0u, 0u, 0u, 0u}, vreg = (v4u){0u, 0u, 0u, 0u};
#define AT_LOAD(j) do { \
        if (!sample) { const int kc_ = 4 * qg - 8 + (j); if (kc_ >= 0) { const bf16* zr_ = Z + (size_t)(b * SEQ + 64 * kc_ + sr) * ZW + 64 * h + 8 * sch; \
                kreg = *(const GAS v4u*)(zr_ + ZK); vreg = *(const GAS v4u*)(zr_ + ZV); } } \
        else if ((j) < 8) { const size_t o_ = ((size_t)(64 * (j) + sr) * 8 + h) * 64 + 8 * sch; \
                const f32x4 k0_ = *(const GAS f32x4*)(ck + o_), k1_ = *(const GAS f32x4*)(ck + o_ + 4), v0_ = *(const GAS f32x4*)(cv + o_), v1_ = *(const GAS f32x4*)(cv + o_ + 4); \
                kreg = (v4u){pk2(k0_.x, k0_.y), pk2(k0_.z, k0_.w), pk2(k1_.x, k1_.y), pk2(k1_.z, k1_.w)}; vreg = (v4u){pk2(v0_.x, v0_.y), pk2(v0_.z, v0_.w), pk2(v1_.x, v1_.y), pk2(v1_.z, v1_.w)}; } \
        else if (sr < 32) { const bf16* zr_ = Z + (size_t)(MP + 32 * b + sr) * ZW + 64 * h + 8 * sch; kreg = *(const GAS v4u*)(zr_ + ZK); vreg = *(const GAS v4u*)(zr_ + ZV); } \
        else { kreg = (v4u){0u, 0u, 0u, 0u}; vreg = (v4u){0u, 0u, 0u, 0u}; } } while (0)
    AT_LOAD(0);
    for (int j = 0; j < ntile; ++j) {
        const int kc = 4 * qg - 8 + j;
        if (!sample && kc < 0) { AT_LOAD(j + 1); continue; }
        *(LAS v4u*)(Ks + sr * AT_PITCH + sch * 16) = kreg;
        { LAS bf16* vt = (LAS bf16*)VTs + (8 * sch) * (AT_PITCH / 2) + sr;
          vt[0 * (AT_PITCH / 2)] = (bf16)(vreg.x & 0xffffu); vt[1 * (AT_PITCH / 2)] = (bf16)(vreg.x >> 16); vt[2 * (AT_PITCH / 2)] = (bf16)(vreg.y & 0xffffu); vt[3 * (AT_PITCH / 2)] = (bf16)(vreg.y >> 16);
          vt[4 * (AT_PITCH / 2)] = (bf16)(vreg.z & 0xffffu); vt[5 * (AT_PITCH / 2)] = (bf16)(vreg.z >> 16); vt[6 * (AT_PITCH / 2)] = (bf16)(vreg.w & 0xffffu); vt[7 * (AT_PITCH / 2)] = (bf16)(vreg.w >> 16); }
        __syncthreads();
        if (j + 1 < ntile) AT_LOAD(j + 1);
        const bool active = sample ? (w == 0) : (kc >= qc - 8 && kc <= qc);
        if (active) {
            f32x16 p0, p1;
#pragma unroll
            for (int r = 0; r < 16; ++r) { p0[r] = 0.f; p1[r] = 0.f; }
#pragma unroll
            for (int d0 = 0; d0 < 4; ++d0) {
                const bf16x8 a0 = *(const LAS bf16x8*)(Ks + l31 * AT_PITCH + (16 * d0 + 8 * hh) * 2);
                const bf16x8 a1 = *(const LAS bf16x8*)(Ks + (32 + l31) * AT_PITCH + (16 * d0 + 8 * hh) * 2);
                p0 = MFMA32(a0, qr[d0], p0); p1 = MFMA32(a1, qr[d0], p1);
            }
            const int kbase = sample ? 64 * j - 512 : 64 * kc;
            const int relb = kbase - qpos;
            const int qmin = sample ? 0 : 256 * qg + 32 * w;
            if (kbase + 63 - qmin <= -128) { const float b0 = bt[0];
#pragma unroll
                for (int r = 0; r < 16; ++r) { p0[r] += b0; p1[r] += b0; }
            } else {
#pragma unroll
                for (int r = 0; r < 16; ++r) { const int kv = crow(r, hh); int i0 = relb + kv, i1 = i0 + 32;
                    i0 = (i0 < -128 ? -128 : (i0 > 128 ? 128 : i0)) + 128; i1 = (i1 < -128 ? -128 : (i1 > 128 ? 128 : i1)) + 128;
                    p0[r] += bt[i0]; p1[r] += bt[i1]; }
            }
            if (sample && j == 8) {
#pragma unroll
                for (int r = 0; r < 16; ++r) p1[r] = -1e30f;
            }
            float mx = p0[0];
#pragma unroll
            for (int r = 1; r < 16; ++r) mx = fmaxf(mx, p0[r]);
#pragma unroll
            for (int r = 0; r < 16; ++r) mx = fmaxf(mx, p1[r]);
            mx = fmaxf(mx, __shfl_xor(mx, 32));
            const float mn = fmaxf(mrun, mx), alpha = fast_exp2(mrun - mn); mrun = mn;
            float rs = 0.f;
#pragma unroll
            for (int r = 0; r < 16; ++r) { p0[r] = fast_exp2(p0[r] - mn); p1[r] = fast_exp2(p1[r] - mn); rs += p0[r] + p1[r]; }
            rs += __shfl_xor(rs, 32);
            lrun = lrun * alpha + rs;
#pragma unroll
            for (int r = 0; r < 16; ++r) { o0[r] *= alpha; o1[r] *= alpha; }
            bf16x8 pf[4];
            { v4u t;
              t = (v4u){pk2(p0[0], p0[1]), pk2(p0[2], p0[3]), pk2(p0[4], p0[5]), pk2(p0[6], p0[7])}; pf[0] = __builtin_bit_cast(bf16x8, t);
              t = (v4u){pk2(p0[8], p0[9]), pk2(p0[10], p0[11]), pk2(p0[12], p0[13]), pk2(p0[14], p0[15])}; pf[1] = __builtin_bit_cast(bf16x8, t);
              t = (v4u){pk2(p1[0], p1[1]), pk2(p1[2], p1[3]), pk2(p1[4], p1[5]), pk2(p1[6], p1[7])}; pf[2] = __builtin_bit_cast(bf16x8, t);
              t = (v4u){pk2(p1[8], p1[9]), pk2(p1[10], p1[11]), pk2(p1[12], p1[13]), pk2(p1[14], p1[15])}; pf[3] = __builtin_bit_cast(bf16x8, t); }
#pragma unroll
            for (int xt = 0; xt < 2; ++xt)
#pragma unroll
                for (int s = 0; s < 2; ++s) { const int kvo = 32 * xt + 16 * s + 4 * hh;
                    const v2u lo0 = *(const LAS v2u*)(VTs + l31 * AT_PITCH + kvo * 2), hi0 = *(const LAS v2u*)(VTs + l31 * AT_PITCH + (kvo + 8) * 2);
                    const v2u lo1 = *(const LAS v2u*)(VTs + (32 + l31) * AT_PITCH + kvo * 2), hi1 = *(const LAS v2u*)(VTs + (32 + l31) * AT_PITCH + (kvo + 8) * 2);
                    const v4u f0 = (v4u){lo0.x, lo0.y, hi0.x, hi0.y}, f1 = (v4u){lo1.x, lo1.y, hi1.x, hi1.y};
                    o0 = MFMA32(__builtin_bit_cast(bf16x8, f0), pf[2 * xt + s], o0); o1 = MFMA32(__builtin_bit_cast(bf16x8, f1), pf[2 * xt + s], o1); }
        }
        __syncthreads();
    }
#undef AT_LOAD
    if (wave_on) {
        const float inv = 1.0f / lrun;
        bf16* orow = MIX + (size_t)qrow * MIXW + MIX_B + 64 * h;
#pragma unroll
        for (int g4 = 0; g4 < 4; ++g4) { const int d = 8 * g4 + 4 * hh;
            v2u w0; w0.x = pk2(o0[4 * g4] * inv, o0[4 * g4 + 1] * inv); w0.y = pk2(o0[4 * g4 + 2] * inv, o0[4 * g4 + 3] * inv); *(GAS v2u*)(orow + d) = w0;
            v2u w1; w1.x = pk2(o1[4 * g4] * inv, o1[4 * g4 + 1] * inv); w1.y = pk2(o1[4 * g4 + 2] * inv, o1[4 * g4 + 3] * inv); *(GAS v2u*)(orow + 32 + d) = w1; }
    }
}
__device__ __forceinline__ unsigned sg_off(unsigned row, unsigned ch) { return 256u * row + 16u * (ch ^ (((row & 3u) << 2) | ((row >> 2) & 3u))); }
typedef short v4i16_t __attribute__((ext_vector_type(4)));
__device__ __forceinline__ v2u lds_tr_read(LAS unsigned char* p) { const v4i16_t r = __builtin_amdgcn_ds_read_tr16_b64_v4i16((LAS v4i16_t*)p); return __builtin_bit_cast(v2u, r); }
__device__ __forceinline__ void sg_unit(Frame& F, int layer, int ci, const bf16* Z, bf16* MIX) {
    const int lane = F.lane, w = F.wave, l31 = lane & 31, hh = lane >> 5;
    const bool sample = ci >= MP / 128; const int L = sample ? 32 : 128, row0 = sample ? MP + 32 * (ci - MP / 128) : 128 * ci;
    LAS unsigned char* VN = F.lds;
    {
        const int c8 = 8 * lane;
        const GAS f32x4* lgp = (const GAS f32x4*)(INP(I_SGG) + layer * DC + c8); const GAS f32x4* lbp = (const GAS f32x4*)(INP(I_SGB) + layer * DC + c8);
        const f32x4 lg0 = lgp[0], lg1 = lgp[1], lb0 = lbp[0], lb1 = lbp[1];
        const int nrw = L / 8;
        LAS unsigned char* vbase = VN + (lane >> 4) * 32768;
        for (int i = 0; i < nrw; ++i) { const int rr = w * nrw + i;
            const v4u zv = *(const GAS v4u*)(Z + (size_t)(row0 + rr) * ZW + ZSV + c8);
            float x[8] = {bflo(zv.x), bfhi(zv.x), bflo(zv.y), bfhi(zv.y), bflo(zv.z), bfhi(zv.z), bflo(zv.w), bfhi(zv.w)};
            const float s = ((x[0] + x[1]) + (x[2] + x[3])) + ((x[4] + x[5]) + (x[6] + x[7]));
            const float mean = wave_sum(s) * (1.0f / DC); float q = 0.f;
#pragma unroll
            for (int e = 0; e < 8; ++e) { x[e] -= mean; q += x[e] * x[e]; }
            const float rstd = 1.0f / sqrtf(wave_sum(q) * (1.0f / DC) + EPS);
            float y[8];
            y[0] = x[0] * rstd * lg0.x + lb0.x; y[1] = x[1] * rstd * lg0.y + lb0.y; y[2] = x[2] * rstd * lg0.z + lb0.z; y[3] = x[3] * rstd * lg0.w + lb0.w;
            y[4] = x[4] * rstd * lg1.x + lb1.x; y[5] = x[5] * rstd * lg1.y + lb1.y; y[6] = x[6] * rstd * lg1.z + lb1.z; y[7] = x[7] * rstd * lg1.w + lb1.w;
            *(LAS v4u*)(vbase + sg_off((unsigned)rr, (unsigned)(lane & 15))) = (v4u){pk2(y[0], y[1]), pk2(y[2], y[3]), pk2(y[4], y[5]), pk2(y[6], y[7])};
            if (sample) { float* so = F.out + O_SGV + (((size_t)layer * NBS + (ci - MP / 128)) * TS + rr) * DC + c8;
                *(GAS f32x4*)so = (f32x4){y[0], y[1], y[2], y[3]}; *(GAS f32x4*)(so + 4) = (f32x4){y[4], y[5], y[6], y[7]}; }
        }
    }
    __syncthreads();
    {
        const int g = w >> 1;
        const bf16* Wg = (const bf16*)(lw(F, layer) + LW_SGW) + (size_t)g * 128 * 128;
        LAS unsigned char* vg = VN + g * 32768;
        const int nib = L / 32;
        const unsigned blk = (lane >> 4) & 1, q = (lane & 15) >> 2, p4 = lane & 3;
#pragma unroll
        for (int cbb = 0; cbb < 2; ++cbb) { const int cb = 2 * (w & 1) + cbb;
            f32x16 acc[4];
#pragma unroll
            for (int ib = 0; ib < 4; ++ib)
#pragma unroll
                for (int r = 0; r < 16; ++r) acc[ib][r] = 0.f;
            for (int s = 0; s < 2 * nib; ++s) {
                const v2u a0 = lds_tr_read(vg + sg_off(16u * s + 8u * hh + q, 4u * cb + 2u * blk + (p4 >> 1)) + 8u * (p4 & 1));
                const v2u a1 = lds_tr_read(vg + sg_off(16u * s + 8u * hh + 4u + q, 4u * cb + 2u * blk + (p4 >> 1)) + 8u * (p4 & 1));
                const v4u af = (v4u){a0.x, a0.y, a1.x, a1.y};
#pragma unroll
                for (int ib = 0; ib < 4; ++ib) { if (ib < nib && s < 2 * (ib + 1)) {
                        const bf16x8 bb = *(const GAS bf16x8*)(Wg + (size_t)(32 * ib + l31) * 128 + 16 * s + 8 * hh);
                        acc[ib] = MFMA32(__builtin_bit_cast(bf16x8, af), bb, acc[ib]); } }
            }
#pragma unroll
            for (int ib = 0; ib < 4; ++ib) { if (ib < nib) {
                    const int i = 32 * ib + l31, row = row0 + i; const float bias = INP(I_SGBIAS)[((size_t)layer * 4 + g) * 128 + i];
#pragma unroll
                    for (int rg = 0; rg < 4; ++rg) { const int c4 = 32 * cb + 8 * rg + 4 * hh;
                        const v2u zu = *(const GAS v2u*)(Z + (size_t)row * ZW + ZSU + 128 * g + c4);
                        v2u o; o.x = pk2(bflo(zu.x) * (acc[ib][4 * rg] + bias), bfhi(zu.x) * (acc[ib][4 * rg + 1] + bias)); o.y = pk2(bflo(zu.y) * (acc[ib][4 * rg + 2] + bias), bfhi(zu.y) * (acc[ib][4 * rg + 3] + bias));
                        *(GAS v2u*)(MIX + (size_t)row * MIXW + MIX_D + 128 * g + c4) = o; } } }
        }
    }
    __syncthreads();
}
struct ConvCtx { const GAS unsigned char* zb; const GAS unsigned char* hist; GAS unsigned char* cst; bool sample, first, keep; };
template <int E> __device__ __forceinline__ void conv_row(f32x2 (&acc)[32], const f32x2 (&wt)[31], const ConvCtx& X) {
    f32x2 v;
    if constexpr (E < 30) { if (X.sample) v = *(const GAS f32x2*)(X.hist + (size_t)E * DC * 4);
                            else if (X.first) v = (f32x2){0.f, 0.f};
                            else { const unsigned u = *(const GAS unsigned*)(X.zb + (size_t)E * ZW * 2); v = (f32x2){bflo(u), bfhi(u)}; } }
    else { const unsigned u = *(const GAS unsigned*)(X.zb + (size_t)E * ZW * 2); v = (f32x2){bflo(u), bfhi(u)}; }
    constexpr int T0 = E > 30 ? E - 30 : 0, T1 = E < 31 ? E : 31;
#pragma unroll
    for (int t = T0; t <= T1; ++t) acc[t] = wt[E - t] * v + acc[t];
    if constexpr (E >= 32) { if (X.keep) *(GAS f32x2*)(X.cst + (size_t)(E - 32) * DC * 4) = v; }
}
template <int... Es> __device__ __forceinline__ void conv_rows(f32x2 (&acc)[32], const f32x2 (&wt)[31], const ConvCtx& X, std::integer_sequence<int, Es...>) { (conv_row<Es>(acc, wt, X), ...); }
__device__ __forceinline__ void conv_unit(Frame& F, int layer, int tb, int cq, const bf16* Z, bf16* CA, int ca_pitch) {
    const int c = 128 * cq + 2 * F.lane; const bool sample = tb >= MP / 32; const int sb = tb - MP / 32;
    const int r0 = sample ? MP + 32 * sb : 32 * tb; const bool first = !sample && ((r0 & (SEQ - 1)) == 0);
    ConvCtx X; X.sample = sample; X.first = first; X.keep = sample || ((r0 & (SEQ - 1)) == SEQ - 32);
    X.zb = (const GAS unsigned char*)(Z + ((long)r0 - 30) * ZW + ZU + c); asm volatile("" : "+v"(X.zb));
    const GAS unsigned char* wb = (const GAS unsigned char*)(INP(I_CONVW) + (size_t)layer * 31 * DC + c); asm volatile("" : "+v"(wb));
    f32x2 wt[31];
#pragma unroll
    for (int j = 0; j < 31; ++j) wt[j] = *(const GAS f32x2*)(wb + (size_t)j * DC * 4);
    const f32x2 cbias = *(const GAS f32x2*)(INP(I_CONVB) + layer * DC + c), gg = *(const GAS f32x2*)(INP(I_GNG) + layer * DC + c), gb = *(const GAS f32x2*)(INP(I_GNB) + layer * DC + c);
    f32x2 acc[32];
#pragma unroll
    for (int t = 0; t < 32; ++t) acc[t] = cbias;
    X.hist = (const GAS unsigned char*)(INP(I_CCONV) + ((size_t)layer * NBS + (sample ? sb : 0)) * 30 * DC + c); asm volatile("" : "+v"(X.hist));
    X.cst = (GAS unsigned char*)(sample ? F.out + O_CONVS + ((size_t)layer * NBS + sb) * 30 * DC + c : F.out + O_CONVP + ((size_t)layer * NBP + (r0 >> 13)) * 30 * DC + c); asm volatile("" : "+v"(X.cst));
    GAS unsigned char* cab = (GAS unsigned char*)(CA + (size_t)r0 * ca_pitch + c); asm volatile("" : "+v"(cab));
    conv_rows(acc, wt, X, std::make_integer_sequence<int, 62>{});
#pragma unroll
    for (int t = 0; t < 32; ++t) {
        const f32x2 y = acc[t];
        const float s = half32_sum(y.x + y.y), q = half32_sum(y.x * y.x + y.y * y.y);
        const float mean = s * (1.0f / 64.0f), var = fmaxf(q * (1.0f / 64.0f) - mean * mean, 0.f), rstd = 1.0f / sqrtf(var + EPS);
        const f32x2 n = (y - mean) * rstd * gg + gb;
        *(GAS unsigned*)(cab + (size_t)t * ca_pitch * 2) = pk2(siluf_(n.x), siluf_(n.y));
    }
}
template <int W>
__device__ __forceinline__ void pool_body(Frame& F, int layer, int tb, int cq, const bf16* Z, bf16* PM, int pm_pitch) {
    const int c = 128 * cq + 2 * F.lane; const bool sample = tb >= MP / 32; const int sb = tb - MP / 32;
    const int r0 = sample ? MP + 32 * sb : 32 * tb; const bool first = !sample && ((r0 & (SEQ - 1)) == 0);
    const GAS unsigned char* hist = (const GAS unsigned char*)(INP(I_CPOOL) + ((size_t)layer * NBS + (sample ? sb : 0)) * 15 * DC + c); asm volatile("" : "+v"(hist));
    const bool last_blk = !sample && ((r0 & (SEQ - 1)) == SEQ - 32);
    GAS unsigned char* pst = (GAS unsigned char*)(sample ? F.out + O_POOLS + ((size_t)layer * NBS + sb) * 15 * DC + c : F.out + O_POOLP + ((size_t)layer * NBP + (r0 >> 13)) * 15 * DC + c); asm volatile("" : "+v"(pst));
    const GAS unsigned char* zb = (const GAS unsigned char*)(Z + ((long)r0 - 15) * ZW + ZP + c); asm volatile("" : "+v"(zb));
    GAS unsigned char* pmb = (GAS unsigned char*)(PM + (size_t)r0 * pm_pitch + c); asm volatile("" : "+v"(pmb));
    f32x2 ext[47];
#pragma unroll
    for (int e = 0; e < 47; ++e) {
        if (e < 15) { if (sample) ext[e] = *(const GAS f32x2*)(hist + (size_t)e * DC * 4);
                      else if (first) ext[e] = (f32x2){0.f, 0.f};
                      else { const unsigned u = *(const GAS unsigned*)(zb + (size_t)e * ZW * 2); ext[e] = (f32x2){bflo(u), bfhi(u)}; } }
        else { const unsigned u = *(const GAS unsigned*)(zb + (size_t)e * ZW * 2); ext[e] = (f32x2){bflo(u), bfhi(u)}; }
    }
#pragma unroll
    for (int t = 0; t < 32; ++t) {
        f32x2 win = (f32x2){0.f, 0.f};
#pragma unroll
        for (int i = W - 1; i >= 0; --i) win += ext[15 + t - i];
        const float rc = 1.0f / (float)((first && t + 1 < W) ? t + 1 : W);
        const f32x2 m = win * rc - ext[15 + t];
        *(GAS unsigned*)(pmb + (size_t)t * pm_pitch * 2) = pk2(m.x, m.y);
        if (t >= 17 && (sample || last_blk)) *(GAS f32x2*)(pst + (size_t)(t - 17) * DC * 4) = ext[15 + t];
    }
}
__device__ __forceinline__ void mixer_phase(Frame& F, int layer) {
    const bf16* Z = (const bf16*)(F.ws + WS_Z); bf16* MIX = (bf16*)(F.ws + WS_MIX); bf16* CA = (bf16*)(F.ws + WS_CAPM); bf16* PM = CA + (size_t)MT * DC;
#ifndef PROBE_MIX
#define PROBE_MIX 0
#endif
#define MDUP(k) _Pragma("unroll") for (int mrep_ = 0; mrep_ < 1 + ((PROBE_MIX >> (k)) & 1); ++mrep_)
    MDUP(0) { for (int id = F.vcu; id < NBP * 8 * 32; id += F.G) attn_unit(F, layer, false, id >> 8, (id >> 5) & 7, id & 31, Z, MIX);
    for (int id = F.vcu; id < NBS * 8; id += F.G) attn_unit(F, layer, true, id >> 3, id & 7, 0, Z, MIX); }
    MDUP(1) for (int id = F.vcu; id < MP / 128 + NBS; id += F.G) sg_unit(F, layer, id, Z, MIX);
    const int gw = F.vcu * NWAVES + F.wave, NGW = F.G * NWAVES;
    MDUP(2) for (int id = gw; id < (MT / 32) * 4; id += NGW) conv_unit(F, layer, id >> 2, id & 3, Z, CA, DC);
    MDUP(3) for (int id = gw; id < (MT / 32) * 4; id += NGW) { const int tb = id >> 2, cq = id & 3;
        switch (cq) { case 0: pool_body<2>(F, layer, tb, cq, Z, PM, DC); break; case 1: pool_body<4>(F, layer, tb, cq, Z, PM, DC); break;
                      case 2: pool_body<8>(F, layer, tb, cq, Z, PM, DC); break; default: pool_body<16>(F, layer, tb, cq, Z, PM, DC); break; } }
    const int gt = F.vcu * (NWAVES * 64) + F.tid, NGT = F.G * NWAVES * 64;
    for (int i = gt; i < (NBP * 512 + NBS * TS) * 128; i += NGT) {
        const int rr = i >> 7, kv = (i >> 6) & 1, ch = i & 63;
        int zrow; size_t o;
        if (rr < NBP * 512) { const int b = rr >> 9, t = rr & 511; zrow = b * SEQ + SEQ - 512 + t; o = (kv ? O_VP : O_KP) + (((size_t)layer * NBP + b) * 512 + t) * 512 + 8 * ch; }
        else { const int r2 = rr - NBP * 512, b = r2 >> 5, t = r2 & 31; zrow = MP + r2; o = (kv ? O_VS : O_KS) + (((size_t)layer * NBS + b) * TS + t) * 512 + 8 * ch; }
        const v4u z = *(const GAS v4u*)(Z + (size_t)zrow * ZW + (kv ? ZV : ZK) + 8 * ch);
        *(GAS f32x4*)(F.out + o) = (f32x4){bflo(z.x), bfhi(z.x), bflo(z.y), bfhi(z.y)}; *(GAS f32x4*)(F.out + o + 4) = (f32x4){bflo(z.z), bfhi(z.z), bflo(z.w), bfhi(z.w)};
    }
}

enum { SK_Z = 0, SK_MIX2 = 1, SK_RES = 2, SK_SWI = 3 };
struct SkUnit { int row0, nb0, nb1, ocol0, ocol1; bool pair; float scale; };
template <int KIND, int NTB, int U>
__device__ __forceinline__ void sk_unit(Frame& F, const bf16* A, const bf16* Bt, int K, const SkUnit& u, bf16* obf, int opitch, float* X, const float* gate) {
    const int lane = F.lane, w = F.wave, l31 = lane & 31, hh = lane >> 5;
    const int kw = K >> 3, nch = kw >> 6;
    constexpr int NR = 32 * NTB + 64, NLD = NR / 8;
    LAS unsigned char* stg = F.lds + w * 16384;
    const int lr = lane >> 3, lc = lane & 7;
    const GAS unsigned char* src[NLD];
#pragma unroll
    for (int i = 0; i < NLD; ++i) { const int r = 8 * i + lr;
        const bf16* base = (r < 32 * NTB) ? A + (size_t)(u.row0 + r) * K : (r < 32 * NTB + 32) ? Bt + (size_t)(u.nb0 + r - 32 * NTB) * K : Bt + (size_t)(u.nb1 + r - 32 * NTB - 32) * K;
        src[i] = (const GAS unsigned char*)(base + w * kw + 8 * lc); }
    f32x16 acc[NTB][2];
#pragma unroll
    for (int tb = 0; tb < NTB; ++tb)
#pragma unroll
        for (int c = 0; c < 2; ++c)
#pragma unroll
            for (int r = 0; r < 16; ++r) acc[tb][c][r] = 0.f;
    v4u R[NLD];
#pragma unroll
    for (int i = 0; i < NLD; ++i) R[i] = *(const GAS v4u*)(src[i]);
    for (int ch = 0; ch < nch; ++ch) {
#pragma unroll
        for (int i = 0; i < NLD; ++i) { const int r = 8 * i + lr; *(LAS v4u*)(stg + r * 128 + 16 * (lc ^ (r & 7))) = R[i]; }
        if (ch + 1 < nch) {
#pragma unroll
            for (int i = 0; i < NLD; ++i) R[i] = *(const GAS v4u*)(src[i] + (size_t)(ch + 1) * 128); }
#pragma unroll
        for (int s = 0; s < 4; ++s) { const int cx = 16 * ((2 * s + hh) ^ (l31 & 7));
            bf16x8 xf[NTB];
#pragma unroll
            for (int tb = 0; tb < NTB; ++tb) xf[tb] = *(const LAS bf16x8*)(stg + (32 * tb + l31) * 128 + cx);
            const bf16x8 w0 = *(const LAS bf16x8*)(stg + (32 * NTB + l31) * 128 + cx), w1 = *(const LAS bf16x8*)(stg + (32 * NTB + 32 + l31) * 128 + cx);
#pragma unroll
            for (int tb = 0; tb < NTB; ++tb) { acc[tb][0] = MFMA32(w0, xf[tb], acc[tb][0]); acc[tb][1] = MFMA32(w1, xf[tb], acc[tb][1]); }
        }
    }
    __syncthreads();
    LAS f32x4* red = (LAS f32x4*)F.lds;
#pragma unroll
    for (int tb = 0; tb < NTB; ++tb)
#pragma unroll
        for (int c = 0; c < 2; ++c)
#pragma unroll
            for (int rg = 0; rg < 4; ++rg) red[((((w * NTB + tb) * 2 + c) * 4 + rg) << 6) + lane] = (f32x4){acc[tb][c][4 * rg], acc[tb][c][4 * rg + 1], acc[tb][c][4 * rg + 2], acc[tb][c][4 * rg + 3]};
    __syncthreads();
    {
        const int rg = w & 3, tb = (NTB == 2) ? (w >> 2) : 0, c_lo = (NTB == 2) ? 0 : (w >> 2), c_hi = (NTB == 2) ? 2 : (w >> 2) + 1;
        f32x4 v[2] = {(f32x4){0.f, 0.f, 0.f, 0.f}, (f32x4){0.f, 0.f, 0.f, 0.f}};
#pragma unroll
        for (int c = 0; c < 2; ++c) { if (c >= c_lo && c < c_hi) {
#pragma unroll
                for (int w2 = 0; w2 < 8; ++w2) v[c] += red[((((w2 * NTB + tb) * 2 + c) * 4 + rg) << 6) + lane]; } }
        const int row = u.row0 + 32 * tb + l31, co = 8 * rg + 4 * hh;
        if (KIND == SK_Z) {
            if (u.pair) { v2u o; o.x = pk2(v[0][0] * sigmoidf_(v[1][0]), v[0][1] * sigmoidf_(v[1][1])); o.y = pk2(v[0][2] * sigmoidf_(v[1][2]), v[0][3] * sigmoidf_(v[1][3]));
                *(GAS v2u*)(obf + (size_t)row * opitch + u.ocol0 + co) = o; }
            else {
#pragma unroll
                for (int c = 0; c < 2; ++c) { const f32x4 y = v[c] * u.scale; v2u o; o.x = pk2(y[0], y[1]); o.y = pk2(y[2], y[3]); *(GAS v2u*)(obf + (size_t)row * opitch + (c ? u.ocol1 : u.ocol0) + co) = o; } }
        } else if (KIND == SK_MIX2) {
#pragma unroll
            for (int c = 0; c < 2; ++c) { v2u o; o.x = pk2(v[c][0], v[c][1]); o.y = pk2(v[c][2], v[c][3]); *(GAS v2u*)(obf + (size_t)row * opitch + (c ? u.ocol1 : u.ocol0) + co) = o; }
        } else if (KIND == SK_SWI) {
            v2u o; o.x = pk2(siluf_(v[0][0]) * v[1][0], siluf_(v[0][1]) * v[1][1]); o.y = pk2(siluf_(v[0][2]) * v[1][2], siluf_(v[0][3]) * v[1][3]);
            *(GAS v2u*)(obf + (size_t)row * opitch + u.ocol0 + co) = o;
        } else {
            const int c = w >> 2, col = (c ? u.ocol1 : u.ocol0) + co;
            const f32x4 g = *(const GAS f32x4*)(gate + (size_t)batch_of_row(row) * NMOD + col); GAS f32x4* xp = (GAS f32x4*)(X + (size_t)row * DM + col);
            *xp = *xp + g * v[c];
        }
    }
    __syncthreads();
}
constexpr int N_PHASES = 2 + 8 * NL + 1;

__global__ void __launch_bounds__(NWAVES * 64, 2) enc_fwd(Args args) {
    extern __shared__ __attribute__((aligned(16))) unsigned char lds[];
    Frame F;
    F.lds = (LAS unsigned char*)lds;
    F.tid = threadIdx.x; F.lane = F.tid & 63; F.wave = __builtin_amdgcn_readfirstlane(F.tid >> 6);
    F.G = gridDim.x; { const int bx = blockIdx.x; F.vcu = (F.G % 8 == 0) ? (bx % 8) * (F.G / 8) + bx / 8 : bx; }
    F.ka = (KArgs)__builtin_amdgcn_kernarg_segment_ptr();
    F.out = args.out; F.ws = args.ws;
    volatile LAS unsigned* MISC = (volatile LAS unsigned*)(F.lds + MISC_OFF);
    for (int u = F.tid; u < (LDS_BYTES - LDSCTL_OFF) / 4; u += NWAVES * 64) ((LAS unsigned*)(F.lds + LDSCTL_OFF))[u] = 0u;
    __syncthreads();
    const int lo = args.ph_lo, hi = args.ph_hi;
#define REFRESH() do { int t_ = threadIdx.x; asm volatile("" : "+v"(t_)); F.tid = t_; F.lane = t_ & 63; F.wave = __builtin_amdgcn_readfirstlane(t_ >> 6); \
        unsigned long long w_ = (unsigned long long)args.ws, o_ = (unsigned long long)args.out, k_ = (unsigned long long)__builtin_amdgcn_kernarg_segment_ptr(); \
        asm volatile("" : "+s"(w_), "+s"(o_), "+s"(k_)); F.ws = (unsigned char*)(GAS unsigned char*)w_; F.out = (float*)(GAS float*)o_; F.ka = (KArgs)k_; \
        unsigned l_ = (unsigned)(unsigned long long)(LAS unsigned char*)lds; asm volatile("" : "+s"(l_)); F.lds = (LAS unsigned char*)(unsigned long long)l_; } while (0)
    XcdBarrier bar; bar.bar = (unsigned*)(F.ws + WS_CTL) + CW_BAR; bar.x = 0; bar.st = nullptr;
    if (hi - lo > 1) bar = xcd_barrier_post((unsigned*)(F.ws + WS_CTL) + CW_BAR, MISC + 8);
#ifdef ONLY_PHASE
#define IN(k) ((((k) < 2 || (k) == N_PHASES - 1) ? (k) : 2 + ((k) - 2) % 8) == ONLY_PHASE && lo <= (k) && (k) < hi)
#else
#define IN(k) (lo <= (k) && (k) < hi)
#endif
#ifndef PROBE_DUP
#define PROBE_DUP 0
#endif
#define DUP(k) _Pragma("unroll") for (int rep_ = 0; rep_ < 1 + ((PROBE_DUP >> (k)) & 1); ++rep_)
#ifndef STAGGER_TICKS
#define STAGGER_TICKS 0
#endif
#define STAGGER() do { if (STAGGER_TICKS > 0 && (blockIdx.x & 8)) { const unsigned long long t0_ = __builtin_amdgcn_s_memrealtime(); while (__builtin_amdgcn_s_memrealtime() - t0_ < (unsigned long long)STAGGER_TICKS) __builtin_amdgcn_s_sleep(8); } } while (0)
#define SEAM(k) do { if (IN(k) && IN((k) + 1)) { XcdBarrier b_ = bar; unsigned long long p_ = (unsigned long long)b_.bar; asm volatile("" : "+s"(p_)); b_.bar = (unsigned*)p_; xcd_barrier(b_); } } while (0)

    if (IN(0)) DUP(8) { REFRESH(); p0a_phase(F); } SEAM(0);
    if (IN(1)) { REFRESH(); p0b_phase(F); } SEAM(1);
    for (int l = 0; l < NL; ++l) {
        const int pb = 2 + 8 * l;
        if (IN(pb + 0)) DUP(0) { REFRESH(); bf16* H = (bf16*)(F.ws + WS_H); bf16* Zb = (bf16*)(F.ws + WS_Z); bf16* MIX = (bf16*)(F.ws + WS_MIX); bf16* HID = (bf16*)(F.ws + WS_HID); bf16* CAPM = (bf16*)(F.ws + WS_CAPM); (void)H; (void)Zb; (void)MIX; (void)HID; (void)CAPM; const float* mod_l = modp(F, l); unsigned char* wl = lw(F, l); (void)mod_l; (void)wl; if (l == 0) norm_phase<true>(F, INP(I_N1) + l * DM, mod_l, 0, H); else norm_phase<false>(F, INP(I_N1) + l * DM, mod_l, 0, H); } SEAM(pb + 0);
        if (IN(pb + 1)) DUP(1) { REFRESH(); bf16* H = (bf16*)(F.ws + WS_H); bf16* Zb = (bf16*)(F.ws + WS_Z); bf16* MIX = (bf16*)(F.ws + WS_MIX); bf16* HID = (bf16*)(F.ws + WS_HID); bf16* CAPM = (bf16*)(F.ws + WS_CAPM); (void)H; (void)Zb; (void)MIX; (void)HID; (void)CAPM; const float* mod_l = modp(F, l); unsigned char* wl = lw(F, l); (void)mod_l; (void)wl; pg8::Gemm g{H, (const bf16*)(wl + LW_WIN), MP, DIN, DM}; pg8::StaticOrder S; S.init(MP, DIN, F.G, (int)blockIdx.x); pg8::EpiZ E{Zb};
            pg8::gemm_phase<pg8::EpiZ, pg8::StaticOrder, true, true>(F.lds, g, S, E);
            for (int su = F.vcu; su < 4 * 64; su += F.G) { const int rt = su & 3, cb = su >> 2; SkUnit u; u.row0 = MP + 64 * rt;
                if (cb < 16) { const int tt = cb >> 2, x0 = 32 * (cb & 3); u.nb0 = 256 * tt + x0; u.nb1 = u.nb0 + 128; u.ocol0 = 128 * tt + x0; u.ocol1 = 0; u.pair = true; u.scale = 1.f; }
                else { const int pbk = cb - 16; u.nb0 = 1024 + 64 * pbk; u.nb1 = u.nb0 + 32; u.ocol0 = 512 + 64 * pbk; u.ocol1 = u.ocol0 + 32; u.pair = false; u.scale = (u.nb0 < 1536) ? QSCALE : 1.f; }
                sk_unit<SK_Z, 2, 8>(F, H, (const bf16*)(wl + LW_WIN), DM, u, Zb, ZW, nullptr, nullptr); } } SEAM(pb + 1);
        if (IN(pb + 2)) DUP(2) { REFRESH(); bf16* H = (bf16*)(F.ws + WS_H); bf16* Zb = (bf16*)(F.ws + WS_Z); bf16* MIX = (bf16*)(F.ws + WS_MIX); bf16* HID = (bf16*)(F.ws + WS_HID); bf16* CAPM = (bf16*)(F.ws + WS_CAPM); (void)H; (void)Zb; (void)MIX; (void)HID; (void)CAPM; const float* mod_l = modp(F, l); unsigned char* wl = lw(F, l); (void)mod_l; (void)wl; mixer_phase(F, l); } SEAM(pb + 2);
        if (IN(pb + 3)) DUP(3) { REFRESH(); bf16* H = (bf16*)(F.ws + WS_H); bf16* Zb = (bf16*)(F.ws + WS_Z); bf16* MIX = (bf16*)(F.ws + WS_MIX); bf16* HID = (bf16*)(F.ws + WS_HID); bf16* CAPM = (bf16*)(F.ws + WS_CAPM); (void)H; (void)Zb; (void)MIX; (void)HID; (void)CAPM; const float* mod_l = modp(F, l); unsigned char* wl = lw(F, l); (void)mod_l; (void)wl; pg8::Gemm g{CAPM, (const bf16*)(wl + LW_CPW), 2 * MT, 2 * DC, DC}; pg8::Mix2Order S{F.G, (int)blockIdx.x}; pg8::EpiMix2 E{MIX};
            pg8::gemm_phase<pg8::EpiMix2, pg8::Mix2Order, true, true>(F.lds, g, S, E);
            for (int su = F.vcu; su < 2 * 4 * 8; su += F.G) { const int which = su >> 5, rt = su & 3, cb = (su >> 2) & 7; SkUnit u; u.row0 = MP + 64 * rt; u.nb0 = 64 * cb; u.nb1 = u.nb0 + 32;
                u.ocol0 = which * 1024 + 64 * cb; u.ocol1 = u.ocol0 + 32; u.pair = false; u.scale = 1.f;
                sk_unit<SK_MIX2, 2, 4>(F, CAPM + (size_t)which * MT * DC, (const bf16*)(wl + LW_CPW) + (size_t)which * DC * DC, DC, u, MIX, MIXW, nullptr, nullptr); } } SEAM(pb + 3);
        if (IN(pb + 4)) DUP(4) { REFRESH(); bf16* H = (bf16*)(F.ws + WS_H); bf16* Zb = (bf16*)(F.ws + WS_Z); bf16* MIX = (bf16*)(F.ws + WS_MIX); bf16* HID = (bf16*)(F.ws + WS_HID); bf16* CAPM = (bf16*)(F.ws + WS_CAPM); (void)H; (void)Zb; (void)MIX; (void)HID; (void)CAPM; const float* mod_l = modp(F, l); unsigned char* wl = lw(F, l); (void)mod_l; (void)wl; pg8::Gemm g{MIX, (const bf16*)(wl + LW_WOUT), MP, DM, DM}; pg8::StaticOrder S; S.init(MP, DM, F.G, (int)blockIdx.x); pg8::EpiRes E{F.out, mod_l + 2 * DM};
            pg8::gemm_phase<pg8::EpiRes, pg8::StaticOrder, true, true>(F.lds, g, S, E);
            for (int su = F.vcu; su < 8 * 32; su += F.G) { const int rt = su & 7, cb = su >> 3; SkUnit u; u.row0 = MP + 32 * rt; u.nb0 = 64 * cb; u.nb1 = u.nb0 + 32; u.ocol0 = u.nb0; u.ocol1 = u.nb1; u.pair = false; u.scale = 1.f;
                sk_unit<SK_RES, 1, 8>(F, MIX, (const bf16*)(wl + LW_WOUT), DM, u, nullptr, 0, F.out, mod_l + 2 * DM); } } SEAM(pb + 4);
        if (IN(pb + 5)) DUP(5) { REFRESH(); bf16* H = (bf16*)(F.ws + WS_H); bf16* Zb = (bf16*)(F.ws + WS_Z); bf16* MIX = (bf16*)(F.ws + WS_MIX); bf16* HID = (bf16*)(F.ws + WS_HID); bf16* CAPM = (bf16*)(F.ws + WS_CAPM); (void)H; (void)Zb; (void)MIX; (void)HID; (void)CAPM; const float* mod_l = modp(F, l); unsigned char* wl = lw(F, l); (void)mod_l; (void)wl; norm_phase<false>(F, INP(I_N2) + l * DM, mod_l, 3, H); } SEAM(pb + 5);
        if (IN(pb + 6)) DUP(6) { REFRESH(); bf16* H = (bf16*)(F.ws + WS_H); bf16* Zb = (bf16*)(F.ws + WS_Z); bf16* MIX = (bf16*)(F.ws + WS_MIX); bf16* HID = (bf16*)(F.ws + WS_HID); bf16* CAPM = (bf16*)(F.ws + WS_CAPM); (void)H; (void)Zb; (void)MIX; (void)HID; (void)CAPM; const float* mod_l = modp(F, l); unsigned char* wl = lw(F, l); (void)mod_l; (void)wl; STAGGER(); pg8::Gemm g{H, (const bf16*)(wl + LW_WGU), MP, 2 * DFF, DM}; pg8::StaticOrder S; S.init(MP, 2 * DFF, F.G, (int)blockIdx.x); pg8::EpiSwi E{HID};
            pg8::gemm_phase<pg8::EpiSwi, pg8::StaticOrder, true, true>(F.lds, g, S, E);
            for (int su = F.vcu; su < 4 * 176; su += F.G) { const int rt = su & 3, cb = su >> 2, tt = cb >> 2, x0 = 32 * (cb & 3); SkUnit u; u.row0 = MP + 64 * rt; u.nb0 = 256 * tt + x0; u.nb1 = u.nb0 + 128;
                u.ocol0 = 128 * tt + x0; u.ocol1 = 0; u.pair = true; u.scale = 1.f;
                sk_unit<SK_SWI, 2, 8>(F, H, (const bf16*)(wl + LW_WGU), DM, u, HID, DFF, nullptr, nullptr); } } SEAM(pb + 6);
        if (IN(pb + 7)) DUP(7) { REFRESH(); bf16* H = (bf16*)(F.ws + WS_H); bf16* Zb = (bf16*)(F.ws + WS_Z); bf16* MIX = (bf16*)(F.ws + WS_MIX); bf16* HID = (bf16*)(F.ws + WS_HID); bf16* CAPM = (bf16*)(F.ws + WS_CAPM); (void)H; (void)Zb; (void)MIX; (void)HID; (void)CAPM; const float* mod_l = modp(F, l); unsigned char* wl = lw(F, l); (void)mod_l; (void)wl; pg8::Gemm g{HID, (const bf16*)(wl + LW_WD), MP, DM, DFF}; pg8::StaticOrder S; S.init(MP, DM, F.G, (int)blockIdx.x); pg8::EpiRes E{F.out, mod_l + 5 * DM};
            pg8::gemm_phase<pg8::EpiRes, pg8::StaticOrder, true, true>(F.lds, g, S, E);
            for (int su = F.vcu; su < 8 * 32; su += F.G) { const int rt = su & 7, cb = su >> 3; SkUnit u; u.row0 = MP + 32 * rt; u.nb0 = 64 * cb; u.nb1 = u.nb0 + 32; u.ocol0 = u.nb0; u.ocol1 = u.nb1; u.pair = false; u.scale = 1.f;
                sk_unit<SK_RES, 1, 11>(F, HID, (const bf16*)(wl + LW_WD), DFF, u, nullptr, 0, F.out, mod_l + 5 * DM); } } SEAM(pb + 7);
    }
    if (IN(N_PHASES - 1)) { REFRESH(); final_norm_phase(F); }
#undef IN
#undef SEAM
}

extern "C" void kernel_launch(void* const* d_in, const int* in_sizes, int n_in, void* d_out, int out_size, void* d_ws, size_t ws_size, hipStream_t stream) {
    static int grid = 0;
    if (grid == 0) {
        if (n_in != N_IN || in_sizes[0] != MP * DM || (size_t)out_size != O_END || ws_size < WS_END) {
            fprintf(stderr, "kernel_launch: unexpected shapes: n_in %d in0 %d out %d ws %zu (need %zu); nothing launched\n", n_in, n_in > 0 ? in_sizes[0] : -1, out_size, ws_size, (size_t)WS_END); grid = -1; return; }
        int dev = 0, cus = 0;
        if (hipGetDevice(&dev) != hipSuccess || hipDeviceGetAttribute(&cus, hipDeviceAttributeMultiprocessorCount, dev) != hipSuccess) { grid = -1; return; }
        if (hipFuncSetAttribute((const void*)enc_fwd, hipFuncAttributeMaxDynamicSharedMemorySize, LDS_BYTES) != hipSuccess) { fprintf(stderr, "kernel_launch: hipFuncSetAttribute failed\n"); grid = -1; return; }
        int per_cu = 0;
        if (hipOccupancyMaxActiveBlocksPerMultiprocessor(&per_cu, (const void*)enc_fwd, NWAVES * 64, LDS_BYTES) != hipSuccess || per_cu < 1)
            fprintf(stderr, "kernel_launch: note: occupancy query reports %d workgroups per CU\n", per_cu);
        (void)hipGetLastError();
        grid = cus;
    }
    if (grid < 0) return;
    if (hipMemsetAsync((char*)d_ws + WS_CTL, 0, CTL_ZERO_BYTES, stream) != hipSuccess) return;
    Args a{};
    for (int i = 0; i < N_IN; ++i) a.in[i] = (const float*)d_in[i];
    a.out = (float*)d_out; a.ws = (unsigned char*)d_ws; a.pad0 = 0; a.pad1 = 0;
#if MK_ONE_LAUNCH
    a.ph_lo = 0; a.ph_hi = N_PHASES;
    hipLaunchKernelGGL(enc_fwd, dim3(grid), dim3(NWAVES * 64), LDS_BYTES, stream, a);
#else
    for (int ph = 0; ph < N_PHASES; ++ph) { a.ph_lo = ph; a.ph_hi = ph + 1;
        hipLaunchKernelGGL(enc_fwd, dim3(grid), dim3(NWAVES * 64), LDS_BYTES, stream, a); }
#endif
}
```

```cpp
#include <hip/hip_runtime.h>
#include <cstdio>
#include <cstdint>
#include <utility>

#ifndef MK_ONE_LAUNCH
#define MK_ONE_LAUNCH 1
#endif
#ifndef PROBE_DUP
#define PROBE_DUP 0
#endif
#ifndef PROBE_DRY
#define PROBE_DRY 0
#endif
#ifndef PROBE_MIX
#define PROBE_MIX 0
#endif
#ifndef PROBE_EPI2
#define PROBE_EPI2 0
#endif
#ifndef STAGGER_TICKS
#define STAGGER_TICKS 0
#endif

constexpr int DM = 2048, SEQ = 8192, NBP = 4, MP = NBP * SEQ, NBS = 8, TS = 32, MS = NBS * TS, MT = MP + MS, NPANEL = MT / 256;
constexpr int DIN = 4096, DFF = 5632, DC = 512, NL = 4, NMOD = 6 * DM, NBT = NBP + NBS;
constexpr int ZW = 3584, ZU = 0, ZQ = 512, ZK = 1024, ZV = 1536, ZP = 2048, ZSU = 2560, ZSV = 3072;
constexpr int MIXW = 2048, MIX_A = 0, MIX_B = 512, MIX_C = 1024, MIX_D = 1536;
constexpr float EPS = 1e-6f, LOG2E = 1.4426950408889634f, QSCALE = 0.125f * LOG2E;
constexpr int KSPLIT = 16;
constexpr size_t O_YP = 0, O_YS = O_YP + (size_t)MP * DM, O_CONVP = O_YS + (size_t)MS * DM, O_CONVS = O_CONVP + (size_t)NL * NBP * 30 * DC,
    O_KP = O_CONVS + (size_t)NL * NBS * 30 * DC, O_VP = O_KP + (size_t)NL * NBP * 512 * 512, O_KS = O_VP + (size_t)NL * NBP * 512 * 512,
    O_VS = O_KS + (size_t)NL * NBS * TS * 512, O_POOLP = O_VS + (size_t)NL * NBS * TS * 512, O_POOLS = O_POOLP + (size_t)NL * NBP * 15 * DC,
    O_SGV = O_POOLS + (size_t)NL * NBS * 15 * DC, O_END = O_SGV + (size_t)NL * NBS * TS * DC;
static_assert(O_END == 78700544, "output size");
enum { I_XP = 0, I_XS, I_CP, I_CS, I_CCONV, I_CK, I_CV, I_CPOOL, I_ADAW, I_ADAB, I_N1, I_N2, I_WIN, I_CONVW, I_CONVB, I_GNG, I_GNB, I_CPW, I_RELB,
       I_POOLW, I_POOLS, I_SGG, I_SGB, I_SGW, I_SGBIAS, I_WOUT, I_WG, I_WU, I_WD, I_FING, N_IN };
static_assert(N_IN == 30, "30 inputs");

constexpr size_t MiB = 1u << 20;
constexpr size_t WS_CTL = 0, CTL_ZERO_BYTES = 1 * MiB;
constexpr size_t WS_MOD = 1 * MiB;
constexpr size_t WS_MODP = 4 * MiB;
constexpr size_t WS_W = 40 * MiB;
constexpr size_t LW_WIN = 0, LW_WOUT = 16 * MiB, LW_WGU = 24 * MiB, LW_WD = 68 * MiB, LW_CPW = 90 * MiB, LW_PWD = LW_CPW + 512 * 1024, LW_SGW = 91 * MiB, LW = 91 * MiB + 256 * 1024;
constexpr size_t WS_H = WS_W + NL * LW;
constexpr size_t WS_Z = WS_H + (size_t)MT * DM * 2;
constexpr size_t WS_MIX = WS_Z + (size_t)MT * ZW * 2;
constexpr size_t WS_HID = WS_Z;
constexpr size_t WS_CAPM = WS_MIX + (size_t)MT * MIXW * 2;
constexpr size_t WS_END = WS_CAPM + (size_t)2 * MT * DC * 2;
static_assert(WS_HID + (size_t)MT * DFF * 2 <= WS_CAPM, "HID overlay");
static_assert((size_t)NL * 12 * NMOD * 4 <= 3 * MiB && (size_t)KSPLIT * NL * 12 * NMOD * 4 <= 36 * MiB, "mod buffers");
constexpr int CW_BAR = 4096;

constexpr int RING_BYTES = 131072;
constexpr int LDSCTL_OFF = RING_BYTES, MISC_OFF = LDSCTL_OFF + 320;
constexpr int LDS_BYTES = 147456;
constexpr int NWAVES = 8;

#define GAS __attribute__((address_space(1)))
#define LAS __attribute__((address_space(3)))
typedef unsigned short bf16;
typedef unsigned v4u __attribute__((ext_vector_type(4)));
typedef unsigned v2u __attribute__((ext_vector_type(2)));
typedef float f32x4 __attribute__((ext_vector_type(4)));
typedef float f32x2 __attribute__((ext_vector_type(2)));
typedef float f32x16 __attribute__((ext_vector_type(16)));
typedef short bf16x8 __attribute__((ext_vector_type(8)));
typedef __bf16 bf16x2_t __attribute__((ext_vector_type(2)));
typedef GAS unsigned gu32;
#define RLX_AGENT __ATOMIC_RELAXED, __HIP_MEMORY_SCOPE_AGENT
#define LDS_WAIT() asm volatile("s_waitcnt lgkmcnt(0)" ::: "memory")
#define VM_WAIT() asm volatile("s_waitcnt vmcnt(0)" ::: "memory")

__device__ __forceinline__ unsigned pk2(float lo, float hi) { f32x2 v = {lo, hi}; bf16x2_t b = __builtin_convertvector(v, bf16x2_t); return __builtin_bit_cast(unsigned, b); }
__device__ __forceinline__ float bflo(unsigned u) { return __uint_as_float(u << 16); }
__device__ __forceinline__ float bfhi(unsigned u) { return __uint_as_float(u & 0xffff0000u); }
__device__ __forceinline__ float bf2f(bf16 h) { return __uint_as_float((unsigned)h << 16); }
__device__ __forceinline__ float fast_exp2(float x) { return __builtin_amdgcn_exp2f(x); }
__device__ __forceinline__ float fast_rcp(float x) { return __builtin_amdgcn_rcpf(x); }
__device__ __forceinline__ float sigmoidf_(float x) { return fast_rcp(1.0f + fast_exp2(-x * LOG2E)); }
__device__ __forceinline__ float siluf_(float x) { return x * sigmoidf_(x); }
template <int CTRL> __device__ __forceinline__ float dpp_f(float v) { return __int_as_float(__builtin_amdgcn_update_dpp(0, __float_as_int(v), CTRL, 0xF, 0xF, true)); }
__device__ __forceinline__ float row16_sum(float v) { v += dpp_f<0xB1>(v); v += dpp_f<0x4E>(v); v += dpp_f<0x141>(v); v += dpp_f<0x140>(v); return v; }
__device__ __forceinline__ float half32_sum(float v) { v = row16_sum(v); v += __int_as_float(__builtin_amdgcn_ds_swizzle(__float_as_int(v), 0x401F)); return v; }
__device__ __forceinline__ float wave_sum(float v) { v = half32_sum(v);
    return __int_as_float(__builtin_amdgcn_readlane(__float_as_int(v), 0)) + __int_as_float(__builtin_amdgcn_readlane(__float_as_int(v), 32)); }
__device__ __forceinline__ int batch_of_row(int row) { return row < MP ? (row >> 13) : NBP + ((row - MP) >> 5); }

namespace pg8 {
#define PG8_LAS __attribute__((address_space(3)))
typedef unsigned short bf16_t;
typedef short bf16x8 __attribute__((ext_vector_type(8)));
typedef float f32x4 __attribute__((ext_vector_type(4)));
typedef unsigned u32x4 __attribute__((ext_vector_type(4)));
constexpr int BM = 256, BK = 64, HALF = 128, HTB = HALF * BK * 2  , STAGE_BYTES = 8 * HTB, NXCD = 8, WGM = 8;

__host__ __device__ __forceinline__ int lds_byte(int r, int c) { const int st = (r >> 4) * 2 + (c >> 5), rr = r & 15, cc = c & 31, ob = rr * 64 + cc * 2; return st * 1024 + (ob ^ (((ob >> 9) & 1) << 5)); }
__host__ __device__ __forceinline__ void stage_rc(int b, int& R, int& C) { const int st = b / 1024, sb = b % 1024, swz = sb ^ (((sb >> 9) & 1) << 5); R = (st >> 1) * 16 + swz / 64; C = (st & 1) * 32 + (swz % 64) / 2; }
__host__ __device__ __forceinline__ int perm32(int rho) { const int n = rho >> 4, i = rho & 15; return 8 * (i >> 2) + 4 * n + (i & 3); }

struct Unit { int pm, pn; };
struct Gemm { const bf16_t* A; const bf16_t* Bt; int M, N, K; };

struct StaticOrder {
    int nM, nN, nwg, G, c;
    __host__ __device__ void init(int M, int N, int G_, int c_) { nM = M / BM; nN = N / BM; nwg = nM * nN; G = G_; c = c_; }
    __host__ __device__ bool next(int i, Unit& u) const {
        const long L = (long)i * G + c; if (L >= nwg) return false;
        int wgid = (int)L; { const int q = nwg / NXCD, r = nwg % NXCD, xcd = wgid % NXCD, off = wgid / NXCD; wgid = (xcd < r ? xcd * (q + 1) : r * (q + 1) + (xcd - r) * q) + off; }
        const int nig = WGM * nN, gid = wgid / nig, fm = gid * WGM, gsz = (nM - fm) < WGM ? (nM - fm) : WGM;
        u.pm = fm + ((wgid % nig) % gsz); u.pn = (wgid % nig) / gsz; return true;
    }
    __device__ __forceinline__ void a_ready(const Unit&) const {}
    __device__ __forceinline__ void done(const Unit&) const {}
};
__device__ __forceinline__ unsigned cvt_pk_bf16(float lo, float hi) { return ::pk2(lo, hi); }
struct EpiZ {
    static constexpr bool PERM = true, AFTER_DRAIN = false;
    bf16_t* Z; int dry;
    __device__ __forceinline__ void operator()(const f32x4 (&acc)[2][2][4][2], const Unit& u, int wr, int wc, int fr, int fq) const {
        const int row0 = u.pm * BM + wr * 64 + fr;
        if (dry) return;
        if (u.pn < 4) {
            const int col0 = 128 * u.pn + wc * 32 + 8 * fq;
#pragma unroll
            for (int ai = 0; ai < 2; ++ai)
#pragma unroll
                for (int m = 0; m < 4; ++m) { bf16_t* rowp = Z + (size_t)(row0 + ai * HALF + m * 16) * ::ZW + col0;
                    const f32x4 a0 = acc[ai][0][m][0], a1 = acc[ai][0][m][1], g0 = acc[ai][1][m][0], g1 = acc[ai][1][m][1];
                    u32x4 w; w.x = cvt_pk_bf16(a0[0] * ::sigmoidf_(g0[0]), a0[1] * ::sigmoidf_(g0[1])); w.y = cvt_pk_bf16(a0[2] * ::sigmoidf_(g0[2]), a0[3] * ::sigmoidf_(g0[3]));
                    w.z = cvt_pk_bf16(a1[0] * ::sigmoidf_(g1[0]), a1[1] * ::sigmoidf_(g1[1])); w.w = cvt_pk_bf16(a1[2] * ::sigmoidf_(g1[2]), a1[3] * ::sigmoidf_(g1[3]));
                    *(u32x4*)rowp = w; }
        } else {
            const float sc = (u.pn < 6) ? ::QSCALE : 1.0f;
            const int col0 = 512 + 256 * (u.pn - 4) + wc * 32 + 8 * fq;
#pragma unroll
            for (int ai = 0; ai < 2; ++ai)
#pragma unroll
                for (int m = 0; m < 4; ++m) { bf16_t* rowp = Z + (size_t)(row0 + ai * HALF + m * 16) * ::ZW + col0;
#pragma unroll
                    for (int bj = 0; bj < 2; ++bj) { const f32x4 v0 = acc[ai][bj][m][0] * sc, v1 = acc[ai][bj][m][1] * sc;
                        u32x4 w; w.x = cvt_pk_bf16(v0[0], v0[1]); w.y = cvt_pk_bf16(v0[2], v0[3]); w.z = cvt_pk_bf16(v1[0], v1[1]); w.w = cvt_pk_bf16(v1[2], v1[3]);
                        *(u32x4*)(rowp + bj * HALF) = w; } }
        }
    }
};
struct EpiMix2 {
    static constexpr bool PERM = true, AFTER_DRAIN = false;
    bf16_t* MIX;
    __device__ __forceinline__ void operator()(const f32x4 (&acc)[2][2][4][2], const Unit& u, int wr, int wc, int fr, int fq) const {
        const int which = u.pn >> 1, pm = u.pm - which * ::NPANEL;
        const int row0 = pm * BM + wr * 64 + fr, col0 = which * 1024 + (u.pn & 1) * 256 + wc * 32 + 8 * fq;
#pragma unroll
        for (int ai = 0; ai < 2; ++ai)
#pragma unroll
            for (int m = 0; m < 4; ++m) { bf16_t* rowp = MIX + (size_t)(row0 + ai * HALF + m * 16) * ::MIXW + col0;
#pragma unroll
                for (int bj = 0; bj < 2; ++bj) { const f32x4 v0 = acc[ai][bj][m][0], v1 = acc[ai][bj][m][1];
                    u32x4 w; w.x = cvt_pk_bf16(v0[0], v0[1]); w.y = cvt_pk_bf16(v0[2], v0[3]); w.z = cvt_pk_bf16(v1[0], v1[1]); w.w = cvt_pk_bf16(v1[2], v1[3]);
                    *(u32x4*)(rowp + bj * HALF) = w; } }
    }
};
struct EpiRes {
    static constexpr bool PERM = false, AFTER_DRAIN = false;
    float* X; const float* gate;
    __device__ __forceinline__ void operator()(const f32x4 (&acc)[2][2][4][2], const Unit& u, int wr, int wc, int fr, int fq) const {
        const int col0 = u.pn * BM + wc * 32 + 4 * fq;
#pragma unroll
        for (int ai = 0; ai < 2; ++ai)
#pragma unroll
            for (int m = 0; m < 4; ++m) { const int row = u.pm * BM + ai * HALF + wr * 64 + m * 16 + fr;
                const float* gp = gate + (size_t)::batch_of_row(row) * ::NMOD + col0; float* xp = X + (size_t)row * ::DM + col0;
#pragma unroll
                for (int bj = 0; bj < 2; ++bj)
#pragma unroll
                    for (int n = 0; n < 2; ++n) { const f32x4 g = *(const f32x4*)(gp + bj * HALF + n * 16); f32x4 x = *(const f32x4*)(xp + bj * HALF + n * 16);
                        x = x + g * acc[ai][bj][m][n]; *(f32x4*)(xp + bj * HALF + n * 16) = x; } }
    }
};
struct EpiSwi {
    static constexpr bool PERM = true, AFTER_DRAIN = false;
    bf16_t* HID;
    __device__ __forceinline__ void operator()(const f32x4 (&acc)[2][2][4][2], const Unit& u, int wr, int wc, int fr, int fq) const {
        const int row0 = u.pm * BM + wr * 64 + fr, col0 = 128 * u.pn + wc * 32 + 8 * fq;
#pragma unroll
        for (int ai = 0; ai < 2; ++ai)
#pragma unroll
            for (int m = 0; m < 4; ++m) { bf16_t* rowp = HID + (size_t)(row0 + ai * HALF + m * 16) * ::DFF + col0;
                const f32x4 g0 = acc[ai][0][m][0], g1 = acc[ai][0][m][1], u0 = acc[ai][1][m][0], u1 = acc[ai][1][m][1];
                u32x4 w; w.x = cvt_pk_bf16(::siluf_(g0[0]) * u0[0], ::siluf_(g0[1]) * u0[1]); w.y = cvt_pk_bf16(::siluf_(g0[2]) * u0[2], ::siluf_(g0[3]) * u0[3]);
                w.z = cvt_pk_bf16(::siluf_(g1[0]) * u1[0], ::siluf_(g1[1]) * u1[1]); w.w = cvt_pk_bf16(::siluf_(g1[2]) * u1[2], ::siluf_(g1[3]) * u1[3]);
                *(u32x4*)rowp = w; }
    }
};
struct Mix2Order {
    int G, c;
    __device__ __forceinline__ bool next(int i, Unit& u) const {
        const int L = i * G + c; if (L >= 4 * (::MP / 256)) return false;
        const int which = L / (2 * (::MP / 256)), rem = L % (2 * (::MP / 256));
        u.pm = which * ::NPANEL + (rem >> 1); u.pn = which * 2 + (rem & 1); return true;
    }
    __device__ __forceinline__ void a_ready(const Unit&) const {}
    __device__ __forceinline__ void done(const Unit&) const {}
};

template <class Epi, class Sched, bool ALIGN_EPI = false, bool SP2 = false>
__device__ __forceinline__ void gemm_phase(PG8_LAS unsigned char* lds, const Gemm g, const Sched& S, const Epi& E) {
    int tid_ = threadIdx.x; asm volatile("" : "+v"(tid_));
    const int tid = tid_, wid = __builtin_amdgcn_readfirstlane(tid >> 6), lane = tid & 63, wr = wid >> 2, wc = wid & 3, fr = lane & 15, fq = lane >> 4;
    const int K = g.K, nt = K / BK;
    unsigned voffA[2], voffB[2];
#pragma unroll
    for (int i = 0; i < 2; ++i) { int R, C; stage_rc(tid * 16 + i * 8192, R, C); const int Rb = Epi::PERM ? ((R & ~31) + perm32(R & 31)) : R;
        voffA[i] = (unsigned)(R * K + C) * 2u; voffB[i] = (unsigned)(Rb * K + C) * 2u; }
    const size_t kstep = (size_t)(BK * 2);
    const size_t hstep = (size_t)HALF * K * 2;
    const size_t tstep = 2 * hstep;
    const unsigned ldsw = (unsigned)wid * 1024u;
    const int aoff = lds_byte(wr * 64 + fr, fq * 8), boff = lds_byte(wc * 32 + fr, fq * 8);
#define PG8_SA(b, h) (((b) * 2 + (h)) * HTB)
#define PG8_SB(b, h) ((4 + (b) * 2 + (h)) * HTB)
#define PG8_STAGE(bufoff, gbase, voff) do { _Pragma("unroll") for (int _i = 0; _i < 2; ++_i) \
        __builtin_amdgcn_global_load_lds((const unsigned*)((const char*)(gbase) + (voff)[_i]), (PG8_LAS unsigned*)(lds + (bufoff) + ldsw + _i * 8192), 16, 0, 0); } while (0)
#define PG8_LDA(dst, b, h) do { _Pragma("unroll") for (int m = 0; m < 4; ++m) _Pragma("unroll") for (int k = 0; k < 2; ++k) dst[m][k] = *(const PG8_LAS bf16x8*)(lds + PG8_SA(b, h) + aoff + m * 2048 + k * 1024); } while (0)
#define PG8_LDB(dst, b, h) do { _Pragma("unroll") for (int n = 0; n < 2; ++n) _Pragma("unroll") for (int k = 0; k < 2; ++k) dst[n][k] = *(const PG8_LAS bf16x8*)(lds + PG8_SB(b, h) + boff + n * 2048 + k * 1024); } while (0)
#define PG8_MMA(ai, bj, At, Bt) do { __builtin_amdgcn_s_setprio(1); _Pragma("unroll") for (int m = 0; m < 4; ++m) _Pragma("unroll") for (int n = 0; n < 2; ++n) _Pragma("unroll") for (int k = 0; k < 2; ++k) \
        acc[ai][bj][m][n] = __builtin_amdgcn_mfma_f32_16x16x32_bf16(Bt[n][k], At[m][k], acc[ai][bj][m][n], 0, 0, 0); __builtin_amdgcn_s_setprio(0); } while (0)
#define PG8_WAIT_V(n) asm volatile("s_waitcnt vmcnt(" #n ")" ::: "memory")
#define PG8_WAIT_L(n) asm volatile("s_waitcnt lgkmcnt(" #n ")" ::: "memory")
#define PG8_BAR __builtin_amdgcn_s_barrier()
#define PG8_SCHED __builtin_amdgcn_sched_barrier(0)
    Unit cur, nxt; int ui = 0;
    if (!S.next(0, cur)) return;
    f32x4 acc[2][2][4][2];
#pragma unroll
    for (int a = 0; a < 2; ++a)
#pragma unroll
        for (int b = 0; b < 2; ++b)
#pragma unroll
            for (int m = 0; m < 4; ++m)
#pragma unroll
                for (int n = 0; n < 2; ++n) acc[a][b][m][n] = (f32x4){0.f, 0.f, 0.f, 0.f};
    bf16x8 At[4][2], B0[2][2], B1[2][2];
    const char* cA = (const char*)g.A + (size_t)cur.pm * tstep; const char* cB = (const char*)g.Bt + (size_t)cur.pn * tstep;
    S.a_ready(cur);
    if constexpr (SP2) {
        PG8_STAGE(PG8_SB(0, 0), cB, voffB); PG8_STAGE(PG8_SB(0, 1), cB + hstep, voffB); PG8_STAGE(PG8_SA(0, 0), cA, voffA); PG8_STAGE(PG8_SA(0, 1), cA + hstep, voffA);
        if (wr == 1) PG8_BAR;
        PG8_WAIT_V(2); PG8_BAR;
        PG8_STAGE(PG8_SB(1, 0), cB + kstep, voffB); PG8_STAGE(PG8_SA(1, 0), cA + kstep, voffA); PG8_STAGE(PG8_SB(1, 1), cB + hstep + kstep, voffB);
        PG8_WAIT_V(6); PG8_BAR;
    } else {
        PG8_STAGE(PG8_SB(0, 0), cB, voffB); PG8_STAGE(PG8_SA(0, 0), cA, voffA); PG8_STAGE(PG8_SB(0, 1), cB + hstep, voffB); PG8_STAGE(PG8_SA(0, 1), cA + hstep, voffA);
        if (wr == 1) PG8_BAR;
        PG8_WAIT_V(4); PG8_BAR;
        PG8_STAGE(PG8_SB(1, 0), cB + kstep, voffB); PG8_STAGE(PG8_SA(1, 0), cA + kstep, voffA); PG8_STAGE(PG8_SB(1, 1), cB + hstep + kstep, voffB);
        PG8_WAIT_V(6); PG8_BAR;
    }
    for (;;) {
        const bool has_next = S.next(ui + 1, nxt);
        const char* nA = has_next ? (const char*)g.A + (size_t)nxt.pm * tstep : cA; const char* nB = has_next ? (const char*)g.Bt + (size_t)nxt.pn * tstep : cB;
        for (int t = 0; t < nt; t += 2) {
            const bool last = (t == nt - 2);
            const char* a1 = cA + (size_t)(t + 1) * kstep;
            const char* a2 = last ? nA : cA + (size_t)(t + 2) * kstep; const char* b2 = last ? nB : cB + (size_t)(t + 2) * kstep;
            const char* a3 = a2 + kstep; const char* b3 = b2 + kstep;
            if (last && has_next) S.a_ready(nxt);
            if constexpr (SP2) {
            PG8_LDB(B0, 0, 0); PG8_LDB(B1, 0, 1); PG8_SCHED; PG8_LDA(At, 0, 0); PG8_STAGE(PG8_SA(1, 1), a1 + hstep, voffA);
            PG8_WAIT_V(8); PG8_WAIT_L(0); PG8_BAR; PG8_MMA(0, 0, At, B0); PG8_MMA(0, 1, At, B1); PG8_BAR; PG8_SCHED;
            PG8_LDA(At, 0, 1); PG8_STAGE(PG8_SB(0, 0), b2, voffB); PG8_STAGE(PG8_SB(0, 1), b2 + hstep, voffB); PG8_STAGE(PG8_SA(0, 0), a2, voffA);
            PG8_WAIT_V(8); PG8_WAIT_L(0); PG8_BAR; PG8_MMA(1, 0, At, B0); PG8_MMA(1, 1, At, B1); PG8_BAR; PG8_SCHED;
            PG8_LDB(B0, 1, 0); PG8_LDB(B1, 1, 1); PG8_SCHED; PG8_LDA(At, 1, 0); PG8_STAGE(PG8_SA(0, 1), a2 + hstep, voffA);
            PG8_WAIT_V(8); PG8_WAIT_L(0); PG8_BAR; PG8_MMA(0, 0, At, B0); PG8_MMA(0, 1, At, B1); PG8_BAR; PG8_SCHED;
            PG8_LDA(At, 1, 1); PG8_STAGE(PG8_SB(1, 0), b3, voffB); PG8_STAGE(PG8_SB(1, 1), b3 + hstep, voffB); PG8_STAGE(PG8_SA(1, 0), a3, voffA);
            PG8_WAIT_V(8); PG8_WAIT_L(0); PG8_BAR; PG8_MMA(1, 0, At, B0); PG8_MMA(1, 1, At, B1); PG8_BAR; PG8_SCHED;
            } else {
            PG8_LDB(B0, 0, 0); PG8_SCHED; PG8_LDA(At, 0, 0); PG8_STAGE(PG8_SA(1, 1), a1 + hstep, voffA);
            PG8_WAIT_L(8); PG8_BAR; PG8_WAIT_L(0); PG8_MMA(0, 0, At, B0); PG8_BAR; PG8_SCHED;
            PG8_LDB(B1, 0, 1); PG8_STAGE(PG8_SB(0, 0), b2, voffB);
            PG8_BAR; PG8_WAIT_L(0); PG8_MMA(0, 1, At, B1); PG8_BAR;
            PG8_LDA(At, 0, 1); PG8_STAGE(PG8_SA(0, 0), a2, voffA);
            PG8_BAR; PG8_WAIT_L(0); PG8_MMA(1, 0, At, B0); PG8_BAR; PG8_SCHED;
            PG8_STAGE(PG8_SB(0, 1), b2 + hstep, voffB);
            PG8_WAIT_V(6); PG8_BAR; PG8_MMA(1, 1, At, B1); PG8_BAR;
            PG8_LDB(B0, 1, 0); PG8_SCHED; PG8_LDA(At, 1, 0); PG8_STAGE(PG8_SA(0, 1), a2 + hstep, voffA);
            PG8_WAIT_L(8); PG8_BAR; PG8_WAIT_L(0); PG8_MMA(0, 0, At, B0); PG8_BAR; PG8_SCHED;
            PG8_LDB(B1, 1, 1); PG8_STAGE(PG8_SB(1, 0), b3, voffB);
            PG8_BAR; PG8_WAIT_L(0); PG8_MMA(0, 1, At, B1); PG8_BAR;
            PG8_LDA(At, 1, 1); PG8_STAGE(PG8_SA(1, 0), a3, voffA);
            PG8_BAR; PG8_WAIT_L(0); PG8_MMA(1, 0, At, B0); PG8_BAR; PG8_SCHED;
            PG8_STAGE(PG8_SB(1, 1), b3 + hstep, voffB);
            PG8_WAIT_V(6); PG8_BAR; PG8_MMA(1, 1, At, B1); PG8_BAR;
            }
        }
        if constexpr (ALIGN_EPI) { if (wr == 0) PG8_BAR; }
        if constexpr (!Epi::AFTER_DRAIN) { E(acc, cur, wr, wc, fr, fq);
#if PROBE_EPI2
            if constexpr (Epi::PERM) { asm volatile("" ::: "memory"); E(acc, cur, wr, wc, fr, fq); }
#endif
            S.done(cur); }
        if (!has_next) break;
#pragma unroll
        for (int a = 0; a < 2; ++a)
#pragma unroll
            for (int b = 0; b < 2; ++b)
#pragma unroll
                for (int m = 0; m < 4; ++m)
#pragma unroll
                    for (int n = 0; n < 2; ++n) acc[a][b][m][n] = (f32x4){0.f, 0.f, 0.f, 0.f};
        cur = nxt; cA = nA; cB = nB; ++ui;
        if constexpr (ALIGN_EPI) { if (wr == 1) PG8_BAR; }
    }
    PG8_WAIT_V(0);
    if constexpr (!ALIGN_EPI) { if (wr == 0) PG8_BAR; }
    PG8_BAR;
    if constexpr (Epi::AFTER_DRAIN) { E.fused(acc, cur, wr, wc, fr, fq, lds, wid, lane); S.done(cur); }
#undef PG8_SA
#undef PG8_SB
#undef PG8_STAGE
#undef PG8_LDA
#undef PG8_LDB
#undef PG8_MMA
#undef PG8_WAIT_V
#undef PG8_WAIT_L
#undef PG8_BAR
#undef PG8_SCHED
}
}
#define XB_TMO      128
#define XB_XCNT(j)  (256  + 64 * (j))
#define XB_XSUB(j)  (1280 + 64 * (j))
#define XB_XGEN(j)  (2304 + 64 * (j))
#define XB_TOP      3328
#define XB_TOPGEN   3392
#define XCD_BAR_WORDS 3456
#define XB_SPIN_CAP (1u << 18)

__device__ __forceinline__ unsigned xb_ld(unsigned* p)              { return __hip_atomic_load(p, __ATOMIC_RELAXED, __HIP_MEMORY_SCOPE_AGENT); }
__device__ __forceinline__ unsigned xb_add(unsigned* p, unsigned v) { return __hip_atomic_fetch_add(p, v, __ATOMIC_RELAXED, __HIP_MEMORY_SCOPE_AGENT); }
__device__ __forceinline__ unsigned xb_xcc_id() { return (unsigned)__builtin_amdgcn_s_getreg((3 << 11) | 20) & 0xFu; }
#define XB_SPIN(cond, bar) do { unsigned _sp = 0; while (cond) { __builtin_amdgcn_s_sleep(1); \
    if ((++_sp & 255u) == 0u) { if (xb_ld(&(bar)[XB_TMO])) break; if (_sp > XB_SPIN_CAP) { atomicAdd(&(bar)[XB_TMO], 1u); break; } } } } while (0)

struct XcdBarrier {
    unsigned* bar; unsigned x;
    volatile LAS unsigned* st;
};

__device__ __forceinline__ XcdBarrier xcd_barrier_post(unsigned* bar, volatile LAS unsigned* st) {
    XcdBarrier b; b.bar = bar; b.x = xb_xcc_id(); b.st = st;
    if (threadIdx.x == 0) (void)xb_add(&bar[XB_XCNT(b.x)], 1u);
    return b;
}
__device__ __forceinline__ void xcd_barrier_complete(unsigned* bar, unsigned x, unsigned& nloc, unsigned& nx) {
    const unsigned G = gridDim.x * gridDim.y * gridDim.z;
    unsigned sum, cnt, mine, sp = 0u;
    for (;;) {
        sum = 0u; cnt = 0u; mine = 0u;
#pragma unroll
        for (unsigned j = 0; j < 16; ++j) { const unsigned c = xb_ld(&bar[XB_XCNT(j)]); sum += c; cnt += (c > 0u) ? 1u : 0u; mine = (j == x) ? c : mine; }
        if (sum == G) break;
        __builtin_amdgcn_s_sleep(1);
        if ((++sp & 255u) == 0u) { if (xb_ld(&bar[XB_TMO])) break; if (sp > XB_SPIN_CAP) { atomicAdd(&bar[XB_TMO], 1u); break; } }
    }
    nloc = mine > 0u ? mine : 1u; nx = cnt > 0u ? cnt : 1u;
}

__device__ __forceinline__ void xcd_barrier(const XcdBarrier& b) {
    asm volatile("s_waitcnt vmcnt(0)" ::: "memory");
    __syncthreads();
    if (threadIdx.x == 0) {
        unsigned* bar = b.bar;
        __builtin_amdgcn_s_waitcnt(0);
        unsigned nloc = b.st[0], nx = b.st[1];
        if (nloc == 0u) { xcd_barrier_complete(bar, b.x, nloc, nx); b.st[0] = nloc; b.st[1] = nx; }
        const unsigned old = xb_add(&bar[XB_XSUB(b.x)], 1u);
        const unsigned gen = old / nloc;
        if (old + 1u == (gen + 1u) * nloc) {
            __builtin_amdgcn_fence(__ATOMIC_RELEASE, "agent");
            asm volatile("s_waitcnt vmcnt(0)" ::: "memory");
            const unsigned og = xb_add(&bar[XB_TOP], 1u);
            const unsigned tg = og / nx;
            if (og + 1u == (tg + 1u) * nx) xb_add(&bar[XB_TOPGEN], 1u);
            else XB_SPIN(xb_ld(&bar[XB_TOPGEN]) == tg, bar);
            __builtin_amdgcn_fence(__ATOMIC_ACQUIRE, "agent");
            xb_add(&bar[XB_XGEN(b.x)], 1u);
            asm volatile("s_waitcnt vmcnt(0)" ::: "memory");
        } else {
            XB_SPIN(xb_ld(&bar[XB_XGEN(b.x)]) == gen, bar);
            __builtin_amdgcn_fence(__ATOMIC_ACQUIRE, "agent");
            asm volatile("s_waitcnt vmcnt(0)" ::: "memory");
        }
    }
    __syncthreads();
}
struct Args { const float* in[N_IN]; float* out; unsigned char* ws; int ph_lo, ph_hi, pad0, pad1; };
static_assert(sizeof(Args) == (N_IN + 2) * 8 + 16, "Args has no padding");
struct DevArgs { const GAS float* in[N_IN]; GAS float* out; GAS unsigned char* ws; int ph_lo, ph_hi, pad0, pad1; };
static_assert(sizeof(DevArgs) == sizeof(Args), "DevArgs mirrors Args");
typedef const __attribute__((address_space(4))) DevArgs* KArgs;
#define INP(i) ((const float*)F.ka->in[i])
struct Frame {
    LAS unsigned char* lds;
    int tid, lane, wave, vcu, G;
    KArgs ka;
    float* out; unsigned char* ws;
};
__device__ __forceinline__ const float* modp(const Frame& F, int layer) { return (const float*)(F.ws + WS_MOD) + (size_t)layer * 12 * NMOD; }
__device__ __forceinline__ unsigned char* lw(const Frame& F, int layer) { return F.ws + WS_W + (size_t)layer * LW; }

__device__ __forceinline__ void transpose_item(const float* W, int K, int N, bf16* WT, int k0, int n0, int orow0, LAS float* scr, int lane) {
#pragma unroll 8
    for (int i = 0; i < 32; ++i) { const int kk = 2 * i + (lane >> 5); scr[kk * 33 + (lane & 31)] = W[(size_t)(k0 + kk) * N + n0 + (lane & 31)]; }
    LDS_WAIT(); asm volatile("" ::: "memory");
    const int c = lane & 7;
#pragma unroll
    for (int j = 0; j < 4; ++j) { const int n = (lane >> 3) + 8 * j; const LAS float* s = scr + (8 * c) * 33 + n;
        v4u o; o.x = pk2(s[0 * 33], s[1 * 33]); o.y = pk2(s[2 * 33], s[3 * 33]); o.z = pk2(s[4 * 33], s[5 * 33]); o.w = pk2(s[6 * 33], s[7 * 33]);
        *(GAS v4u*)(WT + (size_t)(orow0 + n) * K + k0 + 8 * c) = o; }
    LDS_WAIT(); asm volatile("" ::: "memory");
}
__device__ __forceinline__ void p0a_phase(Frame& F) {
    const int gw = F.vcu * NWAVES + F.wave, NGW = F.G * NWAVES, gt = F.vcu * (NWAVES * 64) + F.tid, NGT = F.G * NWAVES * 64;
    {
        LAS float* sil = (LAS float*)F.lds;
        for (int i = F.tid; i < 12 * DM; i += NWAVES * 64) { const int b = i / DM, k = i % DM;
            const float c = b < NBP ? INP(I_CP)[b * DM + k] : INP(I_CS)[(b - NBP) * DM + k]; sil[k * 12 + b] = siluf_(c); }
        __syncthreads();
        constexpr int KC = DM / KSPLIT, NCB = NMOD / 256;
        float* part = (float*)(F.ws + WS_MODP);
        for (int it = gw; it < NL * KSPLIT * NCB; it += NGW) {
            const int l = it / (KSPLIT * NCB), ks = (it / NCB) % KSPLIT, cb = it % NCB, col = cb * 256 + 4 * F.lane;
            const GAS f32x4* wp = (const GAS f32x4*)(INP(I_ADAW) + ((size_t)l * DM + ks * KC) * NMOD + col);
            f32x4 acc[12];
#pragma unroll
            for (int b = 0; b < 12; ++b) acc[b] = (f32x4){0.f, 0.f, 0.f, 0.f};
#pragma unroll 4
            for (int k = 0; k < KC; ++k) { const f32x4 wv = wp[(size_t)k * (NMOD / 4)];
                const LAS f32x4* sp = (const LAS f32x4*)(sil + (ks * KC + k) * 12); const f32x4 s0 = sp[0], s1 = sp[1], s2 = sp[2];
                acc[0] += wv * s0[0]; acc[1] += wv * s0[1]; acc[2] += wv * s0[2]; acc[3] += wv * s0[3];
                acc[4] += wv * s1[0]; acc[5] += wv * s1[1]; acc[6] += wv * s1[2]; acc[7] += wv * s1[3];
                acc[8] += wv * s2[0]; acc[9] += wv * s2[1]; acc[10] += wv * s2[2]; acc[11] += wv * s2[3]; }
#pragma unroll
            for (int b = 0; b < 12; ++b) *(GAS f32x4*)(part + (((size_t)ks * NL + l) * 12 + b) * NMOD + col) = acc[b];
        }
        __syncthreads();
    }
    {
        LAS float* scr = (LAS float*)(F.lds + F.wave * 16384);
        constexpr int I_IN = (DM / 64) * (DIN / 32), I_OUT = (DM / 64) * (DM / 32), I_G = (DM / 64) * (DFF / 32), I_D = (DFF / 64) * (DM / 32), I_C = (DC / 64) * (DC / 32);
        constexpr int PER_L = I_IN + I_OUT + 2 * I_G + I_D + I_C;
        for (int it = gw; it < NL * PER_L; it += NGW) {
            const int l = it / PER_L; int r = it % PER_L; unsigned char* wl = lw(F, l);
            if (r < I_IN) { const int nblk = DIN / 32, k0 = 64 * (r / nblk), n0 = 32 * (r % nblk);
                int orow0 = n0; if (n0 < 512) orow0 = 256 * (n0 >> 7) + (n0 & 127); else if (n0 < 1024) orow0 = 256 * ((n0 - 512) >> 7) + 128 + (n0 & 127);
                transpose_item(INP(I_WIN) + (size_t)l * DM * DIN, DM, DIN, (bf16*)(wl + LW_WIN), k0, n0, orow0, scr, F.lane); continue; } r -= I_IN;
            if (r < I_OUT) { const int nblk = DM / 32, k0 = 64 * (r / nblk), n0 = 32 * (r % nblk);
                transpose_item(INP(I_WOUT) + (size_t)l * DM * DM, DM, DM, (bf16*)(wl + LW_WOUT), k0, n0, n0, scr, F.lane); continue; } r -= I_OUT;
            if (r < 2 * I_G) { const int up = r >= I_G; if (up) r -= I_G; const int nblk = DFF / 32, k0 = 64 * (r / nblk), n0 = 32 * (r % nblk);
                const int orow0 = 256 * (n0 >> 7) + 128 * up + (n0 & 127);
                transpose_item(INP(up ? I_WU : I_WG) + (size_t)l * DM * DFF, DM, DFF, (bf16*)(wl + LW_WGU), k0, n0, orow0, scr, F.lane); continue; } r -= 2 * I_G;
            if (r < I_D) { const int nblk = DM / 32, k0 = 64 * (r / nblk), n0 = 32 * (r % nblk);
                transpose_item(INP(I_WD) + (size_t)l * DFF * DM, DFF, DM, (bf16*)(wl + LW_WD), k0, n0, n0, scr, F.lane); continue; } r -= I_D;
            { const int nblk = DC / 32, k0 = 64 * (r / nblk), n0 = 32 * (r % nblk);
                transpose_item(INP(I_CPW) + (size_t)l * DC * DC, DC, DC, (bf16*)(wl + LW_CPW), k0, n0, n0, scr, F.lane); }
        }
        for (int i = gt; i < NL * DC * DC; i += NGT) { const int l = i / (DC * DC), n = (i / DC) % DC, k = i % DC; float v = 0.f;
            if ((n >> 7) == (k >> 7)) v = INP(I_POOLW)[(((size_t)l * 4 + (n >> 7)) * 128 + (k & 127)) * 128 + (n & 127)] * INP(I_POOLS)[l * DC + n];
            ((bf16*)(lw(F, l) + LW_PWD))[n * DC + k] = (bf16)(pk2(v, 0.f) & 0xffffu); }
        for (int i = gt; i < NL * 4 * 128 * 128; i += NGT) { const int l = i / 65536, r = i % 65536, ii = (r >> 7) & 127, jj = r & 127;
            const float v = (jj <= ii) ? INP(I_SGW)[i] : 0.f; ((bf16*)(lw(F, l) + LW_SGW))[r] = (bf16)(pk2(v, 0.f) & 0xffffu); }
    }
    __syncthreads();
}
__device__ __forceinline__ void p0b_phase(Frame& F) {
    const int gt = F.vcu * (NWAVES * 64) + F.tid, NGT = F.G * NWAVES * 64;
    const float* part = (const float*)(F.ws + WS_MODP); float* mod = (float*)(F.ws + WS_MOD);
    for (int i = gt; i < NL * 12 * NMOD; i += NGT) { const int l = i / (12 * NMOD), n = i % NMOD; float s = INP(I_ADAB)[l * NMOD + n];
#pragma unroll
        for (int ks = 0; ks < KSPLIT; ++ks) s += part[(size_t)ks * NL * 12 * NMOD + i];
        mod[i] = s; }
}
template <bool COPY>
__device__ __forceinline__ void norm_phase(Frame& F, const float* gain, const float* mod_l, int sh_idx, bf16* H) {
    const int gw = F.vcu * NWAVES + F.wave, NGW = F.G * NWAVES;
    float* X = F.out;
    for (int m = gw; m < MT; m += NGW) {
        const float* src = COPY ? (m < MP ? INP(I_XP) + (size_t)m * DM : INP(I_XS) + (size_t)(m - MP) * DM) : X + (size_t)m * DM;
        const GAS f32x4* xr = (const GAS f32x4*)src + F.lane;
        f32x4 v[8]; float s = 0.f;
#pragma unroll
        for (int j = 0; j < 8; ++j) { v[j] = xr[64 * j]; s += (v[j].x * v[j].x + v[j].y * v[j].y) + (v[j].z * v[j].z + v[j].w * v[j].w); }
        if (COPY) { GAS f32x4* xo = (GAS f32x4*)(X + (size_t)m * DM) + F.lane;
#pragma unroll
            for (int j = 0; j < 8; ++j) xo[64 * j] = v[j]; }
        const float rstd = 1.0f / sqrtf(wave_sum(s) * (1.0f / DM) + EPS);
        const float* mb = mod_l + (size_t)batch_of_row(m) * NMOD;
        const GAS f32x4* shp = (const GAS f32x4*)(mb + sh_idx * DM) + F.lane; const GAS f32x4* scp = (const GAS f32x4*)(mb + (sh_idx + 1) * DM) + F.lane;
        const GAS f32x4* gp = (const GAS f32x4*)gain + F.lane;
        GAS v2u* o8 = (GAS v2u*)(H + (size_t)m * DM) + F.lane;
#pragma unroll
        for (int j = 0; j < 8; ++j) { const f32x4 g = gp[64 * j], sc = scp[64 * j], sh = shp[64 * j];
            const f32x4 y = v[j] * rstd * g * (sc + 1.0f) + sh; v2u w; w.x = pk2(y.x, y.y); w.y = pk2(y.z, y.w); o8[64 * j] = w; }
    }
}
__device__ __forceinline__ void final_norm_phase(Frame& F) {
    const int gw = F.vcu * NWAVES + F.wave, NGW = F.G * NWAVES;
    for (int m = gw; m < MT; m += NGW) {
        GAS f32x4* xr = (GAS f32x4*)(F.out + (size_t)m * DM) + F.lane;
        f32x4 v[8]; float s = 0.f;
#pragma unroll
        for (int j = 0; j < 8; ++j) { v[j] = xr[64 * j]; s += (v[j].x * v[j].x + v[j].y * v[j].y) + (v[j].z * v[j].z + v[j].w * v[j].w); }
        const float rstd = 1.0f / sqrtf(wave_sum(s) * (1.0f / DM) + EPS);
        const GAS f32x4* gp = (const GAS f32x4*)INP(I_FING) + F.lane;
#pragma unroll
        for (int j = 0; j < 8; ++j) xr[64 * j] = v[j] * rstd * gp[64 * j];
    }
}

__device__ __forceinline__ int crow(int r, int hi) { return (r & 3) + 8 * (r >> 2) + 4 * hi; }
#define MFMA32(a, b, c) __builtin_amdgcn_mfma_f32_32x32x16_bf16((a), (b), (c), 0, 0, 0)
constexpr int AT_KP = 144, AT_VP = 192, AT_KB = 64 * AT_KP, AT_VB = 64 * AT_VP;
constexpr int AT_K0 = 0, AT_V0 = 2 * AT_KB, AT_BT = AT_V0 + 2 * AT_VB;
typedef short v4i16_t __attribute__((ext_vector_type(4)));
__device__ __forceinline__ v2u lds_tr_read(LAS unsigned char* p) { const v4i16_t r = __builtin_amdgcn_ds_read_tr16_b64_v4i16((LAS v4i16_t*)p); return __builtin_bit_cast(v2u, r); }
__device__ __forceinline__ float xhalf_max(float v) { auto rr = __builtin_amdgcn_permlane32_swap(__float_as_uint(v), __float_as_uint(v), false, false); return fmaxf(__uint_as_float(rr[0]), __uint_as_float(rr[1])); }
__device__ __forceinline__ float xhalf_sum(float v) { auto rr = __builtin_amdgcn_permlane32_swap(__float_as_uint(v), __float_as_uint(v), false, false); return __uint_as_float(rr[0]) + __uint_as_float(rr[1]); }
__device__ __forceinline__ void attn_unit(Frame& F, int layer, bool sample, int b, int h, int qg, const bf16* Z, bf16* MIX) {
    const int tid = F.tid, lane = F.lane, w = F.wave, l31 = lane & 31, hh = lane >> 5;
    LAS float* bt = (LAS float*)(F.lds + AT_BT);
    if (tid < 257) bt[tid] = INP(I_RELB)[((size_t)layer * 8 + h) * 257 + tid] * LOG2E;
    const bool wave_on = sample ? (w == 0) : true;
    const int qpos = sample ? l31 : 256 * qg + 32 * w + l31;
    const int qrow = sample ? MP + 32 * b + l31 : b * SEQ + qpos;
    bf16x8 qr[4];
#pragma unroll
    for (int d0 = 0; d0 < 4; ++d0) qr[d0] = *(const GAS bf16x8*)(Z + (size_t)qrow * ZW + ZQ + 64 * h + 16 * d0 + 8 * hh);
    f32x16 o0, o1;
#pragma unroll
    for (int r = 0; r < 16; ++r) { o0[r] = 0.f; o1[r] = 0.f; }
    float mrun = -1e30f, lrun = 0.f;
    const int ntile = sample ? 9 : 12, qc = 4 * qg + (w >> 1);
    const int jstart = sample ? 0 : (4 * qg >= 8 ? 0 : 8 - 4 * qg);
    const int sr = tid >> 3, sch = tid & 7;
    const float* ck = INP(I_CK) + ((size_t)layer * NBS + b) * 512 * 512; const float* cv = INP(I_CV) + ((size_t)layer * NBS + b) * 512 * 512;
    v4u kreg = (v4u){0u, 0u, 0u, 0u}, vreg = (v4u){0u, 0u, 0u, 0u};
#define AT_LOAD(j) do { \
        if (!sample) { const bf16* zr_ = Z + (size_t)(b * SEQ + 64 * (4 * qg - 8 + (j)) + sr) * ZW + 64 * h + 8 * sch; kreg = *(const GAS v4u*)(zr_ + ZK); vreg = *(const GAS v4u*)(zr_ + ZV); } \
        else if ((j) < 8) { const size_t o_ = ((size_t)(64 * (j) + sr) * 8 + h) * 64 + 8 * sch; \
                const f32x4 k0_ = *(const GAS f32x4*)(ck + o_), k1_ = *(const GAS f32x4*)(ck + o_ + 4), v0_ = *(const GAS f32x4*)(cv + o_), v1_ = *(const GAS f32x4*)(cv + o_ + 4); \
                kreg = (v4u){pk2(k0_.x, k0_.y), pk2(k0_.z, k0_.w), pk2(k1_.x, k1_.y), pk2(k1_.z, k1_.w)}; vreg = (v4u){pk2(v0_.x, v0_.y), pk2(v0_.z, v0_.w), pk2(v1_.x, v1_.y), pk2(v1_.z, v1_.w)}; } \
        else if (sr < 32) { const bf16* zr_ = Z + (size_t)(MP + 32 * b + sr) * ZW + 64 * h + 8 * sch; kreg = *(const GAS v4u*)(zr_ + ZK); vreg = *(const GAS v4u*)(zr_ + ZV); } \
        else { kreg = (v4u){0u, 0u, 0u, 0u}; vreg = (v4u){0u, 0u, 0u, 0u}; } } while (0)
#define AT_STORE(bf_) do { *(LAS v4u*)(F.lds + AT_K0 + (bf_) * AT_KB + sr * AT_KP + sch * 16) = kreg; *(LAS v4u*)(F.lds + AT_V0 + (bf_) * AT_VB + sr * AT_VP + sch * 16) = vreg; } while (0)
    AT_LOAD(jstart); AT_STORE(0);
    __syncthreads();
    const int tro = ((lane & 15) >> 2) * AT_VP + (16 * ((lane >> 4) & 1) + 4 * (lane & 3)) * 2 + 4 * hh * AT_VP;
    int buf = 0;
    for (int j = jstart; j < ntile; ++j) {
        const int kc = 4 * qg - 8 + j;
        const bool more = j + 1 < ntile;
        if (more) AT_LOAD(j + 1);
        const bool active = sample ? (w == 0) : (kc >= qc - 8 && kc <= qc);
        if (active) {
            LAS unsigned char* Ks = F.lds + AT_K0 + buf * AT_KB; LAS unsigned char* Vs = F.lds + AT_V0 + buf * AT_VB + tro;
            f32x16 p0, p1;
#pragma unroll
            for (int r = 0; r < 16; ++r) { p0[r] = 0.f; p1[r] = 0.f; }
#pragma unroll
            for (int d0 = 0; d0 < 4; ++d0) {
                const bf16x8 a0 = *(const LAS bf16x8*)(Ks + l31 * AT_KP + (16 * d0 + 8 * hh) * 2);
                const bf16x8 a1 = *(const LAS bf16x8*)(Ks + (32 + l31) * AT_KP + (16 * d0 + 8 * hh) * 2);
                p0 = MFMA32(a0, qr[d0], p0); p1 = MFMA32(a1, qr[d0], p1);
            }
            const int kbase = sample ? 64 * j - 512 : 64 * kc;
            const int relb = kbase - qpos;
            const int qmin = sample ? 0 : 256 * qg + 32 * w;
            float boff = 0.f;
            if (kbase + 63 - qmin <= -128) boff = bt[0];
            else {
#pragma unroll
                for (int r = 0; r < 16; ++r) { const int kv = crow(r, hh); int i0 = relb + kv, i1 = i0 + 32;
                    i0 = (i0 < -128 ? -128 : (i0 > 128 ? 128 : i0)) + 128; i1 = (i1 < -128 ? -128 : (i1 > 128 ? 128 : i1)) + 128;
                    p0[r] += bt[i0]; p1[r] += bt[i1]; }
            }
            if (sample && j == 8) {
#pragma unroll
                for (int r = 0; r < 16; ++r) p1[r] = -1e30f;
            }
            float mx = p0[0];
#pragma unroll
            for (int r = 1; r < 16; ++r) mx = fmaxf(mx, p0[r]);
#pragma unroll
            for (int r = 0; r < 16; ++r) mx = fmaxf(mx, p1[r]);
            mx = xhalf_max(mx) + boff;
            const float mn = fmaxf(mrun, mx), msub = mn - boff;
            if (__builtin_amdgcn_ballot_w64(mn > mrun) != 0ull) {
                const float alpha = fast_exp2(mrun - mn); lrun *= alpha;
#pragma unroll
                for (int r = 0; r < 16; ++r) { o0[r] *= alpha; o1[r] *= alpha; }
            }
            mrun = mn;
            float rs = 0.f;
#pragma unroll
            for (int r = 0; r < 16; ++r) { p0[r] = fast_exp2(p0[r] - msub); p1[r] = fast_exp2(p1[r] - msub); rs += p0[r] + p1[r]; }
            lrun += xhalf_sum(rs);
            bf16x8 pf[4];
            { v4u t;
              t = (v4u){pk2(p0[0], p0[1]), pk2(p0[2], p0[3]), pk2(p0[4], p0[5]), pk2(p0[6], p0[7])}; pf[0] = __builtin_bit_cast(bf16x8, t);
              t = (v4u){pk2(p0[8], p0[9]), pk2(p0[10], p0[11]), pk2(p0[12], p0[13]), pk2(p0[14], p0[15])}; pf[1] = __builtin_bit_cast(bf16x8, t);
              t = (v4u){pk2(p1[0], p1[1]), pk2(p1[2], p1[3]), pk2(p1[4], p1[5]), pk2(p1[6], p1[7])}; pf[2] = __builtin_bit_cast(bf16x8, t);
              t = (v4u){pk2(p1[8], p1[9]), pk2(p1[10], p1[11]), pk2(p1[12], p1[13]), pk2(p1[14], p1[15])}; pf[3] = __builtin_bit_cast(bf16x8, t); }
#pragma unroll
            for (int xt = 0; xt < 2; ++xt)
#pragma unroll
                for (int s = 0; s < 2; ++s) { const int ro = (32 * xt + 16 * s) * AT_VP;
                    const v2u lo0 = lds_tr_read(Vs + ro), hi0 = lds_tr_read(Vs + ro + 8 * AT_VP);
                    const v2u lo1 = lds_tr_read(Vs + ro + 64), hi1 = lds_tr_read(Vs + ro + 8 * AT_VP + 64);
                    const v4u f0 = (v4u){lo0.x, lo0.y, hi0.x, hi0.y}, f1 = (v4u){lo1.x, lo1.y, hi1.x, hi1.y};
                    o0 = MFMA32(__builtin_bit_cast(bf16x8, f0), pf[2 * xt + s], o0); o1 = MFMA32(__builtin_bit_cast(bf16x8, f1), pf[2 * xt + s], o1); }
        }
        if (more) AT_STORE(buf ^ 1);
        __syncthreads();
        buf ^= 1;
    }
#undef AT_LOAD
#undef AT_STORE
    if (wave_on) {
        const float inv = 1.0f / lrun;
        bf16* orow = MIX + (size_t)qrow * MIXW + MIX_B + 64 * h;
#pragma unroll
        for (int g4 = 0; g4 < 4; ++g4) { const int d = 8 * g4 + 4 * hh;
            v2u w0; w0.x = pk2(o0[4 * g4] * inv, o0[4 * g4 + 1] * inv); w0.y = pk2(o0[4 * g4 + 2] * inv, o0[4 * g4 + 3] * inv); *(GAS v2u*)(orow + d) = w0;
            v2u w1; w1.x = pk2(o1[4 * g4] * inv, o1[4 * g4 + 1] * inv); w1.y = pk2(o1[4 * g4 + 2] * inv, o1[4 * g4 + 3] * inv); *(GAS v2u*)(orow + 32 + d) = w1; }
    }
}
__device__ __forceinline__ unsigned sg_off(unsigned row, unsigned ch) { return 256u * row + 16u * (ch ^ (((row & 3u) << 2) | ((row >> 2) & 3u))); }
__device__ __forceinline__ void sg_unit(Frame& F, int layer, int ci, const bf16* Z, bf16* MIX) {
    const int lane = F.lane, w = F.wave, l31 = lane & 31, hh = lane >> 5;
    const bool sample = ci >= MP / 128; const int L = sample ? 32 : 128, row0 = sample ? MP + 32 * (ci - MP / 128) : 128 * ci;
    LAS unsigned char* VN = F.lds;
    {
        const int c8 = 8 * lane;
        const GAS f32x4* lgp = (const GAS f32x4*)(INP(I_SGG) + layer * DC + c8); const GAS f32x4* lbp = (const GAS f32x4*)(INP(I_SGB) + layer * DC + c8);
        const f32x4 lg0 = lgp[0], lg1 = lgp[1], lb0 = lbp[0], lb1 = lbp[1];
        const int nrw = L / 8;
        LAS unsigned char* vbase = VN + (lane >> 4) * 32768;
        v4u zrow[16];
#pragma unroll
        for (int i = 0; i < 16; ++i) { if (i < nrw) zrow[i] = *(const GAS v4u*)(Z + (size_t)(row0 + w * nrw + i) * ZW + ZSV + c8); else zrow[i] = (v4u){0u, 0u, 0u, 0u}; }
#pragma unroll
        for (int i = 0; i < 16; ++i) { if (i < nrw) { const int rr = w * nrw + i;
            const v4u zv = zrow[i];
            float x[8] = {bflo(zv.x), bfhi(zv.x), bflo(zv.y), bfhi(zv.y), bflo(zv.z), bfhi(zv.z), bflo(zv.w), bfhi(zv.w)};
            const float s = ((x[0] + x[1]) + (x[2] + x[3])) + ((x[4] + x[5]) + (x[6] + x[7]));
            const float mean = wave_sum(s) * (1.0f / DC); float q = 0.f;
#pragma unroll
            for (int e = 0; e < 8; ++e) { x[e] -= mean; q += x[e] * x[e]; }
            const float rstd = 1.0f / sqrtf(wave_sum(q) * (1.0f / DC) + EPS);
            float y[8];
            y[0] = x[0] * rstd * lg0.x + lb0.x; y[1] = x[1] * rstd * lg0.y + lb0.y; y[2] = x[2] * rstd * lg0.z + lb0.z; y[3] = x[3] * rstd * lg0.w + lb0.w;
            y[4] = x[4] * rstd * lg1.x + lb1.x; y[5] = x[5] * rstd * lg1.y + lb1.y; y[6] = x[6] * rstd * lg1.z + lb1.z; y[7] = x[7] * rstd * lg1.w + lb1.w;
            *(LAS v4u*)(vbase + sg_off((unsigned)rr, (unsigned)(lane & 15))) = (v4u){pk2(y[0], y[1]), pk2(y[2], y[3]), pk2(y[4], y[5]), pk2(y[6], y[7])};
            if (sample) { float* so = F.out + O_SGV + (((size_t)layer * NBS + (ci - MP / 128)) * TS + rr) * DC + c8;
                *(GAS f32x4*)so = (f32x4){y[0], y[1], y[2], y[3]}; *(GAS f32x4*)(so + 4) = (f32x4){y[4], y[5], y[6], y[7]}; }
        } }
    }
    __syncthreads();
    {
        const int g = w >> 1;
        const GAS bf16* Wg = (const GAS bf16*)((const bf16*)(lw(F, layer) + LW_SGW) + (size_t)g * 128 * 128 + (size_t)l31 * 128 + 8 * hh); asm volatile("" : "+v"(Wg));
        LAS unsigned char* vg = VN + g * 32768;
        const int nib = L / 32;
        const unsigned blk = (lane >> 4) & 1, q = (lane & 15) >> 2, p4 = lane & 3;
        bf16x8 Bf[4][8];
#pragma unroll
        for (int ib = 0; ib < 4; ++ib)
#pragma unroll
            for (int s = 0; s < 8; ++s) { if (s < 2 * (ib + 1)) { if (ib < nib) Bf[ib][s] = *(const GAS bf16x8*)(Wg + (32 * ib) * 128 + 16 * s); else Bf[ib][s] = (bf16x8){0, 0, 0, 0, 0, 0, 0, 0}; } }
#pragma unroll
        for (int cbb = 0; cbb < 2; ++cbb) { const int cb = 2 * (w & 1) + cbb;
            f32x16 acc[4];
#pragma unroll
            for (int ib = 0; ib < 4; ++ib)
#pragma unroll
                for (int r = 0; r < 16; ++r) acc[ib][r] = 0.f;
#pragma unroll
            for (int s = 0; s < 8; ++s) { if (s < 2 * nib) {
                const v2u a0 = lds_tr_read(vg + sg_off(16u * s + 8u * hh + q, 4u * cb + 2u * blk + (p4 >> 1)) + 8u * (p4 & 1));
                const v2u a1 = lds_tr_read(vg + sg_off(16u * s + 8u * hh + 4u + q, 4u * cb + 2u * blk + (p4 >> 1)) + 8u * (p4 & 1));
                const v4u af = (v4u){a0.x, a0.y, a1.x, a1.y};
#pragma unroll
                for (int ib = 0; ib < 4; ++ib) { if (s < 2 * (ib + 1)) { if (ib < nib) acc[ib] = MFMA32(__builtin_bit_cast(bf16x8, af), Bf[ib][s], acc[ib]); } }
            } }
#pragma unroll
            for (int ib = 0; ib < 4; ++ib) { if (ib < nib) {
                    const int i = 32 * ib + l31, row = row0 + i; const float bias = INP(I_SGBIAS)[((size_t)layer * 4 + g) * 128 + i];
#pragma unroll
                    for (int rg = 0; rg < 4; ++rg) { const int c4 = 32 * cb + 8 * rg + 4 * hh;
                        const v2u zu = *(const GAS v2u*)(Z + (size_t)row * ZW + ZSU + 128 * g + c4);
                        v2u o; o.x = pk2(bflo(zu.x) * (acc[ib][4 * rg] + bias), bfhi(zu.x) * (acc[ib][4 * rg + 1] + bias)); o.y = pk2(bflo(zu.y) * (acc[ib][4 * rg + 2] + bias), bfhi(zu.y) * (acc[ib][4 * rg + 3] + bias));
                        *(GAS v2u*)(MIX + (size_t)row * MIXW + MIX_D + 128 * g + c4) = o; } } }
        }
    }
    __syncthreads();
}
struct ConvCtx { const GAS unsigned char* zb; const GAS unsigned char* hist; GAS unsigned char* cst; bool sample, first, keep; };
template <int E> __device__ __forceinline__ void conv_load(unsigned (&ex)[62], const ConvCtx& X) {
    if constexpr (E < 30) { if (X.sample) { const f32x2 hv = *(const GAS f32x2*)(X.hist + (size_t)E * DC * 4); ex[E] = pk2(hv.x, hv.y); }
                            else if (X.first) ex[E] = 0u;
                            else ex[E] = *(const GAS unsigned*)(X.zb + (size_t)E * ZW * 2); }
    else ex[E] = *(const GAS unsigned*)(X.zb + (size_t)E * ZW * 2);
}
template <int... Es> __device__ __forceinline__ void conv_loads(unsigned (&ex)[62], const ConvCtx& X, std::integer_sequence<int, Es...>) { (conv_load<Es>(ex, X), ...); }
template <int E> __device__ __forceinline__ void conv_row(f32x2 (&acc)[32], const f32x2 (&wt)[31], const unsigned (&ex)[62], const ConvCtx& X) {
    const f32x2 v = (f32x2){bflo(ex[E]), bfhi(ex[E])};
    constexpr int T0 = E > 30 ? E - 30 : 0, T1 = E < 31 ? E : 31;
#pragma unroll
    for (int t = T0; t <= T1; ++t) acc[t] = wt[E - t] * v + acc[t];
    if constexpr (E >= 32) { if (X.keep) *(GAS f32x2*)(X.cst + (size_t)(E - 32) * DC * 4) = v; }
}
template <int... Es> __device__ __forceinline__ void conv_rows(f32x2 (&acc)[32], const f32x2 (&wt)[31], const unsigned (&ex)[62], const ConvCtx& X, std::integer_sequence<int, Es...>) { (conv_row<Es>(acc, wt, ex, X), ...); }
__device__ __forceinline__ void conv_unit(Frame& F, int layer, int tb, int cq, const bf16* Z, bf16* CA, int ca_pitch) {
    const int c = 128 * cq + 2 * F.lane; const bool sample = tb >= MP / 32; const int sb = tb - MP / 32;
    const int r0 = sample ? MP + 32 * sb : 32 * tb; const bool first = !sample && ((r0 & (SEQ - 1)) == 0);
    ConvCtx X; X.sample = sample; X.first = first; X.keep = sample || ((r0 & (SEQ - 1)) == SEQ - 32);
    X.zb = (const GAS unsigned char*)(Z + ((long)r0 - 30) * ZW + ZU + c); asm volatile("" : "+v"(X.zb));
    const GAS unsigned char* wb = (const GAS unsigned char*)(INP(I_CONVW) + (size_t)layer * 31 * DC + c); asm volatile("" : "+v"(wb));
    f32x2 wt[31];
#pragma unroll
    for (int j = 0; j < 31; ++j) wt[j] = *(const GAS f32x2*)(wb + (size_t)j * DC * 4);
    const f32x2 cbias = *(const GAS f32x2*)(INP(I_CONVB) + layer * DC + c), gg = *(const GAS f32x2*)(INP(I_GNG) + layer * DC + c), gb = *(const GAS f32x2*)(INP(I_GNB) + layer * DC + c);
    f32x2 acc[32];
#pragma unroll
    for (int t = 0; t < 32; ++t) acc[t] = cbias;
    X.hist = (const GAS unsigned char*)(INP(I_CCONV) + ((size_t)layer * NBS + (sample ? sb : 0)) * 30 * DC + c); asm volatile("" : "+v"(X.hist));
    X.cst = (GAS unsigned char*)(sample ? F.out + O_CONVS + ((size_t)layer * NBS + sb) * 30 * DC + c : F.out + O_CONVP + ((size_t)layer * NBP + (r0 >> 13)) * 30 * DC + c); asm volatile("" : "+v"(X.cst));
    GAS unsigned char* cab = (GAS unsigned char*)(CA + (size_t)r0 * ca_pitch + c); asm volatile("" : "+v"(cab));
    unsigned ex[62];
    conv_loads(ex, X, std::make_integer_sequence<int, 62>{});
    conv_rows(acc, wt, ex, X, std::make_integer_sequence<int, 62>{});
#pragma unroll
    for (int t = 0; t < 32; ++t) {
        const f32x2 y = acc[t];
        const float s = half32_sum(y.x + y.y), q = half32_sum(y.x * y.x + y.y * y.y);
        const float mean = s * (1.0f / 64.0f), var = fmaxf(q * (1.0f / 64.0f) - mean * mean, 0.f), rstd = 1.0f / sqrtf(var + EPS);
        const f32x2 n = (y - mean) * rstd * gg + gb;
        *(GAS unsigned*)(cab + (size_t)t * ca_pitch * 2) = pk2(siluf_(n.x), siluf_(n.y));
    }
}
template <int W>
__device__ __forceinline__ void pool_body(Frame& F, int layer, int tb, int cq, const bf16* Z, bf16* PM, int pm_pitch) {
    const int c = 128 * cq + 2 * F.lane; const bool sample = tb >= MP / 32; const int sb = tb - MP / 32;
    const int r0 = sample ? MP + 32 * sb : 32 * tb; const bool first = !sample && ((r0 & (SEQ - 1)) == 0);
    const GAS unsigned char* hist = (const GAS unsigned char*)(INP(I_CPOOL) + ((size_t)layer * NBS + (sample ? sb : 0)) * 15 * DC + c); asm volatile("" : "+v"(hist));
    const bool last_blk = !sample && ((r0 & (SEQ - 1)) == SEQ - 32);
    GAS unsigned char* pst = (GAS unsigned char*)(sample ? F.out + O_POOLS + ((size_t)layer * NBS + sb) * 15 * DC + c : F.out + O_POOLP + ((size_t)layer * NBP + (r0 >> 13)) * 15 * DC + c); asm volatile("" : "+v"(pst));
    const GAS unsigned char* zb = (const GAS unsigned char*)(Z + ((long)r0 - 15) * ZW + ZP + c); asm volatile("" : "+v"(zb));
    GAS unsigned char* pmb = (GAS unsigned char*)(PM + (size_t)r0 * pm_pitch + c); asm volatile("" : "+v"(pmb));
    f32x2 ext[47];
#pragma unroll
    for (int e = 0; e < 47; ++e) {
        if (e < 15) { if (sample) ext[e] = *(const GAS f32x2*)(hist + (size_t)e * DC * 4);
                      else if (first) ext[e] = (f32x2){0.f, 0.f};
                      else { const unsigned u = *(const GAS unsigned*)(zb + (size_t)e * ZW * 2); ext[e] = (f32x2){bflo(u), bfhi(u)}; } }
        else { const unsigned u = *(const GAS unsigned*)(zb + (size_t)e * ZW * 2); ext[e] = (f32x2){bflo(u), bfhi(u)}; }
    }
#pragma unroll
    for (int t = 0; t < 32; ++t) {
        f32x2 win = (f32x2){0.f, 0.f};
#pragma unroll
        for (int i = W - 1; i >= 0; --i) win += ext[15 + t - i];
        const float rc = 1.0f / (float)((first && t + 1 < W) ? t + 1 : W);
        const f32x2 m = win * rc - ext[15 + t];
        *(GAS unsigned*)(pmb + (size_t)t * pm_pitch * 2) = pk2(m.x, m.y);
        if (t >= 17 && (sample || last_blk)) *(GAS f32x2*)(pst + (size_t)(t - 17) * DC * 4) = ext[15 + t];
    }
}
#define MIX_FENCE() do { int t_ = F.tid; asm volatile("" : "+v"(t_)); F.tid = t_; F.lane = t_ & 63; } while (0)
__device__ __forceinline__ void mixer_phase(Frame& F, int layer) {
    const bf16* Z = (const bf16*)(F.ws + WS_Z); bf16* MIX = (bf16*)(F.ws + WS_MIX); bf16* CA = (bf16*)(F.ws + WS_CAPM); bf16* PM = CA + (size_t)MT * DC;
#ifndef PROBE_MIX
#define PROBE_MIX 0
#endif
#define MDUP(k) _Pragma("unroll") for (int mrep_ = 0; mrep_ < 1 + ((PROBE_MIX >> (k)) & 1); ++mrep_)
    MDUP(0) { for (int id = F.vcu; id < NBP * 8 * 32; id += F.G) attn_unit(F, layer, false, id >> 8, (id >> 5) & 7, id & 31, Z, MIX);
    for (int id = F.vcu - 192; id >= 0 && id < NBS * 8; id += F.G) attn_unit(F, layer, true, id >> 3, id & 7, 0, Z, MIX); }
    MIX_FENCE();
    MDUP(1) { for (int id = F.vcu; id < MP / 128; id += F.G) sg_unit(F, layer, id, Z, MIX);
    for (int id = F.vcu - 96; id >= 0 && id < NBS; id += F.G) sg_unit(F, layer, MP / 128 + id, Z, MIX); }
    const int gw = F.vcu * NWAVES + F.wave, NGW = F.G * NWAVES;
    MIX_FENCE();
    MDUP(2) { for (int id = gw; id < (MP / 32) * 4; id += NGW) conv_unit(F, layer, id >> 2, id & 3, Z, CA, DC);
    if (F.wave == 0 && F.vcu >= 128 && F.vcu < 160) { const int id = (MP / 32) * 4 + F.vcu - 128; conv_unit(F, layer, id >> 2, id & 3, Z, CA, DC); } }
    MIX_FENCE();
    MDUP(3) for (int it = 0; it < 3; ++it) { int id = gw + it * NGW;
        if (it == 2) { if (F.wave == 0 && F.vcu >= 160 && F.vcu < 192) id = (MP / 32) * 4 + F.vcu - 160; else break; }
        const int tb = id >> 2, cq = id & 3;
        switch (cq) { case 0: pool_body<2>(F, layer, tb, cq, Z, PM, DC); break; case 1: pool_body<4>(F, layer, tb, cq, Z, PM, DC); break;
                      case 2: pool_body<8>(F, layer, tb, cq, Z, PM, DC); break; default: pool_body<16>(F, layer, tb, cq, Z, PM, DC); break; } }
    MIX_FENCE();
    const int gt = F.vcu * (NWAVES * 64) + F.tid, NGT = F.G * NWAVES * 64;
    for (int i = gt; i < (NBP * 512 + NBS * TS) * 128; i += NGT) {
        const int rr = i >> 7, kv = (i >> 6) & 1, ch = i & 63;
        int zrow; size_t o;
        if (rr < NBP * 512) { const int b = rr >> 9, t = rr & 511; zrow = b * SEQ + SEQ - 512 + t; o = (kv ? O_VP : O_KP) + (((size_t)layer * NBP + b) * 512 + t) * 512 + 8 * ch; }
        else { const int r2 = rr - NBP * 512, b = r2 >> 5, t = r2 & 31; zrow = MP + r2; o = (kv ? O_VS : O_KS) + (((size_t)layer * NBS + b) * TS + t) * 512 + 8 * ch; }
        const v4u z = *(const GAS v4u*)(Z + (size_t)zrow * ZW + (kv ? ZV : ZK) + 8 * ch);
        *(GAS f32x4*)(F.out + o) = (f32x4){bflo(z.x), bfhi(z.x), bflo(z.y), bfhi(z.y)}; *(GAS f32x4*)(F.out + o + 4) = (f32x4){bflo(z.z), bfhi(z.z), bflo(z.w), bfhi(z.w)};
    }
}

enum { SK_Z = 0, SK_MIX2 = 1, SK_RES = 2, SK_SWI = 3 };
struct SkUnit { int row0, nb0, nb1, ocol0, ocol1; bool pair; float scale; };
template <int KIND, int NTB, int U>
__device__ __forceinline__ void sk_unit(Frame& F, const bf16* A, const bf16* Bt, int K, const SkUnit& u, bf16* obf, int opitch, float* X, const float* gate) {
    const int lane = F.lane, w = F.wave, l31 = lane & 31, hh = lane >> 5;
    const int kw = K >> 3, nch = kw >> 6;
    constexpr int NR = 32 * NTB + 64, NLD = NR / 8;
    LAS unsigned char* stg = F.lds + w * 16384;
    const int lr = lane >> 3, lc = lane & 7;
    const GAS unsigned char* src[NLD];
#pragma unroll
    for (int i = 0; i < NLD; ++i) { const int r = 8 * i + lr;
        const bf16* base = (r < 32 * NTB) ? A + (size_t)(u.row0 + r) * K : (r < 32 * NTB + 32) ? Bt + (size_t)(u.nb0 + r - 32 * NTB) * K : Bt + (size_t)(u.nb1 + r - 32 * NTB - 32) * K;
        src[i] = (const GAS unsigned char*)(base + w * kw + 8 * lc); }
    f32x16 acc[NTB][2];
#pragma unroll
    for (int tb = 0; tb < NTB; ++tb)
#pragma unroll
        for (int c = 0; c < 2; ++c)
#pragma unroll
            for (int r = 0; r < 16; ++r) acc[tb][c][r] = 0.f;
    v4u R[NLD];
#pragma unroll
    for (int i = 0; i < NLD; ++i) R[i] = *(const GAS v4u*)(src[i]);
    for (int ch = 0; ch < nch; ++ch) {
#pragma unroll
        for (int i = 0; i < NLD; ++i) { const int r = 8 * i + lr; *(LAS v4u*)(stg + r * 128 + 16 * (lc ^ (r & 7))) = R[i]; }
        if (ch + 1 < nch) {
#pragma unroll
            for (int i = 0; i < NLD; ++i) R[i] = *(const GAS v4u*)(src[i] + (size_t)(ch + 1) * 128); }
#pragma unroll
        for (int s = 0; s < 4; ++s) { const int cx = 16 * ((2 * s + hh) ^ (l31 & 7));
            bf16x8 xf[NTB];
#pragma unroll
            for (int tb = 0; tb < NTB; ++tb) xf[tb] = *(const LAS bf16x8*)(stg + (32 * tb + l31) * 128 + cx);
            const bf16x8 w0 = *(const LAS bf16x8*)(stg + (32 * NTB + l31) * 128 + cx), w1 = *(const LAS bf16x8*)(stg + (32 * NTB + 32 + l31) * 128 + cx);
#pragma unroll
            for (int tb = 0; tb < NTB; ++tb) { acc[tb][0] = MFMA32(w0, xf[tb], acc[tb][0]); acc[tb][1] = MFMA32(w1, xf[tb], acc[tb][1]); }
        }
    }
    __syncthreads();
    LAS f32x4* red = (LAS f32x4*)F.lds;
#pragma unroll
    for (int tb = 0; tb < NTB; ++tb)
#pragma unroll
        for (int c = 0; c < 2; ++c)
#pragma unroll
            for (int rg = 0; rg < 4; ++rg) red[((((w * NTB + tb) * 2 + c) * 4 + rg) << 6) + lane] = (f32x4){acc[tb][c][4 * rg], acc[tb][c][4 * rg + 1], acc[tb][c][4 * rg + 2], acc[tb][c][4 * rg + 3]};
    __syncthreads();
    {
        const int rg = w & 3, tb = (NTB == 2) ? (w >> 2) : 0, c_lo = (NTB == 2) ? 0 : (w >> 2), c_hi = (NTB == 2) ? 2 : (w >> 2) + 1;
        f32x4 v[2] = {(f32x4){0.f, 0.f, 0.f, 0.f}, (f32x4){0.f, 0.f, 0.f, 0.f}};
#pragma unroll
        for (int c = 0; c < 2; ++c) { if (c >= c_lo && c < c_hi) {
#pragma unroll
                for (int w2 = 0; w2 < 8; ++w2) v[c] += red[((((w2 * NTB + tb) * 2 + c) * 4 + rg) << 6) + lane]; } }
        const int row = u.row0 + 32 * tb + l31, co = 8 * rg + 4 * hh;
        if (KIND == SK_Z) {
            if (u.pair) { v2u o; o.x = pk2(v[0][0] * sigmoidf_(v[1][0]), v[0][1] * sigmoidf_(v[1][1])); o.y = pk2(v[0][2] * sigmoidf_(v[1][2]), v[0][3] * sigmoidf_(v[1][3]));
                *(GAS v2u*)(obf + (size_t)row * opitch + u.ocol0 + co) = o; }
            else {
#pragma unroll
                for (int c = 0; c < 2; ++c) { const f32x4 y = v[c] * u.scale; v2u o; o.x = pk2(y[0], y[1]); o.y = pk2(y[2], y[3]); *(GAS v2u*)(obf + (size_t)row * opitch + (c ? u.ocol1 : u.ocol0) + co) = o; } }
        } else if (KIND == SK_MIX2) {
#pragma unroll
            for (int c = 0; c < 2; ++c) { v2u o; o.x = pk2(v[c][0], v[c][1]); o.y = pk2(v[c][2], v[c][3]); *(GAS v2u*)(obf + (size_t)row * opitch + (c ? u.ocol1 : u.ocol0) + co) = o; }
        } else if (KIND == SK_SWI) {
            v2u o; o.x = pk2(siluf_(v[0][0]) * v[1][0], siluf_(v[0][1]) * v[1][1]); o.y = pk2(siluf_(v[0][2]) * v[1][2], siluf_(v[0][3]) * v[1][3]);
            *(GAS v2u*)(obf + (size_t)row * opitch + u.ocol0 + co) = o;
        } else {
            const int c = w >> 2, col = (c ? u.ocol1 : u.ocol0) + co;
            const f32x4 g = *(const GAS f32x4*)(gate + (size_t)batch_of_row(row) * NMOD + col); GAS f32x4* xp = (GAS f32x4*)(X + (size_t)row * DM + col);
            *xp = *xp + g * v[c];
        }
    }
    __syncthreads();
}
constexpr int N_PHASES = 2 + 8 * NL + 1;

__global__ void __launch_bounds__(NWAVES * 64, 2) enc_fwd(Args args) {
    extern __shared__ __attribute__((aligned(16))) unsigned char lds[];
    Frame F;
    F.lds = (LAS unsigned char*)lds;
    F.tid = threadIdx.x; F.lane = F.tid & 63; F.wave = __builtin_amdgcn_readfirstlane(F.tid >> 6);
    F.G = gridDim.x; { const int bx = blockIdx.x; F.vcu = (F.G % 8 == 0) ? (bx % 8) * (F.G / 8) + bx / 8 : bx; }
    F.ka = (KArgs)__builtin_amdgcn_kernarg_segment_ptr();
    F.out = args.out; F.ws = args.ws;
    volatile LAS unsigned* MISC = (volatile LAS unsigned*)(F.lds + MISC_OFF);
    for (int u = F.tid; u < (LDS_BYTES - LDSCTL_OFF) / 4; u += NWAVES * 64) ((LAS unsigned*)(F.lds + LDSCTL_OFF))[u] = 0u;
    __syncthreads();
    const int lo = args.ph_lo, hi = args.ph_hi;
#define REFRESH() do { int t_ = threadIdx.x; asm volatile("" : "+v"(t_)); F.tid = t_; F.lane = t_ & 63; F.wave = __builtin_amdgcn_readfirstlane(t_ >> 6); \
        unsigned long long w_ = (unsigned long long)args.ws, o_ = (unsigned long long)args.out, k_ = (unsigned long long)__builtin_amdgcn_kernarg_segment_ptr(); \
        asm volatile("" : "+s"(w_), "+s"(o_), "+s"(k_)); F.ws = (unsigned char*)(GAS unsigned char*)w_; F.out = (float*)(GAS float*)o_; F.ka = (KArgs)k_; \
        unsigned l_ = (unsigned)(unsigned long long)(LAS unsigned char*)lds; asm volatile("" : "+s"(l_)); F.lds = (LAS unsigned char*)(unsigned long long)l_; } while (0)
    XcdBarrier bar; bar.bar = (unsigned*)(F.ws + WS_CTL) + CW_BAR; bar.x = 0; bar.st = nullptr;
    if (hi - lo > 1) bar = xcd_barrier_post((unsigned*)(F.ws + WS_CTL) + CW_BAR, MISC + 8);
#ifdef ONLY_PHASE
#define IN(k) ((((k) < 2 || (k) == N_PHASES - 1) ? (k) : 2 + ((k) - 2) % 8) == ONLY_PHASE && lo <= (k) && (k) < hi)
#else
#define IN(k) (lo <= (k) && (k) < hi)
#endif
#ifndef PROBE_DUP
#define PROBE_DUP 0
#endif
#define DUP(k) _Pragma("unroll") for (int rep_ = 0; rep_ < 1 + ((PROBE_DUP >> (k)) & 1); ++rep_)
#ifndef STAGGER_TICKS
#define STAGGER_TICKS 0
#endif
#define STAGGER() do { if (STAGGER_TICKS > 0 && (blockIdx.x & 8)) { const unsigned long long t0_ = __builtin_amdgcn_s_memrealtime(); while (__builtin_amdgcn_s_memrealtime() - t0_ < (unsigned long long)STAGGER_TICKS) __builtin_amdgcn_s_sleep(8); } } while (0)
#define SEAM(k) do { if (IN(k) && IN((k) + 1)) { XcdBarrier b_ = bar; unsigned long long p_ = (unsigned long long)b_.bar; asm volatile("" : "+s"(p_)); b_.bar = (unsigned*)p_; xcd_barrier(b_); } } while (0)

    if (IN(0)) DUP(8) { REFRESH(); p0a_phase(F); } SEAM(0);
    if (IN(1)) { REFRESH(); p0b_phase(F); } SEAM(1);
    for (int l = 0; l < NL; ++l) {
        const int pb = 2 + 8 * l;
        if (IN(pb + 0)) DUP(0) { REFRESH(); bf16* H = (bf16*)(F.ws + WS_H); bf16* Zb = (bf16*)(F.ws + WS_Z); bf16* MIX = (bf16*)(F.ws + WS_MIX); bf16* HID = (bf16*)(F.ws + WS_HID); bf16* CAPM = (bf16*)(F.ws + WS_CAPM); (void)H; (void)Zb; (void)MIX; (void)HID; (void)CAPM; const float* mod_l = modp(F, l); unsigned char* wl = lw(F, l); (void)mod_l; (void)wl; if (l == 0) norm_phase<true>(F, INP(I_N1) + l * DM, mod_l, 0, H); else norm_phase<false>(F, INP(I_N1) + l * DM, mod_l, 0, H); } SEAM(pb + 0);
        if (IN(pb + 1)) DUP(1) { REFRESH(); bf16* H = (bf16*)(F.ws + WS_H); bf16* Zb = (bf16*)(F.ws + WS_Z); bf16* MIX = (bf16*)(F.ws + WS_MIX); bf16* HID = (bf16*)(F.ws + WS_HID); bf16* CAPM = (bf16*)(F.ws + WS_CAPM); (void)H; (void)Zb; (void)MIX; (void)HID; (void)CAPM; const float* mod_l = modp(F, l); unsigned char* wl = lw(F, l); (void)mod_l; (void)wl; pg8::Gemm g{H, (const bf16*)(wl + LW_WIN), MP, DIN, DM}; pg8::StaticOrder S; S.init(MP, DIN, F.G, (int)blockIdx.x); int dry_ = (PROBE_DRY != 0) && (rep_ == 1); asm volatile("" : "+s"(dry_)); pg8::EpiZ E{Zb, dry_};
            pg8::gemm_phase<pg8::EpiZ, pg8::StaticOrder, true, true>(F.lds, g, S, E);
            for (int su = F.vcu; su < 4 * 64; su += F.G) { const int rt = su & 3, cb = su >> 2; SkUnit u; u.row0 = MP + 64 * rt;
                if (cb < 16) { const int tt = cb >> 2, x0 = 32 * (cb & 3); u.nb0 = 256 * tt + x0; u.nb1 = u.nb0 + 128; u.ocol0 = 128 * tt + x0; u.ocol1 = 0; u.pair = true; u.scale = 1.f; }
                else { const int pbk = cb - 16; u.nb0 = 1024 + 64 * pbk; u.nb1 = u.nb0 + 32; u.ocol0 = 512 + 64 * pbk; u.ocol1 = u.ocol0 + 32; u.pair = false; u.scale = (u.nb0 < 1536) ? QSCALE : 1.f; }
                sk_unit<SK_Z, 2, 8>(F, H, (const bf16*)(wl + LW_WIN), DM, u, Zb, ZW, nullptr, nullptr); } } SEAM(pb + 1);
        if (IN(pb + 2)) DUP(2) { REFRESH(); bf16* H = (bf16*)(F.ws + WS_H); bf16* Zb = (bf16*)(F.ws + WS_Z); bf16* MIX = (bf16*)(F.ws + WS_MIX); bf16* HID = (bf16*)(F.ws + WS_HID); bf16* CAPM = (bf16*)(F.ws + WS_CAPM); (void)H; (void)Zb; (void)MIX; (void)HID; (void)CAPM; const float* mod_l = modp(F, l); unsigned char* wl = lw(F, l); (void)mod_l; (void)wl; mixer_phase(F, l); } SEAM(pb + 2);
        if (IN(pb + 3)) DUP(3) { REFRESH(); bf16* H = (bf16*)(F.ws + WS_H); bf16* Zb = (bf16*)(F.ws + WS_Z); bf16* MIX = (bf16*)(F.ws + WS_MIX); bf16* HID = (bf16*)(F.ws + WS_HID); bf16* CAPM = (bf16*)(F.ws + WS_CAPM); (void)H; (void)Zb; (void)MIX; (void)HID; (void)CAPM; const float* mod_l = modp(F, l); unsigned char* wl = lw(F, l); (void)mod_l; (void)wl; pg8::Gemm g{CAPM, (const bf16*)(wl + LW_CPW), 2 * MT, 2 * DC, DC}; pg8::Mix2Order S{F.G, (int)blockIdx.x}; pg8::EpiMix2 E{MIX};
            pg8::gemm_phase<pg8::EpiMix2, pg8::Mix2Order, true, true>(F.lds, g, S, E);
            for (int su = F.vcu; su < 2 * 4 * 8; su += F.G) { const int which = su >> 5, rt = su & 3, cb = (su >> 2) & 7; SkUnit u; u.row0 = MP + 64 * rt; u.nb0 = 64 * cb; u.nb1 = u.nb0 + 32;
                u.ocol0 = which * 1024 + 64 * cb; u.ocol1 = u.ocol0 + 32; u.pair = false; u.scale = 1.f;
                sk_unit<SK_MIX2, 2, 4>(F, CAPM + (size_t)which * MT * DC, (const bf16*)(wl + LW_CPW) + (size_t)which * DC * DC, DC, u, MIX, MIXW, nullptr, nullptr); } } SEAM(pb + 3);
        if (IN(pb + 4)) DUP(4) { REFRESH(); bf16* H = (bf16*)(F.ws + WS_H); bf16* Zb = (bf16*)(F.ws + WS_Z); bf16* MIX = (bf16*)(F.ws + WS_MIX); bf16* HID = (bf16*)(F.ws + WS_HID); bf16* CAPM = (bf16*)(F.ws + WS_CAPM); (void)H; (void)Zb; (void)MIX; (void)HID; (void)CAPM; const float* mod_l = modp(F, l); unsigned char* wl = lw(F, l); (void)mod_l; (void)wl; pg8::Gemm g{MIX, (const bf16*)(wl + LW_WOUT), MP, DM, DM}; pg8::StaticOrder S; S.init(MP, DM, F.G, (int)blockIdx.x); pg8::EpiRes E{F.out, mod_l + 2 * DM};
            pg8::gemm_phase<pg8::EpiRes, pg8::StaticOrder, true, true>(F.lds, g, S, E);
            for (int su = F.vcu; su < 8 * 32; su += F.G) { const int rt = su & 7, cb = su >> 3; SkUnit u; u.row0 = MP + 32 * rt; u.nb0 = 64 * cb; u.nb1 = u.nb0 + 32; u.ocol0 = u.nb0; u.ocol1 = u.nb1; u.pair = false; u.scale = 1.f;
                sk_unit<SK_RES, 1, 8>(F, MIX, (const bf16*)(wl + LW_WOUT), DM, u, nullptr, 0, F.out, mod_l + 2 * DM); } } SEAM(pb + 4);
        if (IN(pb + 5)) DUP(5) { REFRESH(); bf16* H = (bf16*)(F.ws + WS_H); bf16* Zb = (bf16*)(F.ws + WS_Z); bf16* MIX = (bf16*)(F.ws + WS_MIX); bf16* HID = (bf16*)(F.ws + WS_HID); bf16* CAPM = (bf16*)(F.ws + WS_CAPM); (void)H; (void)Zb; (void)MIX; (void)HID; (void)CAPM; const float* mod_l = modp(F, l); unsigned char* wl = lw(F, l); (void)mod_l; (void)wl; norm_phase<false>(F, INP(I_N2) + l * DM, mod_l, 3, H); } SEAM(pb + 5);
        if (IN(pb + 6)) DUP(6) { REFRESH(); bf16* H = (bf16*)(F.ws + WS_H); bf16* Zb = (bf16*)(F.ws + WS_Z); bf16* MIX = (bf16*)(F.ws + WS_MIX); bf16* HID = (bf16*)(F.ws + WS_HID); bf16* CAPM = (bf16*)(F.ws + WS_CAPM); (void)H; (void)Zb; (void)MIX; (void)HID; (void)CAPM; const float* mod_l = modp(F, l); unsigned char* wl = lw(F, l); (void)mod_l; (void)wl; STAGGER(); pg8::Gemm g{H, (const bf16*)(wl + LW_WGU), MP, 2 * DFF, DM}; pg8::StaticOrder S; S.init(MP, 2 * DFF, F.G, (int)blockIdx.x); pg8::EpiSwi E{HID};
            pg8::gemm_phase<pg8::EpiSwi, pg8::StaticOrder, true, true>(F.lds, g, S, E);
            for (int su = F.vcu; su < 4 * 176; su += F.G) { const int rt = su & 3, cb = su >> 2, tt = cb >> 2, x0 = 32 * (cb & 3); SkUnit u; u.row0 = MP + 64 * rt; u.nb0 = 256 * tt + x0; u.nb1 = u.nb0 + 128;
                u.ocol0 = 128 * tt + x0; u.ocol1 = 0; u.pair = true; u.scale = 1.f;
                sk_unit<SK_SWI, 2, 8>(F, H, (const bf16*)(wl + LW_WGU), DM, u, HID, DFF, nullptr, nullptr); } } SEAM(pb + 6);
        if (IN(pb + 7)) DUP(7) { REFRESH(); bf16* H = (bf16*)(F.ws + WS_H); bf16* Zb = (bf16*)(F.ws + WS_Z); bf16* MIX = (bf16*)(F.ws + WS_MIX); bf16* HID = (bf16*)(F.ws + WS_HID); bf16* CAPM = (bf16*)(F.ws + WS_CAPM); (void)H; (void)Zb; (void)MIX; (void)HID; (void)CAPM; const float* mod_l = modp(F, l); unsigned char* wl = lw(F, l); (void)mod_l; (void)wl; pg8::Gemm g{HID, (const bf16*)(wl + LW_WD), MP, DM, DFF}; pg8::StaticOrder S; S.init(MP, DM, F.G, (int)blockIdx.x); pg8::EpiRes E{F.out, mod_l + 5 * DM};
            pg8::gemm_phase<pg8::EpiRes, pg8::StaticOrder, true, true>(F.lds, g, S, E);
            for (int su = F.vcu; su < 8 * 32; su += F.G) { const int rt = su & 7, cb = su >> 3; SkUnit u; u.row0 = MP + 32 * rt; u.nb0 = 64 * cb; u.nb1 = u.nb0 + 32; u.ocol0 = u.nb0; u.ocol1 = u.nb1; u.pair = false; u.scale = 1.f;
                sk_unit<SK_RES, 1, 11>(F, HID, (const bf16*)(wl + LW_WD), DFF, u, nullptr, 0, F.out, mod_l + 5 * DM); } } SEAM(pb + 7);
    }
    if (IN(N_PHASES - 1)) { REFRESH(); final_norm_phase(F); }
#undef IN
#undef SEAM
}

extern "C" void kernel_launch(void* const* d_in, const int* in_sizes, int n_in, void* d_out, int out_size, void* d_ws, size_t ws_size, hipStream_t stream) {
    static int grid = 0;
    if (grid == 0) {
        if (n_in != N_IN || in_sizes[0] != MP * DM || (size_t)out_size != O_END || ws_size < WS_END) {
            fprintf(stderr, "kernel_launch: unexpected shapes: n_in %d in0 %d out %d ws %zu (need %zu); nothing launched\n", n_in, n_in > 0 ? in_sizes[0] : -1, out_size, ws_size, (size_t)WS_END); grid = -1; return; }
        int dev = 0, cus = 0;
        if (hipGetDevice(&dev) != hipSuccess || hipDeviceGetAttribute(&cus, hipDeviceAttributeMultiprocessorCount, dev) != hipSuccess) { grid = -1; return; }
        if (hipFuncSetAttribute((const void*)enc_fwd, hipFuncAttributeMaxDynamicSharedMemorySize, LDS_BYTES) != hipSuccess) { fprintf(stderr, "kernel_launch: hipFuncSetAttribute failed\n"); grid = -1; return; }
        int per_cu = 0;
        if (hipOccupancyMaxActiveBlocksPerMultiprocessor(&per_cu, (const void*)enc_fwd, NWAVES * 64, LDS_BYTES) != hipSuccess || per_cu < 1)
            fprintf(stderr, "kernel_launch: note: occupancy query reports %d workgroups per CU\n", per_cu);
        (void)hipGetLastError();
        grid = cus;
    }
    if (grid < 0) return;
    if (hipMemsetAsync((char*)d_ws + WS_CTL, 0, CTL_ZERO_BYTES, stream) != hipSuccess) return;
    Args a{};
    for (int i = 0; i < N_IN; ++i) a.in[i] = (const float*)d_in[i];
    a.out = (float*)d_out; a.ws = (unsigned char*)d_ws; a.pad0 = 0; a.pad1 = 0;
#if MK_ONE_LAUNCH
    a.ph_lo = 0; a.ph_hi = N_PHASES;
    hipLaunchKernelGGL(enc_fwd, dim3(grid), dim3(NWAVES * 64), LDS_BYTES, stream, a);
#else
    for (int ph = 0; ph < N_PHASES; ++ph) { a.ph_lo = ph; a.ph_hi = ph + 1;
        hipLaunchKernelGGL(enc_fwd, dim3(grid), dim3(NWAVES * 64), LDS_BYTES, stream, a); }
#endif
}
```

```cpp
#include <hip/hip_runtime.h>
#include <cstdio>
#include <cstdint>
#include <utility>

#ifndef MK_ONE_LAUNCH
#define MK_ONE_LAUNCH 1
#endif
#ifndef PROBE_DUP
#define PROBE_DUP 0
#endif
#ifndef PROBE_DRY
#define PROBE_DRY 0
#endif
#ifndef PROBE_MIX
#define PROBE_MIX 0
#endif
#ifndef PROBE_EPI2
#define PROBE_EPI2 0
#endif
#ifndef STAGGER_TICKS
#define STAGGER_TICKS 0
#endif
#ifndef STAGGER_G3
#define STAGGER_G3 0
#define STAGGER_G5 0
#endif

constexpr int DM = 2048, SEQ = 8192, NBP = 4, MP = NBP * SEQ, NBS = 8, TS = 32, MS = NBS * TS, MT = MP + MS, NPANEL = MT / 256;
constexpr int DIN = 4096, DFF = 5632, DC = 512, NL = 4, NMOD = 6 * DM, NBT = NBP + NBS;
constexpr int ZW = 3584, ZU = 0, ZQ = 512, ZK = 1024, ZV = 1536, ZP = 2048, ZSU = 2560, ZSV = 3072;
constexpr int MIXW = 2048, MIX_A = 0, MIX_B = 512, MIX_C = 1024, MIX_D = 1536;
constexpr float EPS = 1e-6f, LOG2E = 1.4426950408889634f, QSCALE = 0.125f * LOG2E;
constexpr int KSPLIT = 16;
constexpr size_t O_YP = 0, O_YS = O_YP + (size_t)MP * DM, O_CONVP = O_YS + (size_t)MS * DM, O_CONVS = O_CONVP + (size_t)NL * NBP * 30 * DC,
    O_KP = O_CONVS + (size_t)NL * NBS * 30 * DC, O_VP = O_KP + (size_t)NL * NBP * 512 * 512, O_KS = O_VP + (size_t)NL * NBP * 512 * 512,
    O_VS = O_KS + (size_t)NL * NBS * TS * 512, O_POOLP = O_VS + (size_t)NL * NBS * TS * 512, O_POOLS = O_POOLP + (size_t)NL * NBP * 15 * DC,
    O_SGV = O_POOLS + (size_t)NL * NBS * 15 * DC, O_END = O_SGV + (size_t)NL * NBS * TS * DC;
static_assert(O_END == 78700544, "output size");
enum { I_XP = 0, I_XS, I_CP, I_CS, I_CCONV, I_CK, I_CV, I_CPOOL, I_ADAW, I_ADAB, I_N1, I_N2, I_WIN, I_CONVW, I_CONVB, I_GNG, I_GNB, I_CPW, I_RELB,
       I_POOLW, I_POOLS, I_SGG, I_SGB, I_SGW, I_SGBIAS, I_WOUT, I_WG, I_WU, I_WD, I_FING, N_IN };
static_assert(N_IN == 30, "30 inputs");

constexpr size_t MiB = 1u << 20;
constexpr size_t WS_CTL = 0, CTL_ZERO_BYTES = 1 * MiB;
constexpr size_t WS_MOD = 1 * MiB;
constexpr size_t WS_MODP = 4 * MiB;
constexpr size_t WS_W = 40 * MiB;
constexpr size_t LW_WIN = 0, LW_WOUT = 16 * MiB, LW_WGU = 24 * MiB, LW_WD = 68 * MiB, LW_CPW = 90 * MiB, LW_PWD = LW_CPW + 512 * 1024, LW_SGW = 91 * MiB, LW = 91 * MiB + 256 * 1024;
constexpr size_t WS_H = WS_W + NL * LW;
constexpr size_t WS_Z = WS_H + (size_t)MT * DM * 2;
constexpr size_t WS_MIX = WS_Z + (size_t)MT * ZW * 2;
constexpr size_t WS_HID = WS_Z;
constexpr size_t WS_CAPM = WS_MIX + (size_t)MT * MIXW * 2;
constexpr size_t WS_DELTA = WS_CAPM + (size_t)2 * MT * DC * 2;
constexpr size_t WS_END = WS_DELTA + (size_t)MT * DM * 2;
static_assert(WS_HID + (size_t)MT * DFF * 2 <= WS_CAPM, "HID overlay");
static_assert((size_t)NL * 12 * NMOD * 4 <= 3 * MiB && (size_t)KSPLIT * NL * 12 * NMOD * 4 <= 36 * MiB, "mod buffers");
constexpr int CW_BAR = 4096;

constexpr int RING_BYTES = 131072;
constexpr int LDSCTL_OFF = RING_BYTES, MISC_OFF = LDSCTL_OFF + 320;
constexpr int LDS_BYTES = 147456;
constexpr int NWAVES = 8;

#define GAS __attribute__((address_space(1)))
#define LAS __attribute__((address_space(3)))
typedef unsigned short bf16;
typedef unsigned v4u __attribute__((ext_vector_type(4)));
typedef unsigned v2u __attribute__((ext_vector_type(2)));
typedef float f32x4 __attribute__((ext_vector_type(4)));
typedef float f32x2 __attribute__((ext_vector_type(2)));
typedef float f32x16 __attribute__((ext_vector_type(16)));
typedef short bf16x8 __attribute__((ext_vector_type(8)));
typedef __bf16 bf16x2_t __attribute__((ext_vector_type(2)));
typedef GAS unsigned gu32;
#define RLX_AGENT __ATOMIC_RELAXED, __HIP_MEMORY_SCOPE_AGENT
#define LDS_WAIT() asm volatile("s_waitcnt lgkmcnt(0)" ::: "memory")
#define VM_WAIT() asm volatile("s_waitcnt vmcnt(0)" ::: "memory")

__device__ __forceinline__ unsigned pk2(float lo, float hi) { f32x2 v = {lo, hi}; bf16x2_t b = __builtin_convertvector(v, bf16x2_t); return __builtin_bit_cast(unsigned, b); }
__device__ __forceinline__ float bflo(unsigned u) { return __uint_as_float(u << 16); }
__device__ __forceinline__ float bfhi(unsigned u) { return __uint_as_float(u & 0xffff0000u); }
__device__ __forceinline__ float bf2f(bf16 h) { return __uint_as_float((unsigned)h << 16); }
__device__ __forceinline__ float fast_exp2(float x) { return __builtin_amdgcn_exp2f(x); }
__device__ __forceinline__ float fast_rcp(float x) { return __builtin_amdgcn_rcpf(x); }
__device__ __forceinline__ float sigmoidf_(float x) { return fast_rcp(1.0f + fast_exp2(-x * LOG2E)); }
__device__ __forceinline__ float siluf_(float x) { return x * sigmoidf_(x); }
template <int CTRL> __device__ __forceinline__ float dpp_f(float v) { return __int_as_float(__builtin_amdgcn_update_dpp(0, __float_as_int(v), CTRL, 0xF, 0xF, true)); }
__device__ __forceinline__ float row16_sum(float v) { v += dpp_f<0xB1>(v); v += dpp_f<0x4E>(v); v += dpp_f<0x141>(v); v += dpp_f<0x140>(v); return v; }
__device__ __forceinline__ float half32_sum(float v) { v = row16_sum(v); v += __int_as_float(__builtin_amdgcn_ds_swizzle(__float_as_int(v), 0x401F)); return v; }
__device__ __forceinline__ float wave_sum(float v) { v = half32_sum(v);
    return __int_as_float(__builtin_amdgcn_readlane(__float_as_int(v), 0)) + __int_as_float(__builtin_amdgcn_readlane(__float_as_int(v), 32)); }
__device__ __forceinline__ int batch_of_row(int row) { return row < MP ? (row >> 13) : NBP + ((row - MP) >> 5); }

namespace pg8 {
#define PG8_LAS __attribute__((address_space(3)))
typedef unsigned short bf16_t;
typedef short bf16x8 __attribute__((ext_vector_type(8)));
typedef float f32x4 __attribute__((ext_vector_type(4)));
typedef unsigned u32x4 __attribute__((ext_vector_type(4)));
constexpr int BM = 256, BK = 64, HALF = 128, HTB = HALF * BK * 2  , STAGE_BYTES = 8 * HTB, NXCD = 8, WGM = 8;

__host__ __device__ __forceinline__ int lds_byte(int r, int c) { const int st = (r >> 4) * 2 + (c >> 5), rr = r & 15, cc = c & 31, ob = rr * 64 + cc * 2; return st * 1024 + (ob ^ (((ob >> 9) & 1) << 5)); }
__host__ __device__ __forceinline__ void stage_rc(int b, int& R, int& C) { const int st = b / 1024, sb = b % 1024, swz = sb ^ (((sb >> 9) & 1) << 5); R = (st >> 1) * 16 + swz / 64; C = (st & 1) * 32 + (swz % 64) / 2; }
__host__ __device__ __forceinline__ int perm32(int rho) { const int n = rho >> 4, i = rho & 15; return 8 * (i >> 2) + 4 * n + (i & 3); }

struct Unit { int pm, pn; };
struct Gemm { const bf16_t* A; const bf16_t* Bt; int M, N, K; };

struct StaticOrder {
    int nM, nN, nwg, G, c;
    __host__ __device__ void init(int M, int N, int G_, int c_) { nM = M / BM; nN = N / BM; nwg = nM * nN; G = G_; c = c_; }
    __host__ __device__ bool next(int i, Unit& u) const {
        const long L = (long)i * G + c; if (L >= nwg) return false;
        int wgid = (int)L; { const int q = nwg / NXCD, r = nwg % NXCD, xcd = wgid % NXCD, off = wgid / NXCD; wgid = (xcd < r ? xcd * (q + 1) : r * (q + 1) + (xcd - r) * q) + off; }
        const int nig = WGM * nN, gid = wgid / nig, fm = gid * WGM, gsz = (nM - fm) < WGM ? (nM - fm) : WGM;
        u.pm = fm + ((wgid % nig) % gsz); u.pn = (wgid % nig) / gsz; return true;
    }
    __device__ __forceinline__ void a_ready(const Unit&) const {}
    __device__ __forceinline__ void done(const Unit&) const {}
};
__device__ __forceinline__ unsigned cvt_pk_bf16(float lo, float hi) { return ::pk2(lo, hi); }
struct EpiZ {
    static constexpr bool PERM = true, AFTER_DRAIN = false;
    bf16_t* Z; int dry;
    __device__ __forceinline__ void operator()(const f32x4 (&acc)[2][2][4][2], const Unit& u, int wr, int wc, int fr, int fq) const {
        const int row0 = u.pm * BM + wr * 64 + fr;
        if (dry) return;
        if (u.pn < 4) {
            const int col0 = 128 * u.pn + wc * 32 + 8 * fq;
#pragma unroll
            for (int ai = 0; ai < 2; ++ai)
#pragma unroll
                for (int m = 0; m < 4; ++m) { bf16_t* rowp = Z + (size_t)(row0 + ai * HALF + m * 16) * ::ZW + col0;
                    const f32x4 a0 = acc[ai][0][m][0], a1 = acc[ai][0][m][1], g0 = acc[ai][1][m][0], g1 = acc[ai][1][m][1];
                    u32x4 w; w.x = cvt_pk_bf16(a0[0] * ::sigmoidf_(g0[0]), a0[1] * ::sigmoidf_(g0[1])); w.y = cvt_pk_bf16(a0[2] * ::sigmoidf_(g0[2]), a0[3] * ::sigmoidf_(g0[3]));
                    w.z = cvt_pk_bf16(a1[0] * ::sigmoidf_(g1[0]), a1[1] * ::sigmoidf_(g1[1])); w.w = cvt_pk_bf16(a1[2] * ::sigmoidf_(g1[2]), a1[3] * ::sigmoidf_(g1[3]));
                    *(u32x4*)rowp = w; }
        } else {
            const float sc = (u.pn < 6) ? ::QSCALE : 1.0f;
            const int col0 = 512 + 256 * (u.pn - 4) + wc * 32 + 8 * fq;
#pragma unroll
            for (int ai = 0; ai < 2; ++ai)
#pragma unroll
                for (int m = 0; m < 4; ++m) { bf16_t* rowp = Z + (size_t)(row0 + ai * HALF + m * 16) * ::ZW + col0;
#pragma unroll
                    for (int bj = 0; bj < 2; ++bj) { const f32x4 v0 = acc[ai][bj][m][0] * sc, v1 = acc[ai][bj][m][1] * sc;
                        u32x4 w; w.x = cvt_pk_bf16(v0[0], v0[1]); w.y = cvt_pk_bf16(v0[2], v0[3]); w.z = cvt_pk_bf16(v1[0], v1[1]); w.w = cvt_pk_bf16(v1[2], v1[3]);
                        *(u32x4*)(rowp + bj * HALF) = w; } }
        }
    }
};
struct EpiMix2 {
    static constexpr bool PERM = true, AFTER_DRAIN = false;
    bf16_t* MIX;
    __device__ __forceinline__ void operator()(const f32x4 (&acc)[2][2][4][2], const Unit& u, int wr, int wc, int fr, int fq) const {
        const int which = u.pn >> 1, pm = u.pm - which * ::NPANEL;
        const int row0 = pm * BM + wr * 64 + fr, col0 = which * 1024 + (u.pn & 1) * 256 + wc * 32 + 8 * fq;
#pragma unroll
        for (int ai = 0; ai < 2; ++ai)
#pragma unroll
            for (int m = 0; m < 4; ++m) { bf16_t* rowp = MIX + (size_t)(row0 + ai * HALF + m * 16) * ::MIXW + col0;
#pragma unroll
                for (int bj = 0; bj < 2; ++bj) { const f32x4 v0 = acc[ai][bj][m][0], v1 = acc[ai][bj][m][1];
                    u32x4 w; w.x = cvt_pk_bf16(v0[0], v0[1]); w.y = cvt_pk_bf16(v0[2], v0[3]); w.z = cvt_pk_bf16(v1[0], v1[1]); w.w = cvt_pk_bf16(v1[2], v1[3]);
                    *(u32x4*)(rowp + bj * HALF) = w; } }
    }
};
struct EpiDelta {
    static constexpr bool PERM = true, AFTER_DRAIN = false;
    bf16_t* D; const float* gate; int dry;
    __device__ __forceinline__ void operator()(const f32x4 (&acc)[2][2][4][2], const Unit& u, int wr, int wc, int fr, int fq) const {
        if (dry) return;
        const int row0 = u.pm * BM + wr * 64 + fr, col0 = u.pn * BM + wc * 32 + 8 * fq;
        const float* gp = gate + (size_t)::batch_of_row(u.pm * BM) * ::NMOD + col0;
        f32x4 gv[2][2];
#pragma unroll
        for (int bj = 0; bj < 2; ++bj)
#pragma unroll
            for (int n = 0; n < 2; ++n) gv[bj][n] = *(const f32x4*)(gp + bj * HALF + 4 * n);
#pragma unroll
        for (int ai = 0; ai < 2; ++ai)
#pragma unroll
            for (int m = 0; m < 4; ++m) { bf16_t* rowp = D + (size_t)(row0 + ai * HALF + m * 16) * ::DM + col0;
#pragma unroll
                for (int bj = 0; bj < 2; ++bj) { const f32x4 v0 = acc[ai][bj][m][0] * gv[bj][0], v1 = acc[ai][bj][m][1] * gv[bj][1];
                    u32x4 w; w.x = cvt_pk_bf16(v0[0], v0[1]); w.y = cvt_pk_bf16(v0[2], v0[3]); w.z = cvt_pk_bf16(v1[0], v1[1]); w.w = cvt_pk_bf16(v1[2], v1[3]);
                    *(u32x4*)(rowp + bj * HALF) = w; } }
    }
};
struct EpiSwi {
    static constexpr bool PERM = true, AFTER_DRAIN = false;
    bf16_t* HID;
    __device__ __forceinline__ void operator()(const f32x4 (&acc)[2][2][4][2], const Unit& u, int wr, int wc, int fr, int fq) const {
        const int row0 = u.pm * BM + wr * 64 + fr, col0 = 128 * u.pn + wc * 32 + 8 * fq;
#pragma unroll
        for (int ai = 0; ai < 2; ++ai)
#pragma unroll
            for (int m = 0; m < 4; ++m) { bf16_t* rowp = HID + (size_t)(row0 + ai * HALF + m * 16) * ::DFF + col0;
                const f32x4 g0 = acc[ai][0][m][0], g1 = acc[ai][0][m][1], u0 = acc[ai][1][m][0], u1 = acc[ai][1][m][1];
                u32x4 w; w.x = cvt_pk_bf16(::siluf_(g0[0]) * u0[0], ::siluf_(g0[1]) * u0[1]); w.y = cvt_pk_bf16(::siluf_(g0[2]) * u0[2], ::siluf_(g0[3]) * u0[3]);
                w.z = cvt_pk_bf16(::siluf_(g1[0]) * u1[0], ::siluf_(g1[1]) * u1[1]); w.w = cvt_pk_bf16(::siluf_(g1[2]) * u1[2], ::siluf_(g1[3]) * u1[3]);
                *(u32x4*)rowp = w; }
    }
};
struct Mix2Order {
    int G, c;
    __device__ __forceinline__ bool next(int i, Unit& u) const {
        const int L = i * G + c; if (L >= 4 * (::MP / 256)) return false;
        const int which = L / (2 * (::MP / 256)), rem = L % (2 * (::MP / 256));
        u.pm = which * ::NPANEL + (rem >> 1); u.pn = which * 2 + (rem & 1); return true;
    }
    __device__ __forceinline__ void a_ready(const Unit&) const {}
    __device__ __forceinline__ void done(const Unit&) const {}
};

template <class Epi, class Sched, bool ALIGN_EPI = false, bool SP2 = false>
__device__ __forceinline__ void gemm_phase(PG8_LAS unsigned char* lds, const Gemm g, const Sched& S, const Epi& E) {
    int tid_ = threadIdx.x; asm volatile("" : "+v"(tid_));
    const int tid = tid_, wid = __builtin_amdgcn_readfirstlane(tid >> 6), lane = tid & 63, wr = wid >> 2, wc = wid & 3, fr = lane & 15, fq = lane >> 4;
    const int K = g.K, nt = K / BK;
    unsigned voffA[2], voffB[2];
#pragma unroll
    for (int i = 0; i < 2; ++i) { int R, C; stage_rc(tid * 16 + i * 8192, R, C); const int Rb = Epi::PERM ? ((R & ~31) + perm32(R & 31)) : R;
        voffA[i] = (unsigned)(R * K + C) * 2u; voffB[i] = (unsigned)(Rb * K + C) * 2u; }
    const size_t kstep = (size_t)(BK * 2);
    const size_t hstep = (size_t)HALF * K * 2;
    const size_t tstep = 2 * hstep;
    const unsigned ldsw = (unsigned)wid * 1024u;
    const int aoff = lds_byte(wr * 64 + fr, fq * 8), boff = lds_byte(wc * 32 + fr, fq * 8);
#define PG8_SA(b, h) (((b) * 2 + (h)) * HTB)
#define PG8_SB(b, h) ((4 + (b) * 2 + (h)) * HTB)
#define PG8_STAGE(bufoff, gbase, voff) do { _Pragma("unroll") for (int _i = 0; _i < 2; ++_i) \
        __builtin_amdgcn_global_load_lds((const unsigned*)((const char*)(gbase) + (voff)[_i]), (PG8_LAS unsigned*)(lds + (bufoff) + ldsw + _i * 8192), 16, 0, 0); } while (0)
#define PG8_LDA(dst, b, h) do { _Pragma("unroll") for (int m = 0; m < 4; ++m) _Pragma("unroll") for (int k = 0; k < 2; ++k) dst[m][k] = *(const PG8_LAS bf16x8*)(lds + PG8_SA(b, h) + aoff + m * 2048 + k * 1024); } while (0)
#define PG8_LDB(dst, b, h) do { _Pragma("unroll") for (int n = 0; n < 2; ++n) _Pragma("unroll") for (int k = 0; k < 2; ++k) dst[n][k] = *(const PG8_LAS bf16x8*)(lds + PG8_SB(b, h) + boff + n * 2048 + k * 1024); } while (0)
#define PG8_MMA(ai, bj, At, Bt) do { __builtin_amdgcn_s_setprio(1); _Pragma("unroll") for (int m = 0; m < 4; ++m) _Pragma("unroll") for (int n = 0; n < 2; ++n) _Pragma("unroll") for (int k = 0; k < 2; ++k) \
        acc[ai][bj][m][n] = __builtin_amdgcn_mfma_f32_16x16x32_bf16(Bt[n][k], At[m][k], acc[ai][bj][m][n], 0, 0, 0); __builtin_amdgcn_s_setprio(0); } while (0)
#define PG8_WAIT_V(n) asm volatile("s_waitcnt vmcnt(" #n ")" ::: "memory")
#define PG8_WAIT_L(n) asm volatile("s_waitcnt lgkmcnt(" #n ")" ::: "memory")
#define PG8_BAR __builtin_amdgcn_s_barrier()
#define PG8_SCHED __builtin_amdgcn_sched_barrier(0)
    Unit cur, nxt; int ui = 0;
    if (!S.next(0, cur)) return;
    f32x4 acc[2][2][4][2];
#pragma unroll
    for (int a = 0; a < 2; ++a)
#pragma unroll
        for (int b = 0; b < 2; ++b)
#pragma unroll
            for (int m = 0; m < 4; ++m)
#pragma unroll
                for (int n = 0; n < 2; ++n) acc[a][b][m][n] = (f32x4){0.f, 0.f, 0.f, 0.f};
    bf16x8 At[4][2], B0[2][2], B1[2][2];
    const char* cA = (const char*)g.A + (size_t)cur.pm * tstep; const char* cB = (const char*)g.Bt + (size_t)cur.pn * tstep;
    S.a_ready(cur);
    if constexpr (SP2) {
        PG8_STAGE(PG8_SB(0, 0), cB, voffB); PG8_STAGE(PG8_SB(0, 1), cB + hstep, voffB); PG8_STAGE(PG8_SA(0, 0), cA, voffA); PG8_STAGE(PG8_SA(0, 1), cA + hstep, voffA);
        if (wr == 1) PG8_BAR;
        PG8_WAIT_V(2); PG8_BAR;
        PG8_STAGE(PG8_SB(1, 0), cB + kstep, voffB); PG8_STAGE(PG8_SA(1, 0), cA + kstep, voffA); PG8_STAGE(PG8_SB(1, 1), cB + hstep + kstep, voffB);
        PG8_WAIT_V(6); PG8_BAR;
    } else {
        PG8_STAGE(PG8_SB(0, 0), cB, voffB); PG8_STAGE(PG8_SA(0, 0), cA, voffA); PG8_STAGE(PG8_SB(0, 1), cB + hstep, voffB); PG8_STAGE(PG8_SA(0, 1), cA + hstep, voffA);
        if (wr == 1) PG8_BAR;
        PG8_WAIT_V(4); PG8_BAR;
        PG8_STAGE(PG8_SB(1, 0), cB + kstep, voffB); PG8_STAGE(PG8_SA(1, 0), cA + kstep, voffA); PG8_STAGE(PG8_SB(1, 1), cB + hstep + kstep, voffB);
        PG8_WAIT_V(6); PG8_BAR;
    }
    for (;;) {
        const bool has_next = S.next(ui + 1, nxt);
        const char* nA = has_next ? (const char*)g.A + (size_t)nxt.pm * tstep : cA; const char* nB = has_next ? (const char*)g.Bt + (size_t)nxt.pn * tstep : cB;
        for (int t = 0; t < nt; t += 2) {
            const bool last = (t == nt - 2);
            const char* a1 = cA + (size_t)(t + 1) * kstep;
            const char* a2 = last ? nA : cA + (size_t)(t + 2) * kstep; const char* b2 = last ? nB : cB + (size_t)(t + 2) * kstep;
            const char* a3 = a2 + kstep; const char* b3 = b2 + kstep;
            if (last && has_next) S.a_ready(nxt);
            if constexpr (SP2) {
            PG8_LDB(B0, 0, 0); PG8_LDB(B1, 0, 1); PG8_SCHED; PG8_LDA(At, 0, 0); PG8_STAGE(PG8_SA(1, 1), a1 + hstep, voffA);
            PG8_WAIT_V(8); PG8_WAIT_L(0); PG8_BAR; PG8_MMA(0, 0, At, B0); PG8_MMA(0, 1, At, B1); PG8_BAR; PG8_SCHED;
            PG8_LDA(At, 0, 1); PG8_STAGE(PG8_SB(0, 0), b2, voffB); PG8_STAGE(PG8_SB(0, 1), b2 + hstep, voffB); PG8_STAGE(PG8_SA(0, 0), a2, voffA);
            PG8_WAIT_V(8); PG8_WAIT_L(0); PG8_BAR; PG8_MMA(1, 0, At, B0); PG8_MMA(1, 1, At, B1); PG8_BAR; PG8_SCHED;
            PG8_LDB(B0, 1, 0); PG8_LDB(B1, 1, 1); PG8_SCHED; PG8_LDA(At, 1, 0); PG8_STAGE(PG8_SA(0, 1), a2 + hstep, voffA);
            PG8_WAIT_V(8); PG8_WAIT_L(0); PG8_BAR; PG8_MMA(0, 0, At, B0); PG8_MMA(0, 1, At, B1); PG8_BAR; PG8_SCHED;
            PG8_LDA(At, 1, 1); PG8_STAGE(PG8_SB(1, 0), b3, voffB); PG8_STAGE(PG8_SB(1, 1), b3 + hstep, voffB); PG8_STAGE(PG8_SA(1, 0), a3, voffA);
            PG8_WAIT_V(8); PG8_WAIT_L(0); PG8_BAR; PG8_MMA(1, 0, At, B0); PG8_MMA(1, 1, At, B1); PG8_BAR; PG8_SCHED;
            } else {
            PG8_LDB(B0, 0, 0); PG8_SCHED; PG8_LDA(At, 0, 0); PG8_STAGE(PG8_SA(1, 1), a1 + hstep, voffA);
            PG8_WAIT_L(8); PG8_BAR; PG8_WAIT_L(0); PG8_MMA(0, 0, At, B0); PG8_BAR; PG8_SCHED;
            PG8_LDB(B1, 0, 1); PG8_STAGE(PG8_SB(0, 0), b2, voffB);
            PG8_BAR; PG8_WAIT_L(0); PG8_MMA(0, 1, At, B1); PG8_BAR;
            PG8_LDA(At, 0, 1); PG8_STAGE(PG8_SA(0, 0), a2, voffA);
            PG8_BAR; PG8_WAIT_L(0); PG8_MMA(1, 0, At, B0); PG8_BAR; PG8_SCHED;
            PG8_STAGE(PG8_SB(0, 1), b2 + hstep, voffB);
            PG8_WAIT_V(6); PG8_BAR; PG8_MMA(1, 1, At, B1); PG8_BAR;
            PG8_LDB(B0, 1, 0); PG8_SCHED; PG8_LDA(At, 1, 0); PG8_STAGE(PG8_SA(0, 1), a2 + hstep, voffA);
            PG8_WAIT_L(8); PG8_BAR; PG8_WAIT_L(0); PG8_MMA(0, 0, At, B0); PG8_BAR; PG8_SCHED;
            PG8_LDB(B1, 1, 1); PG8_STAGE(PG8_SB(1, 0), b3, voffB);
            PG8_BAR; PG8_WAIT_L(0); PG8_MMA(0, 1, At, B1); PG8_BAR;
            PG8_LDA(At, 1, 1); PG8_STAGE(PG8_SA(1, 0), a3, voffA);
            PG8_BAR; PG8_WAIT_L(0); PG8_MMA(1, 0, At, B0); PG8_BAR; PG8_SCHED;
            PG8_STAGE(PG8_SB(1, 1), b3 + hstep, voffB);
            PG8_WAIT_V(6); PG8_BAR; PG8_MMA(1, 1, At, B1); PG8_BAR;
            }
        }
        if constexpr (ALIGN_EPI) { if (wr == 0) PG8_BAR; }
        if constexpr (!Epi::AFTER_DRAIN) { E(acc, cur, wr, wc, fr, fq);
#if PROBE_EPI2
            if constexpr (Epi::PERM) { asm volatile("" ::: "memory"); E(acc, cur, wr, wc, fr, fq); }
#endif
            S.done(cur); }
        if (!has_next) break;
#pragma unroll
        for (int a = 0; a < 2; ++a)
#pragma unroll
            for (int b = 0; b < 2; ++b)
#pragma unroll
                for (int m = 0; m < 4; ++m)
#pragma unroll
                    for (int n = 0; n < 2; ++n) acc[a][b][m][n] = (f32x4){0.f, 0.f, 0.f, 0.f};
        cur = nxt; cA = nA; cB = nB; ++ui;
        if constexpr (ALIGN_EPI) { if (wr == 1) PG8_BAR; }
    }
    PG8_WAIT_V(0);
    if constexpr (!ALIGN_EPI) { if (wr == 0) PG8_BAR; }
    PG8_BAR;
    if constexpr (Epi::AFTER_DRAIN) { E.fused(acc, cur, wr, wc, fr, fq, lds, wid, lane); S.done(cur); }
#undef PG8_SA
#undef PG8_SB
#undef PG8_STAGE
#undef PG8_LDA
#undef PG8_LDB
#undef PG8_MMA
#undef PG8_WAIT_V
#undef PG8_WAIT_L
#undef PG8_BAR
#undef PG8_SCHED
}
}
#define XB_TMO      128
#define XB_XCNT(j)  (256  + 64 * (j))
#define XB_XSUB(j)  (1280 + 64 * (j))
#define XB_XGEN(j)  (2304 + 64 * (j))
#define XB_TOP      3328
#define XB_TOPGEN   3392
#define XCD_BAR_WORDS 3456
#define XB_SPIN_CAP (1u << 18)

__device__ __forceinline__ unsigned xb_ld(unsigned* p)              { return __hip_atomic_load(p, __ATOMIC_RELAXED, __HIP_MEMORY_SCOPE_AGENT); }
__device__ __forceinline__ unsigned xb_add(unsigned* p, unsigned v) { return __hip_atomic_fetch_add(p, v, __ATOMIC_RELAXED, __HIP_MEMORY_SCOPE_AGENT); }
__device__ __forceinline__ unsigned xb_xcc_id() { return (unsigned)__builtin_amdgcn_s_getreg((3 << 11) | 20) & 0xFu; }
#define XB_SPIN(cond, bar) do { unsigned _sp = 0; while (cond) { __builtin_amdgcn_s_sleep(1); \
    if ((++_sp & 255u) == 0u) { if (xb_ld(&(bar)[XB_TMO])) break; if (_sp > XB_SPIN_CAP) { atomicAdd(&(bar)[XB_TMO], 1u); break; } } } } while (0)

struct XcdBarrier {
    unsigned* bar; unsigned x;
    volatile LAS unsigned* st;
};

__device__ __forceinline__ XcdBarrier xcd_barrier_post(unsigned* bar, volatile LAS unsigned* st) {
    XcdBarrier b; b.bar = bar; b.x = xb_xcc_id(); b.st = st;
    if (threadIdx.x == 0) (void)xb_add(&bar[XB_XCNT(b.x)], 1u);
    return b;
}
__device__ __forceinline__ void xcd_barrier_complete(unsigned* bar, unsigned x, unsigned& nloc, unsigned& nx) {
    const unsigned G = gridDim.x * gridDim.y * gridDim.z;
    unsigned sum, cnt, mine, sp = 0u;
    for (;;) {
        sum = 0u; cnt = 0u; mine = 0u;
#pragma unroll
        for (unsigned j = 0; j < 16; ++j) { const unsigned c = xb_ld(&bar[XB_XCNT(j)]); sum += c; cnt += (c > 0u) ? 1u : 0u; mine = (j == x) ? c : mine; }
        if (sum == G) break;
        __builtin_amdgcn_s_sleep(1);
        if ((++sp & 255u) == 0u) { if (xb_ld(&bar[XB_TMO])) break; if (sp > XB_SPIN_CAP) { atomicAdd(&bar[XB_TMO], 1u); break; } }
    }
    nloc = mine > 0u ? mine : 1u; nx = cnt > 0u ? cnt : 1u;
}

__device__ __forceinline__ void xcd_barrier(const XcdBarrier& b) {
    asm volatile("s_waitcnt vmcnt(0)" ::: "memory");
    __syncthreads();
    if (threadIdx.x == 0) {
        unsigned* bar = b.bar;
        __builtin_amdgcn_s_waitcnt(0);
        unsigned nloc = b.st[0], nx = b.st[1];
        if (nloc == 0u) { xcd_barrier_complete(bar, b.x, nloc, nx); b.st[0] = nloc; b.st[1] = nx; }
        const unsigned old = xb_add(&bar[XB_XSUB(b.x)], 1u);
        const unsigned gen = old / nloc;
        if (old + 1u == (gen + 1u) * nloc) {
            __builtin_amdgcn_fence(__ATOMIC_RELEASE, "agent");
            asm volatile("s_waitcnt vmcnt(0)" ::: "memory");
            const unsigned og = xb_add(&bar[XB_TOP], 1u);
            const unsigned tg = og / nx;
            if (og + 1u == (tg + 1u) * nx) xb_add(&bar[XB_TOPGEN], 1u);
            else XB_SPIN(xb_ld(&bar[XB_TOPGEN]) == tg, bar);
            __builtin_amdgcn_fence(__ATOMIC_ACQUIRE, "agent");
            xb_add(&bar[XB_XGEN(b.x)], 1u);
            asm volatile("s_waitcnt vmcnt(0)" ::: "memory");
        } else {
            XB_SPIN(xb_ld(&bar[XB_XGEN(b.x)]) == gen, bar);
            __builtin_amdgcn_fence(__ATOMIC_ACQUIRE, "agent");
            asm volatile("s_waitcnt vmcnt(0)" ::: "memory");
        }
    }
    __syncthreads();
}
struct Args { const float* in[N_IN]; float* out; unsigned char* ws; int ph_lo, ph_hi, pad0, pad1; };
static_assert(sizeof(Args) == (N_IN + 2) * 8 + 16, "Args has no padding");
struct DevArgs { const GAS float* in[N_IN]; GAS float* out; GAS unsigned char* ws; int ph_lo, ph_hi, pad0, pad1; };
static_assert(sizeof(DevArgs) == sizeof(Args), "DevArgs mirrors Args");
typedef const __attribute__((address_space(4))) DevArgs* KArgs;
#define INP(i) ((const float*)F.ka->in[i])
struct Frame {
    LAS unsigned char* lds;
    int tid, lane, wave, vcu, G;
    KArgs ka;
    float* out; unsigned char* ws;
};
__device__ __forceinline__ const float* modp(const Frame& F, int layer) { return (const float*)(F.ws + WS_MOD) + (size_t)layer * 12 * NMOD; }
__device__ __forceinline__ unsigned char* lw(const Frame& F, int layer) { return F.ws + WS_W + (size_t)layer * LW; }

__device__ __forceinline__ void transpose_item(const float* W, int K, int N, bf16* WT, int k0, int n0, int orow0, LAS float* scr, int lane) {
#pragma unroll 8
    for (int i = 0; i < 32; ++i) { const int kk = 2 * i + (lane >> 5); scr[kk * 33 + (lane & 31)] = W[(size_t)(k0 + kk) * N + n0 + (lane & 31)]; }
    LDS_WAIT(); asm volatile("" ::: "memory");
    const int c = lane & 7;
#pragma unroll
    for (int j = 0; j < 4; ++j) { const int n = (lane >> 3) + 8 * j; const LAS float* s = scr + (8 * c) * 33 + n;
        v4u o; o.x = pk2(s[0 * 33], s[1 * 33]); o.y = pk2(s[2 * 33], s[3 * 33]); o.z = pk2(s[4 * 33], s[5 * 33]); o.w = pk2(s[6 * 33], s[7 * 33]);
        *(GAS v4u*)(WT + (size_t)(orow0 + n) * K + k0 + 8 * c) = o; }
    LDS_WAIT(); asm volatile("" ::: "memory");
}
__device__ __forceinline__ void p0a_phase(Frame& F) {
    const int gw = F.vcu * NWAVES + F.wave, NGW = F.G * NWAVES, gt = F.vcu * (NWAVES * 64) + F.tid, NGT = F.G * NWAVES * 64;
    {
        LAS float* sil = (LAS float*)F.lds;
        for (int i = F.tid; i < 12 * DM; i += NWAVES * 64) { const int b = i / DM, k = i % DM;
            const float c = b < NBP ? INP(I_CP)[b * DM + k] : INP(I_CS)[(b - NBP) * DM + k]; sil[k * 12 + b] = siluf_(c); }
        __syncthreads();
        constexpr int KC = DM / KSPLIT, NCB = NMOD / 256;
        float* part = (float*)(F.ws + WS_MODP);
        for (int it = gw; it < NL * KSPLIT * NCB; it += NGW) {
            const int l = it / (KSPLIT * NCB), ks = (it / NCB) % KSPLIT, cb = it % NCB, col = cb * 256 + 4 * F.lane;
            const GAS f32x4* wp = (const GAS f32x4*)(INP(I_ADAW) + ((size_t)l * DM + ks * KC) * NMOD + col);
            f32x4 acc[12];
#pragma unroll
            for (int b = 0; b < 12; ++b) acc[b] = (f32x4){0.f, 0.f, 0.f, 0.f};
#pragma unroll 4
            for (int k = 0; k < KC; ++k) { const f32x4 wv = wp[(size_t)k * (NMOD / 4)];
                const LAS f32x4* sp = (const LAS f32x4*)(sil + (ks * KC + k) * 12); const f32x4 s0 = sp[0], s1 = sp[1], s2 = sp[2];
                acc[0] += wv * s0[0]; acc[1] += wv * s0[1]; acc[2] += wv * s0[2]; acc[3] += wv * s0[3];
                acc[4] += wv * s1[0]; acc[5] += wv * s1[1]; acc[6] += wv * s1[2]; acc[7] += wv * s1[3];
                acc[8] += wv * s2[0]; acc[9] += wv * s2[1]; acc[10] += wv * s2[2]; acc[11] += wv * s2[3]; }
#pragma unroll
            for (int b = 0; b < 12; ++b) *(GAS f32x4*)(part + (((size_t)ks * NL + l) * 12 + b) * NMOD + col) = acc[b];
        }
        __syncthreads();
    }
    {
        LAS float* scr = (LAS float*)(F.lds + F.wave * 16384);
        constexpr int I_IN = (DM / 64) * (DIN / 32), I_OUT = (DM / 64) * (DM / 32), I_G = (DM / 64) * (DFF / 32), I_D = (DFF / 64) * (DM / 32), I_C = (DC / 64) * (DC / 32);
        constexpr int PER_L = I_IN + I_OUT + 2 * I_G + I_D + I_C;
        for (int it = gw; it < NL * PER_L; it += NGW) {
            const int l = it / PER_L; int r = it % PER_L; unsigned char* wl = lw(F, l);
            if (r < I_IN) { const int nblk = DIN / 32, k0 = 64 * (r / nblk), n0 = 32 * (r % nblk);
                int orow0 = n0; if (n0 < 512) orow0 = 256 * (n0 >> 7) + (n0 & 127); else if (n0 < 1024) orow0 = 256 * ((n0 - 512) >> 7) + 128 + (n0 & 127);
                transpose_item(INP(I_WIN) + (size_t)l * DM * DIN, DM, DIN, (bf16*)(wl + LW_WIN), k0, n0, orow0, scr, F.lane); continue; } r -= I_IN;
            if (r < I_OUT) { const int nblk = DM / 32, k0 = 64 * (r / nblk), n0 = 32 * (r % nblk);
                transpose_item(INP(I_WOUT) + (size_t)l * DM * DM, DM, DM, (bf16*)(wl + LW_WOUT), k0, n0, n0, scr, F.lane); continue; } r -= I_OUT;
            if (r < 2 * I_G) { const int up = r >= I_G; if (up) r -= I_G; const int nblk = DFF / 32, k0 = 64 * (r / nblk), n0 = 32 * (r % nblk);
                const int orow0 = 256 * (n0 >> 7) + 128 * up + (n0 & 127);
                transpose_item(INP(up ? I_WU : I_WG) + (size_t)l * DM * DFF, DM, DFF, (bf16*)(wl + LW_WGU), k0, n0, orow0, scr, F.lane); continue; } r -= 2 * I_G;
            if (r < I_D) { const int nblk = DM / 32, k0 = 64 * (r / nblk), n0 = 32 * (r % nblk);
                transpose_item(INP(I_WD) + (size_t)l * DFF * DM, DFF, DM, (bf16*)(wl + LW_WD), k0, n0, n0, scr, F.lane); continue; } r -= I_D;
            { const int nblk = DC / 32, k0 = 64 * (r / nblk), n0 = 32 * (r % nblk);
                transpose_item(INP(I_CPW) + (size_t)l * DC * DC, DC, DC, (bf16*)(wl + LW_CPW), k0, n0, n0, scr, F.lane); }
        }
        for (int i = gt; i < NL * DC * DC; i += NGT) { const int l = i / (DC * DC), n = (i / DC) % DC, k = i % DC; float v = 0.f;
            if ((n >> 7) == (k >> 7)) v = INP(I_POOLW)[(((size_t)l * 4 + (n >> 7)) * 128 + (k & 127)) * 128 + (n & 127)] * INP(I_POOLS)[l * DC + n];
            ((bf16*)(lw(F, l) + LW_PWD))[n * DC + k] = (bf16)(pk2(v, 0.f) & 0xffffu); }
        for (int i = gt; i < NL * 4 * 128 * 128; i += NGT) { const int l = i / 65536, r = i % 65536, ii = (r >> 7) & 127, jj = r & 127;
            const float v = (jj <= ii) ? INP(I_SGW)[i] : 0.f; ((bf16*)(lw(F, l) + LW_SGW))[r] = (bf16)(pk2(v, 0.f) & 0xffffu); }
    }
    __syncthreads();
}
__device__ __forceinline__ void p0b_phase(Frame& F) {
    const int gt = F.vcu * (NWAVES * 64) + F.tid, NGT = F.G * NWAVES * 64;
    const float* part = (const float*)(F.ws + WS_MODP); float* mod = (float*)(F.ws + WS_MOD);
    for (int i = gt; i < NL * 12 * NMOD; i += NGT) { const int l = i / (12 * NMOD), n = i % NMOD; float s = INP(I_ADAB)[l * NMOD + n];
#pragma unroll
        for (int ks = 0; ks < KSPLIT; ++ks) s += part[(size_t)ks * NL * 12 * NMOD + i];
        mod[i] = s; }
}
template <bool COPY, bool DELTA>
__device__ __forceinline__ void norm_phase(Frame& F, const float* gain, const float* mod_l, int sh_idx, bf16* H, const bf16* D) {
    const int gw = F.vcu * NWAVES + F.wave, NGW = F.G * NWAVES;
    float* X = F.out;
    for (int m = gw; m < MT; m += NGW) {
        const float* src = COPY ? (m < MP ? INP(I_XP) + (size_t)m * DM : INP(I_XS) + (size_t)(m - MP) * DM) : X + (size_t)m * DM;
        const GAS f32x4* xr = (const GAS f32x4*)src + F.lane;
        f32x4 v[8]; float s = 0.f;
#pragma unroll
        for (int j = 0; j < 8; ++j) v[j] = xr[64 * j];
        if (DELTA) { const GAS v2u* dr = (const GAS v2u*)(D + (size_t)m * DM) + F.lane;
#pragma unroll
            for (int j = 0; j < 8; ++j) { const v2u d = dr[64 * j]; v[j] += (f32x4){bflo(d.x), bfhi(d.x), bflo(d.y), bfhi(d.y)}; } }
#pragma unroll
        for (int j = 0; j < 8; ++j) s += (v[j].x * v[j].x + v[j].y * v[j].y) + (v[j].z * v[j].z + v[j].w * v[j].w);
        if (COPY || DELTA) { GAS f32x4* xo = (GAS f32x4*)(X + (size_t)m * DM) + F.lane;
#pragma unroll
            for (int j = 0; j < 8; ++j) xo[64 * j] = v[j]; }
        const float rstd = 1.0f / sqrtf(wave_sum(s) * (1.0f / DM) + EPS);
        const float* mb = mod_l + (size_t)batch_of_row(m) * NMOD;
        const GAS f32x4* shp = (const GAS f32x4*)(mb + sh_idx * DM) + F.lane; const GAS f32x4* scp = (const GAS f32x4*)(mb + (sh_idx + 1) * DM) + F.lane;
        const GAS f32x4* gp = (const GAS f32x4*)gain + F.lane;
        GAS v2u* o8 = (GAS v2u*)(H + (size_t)m * DM) + F.lane;
#pragma unroll
        for (int j = 0; j < 8; ++j) { const f32x4 g = gp[64 * j], sc = scp[64 * j], sh = shp[64 * j];
            const f32x4 y = v[j] * rstd * g * (sc + 1.0f) + sh; v2u w; w.x = pk2(y.x, y.y); w.y = pk2(y.z, y.w); o8[64 * j] = w; }
    }
}
__device__ __forceinline__ void final_norm_phase(Frame& F, const bf16* D) {
    const int gw = F.vcu * NWAVES + F.wave, NGW = F.G * NWAVES;
    for (int m = gw; m < MT; m += NGW) {
        GAS f32x4* xr = (GAS f32x4*)(F.out + (size_t)m * DM) + F.lane;
        const GAS v2u* dr = (const GAS v2u*)(D + (size_t)m * DM) + F.lane;
        f32x4 v[8]; float s = 0.f;
#pragma unroll
        for (int j = 0; j < 8; ++j) { const v2u d = dr[64 * j]; v[j] = xr[64 * j] + (f32x4){bflo(d.x), bfhi(d.x), bflo(d.y), bfhi(d.y)}; s += (v[j].x * v[j].x + v[j].y * v[j].y) + (v[j].z * v[j].z + v[j].w * v[j].w); }
        const float rstd = 1.0f / sqrtf(wave_sum(s) * (1.0f / DM) + EPS);
        const GAS f32x4* gp = (const GAS f32x4*)INP(I_FING) + F.lane;
#pragma unroll
        for (int j = 0; j < 8; ++j) xr[64 * j] = v[j] * rstd * gp[64 * j];
    }
}

__device__ __forceinline__ int crow(int r, int hi) { return (r & 3) + 8 * (r >> 2) + 4 * hi; }
#define MFMA32(a, b, c) __builtin_amdgcn_mfma_f32_32x32x16_bf16((a), (b), (c), 0, 0, 0)
constexpr int AT_KP = 144, AT_VP = 192, AT_KB = 64 * AT_KP, AT_VB = 64 * AT_VP;
constexpr int AT_K0 = 0, AT_V0 = 2 * AT_KB, AT_BT = AT_V0 + 2 * AT_VB;
typedef short v4i16_t __attribute__((ext_vector_type(4)));
__device__ __forceinline__ v2u lds_tr_read(LAS unsigned char* p) { const v4i16_t r = __builtin_amdgcn_ds_read_tr16_b64_v4i16((LAS v4i16_t*)p); return __builtin_bit_cast(v2u, r); }
__device__ __forceinline__ float xhalf_max(float v) { auto rr = __builtin_amdgcn_permlane32_swap(__float_as_uint(v), __float_as_uint(v), false, false); return fmaxf(__uint_as_float(rr[0]), __uint_as_float(rr[1])); }
__device__ __forceinline__ float xhalf_sum(float v) { auto rr = __builtin_amdgcn_permlane32_swap(__float_as_uint(v), __float_as_uint(v), false, false); return __uint_as_float(rr[0]) + __uint_as_float(rr[1]); }
__device__ __forceinline__ void attn_unit(Frame& F, int layer, bool sample, int b, int h, int qg, const bf16* Z, bf16* MIX) {
    const int tid = F.tid, lane = F.lane, w = F.wave, l31 = lane & 31, hh = lane >> 5;
    LAS float* bt = (LAS float*)(F.lds + AT_BT);
    if (tid < 257) bt[tid] = INP(I_RELB)[((size_t)layer * 8 + h) * 257 + tid] * LOG2E;
    const bool wave_on = sample ? (w == 0) : true;
    const int qpos = sample ? l31 : 256 * qg + 32 * w + l31;
    const int qrow = sample ? MP + 32 * b + l31 : b * SEQ + qpos;
    bf16x8 qr[4];
#pragma unroll
    for (int d0 = 0; d0 < 4; ++d0) qr[d0] = *(const GAS bf16x8*)(Z + (size_t)qrow * ZW + ZQ + 64 * h + 16 * d0 + 8 * hh);
    f32x16 o0, o1;
#pragma unroll
    for (int r = 0; r < 16; ++r) { o0[r] = 0.f; o1[r] = 0.f; }
    float mrun = -1e30f, lrun = 0.f;
    const int ntile = sample ? 9 : 12, qc = 4 * qg + (w >> 1);
    const int jstart = sample ? 0 : (4 * qg >= 8 ? 0 : 8 - 4 * qg);
    const int sr = tid >> 3, sch = tid & 7;
    const float* ck = INP(I_CK) + ((size_t)layer * NBS + b) * 512 * 512; const float* cv = INP(I_CV) + ((size_t)layer * NBS + b) * 512 * 512;
    v4u kreg = (v4u){0u, 0u, 0u, 0u}, vreg = (v4u){0u, 0u, 0u, 0u};
#define AT_LOAD(j) do { \
        if (!sample) { const bf16* zr_ = Z + (size_t)(b * SEQ + 64 * (4 * qg - 8 + (j)) + sr) * ZW + 64 * h + 8 * sch; kreg = *(const GAS v4u*)(zr_ + ZK); vreg = *(const GAS v4u*)(zr_ + ZV); } \
        else if ((j) < 8) { const size_t o_ = ((size_t)(64 * (j) + sr) * 8 + h) * 64 + 8 * sch; \
                const f32x4 k0_ = *(const GAS f32x4*)(ck + o_), k1_ = *(const GAS f32x4*)(ck + o_ + 4), v0_ = *(const GAS f32x4*)(cv + o_), v1_ = *(const GAS f32x4*)(cv + o_ + 4); \
                kreg = (v4u){pk2(k0_.x, k0_.y), pk2(k0_.z, k0_.w), pk2(k1_.x, k1_.y), pk2(k1_.z, k1_.w)}; vreg = (v4u){pk2(v0_.x, v0_.y), pk2(v0_.z, v0_.w), pk2(v1_.x, v1_.y), pk2(v1_.z, v1_.w)}; } \
        else if (sr < 32) { const bf16* zr_ = Z + (size_t)(MP + 32 * b + sr) * ZW + 64 * h + 8 * sch; kreg = *(const GAS v4u*)(zr_ + ZK); vreg = *(const GAS v4u*)(zr_ + ZV); } \
        else { kreg = (v4u){0u, 0u, 0u, 0u}; vreg = (v4u){0u, 0u, 0u, 0u}; } } while (0)
#define AT_STORE(bf_) do { *(LAS v4u*)(F.lds + AT_K0 + (bf_) * AT_KB + sr * AT_KP + sch * 16) = kreg; *(LAS v4u*)(F.lds + AT_V0 + (bf_) * AT_VB + sr * AT_VP + sch * 16) = vreg; } while (0)
    AT_LOAD(jstart); AT_STORE(0);
    __syncthreads();
    const int tro = ((lane & 15) >> 2) * AT_VP + (16 * ((lane >> 4) & 1) + 4 * (lane & 3)) * 2 + 4 * hh * AT_VP;
    int buf = 0;
    for (int j = jstart; j < ntile; ++j) {
        const int kc = 4 * qg - 8 + j;
        const bool more = j + 1 < ntile;
        if (more) AT_LOAD(j + 1);
        const bool active = sample ? (w == 0) : (kc >= qc - 8 && kc <= qc);
        if (active) {
            LAS unsigned char* Ks = F.lds + AT_K0 + buf * AT_KB; LAS unsigned char* Vs = F.lds + AT_V0 + buf * AT_VB + tro;
            f32x16 p0, p1;
#pragma unroll
            for (int r = 0; r < 16; ++r) { p0[r] = 0.f; p1[r] = 0.f; }
#pragma unroll
            for (int d0 = 0; d0 < 4; ++d0) {
                const bf16x8 a0 = *(const LAS bf16x8*)(Ks + l31 * AT_KP + (16 * d0 + 8 * hh) * 2);
                const bf16x8 a1 = *(const LAS bf16x8*)(Ks + (32 + l31) * AT_KP + (16 * d0 + 8 * hh) * 2);
                p0 = MFMA32(a0, qr[d0], p0); p1 = MFMA32(a1, qr[d0], p1);
            }
            const int kbase = sample ? 64 * j - 512 : 64 * kc;
            const int relb = kbase - qpos;
            const int qmin = sample ? 0 : 256 * qg + 32 * w;
            float boff = 0.f;
            if (kbase + 63 - qmin <= -128) boff = bt[0];
            else {
#pragma unroll
                for (int r = 0; r < 16; ++r) { const int kv = crow(r, hh); int i0 = relb + kv, i1 = i0 + 32;
                    i0 = (i0 < -128 ? -128 : (i0 > 128 ? 128 : i0)) + 128; i1 = (i1 < -128 ? -128 : (i1 > 128 ? 128 : i1)) + 128;
                    p0[r] += bt[i0]; p1[r] += bt[i1]; }
            }
            if (sample && j == 8) {
#pragma unroll
                for (int r = 0; r < 16; ++r) p1[r] = -1e30f;
            }
            float mx = p0[0];
#pragma unroll
            for (int r = 1; r < 16; ++r) mx = fmaxf(mx, p0[r]);
#pragma unroll
            for (int r = 0; r < 16; ++r) mx = fmaxf(mx, p1[r]);
            mx = xhalf_max(mx) + boff;
            const float mn = fmaxf(mrun, mx), msub = mn - boff;
            if (__builtin_amdgcn_ballot_w64(mn > mrun) != 0ull) {
                const float alpha = fast_exp2(mrun - mn); lrun *= alpha;
#pragma unroll
                for (int r = 0; r < 16; ++r) { o0[r] *= alpha; o1[r] *= alpha; }
            }
            mrun = mn;
            float rs = 0.f;
#pragma unroll
            for (int r = 0; r < 16; ++r) { p0[r] = fast_exp2(p0[r] - msub); p1[r] = fast_exp2(p1[r] - msub); rs += p0[r] + p1[r]; }
            lrun += xhalf_sum(rs);
            bf16x8 pf[4];
            { v4u t;
              t = (v4u){pk2(p0[0], p0[1]), pk2(p0[2], p0[3]), pk2(p0[4], p0[5]), pk2(p0[6], p0[7])}; pf[0] = __builtin_bit_cast(bf16x8, t);
              t = (v4u){pk2(p0[8], p0[9]), pk2(p0[10], p0[11]), pk2(p0[12], p0[13]), pk2(p0[14], p0[15])}; pf[1] = __builtin_bit_cast(bf16x8, t);
              t = (v4u){pk2(p1[0], p1[1]), pk2(p1[2], p1[3]), pk2(p1[4], p1[5]), pk2(p1[6], p1[7])}; pf[2] = __builtin_bit_cast(bf16x8, t);
              t = (v4u){pk2(p1[8], p1[9]), pk2(p1[10], p1[11]), pk2(p1[12], p1[13]), pk2(p1[14], p1[15])}; pf[3] = __builtin_bit_cast(bf16x8, t); }
#pragma unroll
            for (int xt = 0; xt < 2; ++xt)
#pragma unroll
                for (int s = 0; s < 2; ++s) { const int ro = (32 * xt + 16 * s) * AT_VP;
                    const v2u lo0 = lds_tr_read(Vs + ro), hi0 = lds_tr_read(Vs + ro + 8 * AT_VP);
                    const v2u lo1 = lds_tr_read(Vs + ro + 64), hi1 = lds_tr_read(Vs + ro + 8 * AT_VP + 64);
                    const v4u f0 = (v4u){lo0.x, lo0.y, hi0.x, hi0.y}, f1 = (v4u){lo1.x, lo1.y, hi1.x, hi1.y};
                    o0 = MFMA32(__builtin_bit_cast(bf16x8, f0), pf[2 * xt + s], o0); o1 = MFMA32(__builtin_bit_cast(bf16x8, f1), pf[2 * xt + s], o1); }
        }
        if (more) AT_STORE(buf ^ 1);
        __syncthreads();
        buf ^= 1;
    }
#undef AT_LOAD
#undef AT_STORE
    if (wave_on) {
        const float inv = 1.0f / lrun;
        bf16* orow = MIX + (size_t)qrow * MIXW + MIX_B + 64 * h;
#pragma unroll
        for (int g4 = 0; g4 < 4; ++g4) { const int d = 8 * g4 + 4 * hh;
            v2u w0; w0.x = pk2(o0[4 * g4] * inv, o0[4 * g4 + 1] * inv); w0.y = pk2(o0[4 * g4 + 2] * inv, o0[4 * g4 + 3] * inv); *(GAS v2u*)(orow + d) = w0;
            v2u w1; w1.x = pk2(o1[4 * g4] * inv, o1[4 * g4 + 1] * inv); w1.y = pk2(o1[4 * g4 + 2] * inv, o1[4 * g4 + 3] * inv); *(GAS v2u*)(orow + 32 + d) = w1; }
    }
}
__device__ __forceinline__ unsigned sg_off(unsigned row, unsigned ch) { return 256u * row + 16u * (ch ^ (((row & 3u) << 2) | ((row >> 2) & 3u))); }
__device__ __forceinline__ void sg_unit(Frame& F, int layer, int ci, const bf16* Z, bf16* MIX) {
    const int lane = F.lane, w = F.wave, l31 = lane & 31, hh = lane >> 5;
    const bool sample = ci >= MP / 128; const int L = sample ? 32 : 128, row0 = sample ? MP + 32 * (ci - MP / 128) : 128 * ci;
    LAS unsigned char* VN = F.lds;
    {
        const int c8 = 8 * lane;
        const GAS f32x4* lgp = (const GAS f32x4*)(INP(I_SGG) + layer * DC + c8); const GAS f32x4* lbp = (const GAS f32x4*)(INP(I_SGB) + layer * DC + c8);
        const f32x4 lg0 = lgp[0], lg1 = lgp[1], lb0 = lbp[0], lb1 = lbp[1];
        const int nrw = L / 8;
        LAS unsigned char* vbase = VN + (lane >> 4) * 32768;
        v4u zrow[16];
#pragma unroll
        for (int i = 0; i < 16; ++i) { if (i < nrw) zrow[i] = *(const GAS v4u*)(Z + (size_t)(row0 + w * nrw + i) * ZW + ZSV + c8); else zrow[i] = (v4u){0u, 0u, 0u, 0u}; }
#pragma unroll
        for (int i = 0; i < 16; ++i) { if (i < nrw) { const int rr = w * nrw + i;
            const v4u zv = zrow[i];
            float x[8] = {bflo(zv.x), bfhi(zv.x), bflo(zv.y), bfhi(zv.y), bflo(zv.z), bfhi(zv.z), bflo(zv.w), bfhi(zv.w)};
            const float s = ((x[0] + x[1]) + (x[2] + x[3])) + ((x[4] + x[5]) + (x[6] + x[7]));
            const float mean = wave_sum(s) * (1.0f / DC); float q = 0.f;
#pragma unroll
            for (int e = 0; e < 8; ++e) { x[e] -= mean; q += x[e] * x[e]; }
            const float rstd = 1.0f / sqrtf(wave_sum(q) * (1.0f / DC) + EPS);
            float y[8];
            y[0] = x[0] * rstd * lg0.x + lb0.x; y[1] = x[1] * rstd * lg0.y + lb0.y; y[2] = x[2] * rstd * lg0.z + lb0.z; y[3] = x[3] * rstd * lg0.w + lb0.w;
            y[4] = x[4] * rstd * lg1.x + lb1.x; y[5] = x[5] * rstd * lg1.y + lb1.y; y[6] = x[6] * rstd * lg1.z + lb1.z; y[7] = x[7] * rstd * lg1.w + lb1.w;
            *(LAS v4u*)(vbase + sg_off((unsigned)rr, (unsigned)(lane & 15))) = (v4u){pk2(y[0], y[1]), pk2(y[2], y[3]), pk2(y[4], y[5]), pk2(y[6], y[7])};
            if (sample) { float* so = F.out + O_SGV + (((size_t)layer * NBS + (ci - MP / 128)) * TS + rr) * DC + c8;
                *(GAS f32x4*)so = (f32x4){y[0], y[1], y[2], y[3]}; *(GAS f32x4*)(so + 4) = (f32x4){y[4], y[5], y[6], y[7]}; }
        } }
    }
    __syncthreads();
    {
        const int g = w >> 1;
        const GAS bf16* Wg = (const GAS bf16*)((const bf16*)(lw(F, layer) + LW_SGW) + (size_t)g * 128 * 128 + (size_t)l31 * 128 + 8 * hh); asm volatile("" : "+v"(Wg));
        LAS unsigned char* vg = VN + g * 32768;
        const int nib = L / 32;
        const unsigned blk = (lane >> 4) & 1, q = (lane & 15) >> 2, p4 = lane & 3;
        bf16x8 Bf[4][8];
#pragma unroll
        for (int ib = 0; ib < 4; ++ib)
#pragma unroll
            for (int s = 0; s < 8; ++s) { if (s < 2 * (ib + 1)) { if (ib < nib) Bf[ib][s] = *(const GAS bf16x8*)(Wg + (32 * ib) * 128 + 16 * s); else Bf[ib][s] = (bf16x8){0, 0, 0, 0, 0, 0, 0, 0}; } }
#pragma unroll
        for (int cbb = 0; cbb < 2; ++cbb) { const int cb = 2 * (w & 1) + cbb;
            f32x16 acc[4];
#pragma unroll
            for (int ib = 0; ib < 4; ++ib)
#pragma unroll
                for (int r = 0; r < 16; ++r) acc[ib][r] = 0.f;
#pragma unroll
            for (int s = 0; s < 8; ++s) { if (s < 2 * nib) {
                const v2u a0 = lds_tr_read(vg + sg_off(16u * s + 8u * hh + q, 4u * cb + 2u * blk + (p4 >> 1)) + 8u * (p4 & 1));
                const v2u a1 = lds_tr_read(vg + sg_off(16u * s + 8u * hh + 4u + q, 4u * cb + 2u * blk + (p4 >> 1)) + 8u * (p4 & 1));
                const v4u af = (v4u){a0.x, a0.y, a1.x, a1.y};
#pragma unroll
                for (int ib = 0; ib < 4; ++ib) { if (s < 2 * (ib + 1)) { if (ib < nib) acc[ib] = MFMA32(__builtin_bit_cast(bf16x8, af), Bf[ib][s], acc[ib]); } }
            } }
#pragma unroll
            for (int ib = 0; ib < 4; ++ib) { if (ib < nib) {
                    const int i = 32 * ib + l31, row = row0 + i; const float bias = INP(I_SGBIAS)[((size_t)layer * 4 + g) * 128 + i];
#pragma unroll
                    for (int rg = 0; rg < 4; ++rg) { const int c4 = 32 * cb + 8 * rg + 4 * hh;
                        const v2u zu = *(const GAS v2u*)(Z + (size_t)row * ZW + ZSU + 128 * g + c4);
                        v2u o; o.x = pk2(bflo(zu.x) * (acc[ib][4 * rg] + bias), bfhi(zu.x) * (acc[ib][4 * rg + 1] + bias)); o.y = pk2(bflo(zu.y) * (acc[ib][4 * rg + 2] + bias), bfhi(zu.y) * (acc[ib][4 * rg + 3] + bias));
                        *(GAS v2u*)(MIX + (size_t)row * MIXW + MIX_D + 128 * g + c4) = o; } } }
        }
    }
    __syncthreads();
}
struct ConvCtx { const GAS unsigned char* zb; const GAS unsigned char* hist; GAS unsigned char* cst; bool sample, first, keep; };
template <int E> __device__ __forceinline__ void conv_load(unsigned (&ex)[62], const ConvCtx& X) {
    if constexpr (E < 30) { if (X.sample) { const f32x2 hv = *(const GAS f32x2*)(X.hist + (size_t)E * DC * 4); ex[E] = pk2(hv.x, hv.y); }
                            else if (X.first) ex[E] = 0u;
                            else ex[E] = *(const GAS unsigned*)(X.zb + (size_t)E * ZW * 2); }
    else ex[E] = *(const GAS unsigned*)(X.zb + (size_t)E * ZW * 2);
}
template <int... Es> __device__ __forceinline__ void conv_loads(unsigned (&ex)[62], const ConvCtx& X, std::integer_sequence<int, Es...>) { (conv_load<Es>(ex, X), ...); }
template <int E> __device__ __forceinline__ void conv_row(f32x2 (&acc)[32], const f32x2 (&wt)[31], const unsigned (&ex)[62], const ConvCtx& X) {
    const f32x2 v = (f32x2){bflo(ex[E]), bfhi(ex[E])};
    constexpr int T0 = E > 30 ? E - 30 : 0, T1 = E < 31 ? E : 31;
#pragma unroll
    for (int t = T0; t <= T1; ++t) acc[t] = wt[E - t] * v + acc[t];
    if constexpr (E >= 32) { if (X.keep) *(GAS f32x2*)(X.cst + (size_t)(E - 32) * DC * 4) = v; }
}
template <int... Es> __device__ __forceinline__ void conv_rows(f32x2 (&acc)[32], const f32x2 (&wt)[31], const unsigned (&ex)[62], const ConvCtx& X, std::integer_sequence<int, Es...>) { (conv_row<Es>(acc, wt, ex, X), ...); }
__device__ __forceinline__ void conv_unit(Frame& F, int layer, int tb, int cq, const bf16* Z, bf16* CA, int ca_pitch) {
    const int c = 128 * cq + 2 * F.lane; const bool sample = tb >= MP / 32; const int sb = tb - MP / 32;
    const int r0 = sample ? MP + 32 * sb : 32 * tb; const bool first = !sample && ((r0 & (SEQ - 1)) == 0);
    ConvCtx X; X.sample = sample; X.first = first; X.keep = sample || ((r0 & (SEQ - 1)) == SEQ - 32);
    X.zb = (const GAS unsigned char*)(Z + ((long)r0 - 30) * ZW + ZU + c); asm volatile("" : "+v"(X.zb));
    const GAS unsigned char* wb = (const GAS unsigned char*)(INP(I_CONVW) + (size_t)layer * 31 * DC + c); asm volatile("" : "+v"(wb));
    f32x2 wt[31];
#pragma unroll
    for (int j = 0; j < 31; ++j) wt[j] = *(const GAS f32x2*)(wb + (size_t)j * DC * 4);
    const f32x2 cbias = *(const GAS f32x2*)(INP(I_CONVB) + layer * DC + c), gg = *(const GAS f32x2*)(INP(I_GNG) + layer * DC + c), gb = *(const GAS f32x2*)(INP(I_GNB) + layer * DC + c);
    f32x2 acc[32];
#pragma unroll
    for (int t = 0; t < 32; ++t) acc[t] = cbias;
    X.hist = (const GAS unsigned char*)(INP(I_CCONV) + ((size_t)layer * NBS + (sample ? sb : 0)) * 30 * DC + c); asm volatile("" : "+v"(X.hist));
    X.cst = (GAS unsigned char*)(sample ? F.out + O_CONVS + ((size_t)layer * NBS + sb) * 30 * DC + c : F.out + O_CONVP + ((size_t)layer * NBP + (r0 >> 13)) * 30 * DC + c); asm volatile("" : "+v"(X.cst));
    GAS unsigned char* cab = (GAS unsigned char*)(CA + (size_t)r0 * ca_pitch + c); asm volatile("" : "+v"(cab));
    unsigned ex[62];
    conv_loads(ex, X, std::make_integer_sequence<int, 62>{});
    conv_rows(acc, wt, ex, X, std::make_integer_sequence<int, 62>{});
#pragma unroll
    for (int t = 0; t < 32; ++t) {
        const f32x2 y = acc[t];
        const float s = half32_sum(y.x + y.y), q = half32_sum(y.x * y.x + y.y * y.y);
        const float mean = s * (1.0f / 64.0f), var = fmaxf(q * (1.0f / 64.0f) - mean * mean, 0.f), rstd = 1.0f / sqrtf(var + EPS);
        const f32x2 n = (y - mean) * rstd * gg + gb;
        *(GAS unsigned*)(cab + (size_t)t * ca_pitch * 2) = pk2(siluf_(n.x), siluf_(n.y));
    }
}
template <int W>
__device__ __forceinline__ void pool_body(Frame& F, int layer, int tb, int cq, const bf16* Z, bf16* PM, int pm_pitch) {
    const int c = 128 * cq + 2 * F.lane; const bool sample = tb >= MP / 32; const int sb = tb - MP / 32;
    const int r0 = sample ? MP + 32 * sb : 32 * tb; const bool first = !sample && ((r0 & (SEQ - 1)) == 0);
    const GAS unsigned char* hist = (const GAS unsigned char*)(INP(I_CPOOL) + ((size_t)layer * NBS + (sample ? sb : 0)) * 15 * DC + c); asm volatile("" : "+v"(hist));
    const bool last_blk = !sample && ((r0 & (SEQ - 1)) == SEQ - 32);
    GAS unsigned char* pst = (GAS unsigned char*)(sample ? F.out + O_POOLS + ((size_t)layer * NBS + sb) * 15 * DC + c : F.out + O_POOLP + ((size_t)layer * NBP + (r0 >> 13)) * 15 * DC + c); asm volatile("" : "+v"(pst));
    const GAS unsigned char* zb = (const GAS unsigned char*)(Z + ((long)r0 - 15) * ZW + ZP + c); asm volatile("" : "+v"(zb));
    GAS unsigned char* pmb = (GAS unsigned char*)(PM + (size_t)r0 * pm_pitch + c); asm volatile("" : "+v"(pmb));
    f32x2 ext[47];
#pragma unroll
    for (int e = 0; e < 47; ++e) {
        if (e < 15) { if (sample) ext[e] = *(const GAS f32x2*)(hist + (size_t)e * DC * 4);
                      else if (first) ext[e] = (f32x2){0.f, 0.f};
                      else { const unsigned u = *(const GAS unsigned*)(zb + (size_t)e * ZW * 2); ext[e] = (f32x2){bflo(u), bfhi(u)}; } }
        else { const unsigned u = *(const GAS unsigned*)(zb + (size_t)e * ZW * 2); ext[e] = (f32x2){bflo(u), bfhi(u)}; }
    }
#pragma unroll
    for (int t = 0; t < 32; ++t) {
        f32x2 win = (f32x2){0.f, 0.f};
#pragma unroll
        for (int i = W - 1; i >= 0; --i) win += ext[15 + t - i];
        const float rc = 1.0f / (float)((first && t + 1 < W) ? t + 1 : W);
        const f32x2 m = win * rc - ext[15 + t];
        *(GAS unsigned*)(pmb + (size_t)t * pm_pitch * 2) = pk2(m.x, m.y);
        if (t >= 17 && (sample || last_blk)) *(GAS f32x2*)(pst + (size_t)(t - 17) * DC * 4) = ext[15 + t];
    }
}
#define MIX_FENCE() do { int t_ = F.tid; asm volatile("" : "+v"(t_)); F.tid = t_; F.lane = t_ & 63; } while (0)
__device__ __forceinline__ void mixer_phase(Frame& F, int layer) {
    const bf16* Z = (const bf16*)(F.ws + WS_Z); bf16* MIX = (bf16*)(F.ws + WS_MIX); bf16* CA = (bf16*)(F.ws + WS_CAPM); bf16* PM = CA + (size_t)MT * DC;
#ifndef PROBE_MIX
#define PROBE_MIX 0
#endif
#define MDUP(k) _Pragma("unroll") for (int mrep_ = 0; mrep_ < 1 + ((PROBE_MIX >> (k)) & 1); ++mrep_)
    MDUP(0) { for (int id = F.vcu; id < NBP * 8 * 32; id += F.G) attn_unit(F, layer, false, id >> 8, (id >> 5) & 7, id & 31, Z, MIX);
    for (int id = F.vcu - 192; id >= 0 && id < NBS * 8; id += F.G) attn_unit(F, layer, true, id >> 3, id & 7, 0, Z, MIX); }
    MIX_FENCE();
    MDUP(1) { for (int id = F.vcu; id < MP / 128; id += F.G) sg_unit(F, layer, id, Z, MIX);
    for (int id = F.vcu - 96; id >= 0 && id < NBS; id += F.G) sg_unit(F, layer, MP / 128 + id, Z, MIX); }
    const int gw = F.vcu * NWAVES + F.wave, NGW = F.G * NWAVES;
    MIX_FENCE();
    MDUP(2) { for (int id = gw; id < (MP / 32) * 4; id += NGW) conv_unit(F, layer, id >> 2, id & 3, Z, CA, DC);
    if (F.wave == 0 && F.vcu >= 128 && F.vcu < 160) { const int id = (MP / 32) * 4 + F.vcu - 128; conv_unit(F, layer, id >> 2, id & 3, Z, CA, DC); } }
    MIX_FENCE();
    MDUP(3) for (int it = 0; it < 3; ++it) { int id = gw + it * NGW;
        if (it == 2) { if (F.wave == 0 && F.vcu >= 160 && F.vcu < 192) id = (MP / 32) * 4 + F.vcu - 160; else break; }
        const int tb = id >> 2, cq = id & 3;
        switch (cq) { case 0: pool_body<2>(F, layer, tb, cq, Z, PM, DC); break; case 1: pool_body<4>(F, layer, tb, cq, Z, PM, DC); break;
                      case 2: pool_body<8>(F, layer, tb, cq, Z, PM, DC); break; default: pool_body<16>(F, layer, tb, cq, Z, PM, DC); break; } }
    MIX_FENCE();
    const int gt = F.vcu * (NWAVES * 64) + F.tid, NGT = F.G * NWAVES * 64;
    for (int i = gt; i < (NBP * 512 + NBS * TS) * 128; i += NGT) {
        const int rr = i >> 7, kv = (i >> 6) & 1, ch = i & 63;
        int zrow; size_t o;
        if (rr < NBP * 512) { const int b = rr >> 9, t = rr & 511; zrow = b * SEQ + SEQ - 512 + t; o = (kv ? O_VP : O_KP) + (((size_t)layer * NBP + b) * 512 + t) * 512 + 8 * ch; }
        else { const int r2 = rr - NBP * 512, b = r2 >> 5, t = r2 & 31; zrow = MP + r2; o = (kv ? O_VS : O_KS) + (((size_t)layer * NBS + b) * TS + t) * 512 + 8 * ch; }
        const v4u z = *(const GAS v4u*)(Z + (size_t)zrow * ZW + (kv ? ZV : ZK) + 8 * ch);
        *(GAS f32x4*)(F.out + o) = (f32x4){bflo(z.x), bfhi(z.x), bflo(z.y), bfhi(z.y)}; *(GAS f32x4*)(F.out + o + 4) = (f32x4){bflo(z.z), bfhi(z.z), bflo(z.w), bfhi(z.w)};
    }
}

enum { SK_Z = 0, SK_MIX2 = 1, SK_RES = 2, SK_SWI = 3 };
struct SkUnit { int row0, nb0, nb1, ocol0, ocol1; bool pair; float scale; };
template <int KIND, int NTB, int U>
__device__ __forceinline__ void sk_unit(Frame& F, const bf16* A, const bf16* Bt, int K, const SkUnit& u, bf16* obf, int opitch, float* X, const float* gate) {
    const int lane = F.lane, w = F.wave, l31 = lane & 31, hh = lane >> 5;
    const int kw = K >> 3, nch = kw >> 6;
    constexpr int NR = 32 * NTB + 64, NLD = NR / 8;
    LAS unsigned char* stg = F.lds + w * 16384;
    const int lr = lane >> 3, lc = lane & 7;
    const GAS unsigned char* src[NLD];
#pragma unroll
    for (int i = 0; i < NLD; ++i) { const int r = 8 * i + lr;
        const bf16* base = (r < 32 * NTB) ? A + (size_t)(u.row0 + r) * K : (r < 32 * NTB + 32) ? Bt + (size_t)(u.nb0 + r - 32 * NTB) * K : Bt + (size_t)(u.nb1 + r - 32 * NTB - 32) * K;
        src[i] = (const GAS unsigned char*)(base + w * kw + 8 * lc); }
    f32x16 acc[NTB][2];
#pragma unroll
    for (int tb = 0; tb < NTB; ++tb)
#pragma unroll
        for (int c = 0; c < 2; ++c)
#pragma unroll
            for (int r = 0; r < 16; ++r) acc[tb][c][r] = 0.f;
    v4u R[NLD];
#pragma unroll
    for (int i = 0; i < NLD; ++i) R[i] = *(const GAS v4u*)(src[i]);
    for (int ch = 0; ch < nch; ++ch) {
#pragma unroll
        for (int i = 0; i < NLD; ++i) { const int r = 8 * i + lr; *(LAS v4u*)(stg + r * 128 + 16 * (lc ^ (r & 7))) = R[i]; }
        if (ch + 1 < nch) {
#pragma unroll
            for (int i = 0; i < NLD; ++i) R[i] = *(const GAS v4u*)(src[i] + (size_t)(ch + 1) * 128); }
#pragma unroll
        for (int s = 0; s < 4; ++s) { const int cx = 16 * ((2 * s + hh) ^ (l31 & 7));
            bf16x8 xf[NTB];
#pragma unroll
            for (int tb = 0; tb < NTB; ++tb) xf[tb] = *(const LAS bf16x8*)(stg + (32 * tb + l31) * 128 + cx);
            const bf16x8 w0 = *(const LAS bf16x8*)(stg + (32 * NTB + l31) * 128 + cx), w1 = *(const LAS bf16x8*)(stg + (32 * NTB + 32 + l31) * 128 + cx);
#pragma unroll
            for (int tb = 0; tb < NTB; ++tb) { acc[tb][0] = MFMA32(w0, xf[tb], acc[tb][0]); acc[tb][1] = MFMA32(w1, xf[tb], acc[tb][1]); }
        }
    }
    __syncthreads();
    LAS f32x4* red = (LAS f32x4*)F.lds;
#pragma unroll
    for (int tb = 0; tb < NTB; ++tb)
#pragma unroll
        for (int c = 0; c < 2; ++c)
#pragma unroll
            for (int rg = 0; rg < 4; ++rg) red[((((w * NTB + tb) * 2 + c) * 4 + rg) << 6) + lane] = (f32x4){acc[tb][c][4 * rg], acc[tb][c][4 * rg + 1], acc[tb][c][4 * rg + 2], acc[tb][c][4 * rg + 3]};
    __syncthreads();
    {
        const int rg = w & 3, tb = (NTB == 2) ? (w >> 2) : 0, c_lo = (NTB == 2) ? 0 : (w >> 2), c_hi = (NTB == 2) ? 2 : (w >> 2) + 1;
        f32x4 v[2] = {(f32x4){0.f, 0.f, 0.f, 0.f}, (f32x4){0.f, 0.f, 0.f, 0.f}};
#pragma unroll
        for (int c = 0; c < 2; ++c) { if (c >= c_lo && c < c_hi) {
#pragma unroll
                for (int w2 = 0; w2 < 8; ++w2) v[c] += red[((((w2 * NTB + tb) * 2 + c) * 4 + rg) << 6) + lane]; } }
        const int row = u.row0 + 32 * tb + l31, co = 8 * rg + 4 * hh;
        if (KIND == SK_Z) {
            if (u.pair) { v2u o; o.x = pk2(v[0][0] * sigmoidf_(v[1][0]), v[0][1] * sigmoidf_(v[1][1])); o.y = pk2(v[0][2] * sigmoidf_(v[1][2]), v[0][3] * sigmoidf_(v[1][3]));
                *(GAS v2u*)(obf + (size_t)row * opitch + u.ocol0 + co) = o; }
            else {
#pragma unroll
                for (int c = 0; c < 2; ++c) { const f32x4 y = v[c] * u.scale; v2u o; o.x = pk2(y[0], y[1]); o.y = pk2(y[2], y[3]); *(GAS v2u*)(obf + (size_t)row * opitch + (c ? u.ocol1 : u.ocol0) + co) = o; } }
        } else if (KIND == SK_MIX2) {
#pragma unroll
            for (int c = 0; c < 2; ++c) { v2u o; o.x = pk2(v[c][0], v[c][1]); o.y = pk2(v[c][2], v[c][3]); *(GAS v2u*)(obf + (size_t)row * opitch + (c ? u.ocol1 : u.ocol0) + co) = o; }
        } else if (KIND == SK_SWI) {
            v2u o; o.x = pk2(siluf_(v[0][0]) * v[1][0], siluf_(v[0][1]) * v[1][1]); o.y = pk2(siluf_(v[0][2]) * v[1][2], siluf_(v[0][3]) * v[1][3]);
            *(GAS v2u*)(obf + (size_t)row * opitch + u.ocol0 + co) = o;
        } else {
            const int c = w >> 2, col = (c ? u.ocol1 : u.ocol0) + co;
            const f32x4 g = *(const GAS f32x4*)(gate + (size_t)batch_of_row(row) * NMOD + col); const f32x4 y = g * v[c];
            v2u o; o.x = pk2(y[0], y[1]); o.y = pk2(y[2], y[3]); *(GAS v2u*)(obf + (size_t)row * opitch + col) = o;
        }
    }
    __syncthreads();
}
constexpr int N_PHASES = 2 + 8 * NL + 1;

__global__ void __launch_bounds__(NWAVES * 64, 2) enc_fwd(Args args) {
    extern __shared__ __attribute__((aligned(16))) unsigned char lds[];
    Frame F;
    F.lds = (LAS unsigned char*)lds;
    F.tid = threadIdx.x; F.lane = F.tid & 63; F.wave = __builtin_amdgcn_readfirstlane(F.tid >> 6);
    F.G = gridDim.x; { const int bx = blockIdx.x; F.vcu = (F.G % 8 == 0) ? (bx % 8) * (F.G / 8) + bx / 8 : bx; }
    F.ka = (KArgs)__builtin_amdgcn_kernarg_segment_ptr();
    F.out = args.out; F.ws = args.ws;
    volatile LAS unsigned* MISC = (volatile LAS unsigned*)(F.lds + MISC_OFF);
    for (int u = F.tid; u < (LDS_BYTES - LDSCTL_OFF) / 4; u += NWAVES * 64) ((LAS unsigned*)(F.lds + LDSCTL_OFF))[u] = 0u;
    __syncthreads();
    const int lo = args.ph_lo, hi = args.ph_hi;
#define REFRESH() do { int t_ = threadIdx.x; asm volatile("" : "+v"(t_)); F.tid = t_; F.lane = t_ & 63; F.wave = __builtin_amdgcn_readfirstlane(t_ >> 6); \
        unsigned long long w_ = (unsigned long long)args.ws, o_ = (unsigned long long)args.out, k_ = (unsigned long long)__builtin_amdgcn_kernarg_segment_ptr(); \
        asm volatile("" : "+s"(w_), "+s"(o_), "+s"(k_)); F.ws = (unsigned char*)(GAS unsigned char*)w_; F.out = (float*)(GAS float*)o_; F.ka = (KArgs)k_; \
        unsigned l_ = (unsigned)(unsigned long long)(LAS unsigned char*)lds; asm volatile("" : "+s"(l_)); F.lds = (LAS unsigned char*)(unsigned long long)l_; } while (0)
    XcdBarrier bar; bar.bar = (unsigned*)(F.ws + WS_CTL) + CW_BAR; bar.x = 0; bar.st = nullptr;
    if (hi - lo > 1) bar = xcd_barrier_post((unsigned*)(F.ws + WS_CTL) + CW_BAR, MISC + 8);
#ifdef ONLY_PHASE
#define IN(k) ((((k) < 2 || (k) == N_PHASES - 1) ? (k) : 2 + ((k) - 2) % 8) == ONLY_PHASE && lo <= (k) && (k) < hi)
#else
#define IN(k) (lo <= (k) && (k) < hi)
#endif
#ifndef PROBE_DUP
#define PROBE_DUP 0
#endif
#define DUP(k) _Pragma("unroll") for (int rep_ = 0; rep_ < 1 + ((PROBE_DUP >> (k)) & 1); ++rep_)
#ifndef STAGGER_TICKS
#define STAGGER_TICKS 0
#endif
#define STAGGER(ticks) do { if ((ticks) > 0 && (blockIdx.x & 8)) { const unsigned long long t0_ = __builtin_amdgcn_s_memrealtime(); while (__builtin_amdgcn_s_memrealtime() - t0_ < (unsigned long long)(ticks)) __builtin_amdgcn_s_sleep(8); } } while (0)
#define SEAM(k) do { if (IN(k) && IN((k) + 1)) { XcdBarrier b_ = bar; unsigned long long p_ = (unsigned long long)b_.bar; asm volatile("" : "+s"(p_)); b_.bar = (unsigned*)p_; xcd_barrier(b_); } } while (0)

    if (IN(0)) DUP(8) { REFRESH(); p0a_phase(F); } SEAM(0);
    if (IN(1)) { REFRESH(); p0b_phase(F); } SEAM(1);
    for (int l = 0; l < NL; ++l) {
        const int pb = 2 + 8 * l;
        if (IN(pb + 0)) DUP(0) { REFRESH(); bf16* H = (bf16*)(F.ws + WS_H); bf16* Zb = (bf16*)(F.ws + WS_Z); bf16* MIX = (bf16*)(F.ws + WS_MIX); bf16* HID = (bf16*)(F.ws + WS_HID); bf16* CAPM = (bf16*)(F.ws + WS_CAPM); bf16* DLT = (bf16*)(F.ws + WS_DELTA); (void)DLT; (void)H; (void)Zb; (void)MIX; (void)HID; (void)CAPM; const float* mod_l = modp(F, l); unsigned char* wl = lw(F, l); (void)mod_l; (void)wl; if (l == 0) norm_phase<true, false>(F, INP(I_N1) + l * DM, mod_l, 0, H, DLT); else norm_phase<false, true>(F, INP(I_N1) + l * DM, mod_l, 0, H, DLT); } SEAM(pb + 0);
        if (IN(pb + 1)) DUP(1) { REFRESH(); bf16* H = (bf16*)(F.ws + WS_H); bf16* Zb = (bf16*)(F.ws + WS_Z); bf16* MIX = (bf16*)(F.ws + WS_MIX); bf16* HID = (bf16*)(F.ws + WS_HID); bf16* CAPM = (bf16*)(F.ws + WS_CAPM); bf16* DLT = (bf16*)(F.ws + WS_DELTA); (void)DLT; (void)H; (void)Zb; (void)MIX; (void)HID; (void)CAPM; const float* mod_l = modp(F, l); unsigned char* wl = lw(F, l); (void)mod_l; (void)wl; pg8::Gemm g{H, (const bf16*)(wl + LW_WIN), MP, DIN, DM}; pg8::StaticOrder S; S.init(MP, DIN, F.G, (int)blockIdx.x); int dry_ = (PROBE_DRY != 0) && (rep_ == 1); asm volatile("" : "+s"(dry_)); pg8::EpiZ E{Zb, dry_};
            pg8::gemm_phase<pg8::EpiZ, pg8::StaticOrder, true, true>(F.lds, g, S, E);
            for (int su = F.vcu; su < 4 * 64; su += F.G) { const int rt = su & 3, cb = su >> 2; SkUnit u; u.row0 = MP + 64 * rt;
                if (cb < 16) { const int tt = cb >> 2, x0 = 32 * (cb & 3); u.nb0 = 256 * tt + x0; u.nb1 = u.nb0 + 128; u.ocol0 = 128 * tt + x0; u.ocol1 = 0; u.pair = true; u.scale = 1.f; }
                else { const int pbk = cb - 16; u.nb0 = 1024 + 64 * pbk; u.nb1 = u.nb0 + 32; u.ocol0 = 512 + 64 * pbk; u.ocol1 = u.ocol0 + 32; u.pair = false; u.scale = (u.nb0 < 1536) ? QSCALE : 1.f; }
                sk_unit<SK_Z, 2, 8>(F, H, (const bf16*)(wl + LW_WIN), DM, u, Zb, ZW, nullptr, nullptr); } } SEAM(pb + 1);
        if (IN(pb + 2)) DUP(2) { REFRESH(); bf16* H = (bf16*)(F.ws + WS_H); bf16* Zb = (bf16*)(F.ws + WS_Z); bf16* MIX = (bf16*)(F.ws + WS_MIX); bf16* HID = (bf16*)(F.ws + WS_HID); bf16* CAPM = (bf16*)(F.ws + WS_CAPM); bf16* DLT = (bf16*)(F.ws + WS_DELTA); (void)DLT; (void)H; (void)Zb; (void)MIX; (void)HID; (void)CAPM; const float* mod_l = modp(F, l); unsigned char* wl = lw(F, l); (void)mod_l; (void)wl; mixer_phase(F, l); } SEAM(pb + 2);
        if (IN(pb + 3)) DUP(3) { REFRESH(); bf16* H = (bf16*)(F.ws + WS_H); bf16* Zb = (bf16*)(F.ws + WS_Z); bf16* MIX = (bf16*)(F.ws + WS_MIX); bf16* HID = (bf16*)(F.ws + WS_HID); bf16* CAPM = (bf16*)(F.ws + WS_CAPM); bf16* DLT = (bf16*)(F.ws + WS_DELTA); (void)DLT; (void)H; (void)Zb; (void)MIX; (void)HID; (void)CAPM; const float* mod_l = modp(F, l); unsigned char* wl = lw(F, l); (void)mod_l; (void)wl; pg8::Gemm g{CAPM, (const bf16*)(wl + LW_CPW), 2 * MT, 2 * DC, DC}; pg8::Mix2Order S{F.G, (int)blockIdx.x}; pg8::EpiMix2 E{MIX};
            pg8::gemm_phase<pg8::EpiMix2, pg8::Mix2Order, true, true>(F.lds, g, S, E);
            for (int su = F.vcu; su < 2 * 4 * 8; su += F.G) { const int which = su >> 5, rt = su & 3, cb = (su >> 2) & 7; SkUnit u; u.row0 = MP + 64 * rt; u.nb0 = 64 * cb; u.nb1 = u.nb0 + 32;
                u.ocol0 = which * 1024 + 64 * cb; u.ocol1 = u.ocol0 + 32; u.pair = false; u.scale = 1.f;
                sk_unit<SK_MIX2, 2, 4>(F, CAPM + (size_t)which * MT * DC, (const bf16*)(wl + LW_CPW) + (size_t)which * DC * DC, DC, u, MIX, MIXW, nullptr, nullptr); } } SEAM(pb + 3);
        if (IN(pb + 4)) DUP(4) { REFRESH(); bf16* H = (bf16*)(F.ws + WS_H); bf16* Zb = (bf16*)(F.ws + WS_Z); bf16* MIX = (bf16*)(F.ws + WS_MIX); bf16* HID = (bf16*)(F.ws + WS_HID); bf16* CAPM = (bf16*)(F.ws + WS_CAPM); bf16* DLT = (bf16*)(F.ws + WS_DELTA); (void)DLT; (void)H; (void)Zb; (void)MIX; (void)HID; (void)CAPM; const float* mod_l = modp(F, l); unsigned char* wl = lw(F, l); (void)mod_l; (void)wl; STAGGER(STAGGER_G3); pg8::Gemm g{MIX, (const bf16*)(wl + LW_WOUT), MP, DM, DM}; pg8::StaticOrder S; S.init(MP, DM, F.G, (int)blockIdx.x); int dry_ = (PROBE_DRY != 0) && (rep_ == 1); asm volatile("" : "+s"(dry_)); pg8::EpiDelta E{DLT, mod_l + 2 * DM, dry_};
            pg8::gemm_phase<pg8::EpiDelta, pg8::StaticOrder, true, true>(F.lds, g, S, E);
            if (!dry_) for (int su = F.vcu; su < 8 * 32; su += F.G) { const int rt = su & 7, cb = su >> 3; SkUnit u; u.row0 = MP + 32 * rt; u.nb0 = 64 * cb; u.nb1 = u.nb0 + 32; u.ocol0 = u.nb0; u.ocol1 = u.nb1; u.pair = false; u.scale = 1.f;
                sk_unit<SK_RES, 1, 8>(F, MIX, (const bf16*)(wl + LW_WOUT), DM, u, DLT, DM, nullptr, mod_l + 2 * DM); } } SEAM(pb + 4);
        if (IN(pb + 5)) DUP(5) { REFRESH(); bf16* H = (bf16*)(F.ws + WS_H); bf16* Zb = (bf16*)(F.ws + WS_Z); bf16* MIX = (bf16*)(F.ws + WS_MIX); bf16* HID = (bf16*)(F.ws + WS_HID); bf16* CAPM = (bf16*)(F.ws + WS_CAPM); bf16* DLT = (bf16*)(F.ws + WS_DELTA); (void)DLT; (void)H; (void)Zb; (void)MIX; (void)HID; (void)CAPM; const float* mod_l = modp(F, l); unsigned char* wl = lw(F, l); (void)mod_l; (void)wl; norm_phase<false, true>(F, INP(I_N2) + l * DM, mod_l, 3, H, DLT); } SEAM(pb + 5);
        if (IN(pb + 6)) DUP(6) { REFRESH(); bf16* H = (bf16*)(F.ws + WS_H); bf16* Zb = (bf16*)(F.ws + WS_Z); bf16* MIX = (bf16*)(F.ws + WS_MIX); bf16* HID = (bf16*)(F.ws + WS_HID); bf16* CAPM = (bf16*)(F.ws + WS_CAPM); bf16* DLT = (bf16*)(F.ws + WS_DELTA); (void)DLT; (void)H; (void)Zb; (void)MIX; (void)HID; (void)CAPM; const float* mod_l = modp(F, l); unsigned char* wl = lw(F, l); (void)mod_l; (void)wl; pg8::Gemm g{H, (const bf16*)(wl + LW_WGU), MP, 2 * DFF, DM}; pg8::StaticOrder S; S.init(MP, 2 * DFF, F.G, (int)blockIdx.x); pg8::EpiSwi E{HID};
            pg8::gemm_phase<pg8::EpiSwi, pg8::StaticOrder, true, true>(F.lds, g, S, E);
            for (int su = F.vcu; su < 4 * 176; su += F.G) { const int rt = su & 3, cb = su >> 2, tt = cb >> 2, x0 = 32 * (cb & 3); SkUnit u; u.row0 = MP + 64 * rt; u.nb0 = 256 * tt + x0; u.nb1 = u.nb0 + 128;
                u.ocol0 = 128 * tt + x0; u.ocol1 = 0; u.pair = true; u.scale = 1.f;
                sk_unit<SK_SWI, 2, 8>(F, H, (const bf16*)(wl + LW_WGU), DM, u, HID, DFF, nullptr, nullptr); } } SEAM(pb + 6);
        if (IN(pb + 7)) DUP(7) { REFRESH(); bf16* H = (bf16*)(F.ws + WS_H); bf16* Zb = (bf16*)(F.ws + WS_Z); bf16* MIX = (bf16*)(F.ws + WS_MIX); bf16* HID = (bf16*)(F.ws + WS_HID); bf16* CAPM = (bf16*)(F.ws + WS_CAPM); bf16* DLT = (bf16*)(F.ws + WS_DELTA); (void)DLT; (void)H; (void)Zb; (void)MIX; (void)HID; (void)CAPM; const float* mod_l = modp(F, l); unsigned char* wl = lw(F, l); (void)mod_l; (void)wl; STAGGER(STAGGER_G5); pg8::Gemm g{HID, (const bf16*)(wl + LW_WD), MP, DM, DFF}; pg8::StaticOrder S; S.init(MP, DM, F.G, (int)blockIdx.x); int dry_ = (PROBE_DRY != 0) && (rep_ == 1); asm volatile("" : "+s"(dry_)); pg8::EpiDelta E{DLT, mod_l + 5 * DM, dry_};
            pg8::gemm_phase<pg8::EpiDelta, pg8::StaticOrder, true, true>(F.lds, g, S, E);
            if (!dry_) for (int su = F.vcu; su < 8 * 32; su += F.G) { const int rt = su & 7, cb = su >> 3; SkUnit u; u.row0 = MP + 32 * rt; u.nb0 = 64 * cb; u.nb1 = u.nb0 + 32; u.ocol0 = u.nb0; u.ocol1 = u.nb1; u.pair = false; u.scale = 1.f;
                sk_unit<SK_RES, 1, 11>(F, HID, (const bf16*)(wl + LW_WD), DFF, u, DLT, DM, nullptr, mod_l + 5 * DM); } } SEAM(pb + 7);
    }
    if (IN(N_PHASES - 1)) { REFRESH(); final_norm_phase(F, (const bf16*)(F.ws + WS_DELTA)); }
#undef IN
#undef SEAM
}

extern "C" void kernel_launch(void* const* d_in, const int* in_sizes, int n_in, void* d_out, int out_size, void* d_ws, size_t ws_size, hipStream_t stream) {
    static int grid = 0;
    if (grid == 0) {
        if (n_in != N_IN || in_sizes[0] != MP * DM || (size_t)out_size != O_END || ws_size < WS_END) {
            fprintf(stderr, "kernel_launch: unexpected shapes: n_in %d in0 %d out %d ws %zu (need %zu); nothing launched\n", n_in, n_in > 0 ? in_sizes[0] : -1, out_size, ws_size, (size_t)WS_END); grid = -1; return; }
        int dev = 0, cus = 0;
        if (hipGetDevice(&dev) != hipSuccess || hipDeviceGetAttribute(&cus, hipDeviceAttributeMultiprocessorCount, dev) != hipSuccess) { grid = -1; return; }
        if (hipFuncSetAttribute((const void*)enc_fwd, hipFuncAttributeMaxDynamicSharedMemorySize, LDS_BYTES) != hipSuccess) { fprintf(stderr, "kernel_launch: hipFuncSetAttribute failed\n"); grid = -1; return; }
        int per_cu = 0;
        if (hipOccupancyMaxActiveBlocksPerMultiprocessor(&per_cu, (const void*)enc_fwd, NWAVES * 64, LDS_BYTES) != hipSuccess || per_cu < 1)
            fprintf(stderr, "kernel_launch: note: occupancy query reports %d workgroups per CU\n", per_cu);
        (void)hipGetLastError();
        grid = cus;
    }
    if (grid < 0) return;
    if (hipMemsetAsync((char*)d_ws + WS_CTL, 0, CTL_ZERO_BYTES, stream) != hipSuccess) return;
    Args a{};
    for (int i = 0; i < N_IN; ++i) a.in[i] = (const float*)d_in[i];
    a.out = (float*)d_out; a.ws = (unsigned char*)d_ws; a.pad0 = 0; a.pad1 = 0;
#if MK_ONE_LAUNCH
    a.ph_lo = 0; a.ph_hi = N_PHASES;
    hipLaunchKernelGGL(enc_fwd, dim3(grid), dim3(NWAVES * 64), LDS_BYTES, stream, a);
#else
    for (int ph = 0; ph < N_PHASES; ++ph) { a.ph_lo = ph; a.ph_hi = ph + 1;
        hipLaunchKernelGGL(enc_fwd, dim3(grid), dim3(NWAVES * 64), LDS_BYTES, stream, a); }
#endif
}
```

```cpp
#include <hip/hip_runtime.h>
#include <cstdio>
#include <cstdint>
#include <utility>

#ifndef MK_ONE_LAUNCH
#define MK_ONE_LAUNCH 1
#endif
#ifndef PROBE_DUP
#define PROBE_DUP 0
#endif
#ifndef PROBE_DRY
#define PROBE_DRY 0
#endif
#ifndef PROBE_MIX
#define PROBE_MIX 0
#endif
#ifndef PROBE_EPI2
#define PROBE_EPI2 0
#endif
#ifndef STAGGER_TICKS
#define STAGGER_TICKS 0
#endif
#ifndef STAGGER_G3
#define STAGGER_G3 0
#define STAGGER_G5 0
#endif

constexpr int DM = 2048, SEQ = 8192, NBP = 4, MP = NBP * SEQ, NBS = 8, TS = 32, MS = NBS * TS, MT = MP + MS, NPANEL = MT / 256;
constexpr int DIN = 4096, DFF = 5632, DC = 512, NL = 4, NMOD = 6 * DM, NBT = NBP + NBS;
constexpr int ZW = 3584, ZU = 0, ZQ = 512, ZK = 1024, ZV = 1536, ZP = 2048, ZSU = 2560, ZSV = 3072;
constexpr int MIXW = 2048, MIX_A = 0, MIX_B = 512, MIX_C = 1024, MIX_D = 1536;
constexpr float EPS = 1e-6f, LOG2E = 1.4426950408889634f, QSCALE = 0.125f * LOG2E;
constexpr int KSPLIT = 16;
constexpr size_t O_YP = 0, O_YS = O_YP + (size_t)MP * DM, O_CONVP = O_YS + (size_t)MS * DM, O_CONVS = O_CONVP + (size_t)NL * NBP * 30 * DC,
    O_KP = O_CONVS + (size_t)NL * NBS * 30 * DC, O_VP = O_KP + (size_t)NL * NBP * 512 * 512, O_KS = O_VP + (size_t)NL * NBP * 512 * 512,
    O_VS = O_KS + (size_t)NL * NBS * TS * 512, O_POOLP = O_VS + (size_t)NL * NBS * TS * 512, O_POOLS = O_POOLP + (size_t)NL * NBP * 15 * DC,
    O_SGV = O_POOLS + (size_t)NL * NBS * 15 * DC, O_END = O_SGV + (size_t)NL * NBS * TS * DC;
static_assert(O_END == 78700544, "output size");
enum { I_XP = 0, I_XS, I_CP, I_CS, I_CCONV, I_CK, I_CV, I_CPOOL, I_ADAW, I_ADAB, I_N1, I_N2, I_WIN, I_CONVW, I_CONVB, I_GNG, I_GNB, I_CPW, I_RELB,
       I_POOLW, I_POOLS, I_SGG, I_SGB, I_SGW, I_SGBIAS, I_WOUT, I_WG, I_WU, I_WD, I_FING, N_IN };
static_assert(N_IN == 30, "30 inputs");

constexpr size_t MiB = 1u << 20;
constexpr size_t WS_CTL = 0, CTL_ZERO_BYTES = 1 * MiB;
constexpr size_t WS_MOD = 1 * MiB;
constexpr size_t WS_MODP = 4 * MiB;
constexpr size_t WS_W = 40 * MiB;
constexpr size_t LW_WIN = 0, LW_WOUT = 16 * MiB, LW_WGU = 24 * MiB, LW_WD = 68 * MiB, LW_CPW = 90 * MiB, LW_PWD = LW_CPW + 512 * 1024, LW_SGW = 91 * MiB, LW = 91 * MiB + 256 * 1024;
constexpr size_t WS_H = WS_W + NL * LW;
constexpr size_t WS_Z = WS_H + (size_t)MT * DM * 2;
constexpr size_t WS_MIX = WS_Z + (size_t)MT * ZW * 2;
constexpr size_t WS_HID = WS_Z;
constexpr size_t WS_CAPM = WS_MIX + (size_t)MT * MIXW * 2;
constexpr size_t WS_XB = WS_CAPM + (size_t)2 * MT * DC * 2;
constexpr size_t WS_END = WS_XB + (size_t)MT * DM * 2;
static_assert(WS_HID + (size_t)MT * DFF * 2 <= WS_CAPM, "HID overlay");
static_assert((size_t)NL * 12 * NMOD * 4 <= 3 * MiB && (size_t)KSPLIT * NL * 12 * NMOD * 4 <= 36 * MiB, "mod buffers");
constexpr int CW_BAR = 4096;

constexpr int RING_BYTES = 131072;
constexpr int LDSCTL_OFF = RING_BYTES, MISC_OFF = LDSCTL_OFF + 320;
constexpr int LDS_BYTES = 147456;
constexpr int NWAVES = 8;

#define GAS __attribute__((address_space(1)))
#define LAS __attribute__((address_space(3)))
typedef unsigned short bf16;
typedef unsigned v4u __attribute__((ext_vector_type(4)));
typedef unsigned v2u __attribute__((ext_vector_type(2)));
typedef float f32x4 __attribute__((ext_vector_type(4)));
typedef float f32x2 __attribute__((ext_vector_type(2)));
typedef float f32x16 __attribute__((ext_vector_type(16)));
typedef short bf16x8 __attribute__((ext_vector_type(8)));
typedef __bf16 bf16x2_t __attribute__((ext_vector_type(2)));
typedef GAS unsigned gu32;
#define RLX_AGENT __ATOMIC_RELAXED, __HIP_MEMORY_SCOPE_AGENT
#define LDS_WAIT() asm volatile("s_waitcnt lgkmcnt(0)" ::: "memory")
#define VM_WAIT() asm volatile("s_waitcnt vmcnt(0)" ::: "memory")

__device__ __forceinline__ unsigned pk2(float lo, float hi) { f32x2 v = {lo, hi}; bf16x2_t b = __builtin_convertvector(v, bf16x2_t); return __builtin_bit_cast(unsigned, b); }
__device__ __forceinline__ float bflo(unsigned u) { return __uint_as_float(u << 16); }
__device__ __forceinline__ float bfhi(unsigned u) { return __uint_as_float(u & 0xffff0000u); }
__device__ __forceinline__ float bf2f(bf16 h) { return __uint_as_float((unsigned)h << 16); }
__device__ __forceinline__ float fast_exp2(float x) { return __builtin_amdgcn_exp2f(x); }
__device__ __forceinline__ float fast_rcp(float x) { return __builtin_amdgcn_rcpf(x); }
__device__ __forceinline__ float sigmoidf_(float x) { return fast_rcp(1.0f + fast_exp2(-x * LOG2E)); }
__device__ __forceinline__ float siluf_(float x) { return x * sigmoidf_(x); }
template <int CTRL> __device__ __forceinline__ float dpp_f(float v) { return __int_as_float(__builtin_amdgcn_update_dpp(0, __float_as_int(v), CTRL, 0xF, 0xF, true)); }
__device__ __forceinline__ float row16_sum(float v) { v += dpp_f<0xB1>(v); v += dpp_f<0x4E>(v); v += dpp_f<0x141>(v); v += dpp_f<0x140>(v); return v; }
__device__ __forceinline__ float half32_sum(float v) { v = row16_sum(v); v += __int_as_float(__builtin_amdgcn_ds_swizzle(__float_as_int(v), 0x401F)); return v; }
__device__ __forceinline__ float wave_sum(float v) { v = half32_sum(v);
    return __int_as_float(__builtin_amdgcn_readlane(__float_as_int(v), 0)) + __int_as_float(__builtin_amdgcn_readlane(__float_as_int(v), 32)); }
__device__ __forceinline__ int batch_of_row(int row) { return row < MP ? (row >> 13) : NBP + ((row - MP) >> 5); }

namespace pg8 {
#define PG8_LAS __attribute__((address_space(3)))
typedef unsigned short bf16_t;
typedef short bf16x8 __attribute__((ext_vector_type(8)));
typedef float f32x4 __attribute__((ext_vector_type(4)));
typedef unsigned u32x4 __attribute__((ext_vector_type(4)));
constexpr int BM = 256, BK = 64, HALF = 128, HTB = HALF * BK * 2  , STAGE_BYTES = 8 * HTB, NXCD = 8, WGM = 8;

__host__ __device__ __forceinline__ int lds_byte(int r, int c) { const int st = (r >> 4) * 2 + (c >> 5), rr = r & 15, cc = c & 31, ob = rr * 64 + cc * 2; return st * 1024 + (ob ^ (((ob >> 9) & 1) << 5)); }
__host__ __device__ __forceinline__ void stage_rc(int b, int& R, int& C) { const int st = b / 1024, sb = b % 1024, swz = sb ^ (((sb >> 9) & 1) << 5); R = (st >> 1) * 16 + swz / 64; C = (st & 1) * 32 + (swz % 64) / 2; }
__host__ __device__ __forceinline__ int perm32(int rho) { const int n = rho >> 4, i = rho & 15; return 8 * (i >> 2) + 4 * n + (i & 3); }

struct Unit { int pm, pn; };
struct Gemm { const bf16_t* A; const bf16_t* Bt; int M, N, K; };

struct StaticOrder {
    int nM, nN, nwg, G, c;
    __host__ __device__ void init(int M, int N, int G_, int c_) { nM = M / BM; nN = N / BM; nwg = nM * nN; G = G_; c = c_; }
    __host__ __device__ bool next(int i, Unit& u) const {
        const long L = (long)i * G + c; if (L >= nwg) return false;
        int wgid = (int)L; { const int q = nwg / NXCD, r = nwg % NXCD, xcd = wgid % NXCD, off = wgid / NXCD; wgid = (xcd < r ? xcd * (q + 1) : r * (q + 1) + (xcd - r) * q) + off; }
        const int nig = WGM * nN, gid = wgid / nig, fm = gid * WGM, gsz = (nM - fm) < WGM ? (nM - fm) : WGM;
        u.pm = fm + ((wgid % nig) % gsz); u.pn = (wgid % nig) / gsz; return true;
    }
    __device__ __forceinline__ void a_ready(const Unit&) const {}
    __device__ __forceinline__ void done(const Unit&) const {}
};
__device__ __forceinline__ unsigned cvt_pk_bf16(float lo, float hi) { return ::pk2(lo, hi); }
struct EpiZ {
    static constexpr bool PERM = true, AFTER_DRAIN = false;
    bf16_t* Z; int dry;
    __device__ __forceinline__ void operator()(const f32x4 (&acc)[2][2][4][2], const Unit& u, int wr, int wc, int fr, int fq) const {
        const int row0 = u.pm * BM + wr * 64 + fr;
        if (dry) return;
        if (u.pn < 4) {
            const int col0 = 128 * u.pn + wc * 32 + 8 * fq;
#pragma unroll
            for (int ai = 0; ai < 2; ++ai)
#pragma unroll
                for (int m = 0; m < 4; ++m) { bf16_t* rowp = Z + (size_t)(row0 + ai * HALF + m * 16) * ::ZW + col0;
                    const f32x4 a0 = acc[ai][0][m][0], a1 = acc[ai][0][m][1], g0 = acc[ai][1][m][0], g1 = acc[ai][1][m][1];
                    u32x4 w; w.x = cvt_pk_bf16(a0[0] * ::sigmoidf_(g0[0]), a0[1] * ::sigmoidf_(g0[1])); w.y = cvt_pk_bf16(a0[2] * ::sigmoidf_(g0[2]), a0[3] * ::sigmoidf_(g0[3]));
                    w.z = cvt_pk_bf16(a1[0] * ::sigmoidf_(g1[0]), a1[1] * ::sigmoidf_(g1[1])); w.w = cvt_pk_bf16(a1[2] * ::sigmoidf_(g1[2]), a1[3] * ::sigmoidf_(g1[3]));
                    *(u32x4*)rowp = w; }
        } else {
            const float sc = (u.pn < 6) ? ::QSCALE : 1.0f;
            const int col0 = 512 + 256 * (u.pn - 4) + wc * 32 + 8 * fq;
#pragma unroll
            for (int ai = 0; ai < 2; ++ai)
#pragma unroll
                for (int m = 0; m < 4; ++m) { bf16_t* rowp = Z + (size_t)(row0 + ai * HALF + m * 16) * ::ZW + col0;
#pragma unroll
                    for (int bj = 0; bj < 2; ++bj) { const f32x4 v0 = acc[ai][bj][m][0] * sc, v1 = acc[ai][bj][m][1] * sc;
                        u32x4 w; w.x = cvt_pk_bf16(v0[0], v0[1]); w.y = cvt_pk_bf16(v0[2], v0[3]); w.z = cvt_pk_bf16(v1[0], v1[1]); w.w = cvt_pk_bf16(v1[2], v1[3]);
                        *(u32x4*)(rowp + bj * HALF) = w; } }
        }
    }
};
struct EpiMix2 {
    static constexpr bool PERM = true, AFTER_DRAIN = false;
    bf16_t* MIX;
    __device__ __forceinline__ void operator()(const f32x4 (&acc)[2][2][4][2], const Unit& u, int wr, int wc, int fr, int fq) const {
        const int which = u.pn >> 1, pm = u.pm - which * ::NPANEL;
        const int row0 = pm * BM + wr * 64 + fr, col0 = which * 1024 + (u.pn & 1) * 256 + wc * 32 + 8 * fq;
#pragma unroll
        for (int ai = 0; ai < 2; ++ai)
#pragma unroll
            for (int m = 0; m < 4; ++m) { bf16_t* rowp = MIX + (size_t)(row0 + ai * HALF + m * 16) * ::MIXW + col0;
#pragma unroll
                for (int bj = 0; bj < 2; ++bj) { const f32x4 v0 = acc[ai][bj][m][0], v1 = acc[ai][bj][m][1];
                    u32x4 w; w.x = cvt_pk_bf16(v0[0], v0[1]); w.y = cvt_pk_bf16(v0[2], v0[3]); w.z = cvt_pk_bf16(v1[0], v1[1]); w.w = cvt_pk_bf16(v1[2], v1[3]);
                    *(u32x4*)(rowp + bj * HALF) = w; } }
    }
};
struct EpiResB {
    static constexpr bool PERM = true, AFTER_DRAIN = false;
    bf16_t* XB; const float* gate; int dry;
    __device__ __forceinline__ void operator()(const f32x4 (&acc)[2][2][4][2], const Unit& u, int wr, int wc, int fr, int fq) const {
        if (dry) return;
        const int row0 = u.pm * BM + wr * 64 + fr, col0 = u.pn * BM + wc * 32 + 8 * fq;
        const float* gp = gate + (size_t)::batch_of_row(u.pm * BM) * ::NMOD + col0;
        f32x4 gv[2][2];
#pragma unroll
        for (int bj = 0; bj < 2; ++bj)
#pragma unroll
            for (int n = 0; n < 2; ++n) gv[bj][n] = *(const f32x4*)(gp + bj * HALF + 4 * n);
#pragma unroll
        for (int ai = 0; ai < 2; ++ai)
#pragma unroll
            for (int m = 0; m < 4; ++m) { bf16_t* rowp = XB + (size_t)(row0 + ai * HALF + m * 16) * ::DM + col0;
#pragma unroll
                for (int bj = 0; bj < 2; ++bj) { const u32x4 xo = *(const u32x4*)(rowp + bj * HALF);
                    const f32x4 v0 = acc[ai][bj][m][0] * gv[bj][0] + (f32x4){::bflo(xo.x), ::bfhi(xo.x), ::bflo(xo.y), ::bfhi(xo.y)};
                    const f32x4 v1 = acc[ai][bj][m][1] * gv[bj][1] + (f32x4){::bflo(xo.z), ::bfhi(xo.z), ::bflo(xo.w), ::bfhi(xo.w)};
                    u32x4 w; w.x = cvt_pk_bf16(v0[0], v0[1]); w.y = cvt_pk_bf16(v0[2], v0[3]); w.z = cvt_pk_bf16(v1[0], v1[1]); w.w = cvt_pk_bf16(v1[2], v1[3]);
                    *(u32x4*)(rowp + bj * HALF) = w; } }
    }
};
struct EpiSwi {
    static constexpr bool PERM = true, AFTER_DRAIN = false;
    bf16_t* HID;
    __device__ __forceinline__ void operator()(const f32x4 (&acc)[2][2][4][2], const Unit& u, int wr, int wc, int fr, int fq) const {
        const int row0 = u.pm * BM + wr * 64 + fr, col0 = 128 * u.pn + wc * 32 + 8 * fq;
#pragma unroll
        for (int ai = 0; ai < 2; ++ai)
#pragma unroll
            for (int m = 0; m < 4; ++m) { bf16_t* rowp = HID + (size_t)(row0 + ai * HALF + m * 16) * ::DFF + col0;
                const f32x4 g0 = acc[ai][0][m][0], g1 = acc[ai][0][m][1], u0 = acc[ai][1][m][0], u1 = acc[ai][1][m][1];
                u32x4 w; w.x = cvt_pk_bf16(::siluf_(g0[0]) * u0[0], ::siluf_(g0[1]) * u0[1]); w.y = cvt_pk_bf16(::siluf_(g0[2]) * u0[2], ::siluf_(g0[3]) * u0[3]);
                w.z = cvt_pk_bf16(::siluf_(g1[0]) * u1[0], ::siluf_(g1[1]) * u1[1]); w.w = cvt_pk_bf16(::siluf_(g1[2]) * u1[2], ::siluf_(g1[3]) * u1[3]);
                *(u32x4*)rowp = w; }
    }
};
struct Mix2Order {
    int G, c;
    __device__ __forceinline__ bool next(int i, Unit& u) const {
        const int L = i * G + c; if (L >= 4 * (::MP / 256)) return false;
        const int which = L / (2 * (::MP / 256)), rem = L % (2 * (::MP / 256));
        u.pm = which * ::NPANEL + (rem >> 1); u.pn = which * 2 + (rem & 1); return true;
    }
    __device__ __forceinline__ void a_ready(const Unit&) const {}
    __device__ __forceinline__ void done(const Unit&) const {}
};

template <class Epi, class Sched, bool ALIGN_EPI = false, bool SP2 = false>
__device__ __forceinline__ void gemm_phase(PG8_LAS unsigned char* lds, const Gemm g, const Sched& S, const Epi& E) {
    int tid_ = threadIdx.x; asm volatile("" : "+v"(tid_));
    const int tid = tid_, wid = __builtin_amdgcn_readfirstlane(tid >> 6), lane = tid & 63, wr = wid >> 2, wc = wid & 3, fr = lane & 15, fq = lane >> 4;
    const int K = g.K, nt = K / BK;
    unsigned voffA[2], voffB[2];
#pragma unroll
    for (int i = 0; i < 2; ++i) { int R, C; stage_rc(tid * 16 + i * 8192, R, C); const int Rb = Epi::PERM ? ((R & ~31) + perm32(R & 31)) : R;
        voffA[i] = (unsigned)(R * K + C) * 2u; voffB[i] = (unsigned)(Rb * K + C) * 2u; }
    const size_t kstep = (size_t)(BK * 2);
    const size_t hstep = (size_t)HALF * K * 2;
    const size_t tstep = 2 * hstep;
    const unsigned ldsw = (unsigned)wid * 1024u;
    const int aoff = lds_byte(wr * 64 + fr, fq * 8), boff = lds_byte(wc * 32 + fr, fq * 8);
#define PG8_SA(b, h) (((b) * 2 + (h)) * HTB)
#define PG8_SB(b, h) ((4 + (b) * 2 + (h)) * HTB)
#define PG8_STAGE(bufoff, gbase, voff) do { _Pragma("unroll") for (int _i = 0; _i < 2; ++_i) \
        __builtin_amdgcn_global_load_lds((const unsigned*)((const char*)(gbase) + (voff)[_i]), (PG8_LAS unsigned*)(lds + (bufoff) + ldsw + _i * 8192), 16, 0, 0); } while (0)
#define PG8_LDA(dst, b, h) do { _Pragma("unroll") for (int m = 0; m < 4; ++m) _Pragma("unroll") for (int k = 0; k < 2; ++k) dst[m][k] = *(const PG8_LAS bf16x8*)(lds + PG8_SA(b, h) + aoff + m * 2048 + k * 1024); } while (0)
#define PG8_LDB(dst, b, h) do { _Pragma("unroll") for (int n = 0; n < 2; ++n) _Pragma("unroll") for (int k = 0; k < 2; ++k) dst[n][k] = *(const PG8_LAS bf16x8*)(lds + PG8_SB(b, h) + boff + n * 2048 + k * 1024); } while (0)
#define PG8_MMA(ai, bj, At, Bt) do { __builtin_amdgcn_s_setprio(1); _Pragma("unroll") for (int m = 0; m < 4; ++m) _Pragma("unroll") for (int n = 0; n < 2; ++n) _Pragma("unroll") for (int k = 0; k < 2; ++k) \
        acc[ai][bj][m][n] = __builtin_amdgcn_mfma_f32_16x16x32_bf16(Bt[n][k], At[m][k], acc[ai][bj][m][n], 0, 0, 0); __builtin_amdgcn_s_setprio(0); } while (0)
#define PG8_WAIT_V(n) asm volatile("s_waitcnt vmcnt(" #n ")" ::: "memory")
#define PG8_WAIT_L(n) asm volatile("s_waitcnt lgkmcnt(" #n ")" ::: "memory")
#define PG8_BAR __builtin_amdgcn_s_barrier()
#define PG8_SCHED __builtin_amdgcn_sched_barrier(0)
    Unit cur, nxt; int ui = 0;
    if (!S.next(0, cur)) return;
    f32x4 acc[2][2][4][2];
#pragma unroll
    for (int a = 0; a < 2; ++a)
#pragma unroll
        for (int b = 0; b < 2; ++b)
#pragma unroll
            for (int m = 0; m < 4; ++m)
#pragma unroll
                for (int n = 0; n < 2; ++n) acc[a][b][m][n] = (f32x4){0.f, 0.f, 0.f, 0.f};
    bf16x8 At[4][2], B0[2][2], B1[2][2];
    const char* cA = (const char*)g.A + (size_t)cur.pm * tstep; const char* cB = (const char*)g.Bt + (size_t)cur.pn * tstep;
    S.a_ready(cur);
    if constexpr (SP2) {
        PG8_STAGE(PG8_SB(0, 0), cB, voffB); PG8_STAGE(PG8_SB(0, 1), cB + hstep, voffB); PG8_STAGE(PG8_SA(0, 0), cA, voffA); PG8_STAGE(PG8_SA(0, 1), cA + hstep, voffA);
        if (wr == 1) PG8_BAR;
        PG8_WAIT_V(2); PG8_BAR;
        PG8_STAGE(PG8_SB(1, 0), cB + kstep, voffB); PG8_STAGE(PG8_SA(1, 0), cA + kstep, voffA); PG8_STAGE(PG8_SB(1, 1), cB + hstep + kstep, voffB);
        PG8_WAIT_V(6); PG8_BAR;
    } else {
        PG8_STAGE(PG8_SB(0, 0), cB, voffB); PG8_STAGE(PG8_SA(0, 0), cA, voffA); PG8_STAGE(PG8_SB(0, 1), cB + hstep, voffB); PG8_STAGE(PG8_SA(0, 1), cA + hstep, voffA);
        if (wr == 1) PG8_BAR;
        PG8_WAIT_V(4); PG8_BAR;
        PG8_STAGE(PG8_SB(1, 0), cB + kstep, voffB); PG8_STAGE(PG8_SA(1, 0), cA + kstep, voffA); PG8_STAGE(PG8_SB(1, 1), cB + hstep + kstep, voffB);
        PG8_WAIT_V(6); PG8_BAR;
    }
    for (;;) {
        const bool has_next = S.next(ui + 1, nxt);
        const char* nA = has_next ? (const char*)g.A + (size_t)nxt.pm * tstep : cA; const char* nB = has_next ? (const char*)g.Bt + (size_t)nxt.pn * tstep : cB;
        for (int t = 0; t < nt; t += 2) {
            const bool last = (t == nt - 2);
            const char* a1 = cA + (size_t)(t + 1) * kstep;
            const char* a2 = last ? nA : cA + (size_t)(t + 2) * kstep; const char* b2 = last ? nB : cB + (size_t)(t + 2) * kstep;
            const char* a3 = a2 + kstep; const char* b3 = b2 + kstep;
            if (last && has_next) S.a_ready(nxt);
            if constexpr (SP2) {
            PG8_LDB(B0, 0, 0); PG8_LDB(B1, 0, 1); PG8_SCHED; PG8_LDA(At, 0, 0); PG8_STAGE(PG8_SA(1, 1), a1 + hstep, voffA);
            PG8_WAIT_V(8); PG8_WAIT_L(0); PG8_BAR; PG8_MMA(0, 0, At, B0); PG8_MMA(0, 1, At, B1); PG8_BAR; PG8_SCHED;
            PG8_LDA(At, 0, 1); PG8_STAGE(PG8_SB(0, 0), b2, voffB); PG8_STAGE(PG8_SB(0, 1), b2 + hstep, voffB); PG8_STAGE(PG8_SA(0, 0), a2, voffA);
            PG8_WAIT_V(8); PG8_WAIT_L(0); PG8_BAR; PG8_MMA(1, 0, At, B0); PG8_MMA(1, 1, At, B1); PG8_BAR; PG8_SCHED;
            PG8_LDB(B0, 1, 0); PG8_LDB(B1, 1, 1); PG8_SCHED; PG8_LDA(At, 1, 0); PG8_STAGE(PG8_SA(0, 1), a2 + hstep, voffA);
            PG8_WAIT_V(8); PG8_WAIT_L(0); PG8_BAR; PG8_MMA(0, 0, At, B0); PG8_MMA(0, 1, At, B1); PG8_BAR; PG8_SCHED;
            PG8_LDA(At, 1, 1); PG8_STAGE(PG8_SB(1, 0), b3, voffB); PG8_STAGE(PG8_SB(1, 1), b3 + hstep, voffB); PG8_STAGE(PG8_SA(1, 0), a3, voffA);
            PG8_WAIT_V(8); PG8_WAIT_L(0); PG8_BAR; PG8_MMA(1, 0, At, B0); PG8_MMA(1, 1, At, B1); PG8_BAR; PG8_SCHED;
            } else {
            PG8_LDB(B0, 0, 0); PG8_SCHED; PG8_LDA(At, 0, 0); PG8_STAGE(PG8_SA(1, 1), a1 + hstep, voffA);
            PG8_WAIT_L(8); PG8_BAR; PG8_WAIT_L(0); PG8_MMA(0, 0, At, B0); PG8_BAR; PG8_SCHED;
            PG8_LDB(B1, 0, 1); PG8_STAGE(PG8_SB(0, 0), b2, voffB);
            PG8_BAR; PG8_WAIT_L(0); PG8_MMA(0, 1, At, B1); PG8_BAR;
            PG8_LDA(At, 0, 1); PG8_STAGE(PG8_SA(0, 0), a2, voffA);
            PG8_BAR; PG8_WAIT_L(0); PG8_MMA(1, 0, At, B0); PG8_BAR; PG8_SCHED;
            PG8_STAGE(PG8_SB(0, 1), b2 + hstep, voffB);
            PG8_WAIT_V(6); PG8_BAR; PG8_MMA(1, 1, At, B1); PG8_BAR;
            PG8_LDB(B0, 1, 0); PG8_SCHED; PG8_LDA(At, 1, 0); PG8_STAGE(PG8_SA(0, 1), a2 + hstep, voffA);
            PG8_WAIT_L(8); PG8_BAR; PG8_WAIT_L(0); PG8_MMA(0, 0, At, B0); PG8_BAR; PG8_SCHED;
            PG8_LDB(B1, 1, 1); PG8_STAGE(PG8_SB(1, 0), b3, voffB);
            PG8_BAR; PG8_WAIT_L(0); PG8_MMA(0, 1, At, B1); PG8_BAR;
            PG8_LDA(At, 1, 1); PG8_STAGE(PG8_SA(1, 0), a3, voffA);
            PG8_BAR; PG8_WAIT_L(0); PG8_MMA(1, 0, At, B0); PG8_BAR; PG8_SCHED;
            PG8_STAGE(PG8_SB(1, 1), b3 + hstep, voffB);
            PG8_WAIT_V(6); PG8_BAR; PG8_MMA(1, 1, At, B1); PG8_BAR;
            }
        }
        if constexpr (ALIGN_EPI) { if (wr == 0) PG8_BAR; }
        if constexpr (!Epi::AFTER_DRAIN) { E(acc, cur, wr, wc, fr, fq);
#if PROBE_EPI2
            if constexpr (Epi::PERM) { asm volatile("" ::: "memory"); E(acc, cur, wr, wc, fr, fq); }
#endif
            S.done(cur); }
        if (!has_next) break;
#pragma unroll
        for (int a = 0; a < 2; ++a)
#pragma unroll
            for (int b = 0; b < 2; ++b)
#pragma unroll
                for (int m = 0; m < 4; ++m)
#pragma unroll
                    for (int n = 0; n < 2; ++n) acc[a][b][m][n] = (f32x4){0.f, 0.f, 0.f, 0.f};
        cur = nxt; cA = nA; cB = nB; ++ui;
        if constexpr (ALIGN_EPI) { if (wr == 1) PG8_BAR; }
    }
    PG8_WAIT_V(0);
    if constexpr (!ALIGN_EPI) { if (wr == 0) PG8_BAR; }
    PG8_BAR;
    if constexpr (Epi::AFTER_DRAIN) { E.fused(acc, cur, wr, wc, fr, fq, lds, wid, lane); S.done(cur); }
#undef PG8_SA
#undef PG8_SB
#undef PG8_STAGE
#undef PG8_LDA
#undef PG8_LDB
#undef PG8_MMA
#undef PG8_WAIT_V
#undef PG8_WAIT_L
#undef PG8_BAR
#undef PG8_SCHED
}
}
#define XB_TMO      128
#define XB_XCNT(j)  (256  + 64 * (j))
#define XB_XSUB(j)  (1280 + 64 * (j))
#define XB_XGEN(j)  (2304 + 64 * (j))
#define XB_TOP      3328
#define XB_TOPGEN   3392
#define XCD_BAR_WORDS 3456
#define XB_SPIN_CAP (1u << 18)

__device__ __forceinline__ unsigned xb_ld(unsigned* p)              { return __hip_atomic_load(p, __ATOMIC_RELAXED, __HIP_MEMORY_SCOPE_AGENT); }
__device__ __forceinline__ unsigned xb_add(unsigned* p, unsigned v) { return __hip_atomic_fetch_add(p, v, __ATOMIC_RELAXED, __HIP_MEMORY_SCOPE_AGENT); }
__device__ __forceinline__ unsigned xb_xcc_id() { return (unsigned)__builtin_amdgcn_s_getreg((3 << 11) | 20) & 0xFu; }
#define XB_SPIN(cond, bar) do { unsigned _sp = 0; while (cond) { __builtin_amdgcn_s_sleep(1); \
    if ((++_sp & 255u) == 0u) { if (xb_ld(&(bar)[XB_TMO])) break; if (_sp > XB_SPIN_CAP) { atomicAdd(&(bar)[XB_TMO], 1u); break; } } } } while (0)

struct XcdBarrier {
    unsigned* bar; unsigned x;
    volatile LAS unsigned* st;
};

__device__ __forceinline__ XcdBarrier xcd_barrier_post(unsigned* bar, volatile LAS unsigned* st) {
    XcdBarrier b; b.bar = bar; b.x = xb_xcc_id(); b.st = st;
    if (threadIdx.x == 0) (void)xb_add(&bar[XB_XCNT(b.x)], 1u);
    return b;
}
__device__ __forceinline__ void xcd_barrier_complete(unsigned* bar, unsigned x, unsigned& nloc, unsigned& nx) {
    const unsigned G = gridDim.x * gridDim.y * gridDim.z;
    unsigned sum, cnt, mine, sp = 0u;
    for (;;) {
        sum = 0u; cnt = 0u; mine = 0u;
#pragma unroll
        for (unsigned j = 0; j < 16; ++j) { const unsigned c = xb_ld(&bar[XB_XCNT(j)]); sum += c; cnt += (c > 0u) ? 1u : 0u; mine = (j == x) ? c : mine; }
        if (sum == G) break;
        __builtin_amdgcn_s_sleep(1);
        if ((++sp & 255u) == 0u) { if (xb_ld(&bar[XB_TMO])) break; if (sp > XB_SPIN_CAP) { atomicAdd(&bar[XB_TMO], 1u); break; } }
    }
    nloc = mine > 0u ? mine : 1u; nx = cnt > 0u ? cnt : 1u;
}

__device__ __forceinline__ void xcd_barrier(const XcdBarrier& b) {
    asm volatile("s_waitcnt vmcnt(0)" ::: "memory");
    __syncthreads();
    if (threadIdx.x == 0) {
        unsigned* bar = b.bar;
        __builtin_amdgcn_s_waitcnt(0);
        unsigned nloc = b.st[0], nx = b.st[1];
        if (nloc == 0u) { xcd_barrier_complete(bar, b.x, nloc, nx); b.st[0] = nloc; b.st[1] = nx; }
        const unsigned old = xb_add(&bar[XB_XSUB(b.x)], 1u);
        const unsigned gen = old / nloc;
        if (old + 1u == (gen + 1u) * nloc) {
            __builtin_amdgcn_fence(__ATOMIC_RELEASE, "agent");
            asm volatile("s_waitcnt vmcnt(0)" ::: "memory");
            const unsigned og = xb_add(&bar[XB_TOP], 1u);
            const unsigned tg = og / nx;
            if (og + 1u == (tg + 1u) * nx) xb_add(&bar[XB_TOPGEN], 1u);
            else XB_SPIN(xb_ld(&bar[XB_TOPGEN]) == tg, bar);
            __builtin_amdgcn_fence(__ATOMIC_ACQUIRE, "agent");
            xb_add(&bar[XB_XGEN(b.x)], 1u);
            asm volatile("s_waitcnt vmcnt(0)" ::: "memory");
        } else {
            XB_SPIN(xb_ld(&bar[XB_XGEN(b.x)]) == gen, bar);
            __builtin_amdgcn_fence(__ATOMIC_ACQUIRE, "agent");
            asm volatile("s_waitcnt vmcnt(0)" ::: "memory");
        }
    }
    __syncthreads();
}
struct Args { const float* in[N_IN]; float* out; unsigned char* ws; int ph_lo, ph_hi, pad0, pad1; };
static_assert(sizeof(Args) == (N_IN + 2) * 8 + 16, "Args has no padding");
struct DevArgs { const GAS float* in[N_IN]; GAS float* out; GAS unsigned char* ws; int ph_lo, ph_hi, pad0, pad1; };
static_assert(sizeof(DevArgs) == sizeof(Args), "DevArgs mirrors Args");
typedef const __attribute__((address_space(4))) DevArgs* KArgs;
#define INP(i) ((const float*)F.ka->in[i])
struct Frame {
    LAS unsigned char* lds;
    int tid, lane, wave, vcu, G;
    KArgs ka;
    float* out; unsigned char* ws;
};
__device__ __forceinline__ const float* modp(const Frame& F, int layer) { return (const float*)(F.ws + WS_MOD) + (size_t)layer * 12 * NMOD; }
__device__ __forceinline__ unsigned char* lw(const Frame& F, int layer) { return F.ws + WS_W + (size_t)layer * LW; }

__device__ __forceinline__ void transpose_item(const float* W, int K, int N, bf16* WT, int k0, int n0, int orow0, LAS float* scr, int lane) {
#pragma unroll 8
    for (int i = 0; i < 32; ++i) { const int kk = 2 * i + (lane >> 5); scr[kk * 33 + (lane & 31)] = W[(size_t)(k0 + kk) * N + n0 + (lane & 31)]; }
    LDS_WAIT(); asm volatile("" ::: "memory");
    const int c = lane & 7;
#pragma unroll
    for (int j = 0; j < 4; ++j) { const int n = (lane >> 3) + 8 * j; const LAS float* s = scr + (8 * c) * 33 + n;
        v4u o; o.x = pk2(s[0 * 33], s[1 * 33]); o.y = pk2(s[2 * 33], s[3 * 33]); o.z = pk2(s[4 * 33], s[5 * 33]); o.w = pk2(s[6 * 33], s[7 * 33]);
        *(GAS v4u*)(WT + (size_t)(orow0 + n) * K + k0 + 8 * c) = o; }
    LDS_WAIT(); asm volatile("" ::: "memory");
}
__device__ __forceinline__ void p0a_phase(Frame& F) {
    const int gw = F.vcu * NWAVES + F.wave, NGW = F.G * NWAVES, gt = F.vcu * (NWAVES * 64) + F.tid, NGT = F.G * NWAVES * 64;
    {
        LAS float* sil = (LAS float*)F.lds;
        for (int i = F.tid; i < 12 * DM; i += NWAVES * 64) { const int b = i / DM, k = i % DM;
            const float c = b < NBP ? INP(I_CP)[b * DM + k] : INP(I_CS)[(b - NBP) * DM + k]; sil[k * 12 + b] = siluf_(c); }
        __syncthreads();
        constexpr int KC = DM / KSPLIT, NCB = NMOD / 256;
        float* part = (float*)(F.ws + WS_MODP);
        for (int it = gw; it < NL * KSPLIT * NCB; it += NGW) {
            const int l = it / (KSPLIT * NCB), ks = (it / NCB) % KSPLIT, cb = it % NCB, col = cb * 256 + 4 * F.lane;
            const GAS f32x4* wp = (const GAS f32x4*)(INP(I_ADAW) + ((size_t)l * DM + ks * KC) * NMOD + col);
            f32x4 acc[12];
#pragma unroll
            for (int b = 0; b < 12; ++b) acc[b] = (f32x4){0.f, 0.f, 0.f, 0.f};
#pragma unroll 4
            for (int k = 0; k < KC; ++k) { const f32x4 wv = wp[(size_t)k * (NMOD / 4)];
                const LAS f32x4* sp = (const LAS f32x4*)(sil + (ks * KC + k) * 12); const f32x4 s0 = sp[0], s1 = sp[1], s2 = sp[2];
                acc[0] += wv * s0[0]; acc[1] += wv * s0[1]; acc[2] += wv * s0[2]; acc[3] += wv * s0[3];
                acc[4] += wv * s1[0]; acc[5] += wv * s1[1]; acc[6] += wv * s1[2]; acc[7] += wv * s1[3];
                acc[8] += wv * s2[0]; acc[9] += wv * s2[1]; acc[10] += wv * s2[2]; acc[11] += wv * s2[3]; }
#pragma unroll
            for (int b = 0; b < 12; ++b) *(GAS f32x4*)(part + (((size_t)ks * NL + l) * 12 + b) * NMOD + col) = acc[b];
        }
        __syncthreads();
    }
    {
        LAS float* scr = (LAS float*)(F.lds + F.wave * 16384);
        constexpr int I_IN = (DM / 64) * (DIN / 32), I_OUT = (DM / 64) * (DM / 32), I_G = (DM / 64) * (DFF / 32), I_D = (DFF / 64) * (DM / 32), I_C = (DC / 64) * (DC / 32);
        constexpr int PER_L = I_IN + I_OUT + 2 * I_G + I_D + I_C;
        for (int it = gw; it < NL * PER_L; it += NGW) {
            const int l = it / PER_L; int r = it % PER_L; unsigned char* wl = lw(F, l);
            if (r < I_IN) { const int nblk = DIN / 32, k0 = 64 * (r / nblk), n0 = 32 * (r % nblk);
                int orow0 = n0; if (n0 < 512) orow0 = 256 * (n0 >> 7) + (n0 & 127); else if (n0 < 1024) orow0 = 256 * ((n0 - 512) >> 7) + 128 + (n0 & 127);
                transpose_item(INP(I_WIN) + (size_t)l * DM * DIN, DM, DIN, (bf16*)(wl + LW_WIN), k0, n0, orow0, scr, F.lane); continue; } r -= I_IN;
            if (r < I_OUT) { const int nblk = DM / 32, k0 = 64 * (r / nblk), n0 = 32 * (r % nblk);
                transpose_item(INP(I_WOUT) + (size_t)l * DM * DM, DM, DM, (bf16*)(wl + LW_WOUT), k0, n0, n0, scr, F.lane); continue; } r -= I_OUT;
            if (r < 2 * I_G) { const int up = r >= I_G; if (up) r -= I_G; const int nblk = DFF / 32, k0 = 64 * (r / nblk), n0 = 32 * (r % nblk);
                const int orow0 = 256 * (n0 >> 7) + 128 * up + (n0 & 127);
                transpose_item(INP(up ? I_WU : I_WG) + (size_t)l * DM * DFF, DM, DFF, (bf16*)(wl + LW_WGU), k0, n0, orow0, scr, F.lane); continue; } r -= 2 * I_G;
            if (r < I_D) { const int nblk = DM / 32, k0 = 64 * (r / nblk), n0 = 32 * (r % nblk);
                transpose_item(INP(I_WD) + (size_t)l * DFF * DM, DFF, DM, (bf16*)(wl + LW_WD), k0, n0, n0, scr, F.lane); continue; } r -= I_D;
            { const int nblk = DC / 32, k0 = 64 * (r / nblk), n0 = 32 * (r % nblk);
                transpose_item(INP(I_CPW) + (size_t)l * DC * DC, DC, DC, (bf16*)(wl + LW_CPW), k0, n0, n0, scr, F.lane); }
        }
        for (int i = gt; i < NL * DC * DC; i += NGT) { const int l = i / (DC * DC), n = (i / DC) % DC, k = i % DC; float v = 0.f;
            if ((n >> 7) == (k >> 7)) v = INP(I_POOLW)[(((size_t)l * 4 + (n >> 7)) * 128 + (k & 127)) * 128 + (n & 127)] * INP(I_POOLS)[l * DC + n];
            ((bf16*)(lw(F, l) + LW_PWD))[n * DC + k] = (bf16)(pk2(v, 0.f) & 0xffffu); }
        for (int i = gt; i < NL * 4 * 128 * 128; i += NGT) { const int l = i / 65536, r = i % 65536, ii = (r >> 7) & 127, jj = r & 127;
            const float v = (jj <= ii) ? INP(I_SGW)[i] : 0.f; ((bf16*)(lw(F, l) + LW_SGW))[r] = (bf16)(pk2(v, 0.f) & 0xffffu); }
    }
    __syncthreads();
}
__device__ __forceinline__ void p0b_phase(Frame& F) {
    const int gt = F.vcu * (NWAVES * 64) + F.tid, NGT = F.G * NWAVES * 64;
    const float* part = (const float*)(F.ws + WS_MODP); float* mod = (float*)(F.ws + WS_MOD);
    for (int i = gt; i < NL * 12 * NMOD; i += NGT) { const int l = i / (12 * NMOD), n = i % NMOD; float s = INP(I_ADAB)[l * NMOD + n];
#pragma unroll
        for (int ks = 0; ks < KSPLIT; ++ks) s += part[(size_t)ks * NL * 12 * NMOD + i];
        mod[i] = s; }
}
template <bool COPY>
__device__ __forceinline__ void norm_phase(Frame& F, const float* gain, const float* mod_l, int sh_idx, bf16* H, bf16* XB) {
    const int gw = F.vcu * NWAVES + F.wave, NGW = F.G * NWAVES;
    for (int m = gw; m < MT; m += NGW) {
        f32x4 v[8]; float s = 0.f;
        if (COPY) { const float* src = m < MP ? INP(I_XP) + (size_t)m * DM : INP(I_XS) + (size_t)(m - MP) * DM;
            const GAS f32x4* xr = (const GAS f32x4*)src + F.lane; GAS v2u* xo = (GAS v2u*)(XB + (size_t)m * DM) + F.lane;
#pragma unroll
            for (int j = 0; j < 8; ++j) { const f32x4 t = xr[64 * j]; v2u w; w.x = pk2(t.x, t.y); w.y = pk2(t.z, t.w); xo[64 * j] = w; v[j] = (f32x4){bflo(w.x), bfhi(w.x), bflo(w.y), bfhi(w.y)}; }
        } else { const GAS v2u* xr = (const GAS v2u*)(XB + (size_t)m * DM) + F.lane;
#pragma unroll
            for (int j = 0; j < 8; ++j) { const v2u d = xr[64 * j]; v[j] = (f32x4){bflo(d.x), bfhi(d.x), bflo(d.y), bfhi(d.y)}; } }
#pragma unroll
        for (int j = 0; j < 8; ++j) s += (v[j].x * v[j].x + v[j].y * v[j].y) + (v[j].z * v[j].z + v[j].w * v[j].w);
        const float rstd = 1.0f / sqrtf(wave_sum(s) * (1.0f / DM) + EPS);
        const float* mb = mod_l + (size_t)batch_of_row(m) * NMOD;
        const GAS f32x4* shp = (const GAS f32x4*)(mb + sh_idx * DM) + F.lane; const GAS f32x4* scp = (const GAS f32x4*)(mb + (sh_idx + 1) * DM) + F.lane;
        const GAS f32x4* gp = (const GAS f32x4*)gain + F.lane;
        GAS v2u* o8 = (GAS v2u*)(H + (size_t)m * DM) + F.lane;
#pragma unroll
        for (int j = 0; j < 8; ++j) { const f32x4 g = gp[64 * j], sc = scp[64 * j], sh = shp[64 * j];
            const f32x4 y = v[j] * rstd * g * (sc + 1.0f) + sh; v2u w; w.x = pk2(y.x, y.y); w.y = pk2(y.z, y.w); o8[64 * j] = w; }
    }
}
__device__ __forceinline__ void final_norm_phase(Frame& F, const bf16* XB) {
    const int gw = F.vcu * NWAVES + F.wave, NGW = F.G * NWAVES;
    for (int m = gw; m < MT; m += NGW) {
        GAS f32x4* yr = (GAS f32x4*)(F.out + (size_t)m * DM) + F.lane;
        const GAS v2u* xr = (const GAS v2u*)(XB + (size_t)m * DM) + F.lane;
        f32x4 v[8]; float s = 0.f;
#pragma unroll
        for (int j = 0; j < 8; ++j) { const v2u d = xr[64 * j]; v[j] = (f32x4){bflo(d.x), bfhi(d.x), bflo(d.y), bfhi(d.y)}; s += (v[j].x * v[j].x + v[j].y * v[j].y) + (v[j].z * v[j].z + v[j].w * v[j].w); }
        const float rstd = 1.0f / sqrtf(wave_sum(s) * (1.0f / DM) + EPS);
        const GAS f32x4* gp = (const GAS f32x4*)INP(I_FING) + F.lane;
#pragma unroll
        for (int j = 0; j < 8; ++j) yr[64 * j] = v[j] * rstd * gp[64 * j];
    }
}

__device__ __forceinline__ int crow(int r, int hi) { return (r & 3) + 8 * (r >> 2) + 4 * hi; }
#define MFMA32(a, b, c) __builtin_amdgcn_mfma_f32_32x32x16_bf16((a), (b), (c), 0, 0, 0)
constexpr int AT_KP = 144, AT_VP = 192, AT_KB = 64 * AT_KP, AT_VB = 64 * AT_VP;
constexpr int AT_K0 = 0, AT_V0 = 2 * AT_KB, AT_BT = AT_V0 + 2 * AT_VB;
typedef short v4i16_t __attribute__((ext_vector_type(4)));
__device__ __forceinline__ v2u lds_tr_read(LAS unsigned char* p) { const v4i16_t r = __builtin_amdgcn_ds_read_tr16_b64_v4i16((LAS v4i16_t*)p); return __builtin_bit_cast(v2u, r); }
__device__ __forceinline__ float xhalf_max(float v) { auto rr = __builtin_amdgcn_permlane32_swap(__float_as_uint(v), __float_as_uint(v), false, false); return fmaxf(__uint_as_float(rr[0]), __uint_as_float(rr[1])); }
__device__ __forceinline__ float xhalf_sum(float v) { auto rr = __builtin_amdgcn_permlane32_swap(__float_as_uint(v), __float_as_uint(v), false, false); return __uint_as_float(rr[0]) + __uint_as_float(rr[1]); }
__device__ __forceinline__ void attn_unit(Frame& F, int layer, bool sample, int b, int h, int qg, const bf16* Z, bf16* MIX) {
    const int tid = F.tid, lane = F.lane, w = F.wave, l31 = lane & 31, hh = lane >> 5;
    LAS float* bt = (LAS float*)(F.lds + AT_BT);
    if (tid < 257) bt[tid] = INP(I_RELB)[((size_t)layer * 8 + h) * 257 + tid] * LOG2E;
    const bool wave_on = sample ? (w == 0) : true;
    const int qpos = sample ? l31 : 256 * qg + 32 * w + l31;
    const int qrow = sample ? MP + 32 * b + l31 : b * SEQ + qpos;
    bf16x8 qr[4];
#pragma unroll
    for (int d0 = 0; d0 < 4; ++d0) qr[d0] = *(const GAS bf16x8*)(Z + (size_t)qrow * ZW + ZQ + 64 * h + 16 * d0 + 8 * hh);
    f32x16 o0, o1;
#pragma unroll
    for (int r = 0; r < 16; ++r) { o0[r] = 0.f; o1[r] = 0.f; }
    float mrun = -1e30f, lrun = 0.f;
    const int ntile = sample ? 9 : 12, qc = 4 * qg + (w >> 1);
    const int jstart = sample ? 0 : (4 * qg >= 8 ? 0 : 8 - 4 * qg);
    const int sr = tid >> 3, sch = tid & 7;
    const float* ck = INP(I_CK) + ((size_t)layer * NBS + b) * 512 * 512; const float* cv = INP(I_CV) + ((size_t)layer * NBS + b) * 512 * 512;
    v4u kreg = (v4u){0u, 0u, 0u, 0u}, vreg = (v4u){0u, 0u, 0u, 0u};
#define AT_LOAD(j) do { \
        if (!sample) { const bf16* zr_ = Z + (size_t)(b * SEQ + 64 * (4 * qg - 8 + (j)) + sr) * ZW + 64 * h + 8 * sch; kreg = *(const GAS v4u*)(zr_ + ZK); vreg = *(const GAS v4u*)(zr_ + ZV); } \
        else if ((j) < 8) { const size_t o_ = ((size_t)(64 * (j) + sr) * 8 + h) * 64 + 8 * sch; \
                const f32x4 k0_ = *(const GAS f32x4*)(ck + o_), k1_ = *(const GAS f32x4*)(ck + o_ + 4), v0_ = *(const GAS f32x4*)(cv + o_), v1_ = *(const GAS f32x4*)(cv + o_ + 4); \
                kreg = (v4u){pk2(k0_.x, k0_.y), pk2(k0_.z, k0_.w), pk2(k1_.x, k1_.y), pk2(k1_.z, k1_.w)}; vreg = (v4u){pk2(v0_.x, v0_.y), pk2(v0_.z, v0_.w), pk2(v1_.x, v1_.y), pk2(v1_.z, v1_.w)}; } \
        else if (sr < 32) { const bf16* zr_ = Z + (size_t)(MP + 32 * b + sr) * ZW + 64 * h + 8 * sch; kreg = *(const GAS v4u*)(zr_ + ZK); vreg = *(const GAS v4u*)(zr_ + ZV); } \
        else { kreg = (v4u){0u, 0u, 0u, 0u}; vreg = (v4u){0u, 0u, 0u, 0u}; } } while (0)
#define AT_STORE(bf_) do { *(LAS v4u*)(F.lds + AT_K0 + (bf_) * AT_KB + sr * AT_KP + sch * 16) = kreg; *(LAS v4u*)(F.lds + AT_V0 + (bf_) * AT_VB + sr * AT_VP + sch * 16) = vreg; } while (0)
    AT_LOAD(jstart); AT_STORE(0);
    __syncthreads();
    const int tro = ((lane & 15) >> 2) * AT_VP + (16 * ((lane >> 4) & 1) + 4 * (lane & 3)) * 2 + 4 * hh * AT_VP;
    int buf = 0;
    for (int j = jstart; j < ntile; ++j) {
        const int kc = 4 * qg - 8 + j;
        const bool more = j + 1 < ntile;
        if (more) AT_LOAD(j + 1);
        const bool active = sample ? (w == 0) : (kc >= qc - 8 && kc <= qc);
        if (active) {
            LAS unsigned char* Ks = F.lds + AT_K0 + buf * AT_KB; LAS unsigned char* Vs = F.lds + AT_V0 + buf * AT_VB + tro;
            f32x16 p0, p1;
#pragma unroll
            for (int r = 0; r < 16; ++r) { p0[r] = 0.f; p1[r] = 0.f; }
#pragma unroll
            for (int d0 = 0; d0 < 4; ++d0) {
                const bf16x8 a0 = *(const LAS bf16x8*)(Ks + l31 * AT_KP + (16 * d0 + 8 * hh) * 2);
                const bf16x8 a1 = *(const LAS bf16x8*)(Ks + (32 + l31) * AT_KP + (16 * d0 + 8 * hh) * 2);
                p0 = MFMA32(a0, qr[d0], p0); p1 = MFMA32(a1, qr[d0], p1);
            }
            const int kbase = sample ? 64 * j - 512 : 64 * kc;
            const int relb = kbase - qpos;
            const int qmin = sample ? 0 : 256 * qg + 32 * w;
            float boff = 0.f;
            if (kbase + 63 - qmin <= -128) boff = bt[0];
            else {
#pragma unroll
                for (int r = 0; r < 16; ++r) { const int kv = crow(r, hh); int i0 = relb + kv, i1 = i0 + 32;
                    i0 = (i0 < -128 ? -128 : (i0 > 128 ? 128 : i0)) + 128; i1 = (i1 < -128 ? -128 : (i1 > 128 ? 128 : i1)) + 128;
                    p0[r] += bt[i0]; p1[r] += bt[i1]; }
            }
            if (sample && j == 8) {
#pragma unroll
                for (int r = 0; r < 16; ++r) p1[r] = -1e30f;
            }
            float mx = p0[0];
#pragma unroll
            for (int r = 1; r < 16; ++r) mx = fmaxf(mx, p0[r]);
#pragma unroll
            for (int r = 0; r < 16; ++r) mx = fmaxf(mx, p1[r]);
            mx = xhalf_max(mx) + boff;
            const float mn = fmaxf(mrun, mx), msub = mn - boff;
            if (__builtin_amdgcn_ballot_w64(mn > mrun) != 0ull) {
                const float alpha = fast_exp2(mrun - mn); lrun *= alpha;
#pragma unroll
                for (int r = 0; r < 16; ++r) { o0[r] *= alpha; o1[r] *= alpha; }
            }
            mrun = mn;
            float rs = 0.f;
#pragma unroll
            for (int r = 0; r < 16; ++r) { p0[r] = fast_exp2(p0[r] - msub); p1[r] = fast_exp2(p1[r] - msub); rs += p0[r] + p1[r]; }
            lrun += xhalf_sum(rs);
            bf16x8 pf[4];
            { v4u t;
              t = (v4u){pk2(p0[0], p0[1]), pk2(p0[2], p0[3]), pk2(p0[4], p0[5]), pk2(p0[6], p0[7])}; pf[0] = __builtin_bit_cast(bf16x8, t);
              t = (v4u){pk2(p0[8], p0[9]), pk2(p0[10], p0[11]), pk2(p0[12], p0[13]), pk2(p0[14], p0[15])}; pf[1] = __builtin_bit_cast(bf16x8, t);
              t = (v4u){pk2(p1[0], p1[1]), pk2(p1[2], p1[3]), pk2(p1[4], p1[5]), pk2(p1[6], p1[7])}; pf[2] = __builtin_bit_cast(bf16x8, t);
              t = (v4u){pk2(p1[8], p1[9]), pk2(p1[10], p1[11]), pk2(p1[12], p1[13]), pk2(p1[14], p1[15])}; pf[3] = __builtin_bit_cast(bf16x8, t); }
#pragma unroll
            for (int xt = 0; xt < 2; ++xt)
#pragma unroll
                for (int s = 0; s < 2; ++s) { const int ro = (32 * xt + 16 * s) * AT_VP;
                    const v2u lo0 = lds_tr_read(Vs + ro), hi0 = lds_tr_read(Vs + ro + 8 * AT_VP);
                    const v2u lo1 = lds_tr_read(Vs + ro + 64), hi1 = lds_tr_read(Vs + ro + 8 * AT_VP + 64);
                    const v4u f0 = (v4u){lo0.x, lo0.y, hi0.x, hi0.y}, f1 = (v4u){lo1.x, lo1.y, hi1.x, hi1.y};
                    o0 = MFMA32(__builtin_bit_cast(bf16x8, f0), pf[2 * xt + s], o0); o1 = MFMA32(__builtin_bit_cast(bf16x8, f1), pf[2 * xt + s], o1); }
        }
        if (more) AT_STORE(buf ^ 1);
        __syncthreads();
        buf ^= 1;
    }
#undef AT_LOAD
#undef AT_STORE
    if (wave_on) {
        const float inv = 1.0f / lrun;
        bf16* orow = MIX + (size_t)qrow * MIXW + MIX_B + 64 * h;
#pragma unroll
        for (int g4 = 0; g4 < 4; ++g4) { const int d = 8 * g4 + 4 * hh;
            v2u w0; w0.x = pk2(o0[4 * g4] * inv, o0[4 * g4 + 1] * inv); w0.y = pk2(o0[4 * g4 + 2] * inv, o0[4 * g4 + 3] * inv); *(GAS v2u*)(orow + d) = w0;
            v2u w1; w1.x = pk2(o1[4 * g4] * inv, o1[4 * g4 + 1] * inv); w1.y = pk2(o1[4 * g4 + 2] * inv, o1[4 * g4 + 3] * inv); *(GAS v2u*)(orow + 32 + d) = w1; }
    }
}
__device__ __forceinline__ unsigned sg_off(unsigned row, unsigned ch) { return 256u * row + 16u * (ch ^ (((row & 3u) << 2) | ((row >> 2) & 3u))); }
__device__ __forceinline__ void sg_unit(Frame& F, int layer, int ci, const bf16* Z, bf16* MIX) {
    const int lane = F.lane, w = F.wave, l31 = lane & 31, hh = lane >> 5;
    const bool sample = ci >= MP / 128; const int L = sample ? 32 : 128, row0 = sample ? MP + 32 * (ci - MP / 128) : 128 * ci;
    LAS unsigned char* VN = F.lds;
    {
        const int c8 = 8 * lane;
        const GAS f32x4* lgp = (const GAS f32x4*)(INP(I_SGG) + layer * DC + c8); const GAS f32x4* lbp = (const GAS f32x4*)(INP(I_SGB) + layer * DC + c8);
        const f32x4 lg0 = lgp[0], lg1 = lgp[1], lb0 = lbp[0], lb1 = lbp[1];
        const int nrw = L / 8;
        LAS unsigned char* vbase = VN + (lane >> 4) * 32768;
        v4u zrow[16];
#pragma unroll
        for (int i = 0; i < 16; ++i) { if (i < nrw) zrow[i] = *(const GAS v4u*)(Z + (size_t)(row0 + w * nrw + i) * ZW + ZSV + c8); else zrow[i] = (v4u){0u, 0u, 0u, 0u}; }
#pragma unroll
        for (int i = 0; i < 16; ++i) { if (i < nrw) { const int rr = w * nrw + i;
            const v4u zv = zrow[i];
            float x[8] = {bflo(zv.x), bfhi(zv.x), bflo(zv.y), bfhi(zv.y), bflo(zv.z), bfhi(zv.z), bflo(zv.w), bfhi(zv.w)};
            const float s = ((x[0] + x[1]) + (x[2] + x[3])) + ((x[4] + x[5]) + (x[6] + x[7]));
            const float mean = wave_sum(s) * (1.0f / DC); float q = 0.f;
#pragma unroll
            for (int e = 0; e < 8; ++e) { x[e] -= mean; q += x[e] * x[e]; }
            const float rstd = 1.0f / sqrtf(wave_sum(q) * (1.0f / DC) + EPS);
            float y[8];
            y[0] = x[0] * rstd * lg0.x + lb0.x; y[1] = x[1] * rstd * lg0.y + lb0.y; y[2] = x[2] * rstd * lg0.z + lb0.z; y[3] = x[3] * rstd * lg0.w + lb0.w;
            y[4] = x[4] * rstd * lg1.x + lb1.x; y[5] = x[5] * rstd * lg1.y + lb1.y; y[6] = x[6] * rstd * lg1.z + lb1.z; y[7] = x[7] * rstd * lg1.w + lb1.w;
            *(LAS v4u*)(vbase + sg_off((unsigned)rr, (unsigned)(lane & 15))) = (v4u){pk2(y[0], y[1]), pk2(y[2], y[3]), pk2(y[4], y[5]), pk2(y[6], y[7])};
            if (sample) { float* so = F.out + O_SGV + (((size_t)layer * NBS + (ci - MP / 128)) * TS + rr) * DC + c8;
                *(GAS f32x4*)so = (f32x4){y[0], y[1], y[2], y[3]}; *(GAS f32x4*)(so + 4) = (f32x4){y[4], y[5], y[6], y[7]}; }
        } }
    }
    __syncthreads();
    {
        const int g = w >> 1;
        const GAS bf16* Wg = (const GAS bf16*)((const bf16*)(lw(F, layer) + LW_SGW) + (size_t)g * 128 * 128 + (size_t)l31 * 128 + 8 * hh); asm volatile("" : "+v"(Wg));
        LAS unsigned char* vg = VN + g * 32768;
        const int nib = L / 32;
        const unsigned blk = (lane >> 4) & 1, q = (lane & 15) >> 2, p4 = lane & 3;
        bf16x8 Bf[4][8];
#pragma unroll
        for (int ib = 0; ib < 4; ++ib)
#pragma unroll
            for (int s = 0; s < 8; ++s) { if (s < 2 * (ib + 1)) { if (ib < nib) Bf[ib][s] = *(const GAS bf16x8*)(Wg + (32 * ib) * 128 + 16 * s); else Bf[ib][s] = (bf16x8){0, 0, 0, 0, 0, 0, 0, 0}; } }
#pragma unroll
        for (int cbb = 0; cbb < 2; ++cbb) { const int cb = 2 * (w & 1) + cbb;
            f32x16 acc[4];
#pragma unroll
            for (int ib = 0; ib < 4; ++ib)
#pragma unroll
                for (int r = 0; r < 16; ++r) acc[ib][r] = 0.f;
#pragma unroll
            for (int s = 0; s < 8; ++s) { if (s < 2 * nib) {
                const v2u a0 = lds_tr_read(vg + sg_off(16u * s + 8u * hh + q, 4u * cb + 2u * blk + (p4 >> 1)) + 8u * (p4 & 1));
                const v2u a1 = lds_tr_read(vg + sg_off(16u * s + 8u * hh + 4u + q, 4u * cb + 2u * blk + (p4 >> 1)) + 8u * (p4 & 1));
                const v4u af = (v4u){a0.x, a0.y, a1.x, a1.y};
#pragma unroll
                for (int ib = 0; ib < 4; ++ib) { if (s < 2 * (ib + 1)) { if (ib < nib) acc[ib] = MFMA32(__builtin_bit_cast(bf16x8, af), Bf[ib][s], acc[ib]); } }
            } }
#pragma unroll
            for (int ib = 0; ib < 4; ++ib) { if (ib < nib) {
                    const int i = 32 * ib + l31, row = row0 + i; const float bias = INP(I_SGBIAS)[((size_t)layer * 4 + g) * 128 + i];
#pragma unroll
                    for (int rg = 0; rg < 4; ++rg) { const int c4 = 32 * cb + 8 * rg + 4 * hh;
                        const v2u zu = *(const GAS v2u*)(Z + (size_t)row * ZW + ZSU + 128 * g + c4);
                        v2u o; o.x = pk2(bflo(zu.x) * (acc[ib][4 * rg] + bias), bfhi(zu.x) * (acc[ib][4 * rg + 1] + bias)); o.y = pk2(bflo(zu.y) * (acc[ib][4 * rg + 2] + bias), bfhi(zu.y) * (acc[ib][4 * rg + 3] + bias));
                        *(GAS v2u*)(MIX + (size_t)row * MIXW + MIX_D + 128 * g + c4) = o; } } }
        }
    }
    __syncthreads();
}
struct ConvCtx { const GAS unsigned char* zb; const GAS unsigned char* hist; GAS unsigned char* cst; bool sample, first, keep; };
template <int E> __device__ __forceinline__ void conv_load(unsigned (&ex)[62], const ConvCtx& X) {
    if constexpr (E < 30) { if (X.sample) { const f32x2 hv = *(const GAS f32x2*)(X.hist + (size_t)E * DC * 4); ex[E] = pk2(hv.x, hv.y); }
                            else if (X.first) ex[E] = 0u;
                            else ex[E] = *(const GAS unsigned*)(X.zb + (size_t)E * ZW * 2); }
    else ex[E] = *(const GAS unsigned*)(X.zb + (size_t)E * ZW * 2);
}
template <int... Es> __device__ __forceinline__ void conv_loads(unsigned (&ex)[62], const ConvCtx& X, std::integer_sequence<int, Es...>) { (conv_load<Es>(ex, X), ...); }
template <int E> __device__ __forceinline__ void conv_row(f32x2 (&acc)[32], const f32x2 (&wt)[31], const unsigned (&ex)[62], const ConvCtx& X) {
    const f32x2 v = (f32x2){bflo(ex[E]), bfhi(ex[E])};
    constexpr int T0 = E > 30 ? E - 30 : 0, T1 = E < 31 ? E : 31;
#pragma unroll
    for (int t = T0; t <= T1; ++t) acc[t] = wt[E - t] * v + acc[t];
    if constexpr (E >= 32) { if (X.keep) *(GAS f32x2*)(X.cst + (size_t)(E - 32) * DC * 4) = v; }
}
template <int... Es> __device__ __forceinline__ void conv_rows(f32x2 (&acc)[32], const f32x2 (&wt)[31], const unsigned (&ex)[62], const ConvCtx& X, std::integer_sequence<int, Es...>) { (conv_row<Es>(acc, wt, ex, X), ...); }
__device__ __forceinline__ void conv_unit(Frame& F, int layer, int tb, int cq, const bf16* Z, bf16* CA, int ca_pitch) {
    const int c = 128 * cq + 2 * F.lane; const bool sample = tb >= MP / 32; const int sb = tb - MP / 32;
    const int r0 = sample ? MP + 32 * sb : 32 * tb; const bool first = !sample && ((r0 & (SEQ - 1)) == 0);
    ConvCtx X; X.sample = sample; X.first = first; X.keep = sample || ((r0 & (SEQ - 1)) == SEQ - 32);
    X.zb = (const GAS unsigned char*)(Z + ((long)r0 - 30) * ZW + ZU + c); asm volatile("" : "+v"(X.zb));
    const GAS unsigned char* wb = (const GAS unsigned char*)(INP(I_CONVW) + (size_t)layer * 31 * DC + c); asm volatile("" : "+v"(wb));
    f32x2 wt[31];
#pragma unroll
    for (int j = 0; j < 31; ++j) wt[j] = *(const GAS f32x2*)(wb + (size_t)j * DC * 4);
    const f32x2 cbias = *(const GAS f32x2*)(INP(I_CONVB) + layer * DC + c), gg = *(const GAS f32x2*)(INP(I_GNG) + layer * DC + c), gb = *(const GAS f32x2*)(INP(I_GNB) + layer * DC + c);
    f32x2 acc[32];
#pragma unroll
    for (int t = 0; t < 32; ++t) acc[t] = cbias;
    X.hist = (const GAS unsigned char*)(INP(I_CCONV) + ((size_t)layer * NBS + (sample ? sb : 0)) * 30 * DC + c); asm volatile("" : "+v"(X.hist));
    X.cst = (GAS unsigned char*)(sample ? F.out + O_CONVS + ((size_t)layer * NBS + sb) * 30 * DC + c : F.out + O_CONVP + ((size_t)layer * NBP + (r0 >> 13)) * 30 * DC + c); asm volatile("" : "+v"(X.cst));
    GAS unsigned char* cab = (GAS unsigned char*)(CA + (size_t)r0 * ca_pitch + c); asm volatile("" : "+v"(cab));
    unsigned ex[62];
    conv_loads(ex, X, std::make_integer_sequence<int, 62>{});
    conv_rows(acc, wt, ex, X, std::make_integer_sequence<int, 62>{});
#pragma unroll
    for (int t = 0; t < 32; ++t) {
        const f32x2 y = acc[t];
        const float s = half32_sum(y.x + y.y), q = half32_sum(y.x * y.x + y.y * y.y);
        const float mean = s * (1.0f / 64.0f), var = fmaxf(q * (1.0f / 64.0f) - mean * mean, 0.f), rstd = 1.0f / sqrtf(var + EPS);
        const f32x2 n = (y - mean) * rstd * gg + gb;
        *(GAS unsigned*)(cab + (size_t)t * ca_pitch * 2) = pk2(siluf_(n.x), siluf_(n.y));
    }
}
template <int W>
__device__ __forceinline__ void pool_body(Frame& F, int layer, int tb, int cq, const bf16* Z, bf16* PM, int pm_pitch) {
    const int c = 128 * cq + 2 * F.lane; const bool sample = tb >= MP / 32; const int sb = tb - MP / 32;
    const int r0 = sample ? MP + 32 * sb : 32 * tb; const bool first = !sample && ((r0 & (SEQ - 1)) == 0);
    const GAS unsigned char* hist = (const GAS unsigned char*)(INP(I_CPOOL) + ((size_t)layer * NBS + (sample ? sb : 0)) * 15 * DC + c); asm volatile("" : "+v"(hist));
    const bool last_blk = !sample && ((r0 & (SEQ - 1)) == SEQ - 32);
    GAS unsigned char* pst = (GAS unsigned char*)(sample ? F.out + O_POOLS + ((size_t)layer * NBS + sb) * 15 * DC + c : F.out + O_POOLP + ((size_t)layer * NBP + (r0 >> 13)) * 15 * DC + c); asm volatile("" : "+v"(pst));
    const GAS unsigned char* zb = (const GAS unsigned char*)(Z + ((long)r0 - 15) * ZW + ZP + c); asm volatile("" : "+v"(zb));
    GAS unsigned char* pmb = (GAS unsigned char*)(PM + (size_t)r0 * pm_pitch + c); asm volatile("" : "+v"(pmb));
    f32x2 ext[47];
#pragma unroll
    for (int e = 0; e < 47; ++e) {
        if (e < 15) { if (sample) ext[e] = *(const GAS f32x2*)(hist + (size_t)e * DC * 4);
                      else if (first) ext[e] = (f32x2){0.f, 0.f};
                      else { const unsigned u = *(const GAS unsigned*)(zb + (size_t)e * ZW * 2); ext[e] = (f32x2){bflo(u), bfhi(u)}; } }
        else { const unsigned u = *(const GAS unsigned*)(zb + (size_t)e * ZW * 2); ext[e] = (f32x2){bflo(u), bfhi(u)}; }
    }
#pragma unroll
    for (int t = 0; t < 32; ++t) {
        f32x2 win = (f32x2){0.f, 0.f};
#pragma unroll
        for (int i = W - 1; i >= 0; --i) win += ext[15 + t - i];
        const float rc = 1.0f / (float)((first && t + 1 < W) ? t + 1 : W);
        const f32x2 m = win * rc - ext[15 + t];
        *(GAS unsigned*)(pmb + (size_t)t * pm_pitch * 2) = pk2(m.x, m.y);
        if (t >= 17 && (sample || last_blk)) *(GAS f32x2*)(pst + (size_t)(t - 17) * DC * 4) = ext[15 + t];
    }
}
#define MIX_FENCE() do { int t_ = F.tid; asm volatile("" : "+v"(t_)); F.tid = t_; F.lane = t_ & 63; } while (0)
__device__ __forceinline__ void mixer_phase(Frame& F, int layer) {
    const bf16* Z = (const bf16*)(F.ws + WS_Z); bf16* MIX = (bf16*)(F.ws + WS_MIX); bf16* CA = (bf16*)(F.ws + WS_CAPM); bf16* PM = CA + (size_t)MT * DC;
#ifndef PROBE_MIX
#define PROBE_MIX 0
#endif
#define MDUP(k) _Pragma("unroll") for (int mrep_ = 0; mrep_ < 1 + ((PROBE_MIX >> (k)) & 1); ++mrep_)
    MDUP(0) { for (int id = F.vcu; id < NBP * 8 * 32; id += F.G) attn_unit(F, layer, false, id >> 8, (id >> 5) & 7, id & 31, Z, MIX);
    for (int id = F.vcu - 192; id >= 0 && id < NBS * 8; id += F.G) attn_unit(F, layer, true, id >> 3, id & 7, 0, Z, MIX); }
    MIX_FENCE();
    MDUP(1) { for (int id = F.vcu; id < MP / 128; id += F.G) sg_unit(F, layer, id, Z, MIX);
    for (int id = F.vcu - 96; id >= 0 && id < NBS; id += F.G) sg_unit(F, layer, MP / 128 + id, Z, MIX); }
    const int gw = F.vcu * NWAVES + F.wave, NGW = F.G * NWAVES;
    MIX_FENCE();
    MDUP(2) { for (int id = gw; id < (MP / 32) * 4; id += NGW) conv_unit(F, layer, id >> 2, id & 3, Z, CA, DC);
    if (F.wave == 0 && F.vcu >= 128 && F.vcu < 160) { const int id = (MP / 32) * 4 + F.vcu - 128; conv_unit(F, layer, id >> 2, id & 3, Z, CA, DC); } }
    MIX_FENCE();
    MDUP(3) for (int it = 0; it < 3; ++it) { int id = gw + it * NGW;
        if (it == 2) { if (F.wave == 0 && F.vcu >= 160 && F.vcu < 192) id = (MP / 32) * 4 + F.vcu - 160; else break; }
        const int tb = id >> 2, cq = id & 3;
        switch (cq) { case 0: pool_body<2>(F, layer, tb, cq, Z, PM, DC); break; case 1: pool_body<4>(F, layer, tb, cq, Z, PM, DC); break;
                      case 2: pool_body<8>(F, layer, tb, cq, Z, PM, DC); break; default: pool_body<16>(F, layer, tb, cq, Z, PM, DC); break; } }
    MIX_FENCE();
    const int gt = F.vcu * (NWAVES * 64) + F.tid, NGT = F.G * NWAVES * 64;
    for (int i = gt; i < (NBP * 512 + NBS * TS) * 128; i += NGT) {
        const int rr = i >> 7, kv = (i >> 6) & 1, ch = i & 63;
        int zrow; size_t o;
        if (rr < NBP * 512) { const int b = rr >> 9, t = rr & 511; zrow = b * SEQ + SEQ - 512 + t; o = (kv ? O_VP : O_KP) + (((size_t)layer * NBP + b) * 512 + t) * 512 + 8 * ch; }
        else { const int r2 = rr - NBP * 512, b = r2 >> 5, t = r2 & 31; zrow = MP + r2; o = (kv ? O_VS : O_KS) + (((size_t)layer * NBS + b) * TS + t) * 512 + 8 * ch; }
        const v4u z = *(const GAS v4u*)(Z + (size_t)zrow * ZW + (kv ? ZV : ZK) + 8 * ch);
        *(GAS f32x4*)(F.out + o) = (f32x4){bflo(z.x), bfhi(z.x), bflo(z.y), bfhi(z.y)}; *(GAS f32x4*)(F.out + o + 4) = (f32x4){bflo(z.z), bfhi(z.z), bflo(z.w), bfhi(z.w)};
    }
}

enum { SK_Z = 0, SK_MIX2 = 1, SK_RES = 2, SK_SWI = 3 };
struct SkUnit { int row0, nb0, nb1, ocol0, ocol1; bool pair; float scale; };
template <int KIND, int NTB, int U>
__device__ __forceinline__ void sk_unit(Frame& F, const bf16* A, const bf16* Bt, int K, const SkUnit& u, bf16* obf, int opitch, float* X, const float* gate) {
    const int lane = F.lane, w = F.wave, l31 = lane & 31, hh = lane >> 5;
    const int kw = K >> 3, nch = kw >> 6;
    constexpr int NR = 32 * NTB + 64, NLD = NR / 8;
    LAS unsigned char* stg = F.lds + w * 16384;
    const int lr = lane >> 3, lc = lane & 7;
    const GAS unsigned char* src[NLD];
#pragma unroll
    for (int i = 0; i < NLD; ++i) { const int r = 8 * i + lr;
        const bf16* base = (r < 32 * NTB) ? A + (size_t)(u.row0 + r) * K : (r < 32 * NTB + 32) ? Bt + (size_t)(u.nb0 + r - 32 * NTB) * K : Bt + (size_t)(u.nb1 + r - 32 * NTB - 32) * K;
        src[i] = (const GAS unsigned char*)(base + w * kw + 8 * lc); }
    f32x16 acc[NTB][2];
#pragma unroll
    for (int tb = 0; tb < NTB; ++tb)
#pragma unroll
        for (int c = 0; c < 2; ++c)
#pragma unroll
            for (int r = 0; r < 16; ++r) acc[tb][c][r] = 0.f;
    v4u R[NLD];
#pragma unroll
    for (int i = 0; i < NLD; ++i) R[i] = *(const GAS v4u*)(src[i]);
    for (int ch = 0; ch < nch; ++ch) {
#pragma unroll
        for (int i = 0; i < NLD; ++i) { const int r = 8 * i + lr; *(LAS v4u*)(stg + r * 128 + 16 * (lc ^ (r & 7))) = R[i]; }
        if (ch + 1 < nch) {
#pragma unroll
            for (int i = 0; i < NLD; ++i) R[i] = *(const GAS v4u*)(src[i] + (size_t)(ch + 1) * 128); }
#pragma unroll
        for (int s = 0; s < 4; ++s) { const int cx = 16 * ((2 * s + hh) ^ (l31 & 7));
            bf16x8 xf[NTB];
#pragma unroll
            for (int tb = 0; tb < NTB; ++tb) xf[tb] = *(const LAS bf16x8*)(stg + (32 * tb + l31) * 128 + cx);
            const bf16x8 w0 = *(const LAS bf16x8*)(stg + (32 * NTB + l31) * 128 + cx), w1 = *(const LAS bf16x8*)(stg + (32 * NTB + 32 + l31) * 128 + cx);
#pragma unroll
            for (int tb = 0; tb < NTB; ++tb) { acc[tb][0] = MFMA32(w0, xf[tb], acc[tb][0]); acc[tb][1] = MFMA32(w1, xf[tb], acc[tb][1]); }
        }
    }
    __syncthreads();
    LAS f32x4* red = (LAS f32x4*)F.lds;
#pragma unroll
    for (int tb = 0; tb < NTB; ++tb)
#pragma unroll
        for (int c = 0; c < 2; ++c)
#pragma unroll
            for (int rg = 0; rg < 4; ++rg) red[((((w * NTB + tb) * 2 + c) * 4 + rg) << 6) + lane] = (f32x4){acc[tb][c][4 * rg], acc[tb][c][4 * rg + 1], acc[tb][c][4 * rg + 2], acc[tb][c][4 * rg + 3]};
    __syncthreads();
    {
        const int rg = w & 3, tb = (NTB == 2) ? (w >> 2) : 0, c_lo = (NTB == 2) ? 0 : (w >> 2), c_hi = (NTB == 2) ? 2 : (w >> 2) + 1;
        f32x4 v[2] = {(f32x4){0.f, 0.f, 0.f, 0.f}, (f32x4){0.f, 0.f, 0.f, 0.f}};
#pragma unroll
        for (int c = 0; c < 2; ++c) { if (c >= c_lo && c < c_hi) {
#pragma unroll
                for (int w2 = 0; w2 < 8; ++w2) v[c] += red[((((w2 * NTB + tb) * 2 + c) * 4 + rg) << 6) + lane]; } }
        const int row = u.row0 + 32 * tb + l31, co = 8 * rg + 4 * hh;
        if (KIND == SK_Z) {
            if (u.pair) { v2u o; o.x = pk2(v[0][0] * sigmoidf_(v[1][0]), v[0][1] * sigmoidf_(v[1][1])); o.y = pk2(v[0][2] * sigmoidf_(v[1][2]), v[0][3] * sigmoidf_(v[1][3]));
                *(GAS v2u*)(obf + (size_t)row * opitch + u.ocol0 + co) = o; }
            else {
#pragma unroll
                for (int c = 0; c < 2; ++c) { const f32x4 y = v[c] * u.scale; v2u o; o.x = pk2(y[0], y[1]); o.y = pk2(y[2], y[3]); *(GAS v2u*)(obf + (size_t)row * opitch + (c ? u.ocol1 : u.ocol0) + co) = o; } }
        } else if (KIND == SK_MIX2) {
#pragma unroll
            for (int c = 0; c < 2; ++c) { v2u o; o.x = pk2(v[c][0], v[c][1]); o.y = pk2(v[c][2], v[c][3]); *(GAS v2u*)(obf + (size_t)row * opitch + (c ? u.ocol1 : u.ocol0) + co) = o; }
        } else if (KIND == SK_SWI) {
            v2u o; o.x = pk2(siluf_(v[0][0]) * v[1][0], siluf_(v[0][1]) * v[1][1]); o.y = pk2(siluf_(v[0][2]) * v[1][2], siluf_(v[0][3]) * v[1][3]);
            *(GAS v2u*)(obf + (size_t)row * opitch + u.ocol0 + co) = o;
        } else {
            const int c = w >> 2, col = (c ? u.ocol1 : u.ocol0) + co;
            const f32x4 g = *(const GAS f32x4*)(gate + (size_t)batch_of_row(row) * NMOD + col); GAS v2u* xp = (GAS v2u*)(obf + (size_t)row * opitch + col); const v2u xo = *xp;
            const f32x4 y = g * v[c] + (f32x4){bflo(xo.x), bfhi(xo.x), bflo(xo.y), bfhi(xo.y)};
            v2u o; o.x = pk2(y[0], y[1]); o.y = pk2(y[2], y[3]); *xp = o;
        }
    }
    __syncthreads();
}
constexpr int N_PHASES = 2 + 8 * NL + 1;

__global__ void __launch_bounds__(NWAVES * 64, 2) enc_fwd(Args args) {
    extern __shared__ __attribute__((aligned(16))) unsigned char lds[];
    Frame F;
    F.lds = (LAS unsigned char*)lds;
    F.tid = threadIdx.x; F.lane = F.tid & 63; F.wave = __builtin_amdgcn_readfirstlane(F.tid >> 6);
    F.G = gridDim.x; { const int bx = blockIdx.x; F.vcu = (F.G % 8 == 0) ? (bx % 8) * (F.G / 8) + bx / 8 : bx; }
    F.ka = (KArgs)__builtin_amdgcn_kernarg_segment_ptr();
    F.out = args.out; F.ws = args.ws;
    volatile LAS unsigned* MISC = (volatile LAS unsigned*)(F.lds + MISC_OFF);
    for (int u = F.tid; u < (LDS_BYTES - LDSCTL_OFF) / 4; u += NWAVES * 64) ((LAS unsigned*)(F.lds + LDSCTL_OFF))[u] = 0u;
    __syncthreads();
    const int lo = args.ph_lo, hi = args.ph_hi;
#define REFRESH() do { int t_ = threadIdx.x; asm volatile("" : "+v"(t_)); F.tid = t_; F.lane = t_ & 63; F.wave = __builtin_amdgcn_readfirstlane(t_ >> 6); \
        unsigned long long w_ = (unsigned long long)args.ws, o_ = (unsigned long long)args.out, k_ = (unsigned long long)__builtin_amdgcn_kernarg_segment_ptr(); \
        asm volatile("" : "+s"(w_), "+s"(o_), "+s"(k_)); F.ws = (unsigned char*)(GAS unsigned char*)w_; F.out = (float*)(GAS float*)o_; F.ka = (KArgs)k_; \
        unsigned l_ = (unsigned)(unsigned long long)(LAS unsigned char*)lds; asm volatile("" : "+s"(l_)); F.lds = (LAS unsigned char*)(unsigned long long)l_; } while (0)
    XcdBarrier bar; bar.bar = (unsigned*)(F.ws + WS_CTL) + CW_BAR; bar.x = 0; bar.st = nullptr;
    if (hi - lo > 1) bar = xcd_barrier_post((unsigned*)(F.ws + WS_CTL) + CW_BAR, MISC + 8);
#ifdef ONLY_PHASE
#define IN(k) ((((k) < 2 || (k) == N_PHASES - 1) ? (k) : 2 + ((k) - 2) % 8) == ONLY_PHASE && lo <= (k) && (k) < hi)
#else
#define IN(k) (lo <= (k) && (k) < hi)
#endif
#ifndef PROBE_DUP
#define PROBE_DUP 0
#endif
#define DUP(k) _Pragma("unroll") for (int rep_ = 0; rep_ < 1 + ((PROBE_DUP >> (k)) & 1); ++rep_)
#ifndef STAGGER_TICKS
#define STAGGER_TICKS 0
#endif
#define STAGGER(ticks) do { if ((ticks) > 0 && (blockIdx.x & 8)) { const unsigned long long t0_ = __builtin_amdgcn_s_memrealtime(); while (__builtin_amdgcn_s_memrealtime() - t0_ < (unsigned long long)(ticks)) __builtin_amdgcn_s_sleep(8); } } while (0)
#define SEAM(k) do { if (IN(k) && IN((k) + 1)) { XcdBarrier b_ = bar; unsigned long long p_ = (unsigned long long)b_.bar; asm volatile("" : "+s"(p_)); b_.bar = (unsigned*)p_; xcd_barrier(b_); } } while (0)

    if (IN(0)) DUP(8) { REFRESH(); p0a_phase(F); } SEAM(0);
    if (IN(1)) { REFRESH(); p0b_phase(F); } SEAM(1);
    for (int l = 0; l < NL; ++l) {
        const int pb = 2 + 8 * l;
        if (IN(pb + 0)) DUP(0) { REFRESH(); bf16* H = (bf16*)(F.ws + WS_H); bf16* Zb = (bf16*)(F.ws + WS_Z); bf16* MIX = (bf16*)(F.ws + WS_MIX); bf16* HID = (bf16*)(F.ws + WS_HID); bf16* CAPM = (bf16*)(F.ws + WS_CAPM); bf16* XB = (bf16*)(F.ws + WS_XB); (void)XB; (void)H; (void)Zb; (void)MIX; (void)HID; (void)CAPM; const float* mod_l = modp(F, l); unsigned char* wl = lw(F, l); (void)mod_l; (void)wl; if (l == 0) norm_phase<true>(F, INP(I_N1) + l * DM, mod_l, 0, H, XB); else norm_phase<false>(F, INP(I_N1) + l * DM, mod_l, 0, H, XB); } SEAM(pb + 0);
        if (IN(pb + 1)) DUP(1) { REFRESH(); bf16* H = (bf16*)(F.ws + WS_H); bf16* Zb = (bf16*)(F.ws + WS_Z); bf16* MIX = (bf16*)(F.ws + WS_MIX); bf16* HID = (bf16*)(F.ws + WS_HID); bf16* CAPM = (bf16*)(F.ws + WS_CAPM); bf16* XB = (bf16*)(F.ws + WS_XB); (void)XB; (void)H; (void)Zb; (void)MIX; (void)HID; (void)CAPM; const float* mod_l = modp(F, l); unsigned char* wl = lw(F, l); (void)mod_l; (void)wl; pg8::Gemm g{H, (const bf16*)(wl + LW_WIN), MP, DIN, DM}; pg8::StaticOrder S; S.init(MP, DIN, F.G, (int)blockIdx.x); int dry_ = (PROBE_DRY != 0) && (rep_ == 1); asm volatile("" : "+s"(dry_)); pg8::EpiZ E{Zb, dry_};
            pg8::gemm_phase<pg8::EpiZ, pg8::StaticOrder, true, true>(F.lds, g, S, E);
            for (int su = F.vcu; su < 4 * 64; su += F.G) { const int rt = su & 3, cb = su >> 2; SkUnit u; u.row0 = MP + 64 * rt;
                if (cb < 16) { const int tt = cb >> 2, x0 = 32 * (cb & 3); u.nb0 = 256 * tt + x0; u.nb1 = u.nb0 + 128; u.ocol0 = 128 * tt + x0; u.ocol1 = 0; u.pair = true; u.scale = 1.f; }
                else { const int pbk = cb - 16; u.nb0 = 1024 + 64 * pbk; u.nb1 = u.nb0 + 32; u.ocol0 = 512 + 64 * pbk; u.ocol1 = u.ocol0 + 32; u.pair = false; u.scale = (u.nb0 < 1536) ? QSCALE : 1.f; }
                sk_unit<SK_Z, 2, 8>(F, H, (const bf16*)(wl + LW_WIN), DM, u, Zb, ZW, nullptr, nullptr); } } SEAM(pb + 1);
        if (IN(pb + 2)) DUP(2) { REFRESH(); bf16* H = (bf16*)(F.ws + WS_H); bf16* Zb = (bf16*)(F.ws + WS_Z); bf16* MIX = (bf16*)(F.ws + WS_MIX); bf16* HID = (bf16*)(F.ws + WS_HID); bf16* CAPM = (bf16*)(F.ws + WS_CAPM); bf16* XB = (bf16*)(F.ws + WS_XB); (void)XB; (void)H; (void)Zb; (void)MIX; (void)HID; (void)CAPM; const float* mod_l = modp(F, l); unsigned char* wl = lw(F, l); (void)mod_l; (void)wl; mixer_phase(F, l); } SEAM(pb + 2);
        if (IN(pb + 3)) DUP(3) { REFRESH(); bf16* H = (bf16*)(F.ws + WS_H); bf16* Zb = (bf16*)(F.ws + WS_Z); bf16* MIX = (bf16*)(F.ws + WS_MIX); bf16* HID = (bf16*)(F.ws + WS_HID); bf16* CAPM = (bf16*)(F.ws + WS_CAPM); bf16* XB = (bf16*)(F.ws + WS_XB); (void)XB; (void)H; (void)Zb; (void)MIX; (void)HID; (void)CAPM; const float* mod_l = modp(F, l); unsigned char* wl = lw(F, l); (void)mod_l; (void)wl; pg8::Gemm g{CAPM, (const bf16*)(wl + LW_CPW), 2 * MT, 2 * DC, DC}; pg8::Mix2Order S{F.G, (int)blockIdx.x}; pg8::EpiMix2 E{MIX};
            pg8::gemm_phase<pg8::EpiMix2, pg8::Mix2Order, true, true>(F.lds, g, S, E);
            for (int su = F.vcu; su < 2 * 4 * 8; su += F.G) { const int which = su >> 5, rt = su & 3, cb = (su >> 2) & 7; SkUnit u; u.row0 = MP + 64 * rt; u.nb0 = 64 * cb; u.nb1 = u.nb0 + 32;
                u.ocol0 = which * 1024 + 64 * cb; u.ocol1 = u.ocol0 + 32; u.pair = false; u.scale = 1.f;
                sk_unit<SK_MIX2, 2, 4>(F, CAPM + (size_t)which * MT * DC, (const bf16*)(wl + LW_CPW) + (size_t)which * DC * DC, DC, u, MIX, MIXW, nullptr, nullptr); } } SEAM(pb + 3);
        if (IN(pb + 4)) DUP(4) { REFRESH(); bf16* H = (bf16*)(F.ws + WS_H); bf16* Zb = (bf16*)(F.ws + WS_Z); bf16* MIX = (bf16*)(F.ws + WS_MIX); bf16* HID = (bf16*)(F.ws + WS_HID); bf16* CAPM = (bf16*)(F.ws + WS_CAPM); bf16* XB = (bf16*)(F.ws + WS_XB); (void)XB; (void)H; (void)Zb; (void)MIX; (void)HID; (void)CAPM; const float* mod_l = modp(F, l); unsigned char* wl = lw(F, l); (void)mod_l; (void)wl; STAGGER(STAGGER_G3); pg8::Gemm g{MIX, (const bf16*)(wl + LW_WOUT), MP, DM, DM}; pg8::StaticOrder S; S.init(MP, DM, F.G, (int)blockIdx.x); int dry_ = (PROBE_DRY != 0) && (rep_ == 1); asm volatile("" : "+s"(dry_)); pg8::EpiResB E{XB, mod_l + 2 * DM, dry_};
            pg8::gemm_phase<pg8::EpiResB, pg8::StaticOrder, true, true>(F.lds, g, S, E);
            if (!dry_) for (int su = F.vcu; su < 8 * 32; su += F.G) { const int rt = su & 7, cb = su >> 3; SkUnit u; u.row0 = MP + 32 * rt; u.nb0 = 64 * cb; u.nb1 = u.nb0 + 32; u.ocol0 = u.nb0; u.ocol1 = u.nb1; u.pair = false; u.scale = 1.f;
                sk_unit<SK_RES, 1, 8>(F, MIX, (const bf16*)(wl + LW_WOUT), DM, u, XB, DM, nullptr, mod_l + 2 * DM); } } SEAM(pb + 4);
        if (IN(pb + 5)) DUP(5) { REFRESH(); bf16* H = (bf16*)(F.ws + WS_H); bf16* Zb = (bf16*)(F.ws + WS_Z); bf16* MIX = (bf16*)(F.ws + WS_MIX); bf16* HID = (bf16*)(F.ws + WS_HID); bf16* CAPM = (bf16*)(F.ws + WS_CAPM); bf16* XB = (bf16*)(F.ws + WS_XB); (void)XB; (void)H; (void)Zb; (void)MIX; (void)HID; (void)CAPM; const float* mod_l = modp(F, l); unsigned char* wl = lw(F, l); (void)mod_l; (void)wl; norm_phase<false>(F, INP(I_N2) + l * DM, mod_l, 3, H, XB); } SEAM(pb + 5);
        if (IN(pb + 6)) DUP(6) { REFRESH(); bf16* H = (bf16*)(F.ws + WS_H); bf16* Zb = (bf16*)(F.ws + WS_Z); bf16* MIX = (bf16*)(F.ws + WS_MIX); bf16* HID = (bf16*)(F.ws + WS_HID); bf16* CAPM = (bf16*)(F.ws + WS_CAPM); bf16* XB = (bf16*)(F.ws + WS_XB); (void)XB; (void)H; (void)Zb; (void)MIX; (void)HID; (void)CAPM; const float* mod_l = modp(F, l); unsigned char* wl = lw(F, l); (void)mod_l; (void)wl; pg8::Gemm g{H, (const bf16*)(wl + LW_WGU), MP, 2 * DFF, DM}; pg8::StaticOrder S; S.init(MP, 2 * DFF, F.G, (int)blockIdx.x); pg8::EpiSwi E{HID};
            pg8::gemm_phase<pg8::EpiSwi, pg8::StaticOrder, true, true>(F.lds, g, S, E);
            for (int su = F.vcu; su < 4 * 176; su += F.G) { const int rt = su & 3, cb = su >> 2, tt = cb >> 2, x0 = 32 * (cb & 3); SkUnit u; u.row0 = MP + 64 * rt; u.nb0 = 256 * tt + x0; u.nb1 = u.nb0 + 128;
                u.ocol0 = 128 * tt + x0; u.ocol1 = 0; u.pair = true; u.scale = 1.f;
                sk_unit<SK_SWI, 2, 8>(F, H, (const bf16*)(wl + LW_WGU), DM, u, HID, DFF, nullptr, nullptr); } } SEAM(pb + 6);
        if (IN(pb + 7)) DUP(7) { REFRESH(); bf16* H = (bf16*)(F.ws + WS_H); bf16* Zb = (bf16*)(F.ws + WS_Z); bf16* MIX = (bf16*)(F.ws + WS_MIX); bf16* HID = (bf16*)(F.ws + WS_HID); bf16* CAPM = (bf16*)(F.ws + WS_CAPM); bf16* XB = (bf16*)(F.ws + WS_XB); (void)XB; (void)H; (void)Zb; (void)MIX; (void)HID; (void)CAPM; const float* mod_l = modp(F, l); unsigned char* wl = lw(F, l); (void)mod_l; (void)wl; STAGGER(STAGGER_G5); pg8::Gemm g{HID, (const bf16*)(wl + LW_WD), MP, DM, DFF}; pg8::StaticOrder S; S.init(MP, DM, F.G, (int)blockIdx.x); int dry_ = (PROBE_DRY != 0) && (rep_ == 1); asm volatile("" : "+s"(dry_)); pg8::EpiResB E{XB, mod_l + 5 * DM, dry_};
            pg8::gemm_phase<pg8::EpiResB, pg8::StaticOrder, true, true>(F.lds, g, S, E);
            if (!dry_) for (int su = F.vcu; su < 8 * 32; su += F.G) { const int rt = su & 7, cb = su >> 3; SkUnit u; u.row0 = MP + 32 * rt; u.nb0 = 64 * cb; u.nb1 = u.nb0 + 32; u.ocol0 = u.nb0; u.ocol1 = u.nb1; u.pair = false; u.scale = 1.f;
                sk_unit<SK_RES, 1, 11>(F, HID, (const bf16*)(wl + LW_WD), DFF, u, XB, DM, nullptr, mod_l + 5 * DM); } } SEAM(pb + 7);
    }
    if (IN(N_PHASES - 1)) { REFRESH(); final_norm_phase(F, (const bf16*)(F.ws + WS_XB)); }
#undef IN
#undef SEAM
}

extern "C" void kernel_launch(void* const* d_in, const int* in_sizes, int n_in, void* d_out, int out_size, void* d_ws, size_t ws_size, hipStream_t stream) {
    static int grid = 0;
    if (grid == 0) {
        if (n_in != N_IN || in_sizes[0] != MP * DM || (size_t)out_size != O_END || ws_size < WS_END) {
            fprintf(stderr, "kernel_launch: unexpected shapes: n_in %d in0 %d out %d ws %zu (need %zu); nothing launched\n", n_in, n_in > 0 ? in_sizes[0] : -1, out_size, ws_size, (size_t)WS_END); grid = -1; return; }
        int dev = 0, cus = 0;
        if (hipGetDevice(&dev) != hipSuccess || hipDeviceGetAttribute(&cus, hipDeviceAttributeMultiprocessorCount, dev) != hipSuccess) { grid = -1; return; }
        if (hipFuncSetAttribute((const void*)enc_fwd, hipFuncAttributeMaxDynamicSharedMemorySize, LDS_BYTES) != hipSuccess) { fprintf(stderr, "kernel_launch: hipFuncSetAttribute failed\n"); grid = -1; return; }
        int per_cu = 0;
        if (hipOccupancyMaxActiveBlocksPerMultiprocessor(&per_cu, (const void*)enc_fwd, NWAVES * 64, LDS_BYTES) != hipSuccess || per_cu < 1)
            fprintf(stderr, "kernel_launch: note: occupancy query reports %d workgroups per CU\n", per_cu);
        (void)hipGetLastError();
        grid = cus;
    }
    if (grid < 0) return;
    if (hipMemsetAsync((char*)d_ws + WS_CTL, 0, CTL_ZERO_BYTES, stream) != hipSuccess) return;
    Args a{};
    for (int i = 0; i < N_IN; ++i) a.in[i] = (const float*)d_in[i];
    a.out = (float*)d_out; a.ws = (unsigned char*)d_ws; a.pad0 = 0; a.pad1 = 0;
#if MK_ONE_LAUNCH
    a.ph_lo = 0; a.ph_hi = N_PHASES;
    hipLaunchKernelGGL(enc_fwd, dim3(grid), dim3(NWAVES * 64), LDS_BYTES, stream, a);
#else
    for (int ph = 0; ph < N_PHASES; ++ph) { a.ph_lo = ph; a.ph_hi = ph + 1;
        hipLaunchKernelGGL(enc_fwd, dim3(grid), dim3(NWAVES * 64), LDS_BYTES, stream, a); }
#endif
}
```

```cpp
#include <hip/hip_runtime.h>
#include <cstdio>
#include <cstdint>
#include <utility>

#ifndef MK_ONE_LAUNCH
#define MK_ONE_LAUNCH 1
#endif
#ifndef PROBE_DUP
#define PROBE_DUP 0
#endif
#ifndef PROBE_DRY
#define PROBE_DRY 0
#endif
#ifndef PROBE_MIX
#define PROBE_MIX 0
#endif
#ifndef PROBE_EPI2
#define PROBE_EPI2 0
#endif
#ifndef STAGGER_TICKS
#define STAGGER_TICKS 0
#endif
#ifndef STAGGER_G3
#define STAGGER_G3 0
#define STAGGER_G5 0
#endif

constexpr int DM = 2048, SEQ = 8192, NBP = 4, MP = NBP * SEQ, NBS = 8, TS = 32, MS = NBS * TS, MT = MP + MS, NPANEL = MT / 256;
constexpr int DIN = 4096, DFF = 5632, DC = 512, NL = 4, NMOD = 6 * DM, NBT = NBP + NBS;
constexpr int ZW = 3584, ZU = 0, ZQ = 512, ZK = 1024, ZV = 1536, ZP = 2048, ZSU = 2560, ZSV = 3072;
constexpr int MIXW = 2048, MIX_A = 0, MIX_B = 512, MIX_C = 1024, MIX_D = 1536;
constexpr float EPS = 1e-6f, LOG2E = 1.4426950408889634f, QSCALE = 0.125f * LOG2E;
constexpr int KSPLIT = 16;
constexpr size_t O_YP = 0, O_YS = O_YP + (size_t)MP * DM, O_CONVP = O_YS + (size_t)MS * DM, O_CONVS = O_CONVP + (size_t)NL * NBP * 30 * DC,
    O_KP = O_CONVS + (size_t)NL * NBS * 30 * DC, O_VP = O_KP + (size_t)NL * NBP * 512 * 512, O_KS = O_VP + (size_t)NL * NBP * 512 * 512,
    O_VS = O_KS + (size_t)NL * NBS * TS * 512, O_POOLP = O_VS + (size_t)NL * NBS * TS * 512, O_POOLS = O_POOLP + (size_t)NL * NBP * 15 * DC,
    O_SGV = O_POOLS + (size_t)NL * NBS * 15 * DC, O_END = O_SGV + (size_t)NL * NBS * TS * DC;
static_assert(O_END == 78700544, "output size");
enum { I_XP = 0, I_XS, I_CP, I_CS, I_CCONV, I_CK, I_CV, I_CPOOL, I_ADAW, I_ADAB, I_N1, I_N2, I_WIN, I_CONVW, I_CONVB, I_GNG, I_GNB, I_CPW, I_RELB,
       I_POOLW, I_POOLS, I_SGG, I_SGB, I_SGW, I_SGBIAS, I_WOUT, I_WG, I_WU, I_WD, I_FING, N_IN };
static_assert(N_IN == 30, "30 inputs");

constexpr size_t MiB = 1u << 20;
constexpr size_t WS_CTL = 0, CTL_ZERO_BYTES = 1 * MiB;
constexpr size_t WS_MOD = 1 * MiB;
constexpr size_t WS_MODP = 4 * MiB;
constexpr size_t WS_W = 40 * MiB;
constexpr size_t LW_WIN = 0, LW_WOUT = 16 * MiB, LW_WGU = 24 * MiB, LW_WD = 68 * MiB, LW_CPW = 90 * MiB, LW_PWD = LW_CPW + 512 * 1024, LW_SGW = 91 * MiB, LW = 91 * MiB + 256 * 1024;
constexpr size_t WS_H = WS_W + NL * LW;
constexpr size_t WS_Z = WS_H + (size_t)MT * DM * 2;
constexpr size_t WS_MIX = WS_Z + (size_t)MT * ZW * 2;
constexpr size_t WS_HID = WS_Z;
constexpr size_t WS_CAPM = WS_MIX + (size_t)MT * MIXW * 2;
constexpr size_t WS_TA = WS_CAPM, WS_FB = WS_CAPM + 16 * MiB;
constexpr size_t WS_XB = WS_CAPM + (size_t)2 * MT * DC * 2;
constexpr size_t WS_END = WS_XB + (size_t)MT * DM * 2;
static_assert(WS_HID + (size_t)MT * DFF * 2 <= WS_CAPM, "HID overlay");
static_assert((size_t)NL * 12 * NMOD * 4 <= 3 * MiB && (size_t)KSPLIT * NL * 12 * NMOD * 4 <= 36 * MiB, "mod buffers");
constexpr int CW_BAR = 4096;

constexpr int RING_BYTES = 131072;
constexpr int LDSCTL_OFF = RING_BYTES, MISC_OFF = LDSCTL_OFF + 320;
constexpr int LDS_BYTES = 147456;
constexpr int NWAVES = 8;

#define GAS __attribute__((address_space(1)))
#define LAS __attribute__((address_space(3)))
typedef unsigned short bf16;
typedef unsigned v4u __attribute__((ext_vector_type(4)));
typedef unsigned v2u __attribute__((ext_vector_type(2)));
typedef float f32x4 __attribute__((ext_vector_type(4)));
typedef float f32x2 __attribute__((ext_vector_type(2)));
typedef float f32x16 __attribute__((ext_vector_type(16)));
typedef short bf16x8 __attribute__((ext_vector_type(8)));
typedef __bf16 bf16x2_t __attribute__((ext_vector_type(2)));
typedef GAS unsigned gu32;
#define RLX_AGENT __ATOMIC_RELAXED, __HIP_MEMORY_SCOPE_AGENT
#define LDS_WAIT() asm volatile("s_waitcnt lgkmcnt(0)" ::: "memory")
#define VM_WAIT() asm volatile("s_waitcnt vmcnt(0)" ::: "memory")

__device__ __forceinline__ unsigned pk2(float lo, float hi) { f32x2 v = {lo, hi}; bf16x2_t b = __builtin_convertvector(v, bf16x2_t); return __builtin_bit_cast(unsigned, b); }
__device__ __forceinline__ float bflo(unsigned u) { return __uint_as_float(u << 16); }
__device__ __forceinline__ float bfhi(unsigned u) { return __uint_as_float(u & 0xffff0000u); }
__device__ __forceinline__ float bf2f(bf16 h) { return __uint_as_float((unsigned)h << 16); }
__device__ __forceinline__ float fast_exp2(float x) { return __builtin_amdgcn_exp2f(x); }
__device__ __forceinline__ float fast_rcp(float x) { return __builtin_amdgcn_rcpf(x); }
__device__ __forceinline__ float sigmoidf_(float x) { return fast_rcp(1.0f + fast_exp2(-x * LOG2E)); }
__device__ __forceinline__ float siluf_(float x) { return x * sigmoidf_(x); }
template <int CTRL> __device__ __forceinline__ float dpp_f(float v) { return __int_as_float(__builtin_amdgcn_update_dpp(0, __float_as_int(v), CTRL, 0xF, 0xF, true)); }
__device__ __forceinline__ float row16_sum(float v) { v += dpp_f<0xB1>(v); v += dpp_f<0x4E>(v); v += dpp_f<0x141>(v); v += dpp_f<0x140>(v); return v; }
__device__ __forceinline__ float half32_sum(float v) { v = row16_sum(v); v += __int_as_float(__builtin_amdgcn_ds_swizzle(__float_as_int(v), 0x401F)); return v; }
__device__ __forceinline__ float wave_sum(float v) { v = half32_sum(v);
    return __int_as_float(__builtin_amdgcn_readlane(__float_as_int(v), 0)) + __int_as_float(__builtin_amdgcn_readlane(__float_as_int(v), 32)); }
__device__ __forceinline__ int batch_of_row(int row) { return row < MP ? (row >> 13) : NBP + ((row - MP) >> 5); }

namespace pg8 {
#define PG8_LAS __attribute__((address_space(3)))
typedef unsigned short bf16_t;
typedef short bf16x8 __attribute__((ext_vector_type(8)));
typedef float f32x4 __attribute__((ext_vector_type(4)));
typedef unsigned u32x4 __attribute__((ext_vector_type(4)));
constexpr int BM = 256, BK = 64, HALF = 128, HTB = HALF * BK * 2  , STAGE_BYTES = 8 * HTB, NXCD = 8, WGM = 8;

__host__ __device__ __forceinline__ int lds_byte(int r, int c) { const int st = (r >> 4) * 2 + (c >> 5), rr = r & 15, cc = c & 31, ob = rr * 64 + cc * 2; return st * 1024 + (ob ^ (((ob >> 9) & 1) << 5)); }
__host__ __device__ __forceinline__ void stage_rc(int b, int& R, int& C) { const int st = b / 1024, sb = b % 1024, swz = sb ^ (((sb >> 9) & 1) << 5); R = (st >> 1) * 16 + swz / 64; C = (st & 1) * 32 + (swz % 64) / 2; }
__host__ __device__ __forceinline__ int perm32(int rho) { const int n = rho >> 4, i = rho & 15; return 8 * (i >> 2) + 4 * n + (i & 3); }

struct Unit { int pm, pn; };
struct Gemm { const bf16_t* A; const bf16_t* Bt; int M, N, K; };

struct StaticOrder {
    int nM, nN, nwg, G, c;
    __host__ __device__ void init(int M, int N, int G_, int c_) { nM = M / BM; nN = N / BM; nwg = nM * nN; G = G_; c = c_; }
    __host__ __device__ bool next(int i, Unit& u) const {
        const long L = (long)i * G + c; if (L >= nwg) return false;
        int wgid = (int)L; { const int q = nwg / NXCD, r = nwg % NXCD, xcd = wgid % NXCD, off = wgid / NXCD; wgid = (xcd < r ? xcd * (q + 1) : r * (q + 1) + (xcd - r) * q) + off; }
        const int nig = WGM * nN, gid = wgid / nig, fm = gid * WGM, gsz = (nM - fm) < WGM ? (nM - fm) : WGM;
        u.pm = fm + ((wgid % nig) % gsz); u.pn = (wgid % nig) / gsz; return true;
    }
    __device__ __forceinline__ void a_ready(const Unit&) const {}
    __device__ __forceinline__ void done(const Unit&) const {}
};
__device__ __forceinline__ unsigned cvt_pk_bf16(float lo, float hi) { return ::pk2(lo, hi); }
struct EpiZ {
    static constexpr bool PERM = true, AFTER_DRAIN = false;
    bf16_t* Z; int dry;
    __device__ __forceinline__ void operator()(const f32x4 (&acc)[2][2][4][2], const Unit& u, int wr, int wc, int fr, int fq) const {
        const int row0 = u.pm * BM + wr * 64 + fr;
        if (dry) return;
        if (u.pn < 4) {
            const int col0 = 128 * u.pn + wc * 32 + 8 * fq;
#pragma unroll
            for (int ai = 0; ai < 2; ++ai)
#pragma unroll
                for (int m = 0; m < 4; ++m) { bf16_t* rowp = Z + (size_t)(row0 + ai * HALF + m * 16) * ::ZW + col0;
                    const f32x4 a0 = acc[ai][0][m][0], a1 = acc[ai][0][m][1], g0 = acc[ai][1][m][0], g1 = acc[ai][1][m][1];
                    u32x4 w; w.x = cvt_pk_bf16(a0[0] * ::sigmoidf_(g0[0]), a0[1] * ::sigmoidf_(g0[1])); w.y = cvt_pk_bf16(a0[2] * ::sigmoidf_(g0[2]), a0[3] * ::sigmoidf_(g0[3]));
                    w.z = cvt_pk_bf16(a1[0] * ::sigmoidf_(g1[0]), a1[1] * ::sigmoidf_(g1[1])); w.w = cvt_pk_bf16(a1[2] * ::sigmoidf_(g1[2]), a1[3] * ::sigmoidf_(g1[3]));
                    *(u32x4*)rowp = w; }
        } else {
            const float sc = (u.pn < 6) ? ::QSCALE : 1.0f;
            const int col0 = 512 + 256 * (u.pn - 4) + wc * 32 + 8 * fq;
#pragma unroll
            for (int ai = 0; ai < 2; ++ai)
#pragma unroll
                for (int m = 0; m < 4; ++m) { bf16_t* rowp = Z + (size_t)(row0 + ai * HALF + m * 16) * ::ZW + col0;
#pragma unroll
                    for (int bj = 0; bj < 2; ++bj) { const f32x4 v0 = acc[ai][bj][m][0] * sc, v1 = acc[ai][bj][m][1] * sc;
                        u32x4 w; w.x = cvt_pk_bf16(v0[0], v0[1]); w.y = cvt_pk_bf16(v0[2], v0[3]); w.z = cvt_pk_bf16(v1[0], v1[1]); w.w = cvt_pk_bf16(v1[2], v1[3]);
                        *(u32x4*)(rowp + bj * HALF) = w; } }
        }
    }
};
struct EpiFold {
    static constexpr bool PERM = true, AFTER_DRAIN = false;
    unsigned char* wbase; size_t lwstride, lwoff;
    __device__ __forceinline__ void operator()(const f32x4 (&acc)[2][2][4][2], const Unit& u, int wr, int wc, int fr, int fq) const {
        const int lwh = u.pn >> 1, layer = lwh >> 1, which = lwh & 1, pm = u.pm - lwh * 8;
        bf16_t* O = (bf16_t*)(wbase + (size_t)layer * lwstride + lwoff);
        const int row0 = pm * BM + wr * 64 + fr, col0 = which * 1024 + (u.pn & 1) * 256 + wc * 32 + 8 * fq;
#pragma unroll
        for (int ai = 0; ai < 2; ++ai)
#pragma unroll
            for (int m = 0; m < 4; ++m) { bf16_t* rowp = O + (size_t)(row0 + ai * HALF + m * 16) * ::DM + col0;
#pragma unroll
                for (int bj = 0; bj < 2; ++bj) { const f32x4 v0 = acc[ai][bj][m][0], v1 = acc[ai][bj][m][1];
                    u32x4 w; w.x = cvt_pk_bf16(v0[0], v0[1]); w.y = cvt_pk_bf16(v0[2], v0[3]); w.z = cvt_pk_bf16(v1[0], v1[1]); w.w = cvt_pk_bf16(v1[2], v1[3]);
                    *(u32x4*)(rowp + bj * HALF) = w; } }
    }
};
struct EpiResB {
    static constexpr bool PERM = true, AFTER_DRAIN = false;
    bf16_t* XB; const float* gate; int dry;
    __device__ __forceinline__ void operator()(const f32x4 (&acc)[2][2][4][2], const Unit& u, int wr, int wc, int fr, int fq) const {
        if (dry) return;
        const int row0 = u.pm * BM + wr * 64 + fr, col0 = u.pn * BM + wc * 32 + 8 * fq;
        const float* gp = gate + (size_t)::batch_of_row(u.pm * BM) * ::NMOD + col0;
        f32x4 gv[2][2];
#pragma unroll
        for (int bj = 0; bj < 2; ++bj)
#pragma unroll
            for (int n = 0; n < 2; ++n) gv[bj][n] = *(const f32x4*)(gp + bj * HALF + 4 * n);
#pragma unroll
        for (int ai = 0; ai < 2; ++ai)
#pragma unroll
            for (int m = 0; m < 4; ++m) { bf16_t* rowp = XB + (size_t)(row0 + ai * HALF + m * 16) * ::DM + col0;
#pragma unroll
                for (int bj = 0; bj < 2; ++bj) { const u32x4 xo = *(const u32x4*)(rowp + bj * HALF);
                    const f32x4 v0 = acc[ai][bj][m][0] * gv[bj][0] + (f32x4){::bflo(xo.x), ::bfhi(xo.x), ::bflo(xo.y), ::bfhi(xo.y)};
                    const f32x4 v1 = acc[ai][bj][m][1] * gv[bj][1] + (f32x4){::bflo(xo.z), ::bfhi(xo.z), ::bflo(xo.w), ::bfhi(xo.w)};
                    u32x4 w; w.x = cvt_pk_bf16(v0[0], v0[1]); w.y = cvt_pk_bf16(v0[2], v0[3]); w.z = cvt_pk_bf16(v1[0], v1[1]); w.w = cvt_pk_bf16(v1[2], v1[3]);
                    *(u32x4*)(rowp + bj * HALF) = w; } }
    }
};
struct EpiSwi {
    static constexpr bool PERM = true, AFTER_DRAIN = false;
    bf16_t* HID;
    __device__ __forceinline__ void operator()(const f32x4 (&acc)[2][2][4][2], const Unit& u, int wr, int wc, int fr, int fq) const {
        const int row0 = u.pm * BM + wr * 64 + fr, col0 = 128 * u.pn + wc * 32 + 8 * fq;
#pragma unroll
        for (int ai = 0; ai < 2; ++ai)
#pragma unroll
            for (int m = 0; m < 4; ++m) { bf16_t* rowp = HID + (size_t)(row0 + ai * HALF + m * 16) * ::DFF + col0;
                const f32x4 g0 = acc[ai][0][m][0], g1 = acc[ai][0][m][1], u0 = acc[ai][1][m][0], u1 = acc[ai][1][m][1];
                u32x4 w; w.x = cvt_pk_bf16(::siluf_(g0[0]) * u0[0], ::siluf_(g0[1]) * u0[1]); w.y = cvt_pk_bf16(::siluf_(g0[2]) * u0[2], ::siluf_(g0[3]) * u0[3]);
                w.z = cvt_pk_bf16(::siluf_(g1[0]) * u1[0], ::siluf_(g1[1]) * u1[1]); w.w = cvt_pk_bf16(::siluf_(g1[2]) * u1[2], ::siluf_(g1[3]) * u1[3]);
                *(u32x4*)rowp = w; }
    }
};
struct FoldOrder {
    int G, c;
    __device__ __forceinline__ bool next(int i, Unit& u) const {
        const int L = i * G + c; if (L >= ::NL * 32) return false;
        const int lwh = L >> 4, pm = (L >> 1) & 7, pn = L & 1;
        u.pm = lwh * 8 + pm; u.pn = lwh * 2 + pn; return true;
    }
    __device__ __forceinline__ void a_ready(const Unit&) const {}
    __device__ __forceinline__ void done(const Unit&) const {}
};

template <class Epi, class Sched, bool ALIGN_EPI = false, bool SP2 = false>
__device__ __forceinline__ void gemm_phase(PG8_LAS unsigned char* lds, const Gemm g, const Sched& S, const Epi& E) {
    int tid_ = threadIdx.x; asm volatile("" : "+v"(tid_));
    const int tid = tid_, wid = __builtin_amdgcn_readfirstlane(tid >> 6), lane = tid & 63, wr = wid >> 2, wc = wid & 3, fr = lane & 15, fq = lane >> 4;
    const int K = g.K, nt = K / BK;
    unsigned voffA[2], voffB[2];
#pragma unroll
    for (int i = 0; i < 2; ++i) { int R, C; stage_rc(tid * 16 + i * 8192, R, C); const int Rb = Epi::PERM ? ((R & ~31) + perm32(R & 31)) : R;
        voffA[i] = (unsigned)(R * K + C) * 2u; voffB[i] = (unsigned)(Rb * K + C) * 2u; }
    const size_t kstep = (size_t)(BK * 2);
    const size_t hstep = (size_t)HALF * K * 2;
    const size_t tstep = 2 * hstep;
    const unsigned ldsw = (unsigned)wid * 1024u;
    const int aoff = lds_byte(wr * 64 + fr, fq * 8), boff = lds_byte(wc * 32 + fr, fq * 8);
#define PG8_SA(b, h) (((b) * 2 + (h)) * HTB)
#define PG8_SB(b, h) ((4 + (b) * 2 + (h)) * HTB)
#define PG8_STAGE(bufoff, gbase, voff) do { _Pragma("unroll") for (int _i = 0; _i < 2; ++_i) \
        __builtin_amdgcn_global_load_lds((const unsigned*)((const char*)(gbase) + (voff)[_i]), (PG8_LAS unsigned*)(lds + (bufoff) + ldsw + _i * 8192), 16, 0, 0); } while (0)
#define PG8_LDA(dst, b, h) do { _Pragma("unroll") for (int m = 0; m < 4; ++m) _Pragma("unroll") for (int k = 0; k < 2; ++k) dst[m][k] = *(const PG8_LAS bf16x8*)(lds + PG8_SA(b, h) + aoff + m * 2048 + k * 1024); } while (0)
#define PG8_LDB(dst, b, h) do { _Pragma("unroll") for (int n = 0; n < 2; ++n) _Pragma("unroll") for (int k = 0; k < 2; ++k) dst[n][k] = *(const PG8_LAS bf16x8*)(lds + PG8_SB(b, h) + boff + n * 2048 + k * 1024); } while (0)
#define PG8_MMA(ai, bj, At, Bt) do { __builtin_amdgcn_s_setprio(1); _Pragma("unroll") for (int m = 0; m < 4; ++m) _Pragma("unroll") for (int n = 0; n < 2; ++n) _Pragma("unroll") for (int k = 0; k < 2; ++k) \
        acc[ai][bj][m][n] = __builtin_amdgcn_mfma_f32_16x16x32_bf16(Bt[n][k], At[m][k], acc[ai][bj][m][n], 0, 0, 0); __builtin_amdgcn_s_setprio(0); } while (0)
#define PG8_WAIT_V(n) asm volatile("s_waitcnt vmcnt(" #n ")" ::: "memory")
#define PG8_WAIT_L(n) asm volatile("s_waitcnt lgkmcnt(" #n ")" ::: "memory")
#define PG8_BAR __builtin_amdgcn_s_barrier()
#define PG8_SCHED __builtin_amdgcn_sched_barrier(0)
    Unit cur, nxt; int ui = 0;
    if (!S.next(0, cur)) return;
    f32x4 acc[2][2][4][2];
#pragma unroll
    for (int a = 0; a < 2; ++a)
#pragma unroll
        for (int b = 0; b < 2; ++b)
#pragma unroll
            for (int m = 0; m < 4; ++m)
#pragma unroll
                for (int n = 0; n < 2; ++n) acc[a][b][m][n] = (f32x4){0.f, 0.f, 0.f, 0.f};
    bf16x8 At[4][2], B0[2][2], B1[2][2];
    const char* cA = (const char*)g.A + (size_t)cur.pm * tstep; const char* cB = (const char*)g.Bt + (size_t)cur.pn * tstep;
    S.a_ready(cur);
    if constexpr (SP2) {
        PG8_STAGE(PG8_SB(0, 0), cB, voffB); PG8_STAGE(PG8_SB(0, 1), cB + hstep, voffB); PG8_STAGE(PG8_SA(0, 0), cA, voffA); PG8_STAGE(PG8_SA(0, 1), cA + hstep, voffA);
        if (wr == 1) PG8_BAR;
        PG8_WAIT_V(2); PG8_BAR;
        PG8_STAGE(PG8_SB(1, 0), cB + kstep, voffB); PG8_STAGE(PG8_SA(1, 0), cA + kstep, voffA); PG8_STAGE(PG8_SB(1, 1), cB + hstep + kstep, voffB);
        PG8_WAIT_V(6); PG8_BAR;
    } else {
        PG8_STAGE(PG8_SB(0, 0), cB, voffB); PG8_STAGE(PG8_SA(0, 0), cA, voffA); PG8_STAGE(PG8_SB(0, 1), cB + hstep, voffB); PG8_STAGE(PG8_SA(0, 1), cA + hstep, voffA);
        if (wr == 1) PG8_BAR;
        PG8_WAIT_V(4); PG8_BAR;
        PG8_STAGE(PG8_SB(1, 0), cB + kstep, voffB); PG8_STAGE(PG8_SA(1, 0), cA + kstep, voffA); PG8_STAGE(PG8_SB(1, 1), cB + hstep + kstep, voffB);
        PG8_WAIT_V(6); PG8_BAR;
    }
    for (;;) {
        const bool has_next = S.next(ui + 1, nxt);
        const char* nA = has_next ? (const char*)g.A + (size_t)nxt.pm * tstep : cA; const char* nB = has_next ? (const char*)g.Bt + (size_t)nxt.pn * tstep : cB;
        for (int t = 0; t < nt; t += 2) {
            const bool last = (t == nt - 2);
            const char* a1 = cA + (size_t)(t + 1) * kstep;
            const char* a2 = last ? nA : cA + (size_t)(t + 2) * kstep; const char* b2 = last ? nB : cB + (size_t)(t + 2) * kstep;
            const char* a3 = a2 + kstep; const char* b3 = b2 + kstep;
            if (last && has_next) S.a_ready(nxt);
            if constexpr (SP2) {
            PG8_LDB(B0, 0, 0); PG8_LDB(B1, 0, 1); PG8_SCHED; PG8_LDA(At, 0, 0); PG8_STAGE(PG8_SA(1, 1), a1 + hstep, voffA);
            PG8_WAIT_V(8); PG8_WAIT_L(0); PG8_BAR; PG8_MMA(0, 0, At, B0); PG8_MMA(0, 1, At, B1); PG8_BAR; PG8_SCHED;
            PG8_LDA(At, 0, 1); PG8_STAGE(PG8_SB(0, 0), b2, voffB); PG8_STAGE(PG8_SB(0, 1), b2 + hstep, voffB); PG8_STAGE(PG8_SA(0, 0), a2, voffA);
            PG8_WAIT_V(8); PG8_WAIT_L(0); PG8_BAR; PG8_MMA(1, 0, At, B0); PG8_MMA(1, 1, At, B1); PG8_BAR; PG8_SCHED;
            PG8_LDB(B0, 1, 0); PG8_LDB(B1, 1, 1); PG8_SCHED; PG8_LDA(At, 1, 0); PG8_STAGE(PG8_SA(0, 1), a2 + hstep, voffA);
            PG8_WAIT_V(8); PG8_WAIT_L(0); PG8_BAR; PG8_MMA(0, 0, At, B0); PG8_MMA(0, 1, At, B1); PG8_BAR; PG8_SCHED;
            PG8_LDA(At, 1, 1); PG8_STAGE(PG8_SB(1, 0), b3, voffB); PG8_STAGE(PG8_SB(1, 1), b3 + hstep, voffB); PG8_STAGE(PG8_SA(1, 0), a3, voffA);
            PG8_WAIT_V(8); PG8_WAIT_L(0); PG8_BAR; PG8_MMA(1, 0, At, B0); PG8_MMA(1, 1, At, B1); PG8_BAR; PG8_SCHED;
            } else {
            PG8_LDB(B0, 0, 0); PG8_SCHED; PG8_LDA(At, 0, 0); PG8_STAGE(PG8_SA(1, 1), a1 + hstep, voffA);
            PG8_WAIT_L(8); PG8_BAR; PG8_WAIT_L(0); PG8_MMA(0, 0, At, B0); PG8_BAR; PG8_SCHED;
            PG8_LDB(B1, 0, 1); PG8_STAGE(PG8_SB(0, 0), b2, voffB);
            PG8_BAR; PG8_WAIT_L(0); PG8_MMA(0, 1, At, B1); PG8_BAR;
            PG8_LDA(At, 0, 1); PG8_STAGE(PG8_SA(0, 0), a2, voffA);
            PG8_BAR; PG8_WAIT_L(0); PG8_MMA(1, 0, At, B0); PG8_BAR; PG8_SCHED;
            PG8_STAGE(PG8_SB(0, 1), b2 + hstep, voffB);
            PG8_WAIT_V(6); PG8_BAR; PG8_MMA(1, 1, At, B1); PG8_BAR;
            PG8_LDB(B0, 1, 0); PG8_SCHED; PG8_LDA(At, 1, 0); PG8_STAGE(PG8_SA(0, 1), a2 + hstep, voffA);
            PG8_WAIT_L(8); PG8_BAR; PG8_WAIT_L(0); PG8_MMA(0, 0, At, B0); PG8_BAR; PG8_SCHED;
            PG8_LDB(B1, 1, 1); PG8_STAGE(PG8_SB(1, 0), b3, voffB);
            PG8_BAR; PG8_WAIT_L(0); PG8_MMA(0, 1, At, B1); PG8_BAR;
            PG8_LDA(At, 1, 1); PG8_STAGE(PG8_SA(1, 0), a3, voffA);
            PG8_BAR; PG8_WAIT_L(0); PG8_MMA(1, 0, At, B0); PG8_BAR; PG8_SCHED;
            PG8_STAGE(PG8_SB(1, 1), b3 + hstep, voffB);
            PG8_WAIT_V(6); PG8_BAR; PG8_MMA(1, 1, At, B1); PG8_BAR;
            }
        }
        if constexpr (ALIGN_EPI) { if (wr == 0) PG8_BAR; }
        if constexpr (!Epi::AFTER_DRAIN) { E(acc, cur, wr, wc, fr, fq);
#if PROBE_EPI2
            if constexpr (Epi::PERM) { asm volatile("" ::: "memory"); E(acc, cur, wr, wc, fr, fq); }
#endif
            S.done(cur); }
        if (!has_next) break;
#pragma unroll
        for (int a = 0; a < 2; ++a)
#pragma unroll
            for (int b = 0; b < 2; ++b)
#pragma unroll
                for (int m = 0; m < 4; ++m)
#pragma unroll
                    for (int n = 0; n < 2; ++n) acc[a][b][m][n] = (f32x4){0.f, 0.f, 0.f, 0.f};
        cur = nxt; cA = nA; cB = nB; ++ui;
        if constexpr (ALIGN_EPI) { if (wr == 1) PG8_BAR; }
    }
    PG8_WAIT_V(0);
    if constexpr (!ALIGN_EPI) { if (wr == 0) PG8_BAR; }
    PG8_BAR;
    if constexpr (Epi::AFTER_DRAIN) { E.fused(acc, cur, wr, wc, fr, fq, lds, wid, lane); S.done(cur); }
#undef PG8_SA
#undef PG8_SB
#undef PG8_STAGE
#undef PG8_LDA
#undef PG8_LDB
#undef PG8_MMA
#undef PG8_WAIT_V
#undef PG8_WAIT_L
#undef PG8_BAR
#undef PG8_SCHED
}
}
#define XB_TMO      128
#define XB_XCNT(j)  (256  + 64 * (j))
#define XB_XSUB(j)  (1280 + 64 * (j))
#define XB_XGEN(j)  (2304 + 64 * (j))
#define XB_TOP      3328
#define XB_TOPGEN   3392
#define XCD_BAR_WORDS 3456
#define XB_SPIN_CAP (1u << 18)

__device__ __forceinline__ unsigned xb_ld(unsigned* p)              { return __hip_atomic_load(p, __ATOMIC_RELAXED, __HIP_MEMORY_SCOPE_AGENT); }
__device__ __forceinline__ unsigned xb_add(unsigned* p, unsigned v) { return __hip_atomic_fetch_add(p, v, __ATOMIC_RELAXED, __HIP_MEMORY_SCOPE_AGENT); }
__device__ __forceinline__ unsigned xb_xcc_id() { return (unsigned)__builtin_amdgcn_s_getreg((3 << 11) | 20) & 0xFu; }
#define XB_SPIN(cond, bar) do { unsigned _sp = 0; while (cond) { __builtin_amdgcn_s_sleep(1); \
    if ((++_sp & 255u) == 0u) { if (xb_ld(&(bar)[XB_TMO])) break; if (_sp > XB_SPIN_CAP) { atomicAdd(&(bar)[XB_TMO], 1u); break; } } } } while (0)

struct XcdBarrier {
    unsigned* bar; unsigned x;
    volatile LAS unsigned* st;
};

__device__ __forceinline__ XcdBarrier xcd_barrier_post(unsigned* bar, volatile LAS unsigned* st) {
    XcdBarrier b; b.bar = bar; b.x = xb_xcc_id(); b.st = st;
    if (threadIdx.x == 0) (void)xb_add(&bar[XB_XCNT(b.x)], 1u);
    return b;
}
__device__ __forceinline__ void xcd_barrier_complete(unsigned* bar, unsigned x, unsigned& nloc, unsigned& nx) {
    const unsigned G = gridDim.x * gridDim.y * gridDim.z;
    unsigned sum, cnt, mine, sp = 0u;
    for (;;) {
        sum = 0u; cnt = 0u; mine = 0u;
#pragma unroll
        for (unsigned j = 0; j < 16; ++j) { const unsigned c = xb_ld(&bar[XB_XCNT(j)]); sum += c; cnt += (c > 0u) ? 1u : 0u; mine = (j == x) ? c : mine; }
        if (sum == G) break;
        __builtin_amdgcn_s_sleep(1);
        if ((++sp & 255u) == 0u) { if (xb_ld(&bar[XB_TMO])) break; if (sp > XB_SPIN_CAP) { atomicAdd(&bar[XB_TMO], 1u); break; } }
    }
    nloc = mine > 0u ? mine : 1u; nx = cnt > 0u ? cnt : 1u;
}

__device__ __forceinline__ void xcd_barrier(const XcdBarrier& b) {
    asm volatile("s_waitcnt vmcnt(0)" ::: "memory");
    __syncthreads();
    if (threadIdx.x == 0) {
        unsigned* bar = b.bar;
        __builtin_amdgcn_s_waitcnt(0);
        unsigned nloc = b.st[0], nx = b.st[1];
        if (nloc == 0u) { xcd_barrier_complete(bar, b.x, nloc, nx); b.st[0] = nloc; b.st[1] = nx; }
        const unsigned old = xb_add(&bar[XB_XSUB(b.x)], 1u);
        const unsigned gen = old / nloc;
        if (old + 1u == (gen + 1u) * nloc) {
            __builtin_amdgcn_fence(__ATOMIC_RELEASE, "agent");
            asm volatile("s_waitcnt vmcnt(0)" ::: "memory");
            const unsigned og = xb_add(&bar[XB_TOP], 1u);
            const unsigned tg = og / nx;
            if (og + 1u == (tg + 1u) * nx) xb_add(&bar[XB_TOPGEN], 1u);
            else XB_SPIN(xb_ld(&bar[XB_TOPGEN]) == tg, bar);
            __builtin_amdgcn_fence(__ATOMIC_ACQUIRE, "agent");
            xb_add(&bar[XB_XGEN(b.x)], 1u);
            asm volatile("s_waitcnt vmcnt(0)" ::: "memory");
        } else {
            XB_SPIN(xb_ld(&bar[XB_XGEN(b.x)]) == gen, bar);
            __builtin_amdgcn_fence(__ATOMIC_ACQUIRE, "agent");
            asm volatile("s_waitcnt vmcnt(0)" ::: "memory");
        }
    }
    __syncthreads();
}
struct Args { const float* in[N_IN]; float* out; unsigned char* ws; int ph_lo, ph_hi, pad0, pad1; };
static_assert(sizeof(Args) == (N_IN + 2) * 8 + 16, "Args has no padding");
struct DevArgs { const GAS float* in[N_IN]; GAS float* out; GAS unsigned char* ws; int ph_lo, ph_hi, pad0, pad1; };
static_assert(sizeof(DevArgs) == sizeof(Args), "DevArgs mirrors Args");
typedef const __attribute__((address_space(4))) DevArgs* KArgs;
#define INP(i) ((const float*)F.ka->in[i])
struct Frame {
    LAS unsigned char* lds;
    int tid, lane, wave, vcu, G;
    KArgs ka;
    float* out; unsigned char* ws;
};
__device__ __forceinline__ const float* modp(const Frame& F, int layer) { return (const float*)(F.ws + WS_MOD) + (size_t)layer * 12 * NMOD; }
__device__ __forceinline__ unsigned char* lw(const Frame& F, int layer) { return F.ws + WS_W + (size_t)layer * LW; }

__device__ __forceinline__ void transpose_item(const float* W, int N, bf16* WT, int opitch, int ocol0, int k0, int n0, int orow0, LAS float* scr, int lane) {
#pragma unroll 8
    for (int i = 0; i < 32; ++i) { const int kk = 2 * i + (lane >> 5); scr[kk * 33 + (lane & 31)] = W[(size_t)(k0 + kk) * N + n0 + (lane & 31)]; }
    LDS_WAIT(); asm volatile("" ::: "memory");
    const int c = lane & 7;
#pragma unroll
    for (int j = 0; j < 4; ++j) { const int n = (lane >> 3) + 8 * j; const LAS float* s = scr + (8 * c) * 33 + n;
        v4u o; o.x = pk2(s[0 * 33], s[1 * 33]); o.y = pk2(s[2 * 33], s[3 * 33]); o.z = pk2(s[4 * 33], s[5 * 33]); o.w = pk2(s[6 * 33], s[7 * 33]);
        *(GAS v4u*)(WT + (size_t)(orow0 + n) * opitch + ocol0 + 8 * c) = o; }
    LDS_WAIT(); asm volatile("" ::: "memory");
}
__device__ __forceinline__ void p0a_phase(Frame& F) {
    const int gw = F.vcu * NWAVES + F.wave, NGW = F.G * NWAVES, gt = F.vcu * (NWAVES * 64) + F.tid, NGT = F.G * NWAVES * 64;
    {
        LAS float* sil = (LAS float*)F.lds;
        for (int i = F.tid; i < 12 * DM; i += NWAVES * 64) { const int b = i / DM, k = i % DM;
            const float c = b < NBP ? INP(I_CP)[b * DM + k] : INP(I_CS)[(b - NBP) * DM + k]; sil[k * 12 + b] = siluf_(c); }
        __syncthreads();
        constexpr int KC = DM / KSPLIT, NCB = NMOD / 256;
        float* part = (float*)(F.ws + WS_MODP);
        for (int it = gw; it < NL * KSPLIT * NCB; it += NGW) {
            const int l = it / (KSPLIT * NCB), ks = (it / NCB) % KSPLIT, cb = it % NCB, col = cb * 256 + 4 * F.lane;
            const GAS f32x4* wp = (const GAS f32x4*)(INP(I_ADAW) + ((size_t)l * DM + ks * KC) * NMOD + col);
            f32x4 acc[12];
#pragma unroll
            for (int b = 0; b < 12; ++b) acc[b] = (f32x4){0.f, 0.f, 0.f, 0.f};
#pragma unroll 4
            for (int k = 0; k < KC; ++k) { const f32x4 wv = wp[(size_t)k * (NMOD / 4)];
                const LAS f32x4* sp = (const LAS f32x4*)(sil + (ks * KC + k) * 12); const f32x4 s0 = sp[0], s1 = sp[1], s2 = sp[2];
                acc[0] += wv * s0[0]; acc[1] += wv * s0[1]; acc[2] += wv * s0[2]; acc[3] += wv * s0[3];
                acc[4] += wv * s1[0]; acc[5] += wv * s1[1]; acc[6] += wv * s1[2]; acc[7] += wv * s1[3];
                acc[8] += wv * s2[0]; acc[9] += wv * s2[1]; acc[10] += wv * s2[2]; acc[11] += wv * s2[3]; }
#pragma unroll
            for (int b = 0; b < 12; ++b) *(GAS f32x4*)(part + (((size_t)ks * NL + l) * 12 + b) * NMOD + col) = acc[b];
        }
        __syncthreads();
    }
    {
        LAS float* scr = (LAS float*)(F.lds + F.wave * 16384);
        constexpr int I_IN = (DM / 64) * (DIN / 32), I_OUT = (DM / 64) * (DM / 32), I_G = (DM / 64) * (DFF / 32), I_D = (DFF / 64) * (DM / 32), I_C = (DC / 64) * (DC / 32);
        constexpr int PER_L = I_IN + I_OUT + 2 * I_G + I_D; (void)I_C;
        for (int it = gw; it < NL * PER_L; it += NGW) {
            const int l = it / PER_L; int r = it % PER_L; unsigned char* wl = lw(F, l);
            if (r < I_IN) { const int nblk = DIN / 32, k0 = 64 * (r / nblk), n0 = 32 * (r % nblk);
                int orow0 = n0; if (n0 < 512) orow0 = 256 * (n0 >> 7) + (n0 & 127); else if (n0 < 1024) orow0 = 256 * ((n0 - 512) >> 7) + 128 + (n0 & 127);
                transpose_item(INP(I_WIN) + (size_t)l * DM * DIN, DIN, (bf16*)(wl + LW_WIN), DM, k0, k0, n0, orow0, scr, F.lane); continue; } r -= I_IN;
            if (r < I_OUT) { const int nblk = DM / 32, k0 = 64 * (r / nblk), n0 = 32 * (r % nblk);
                if ((k0 & 512) == 0) { const int which = k0 >> 10;
                    transpose_item(INP(I_WOUT) + (size_t)l * DM * DM, DM, (bf16*)(F.ws + WS_TA) + ((size_t)l * 2 + which) * DM * DC, DC, k0 & 511, k0, n0, n0, scr, F.lane); }
                else transpose_item(INP(I_WOUT) + (size_t)l * DM * DM, DM, (bf16*)(wl + LW_WOUT), DM, k0, k0, n0, n0, scr, F.lane);
                continue; } r -= I_OUT;
            if (r < 2 * I_G) { const int up = r >= I_G; if (up) r -= I_G; const int nblk = DFF / 32, k0 = 64 * (r / nblk), n0 = 32 * (r % nblk);
                const int orow0 = 256 * (n0 >> 7) + 128 * up + (n0 & 127);
                transpose_item(INP(up ? I_WU : I_WG) + (size_t)l * DM * DFF, DFF, (bf16*)(wl + LW_WGU), DM, k0, k0, n0, orow0, scr, F.lane); continue; } r -= 2 * I_G;
            { const int nblk = DM / 32, k0 = 64 * (r / nblk), n0 = 32 * (r % nblk);
                transpose_item(INP(I_WD) + (size_t)l * DFF * DM, DM, (bf16*)(wl + LW_WD), DFF, k0, k0, n0, n0, scr, F.lane); }
        }
        for (int i = gt; i < NL * 2 * DC * DC; i += NGT) { const int l = i / (2 * DC * DC), which = (i / (DC * DC)) & 1, c = (i / DC) % DC, d = i % DC; float v;
            if (which == 0) v = INP(I_CPW)[((size_t)l * DC + c) * DC + d];
            else v = ((c >> 7) == (d >> 7)) ? INP(I_POOLW)[(((size_t)l * 4 + (c >> 7)) * 128 + (c & 127)) * 128 + (d & 127)] * INP(I_POOLS)[l * DC + d] : 0.f;
            ((bf16*)(F.ws + WS_FB))[i] = (bf16)(pk2(v, 0.f) & 0xffffu); }
        for (int i = gt; i < NL * 4 * 128 * 128; i += NGT) { const int l = i / 65536, r = i % 65536, ii = (r >> 7) & 127, jj = r & 127;
            const float v = (jj <= ii) ? INP(I_SGW)[i] : 0.f; ((bf16*)(lw(F, l) + LW_SGW))[r] = (bf16)(pk2(v, 0.f) & 0xffffu); }
    }
    __syncthreads();
}
__device__ __forceinline__ void p0b_phase(Frame& F) {
    const int gt = F.vcu * (NWAVES * 64) + F.tid, NGT = F.G * NWAVES * 64;
    const float* part = (const float*)(F.ws + WS_MODP); float* mod = (float*)(F.ws + WS_MOD);
    for (int i = gt; i < NL * 12 * NMOD; i += NGT) { const int l = i / (12 * NMOD), n = i % NMOD; float s = INP(I_ADAB)[l * NMOD + n];
#pragma unroll
        for (int ks = 0; ks < KSPLIT; ++ks) s += part[(size_t)ks * NL * 12 * NMOD + i];
        mod[i] = s; }
}
template <bool COPY>
__device__ __forceinline__ void norm_phase(Frame& F, const float* gain, const float* mod_l, int sh_idx, bf16* H, bf16* XB) {
    const int gw = F.vcu * NWAVES + F.wave, NGW = F.G * NWAVES;
    for (int m = gw; m < MT; m += NGW) {
        f32x4 v[8]; float s = 0.f;
        if (COPY) { const float* src = m < MP ? INP(I_XP) + (size_t)m * DM : INP(I_XS) + (size_t)(m - MP) * DM;
            const GAS f32x4* xr = (const GAS f32x4*)src + F.lane; GAS v2u* xo = (GAS v2u*)(XB + (size_t)m * DM) + F.lane;
#pragma unroll
            for (int j = 0; j < 8; ++j) { const f32x4 t = xr[64 * j]; v2u w; w.x = pk2(t.x, t.y); w.y = pk2(t.z, t.w); xo[64 * j] = w; v[j] = (f32x4){bflo(w.x), bfhi(w.x), bflo(w.y), bfhi(w.y)}; }
        } else { const GAS v2u* xr = (const GAS v2u*)(XB + (size_t)m * DM) + F.lane;
#pragma unroll
            for (int j = 0; j < 8; ++j) { const v2u d = xr[64 * j]; v[j] = (f32x4){bflo(d.x), bfhi(d.x), bflo(d.y), bfhi(d.y)}; } }
#pragma unroll
        for (int j = 0; j < 8; ++j) s += (v[j].x * v[j].x + v[j].y * v[j].y) + (v[j].z * v[j].z + v[j].w * v[j].w);
        const float rstd = 1.0f / sqrtf(wave_sum(s) * (1.0f / DM) + EPS);
        const float* mb = mod_l + (size_t)batch_of_row(m) * NMOD;
        const GAS f32x4* shp = (const GAS f32x4*)(mb + sh_idx * DM) + F.lane; const GAS f32x4* scp = (const GAS f32x4*)(mb + (sh_idx + 1) * DM) + F.lane;
        const GAS f32x4* gp = (const GAS f32x4*)gain + F.lane;
        GAS v2u* o8 = (GAS v2u*)(H + (size_t)m * DM) + F.lane;
#pragma unroll
        for (int j = 0; j < 8; ++j) { const f32x4 g = gp[64 * j], sc = scp[64 * j], sh = shp[64 * j];
            const f32x4 y = v[j] * rstd * g * (sc + 1.0f) + sh; v2u w; w.x = pk2(y.x, y.y); w.y = pk2(y.z, y.w); o8[64 * j] = w; }
    }
}
__device__ __forceinline__ void final_norm_phase(Frame& F, const bf16* XB) {
    const int gw = F.vcu * NWAVES + F.wave, NGW = F.G * NWAVES;
    for (int m = gw; m < MT; m += NGW) {
        GAS f32x4* yr = (GAS f32x4*)(F.out + (size_t)m * DM) + F.lane;
        const GAS v2u* xr = (const GAS v2u*)(XB + (size_t)m * DM) + F.lane;
        f32x4 v[8]; float s = 0.f;
#pragma unroll
        for (int j = 0; j < 8; ++j) { const v2u d = xr[64 * j]; v[j] = (f32x4){bflo(d.x), bfhi(d.x), bflo(d.y), bfhi(d.y)}; s += (v[j].x * v[j].x + v[j].y * v[j].y) + (v[j].z * v[j].z + v[j].w * v[j].w); }
        const float rstd = 1.0f / sqrtf(wave_sum(s) * (1.0f / DM) + EPS);
        const GAS f32x4* gp = (const GAS f32x4*)INP(I_FING) + F.lane;
#pragma unroll
        for (int j = 0; j < 8; ++j) yr[64 * j] = v[j] * rstd * gp[64 * j];
    }
}

__device__ __forceinline__ int crow(int r, int hi) { return (r & 3) + 8 * (r >> 2) + 4 * hi; }
#define MFMA32(a, b, c) __builtin_amdgcn_mfma_f32_32x32x16_bf16((a), (b), (c), 0, 0, 0)
constexpr int AT_KP = 144, AT_VP = 192, AT_KB = 64 * AT_KP, AT_VB = 64 * AT_VP;
constexpr int AT_K0 = 0, AT_V0 = 2 * AT_KB, AT_BT = AT_V0 + 2 * AT_VB;
typedef short v4i16_t __attribute__((ext_vector_type(4)));
__device__ __forceinline__ v2u lds_tr_read(LAS unsigned char* p) { const v4i16_t r = __builtin_amdgcn_ds_read_tr16_b64_v4i16((LAS v4i16_t*)p); return __builtin_bit_cast(v2u, r); }
__device__ __forceinline__ float xhalf_max(float v) { auto rr = __builtin_amdgcn_permlane32_swap(__float_as_uint(v), __float_as_uint(v), false, false); return fmaxf(__uint_as_float(rr[0]), __uint_as_float(rr[1])); }
__device__ __forceinline__ float xhalf_sum(float v) { auto rr = __builtin_amdgcn_permlane32_swap(__float_as_uint(v), __float_as_uint(v), false, false); return __uint_as_float(rr[0]) + __uint_as_float(rr[1]); }
__device__ __forceinline__ void attn_unit(Frame& F, int layer, bool sample, int b, int h, int qg, const bf16* Z, bf16* MIX) {
    const int tid = F.tid, lane = F.lane, w = F.wave, l31 = lane & 31, hh = lane >> 5;
    LAS float* bt = (LAS float*)(F.lds + AT_BT);
    if (tid < 257) bt[tid] = INP(I_RELB)[((size_t)layer * 8 + h) * 257 + tid] * LOG2E;
    const bool wave_on = sample ? (w == 0) : true;
    const int qpos = sample ? l31 : 256 * qg + 32 * w + l31;
    const int qrow = sample ? MP + 32 * b + l31 : b * SEQ + qpos;
    bf16x8 qr[4];
#pragma unroll
    for (int d0 = 0; d0 < 4; ++d0) qr[d0] = *(const GAS bf16x8*)(Z + (size_t)qrow * ZW + ZQ + 64 * h + 16 * d0 + 8 * hh);
    f32x16 o0, o1;
#pragma unroll
    for (int r = 0; r < 16; ++r) { o0[r] = 0.f; o1[r] = 0.f; }
    float mrun = -1e30f, lrun = 0.f;
    const int ntile = sample ? 9 : 12, qc = 4 * qg + (w >> 1);
    const int jstart = sample ? 0 : (4 * qg >= 8 ? 0 : 8 - 4 * qg);
    const int sr = tid >> 3, sch = tid & 7;
    const float* ck = INP(I_CK) + ((size_t)layer * NBS + b) * 512 * 512; const float* cv = INP(I_CV) + ((size_t)layer * NBS + b) * 512 * 512;
    v4u kreg = (v4u){0u, 0u, 0u, 0u}, vreg = (v4u){0u, 0u, 0u, 0u};
#define AT_LOAD(j) do { \
        if (!sample) { const bf16* zr_ = Z + (size_t)(b * SEQ + 64 * (4 * qg - 8 + (j)) + sr) * ZW + 64 * h + 8 * sch; kreg = *(const GAS v4u*)(zr_ + ZK); vreg = *(const GAS v4u*)(zr_ + ZV); } \
        else if ((j) < 8) { const size_t o_ = ((size_t)(64 * (j) + sr) * 8 + h) * 64 + 8 * sch; \
                const f32x4 k0_ = *(const GAS f32x4*)(ck + o_), k1_ = *(const GAS f32x4*)(ck + o_ + 4), v0_ = *(const GAS f32x4*)(cv + o_), v1_ = *(const GAS f32x4*)(cv + o_ + 4); \
                kreg = (v4u){pk2(k0_.x, k0_.y), pk2(k0_.z, k0_.w), pk2(k1_.x, k1_.y), pk2(k1_.z, k1_.w)}; vreg = (v4u){pk2(v0_.x, v0_.y), pk2(v0_.z, v0_.w), pk2(v1_.x, v1_.y), pk2(v1_.z, v1_.w)}; } \
        else if (sr < 32) { const bf16* zr_ = Z + (size_t)(MP + 32 * b + sr) * ZW + 64 * h + 8 * sch; kreg = *(const GAS v4u*)(zr_ + ZK); vreg = *(const GAS v4u*)(zr_ + ZV); } \
        else { kreg = (v4u){0u, 0u, 0u, 0u}; vreg = (v4u){0u, 0u, 0u, 0u}; } } while (0)
#define AT_STORE(bf_) do { *(LAS v4u*)(F.lds + AT_K0 + (bf_) * AT_KB + sr * AT_KP + sch * 16) = kreg; *(LAS v4u*)(F.lds + AT_V0 + (bf_) * AT_VB + sr * AT_VP + sch * 16) = vreg; } while (0)
    AT_LOAD(jstart); AT_STORE(0);
    __syncthreads();
    const int tro = ((lane & 15) >> 2) * AT_VP + (16 * ((lane >> 4) & 1) + 4 * (lane & 3)) * 2 + 4 * hh * AT_VP;
    int buf = 0;
    for (int j = jstart; j < ntile; ++j) {
        const int kc = 4 * qg - 8 + j;
        const bool more = j + 1 < ntile;
        if (more) AT_LOAD(j + 1);
        const bool active = sample ? (w == 0) : (kc >= qc - 8 && kc <= qc);
        if (active) {
            LAS unsigned char* Ks = F.lds + AT_K0 + buf * AT_KB; LAS unsigned char* Vs = F.lds + AT_V0 + buf * AT_VB + tro;
            f32x16 p0, p1;
#pragma unroll
            for (int r = 0; r < 16; ++r) { p0[r] = 0.f; p1[r] = 0.f; }
#pragma unroll
            for (int d0 = 0; d0 < 4; ++d0) {
                const bf16x8 a0 = *(const LAS bf16x8*)(Ks + l31 * AT_KP + (16 * d0 + 8 * hh) * 2);
                const bf16x8 a1 = *(const LAS bf16x8*)(Ks + (32 + l31) * AT_KP + (16 * d0 + 8 * hh) * 2);
                p0 = MFMA32(a0, qr[d0], p0); p1 = MFMA32(a1, qr[d0], p1);
            }
            const int kbase = sample ? 64 * j - 512 : 64 * kc;
            const int relb = kbase - qpos;
            const int qmin = sample ? 0 : 256 * qg + 32 * w;
            float boff = 0.f;
            if (kbase + 63 - qmin <= -128) boff = bt[0];
            else {
#pragma unroll
                for (int r = 0; r < 16; ++r) { const int kv = crow(r, hh); int i0 = relb + kv, i1 = i0 + 32;
                    i0 = (i0 < -128 ? -128 : (i0 > 128 ? 128 : i0)) + 128; i1 = (i1 < -128 ? -128 : (i1 > 128 ? 128 : i1)) + 128;
                    p0[r] += bt[i0]; p1[r] += bt[i1]; }
            }
            if (sample && j == 8) {
#pragma unroll
                for (int r = 0; r < 16; ++r) p1[r] = -1e30f;
            }
            float mx = p0[0];
#pragma unroll
            for (int r = 1; r < 16; ++r) mx = fmaxf(mx, p0[r]);
#pragma unroll
            for (int r = 0; r < 16; ++r) mx = fmaxf(mx, p1[r]);
            mx = xhalf_max(mx) + boff;
            const float mn = fmaxf(mrun, mx), msub = mn - boff;
            if (__builtin_amdgcn_ballot_w64(mn > mrun) != 0ull) {
                const float alpha = fast_exp2(mrun - mn); lrun *= alpha;
#pragma unroll
                for (int r = 0; r < 16; ++r) { o0[r] *= alpha; o1[r] *= alpha; }
            }
            mrun = mn;
            float rs = 0.f;
#pragma unroll
            for (int r = 0; r < 16; ++r) { p0[r] = fast_exp2(p0[r] - msub); p1[r] = fast_exp2(p1[r] - msub); rs += p0[r] + p1[r]; }
            lrun += xhalf_sum(rs);
            bf16x8 pf[4];
            { v4u t;
              t = (v4u){pk2(p0[0], p0[1]), pk2(p0[2], p0[3]), pk2(p0[4], p0[5]), pk2(p0[6], p0[7])}; pf[0] = __builtin_bit_cast(bf16x8, t);
              t = (v4u){pk2(p0[8], p0[9]), pk2(p0[10], p0[11]), pk2(p0[12], p0[13]), pk2(p0[14], p0[15])}; pf[1] = __builtin_bit_cast(bf16x8, t);
              t = (v4u){pk2(p1[0], p1[1]), pk2(p1[2], p1[3]), pk2(p1[4], p1[5]), pk2(p1[6], p1[7])}; pf[2] = __builtin_bit_cast(bf16x8, t);
              t = (v4u){pk2(p1[8], p1[9]), pk2(p1[10], p1[11]), pk2(p1[12], p1[13]), pk2(p1[14], p1[15])}; pf[3] = __builtin_bit_cast(bf16x8, t); }
#pragma unroll
            for (int xt = 0; xt < 2; ++xt)
#pragma unroll
                for (int s = 0; s < 2; ++s) { const int ro = (32 * xt + 16 * s) * AT_VP;
                    const v2u lo0 = lds_tr_read(Vs + ro), hi0 = lds_tr_read(Vs + ro + 8 * AT_VP);
                    const v2u lo1 = lds_tr_read(Vs + ro + 64), hi1 = lds_tr_read(Vs + ro + 8 * AT_VP + 64);
                    const v4u f0 = (v4u){lo0.x, lo0.y, hi0.x, hi0.y}, f1 = (v4u){lo1.x, lo1.y, hi1.x, hi1.y};
                    o0 = MFMA32(__builtin_bit_cast(bf16x8, f0), pf[2 * xt + s], o0); o1 = MFMA32(__builtin_bit_cast(bf16x8, f1), pf[2 * xt + s], o1); }
        }
        if (more) AT_STORE(buf ^ 1);
        __syncthreads();
        buf ^= 1;
    }
#undef AT_LOAD
#undef AT_STORE
    if (wave_on) {
        const float inv = 1.0f / lrun;
        bf16* orow = MIX + (size_t)qrow * MIXW + MIX_B + 64 * h;
#pragma unroll
        for (int g4 = 0; g4 < 4; ++g4) { const int d = 8 * g4 + 4 * hh;
            v2u w0; w0.x = pk2(o0[4 * g4] * inv, o0[4 * g4 + 1] * inv); w0.y = pk2(o0[4 * g4 + 2] * inv, o0[4 * g4 + 3] * inv); *(GAS v2u*)(orow + d) = w0;
            v2u w1; w1.x = pk2(o1[4 * g4] * inv, o1[4 * g4 + 1] * inv); w1.y = pk2(o1[4 * g4 + 2] * inv, o1[4 * g4 + 3] * inv); *(GAS v2u*)(orow + 32 + d) = w1; }
    }
}
__device__ __forceinline__ unsigned sg_off(unsigned row, unsigned ch) { return 256u * row + 16u * (ch ^ (((row & 3u) << 2) | ((row >> 2) & 3u))); }
__device__ __forceinline__ void sg_unit(Frame& F, int layer, int ci, const bf16* Z, bf16* MIX) {
    const int lane = F.lane, w = F.wave, l31 = lane & 31, hh = lane >> 5;
    const bool sample = ci >= MP / 128; const int L = sample ? 32 : 128, row0 = sample ? MP + 32 * (ci - MP / 128) : 128 * ci;
    LAS unsigned char* VN = F.lds;
    {
        const int c8 = 8 * lane;
        const GAS f32x4* lgp = (const GAS f32x4*)(INP(I_SGG) + layer * DC + c8); const GAS f32x4* lbp = (const GAS f32x4*)(INP(I_SGB) + layer * DC + c8);
        const f32x4 lg0 = lgp[0], lg1 = lgp[1], lb0 = lbp[0], lb1 = lbp[1];
        const int nrw = L / 8;
        LAS unsigned char* vbase = VN + (lane >> 4) * 32768;
        v4u zrow[16];
#pragma unroll
        for (int i = 0; i < 16; ++i) { if (i < nrw) zrow[i] = *(const GAS v4u*)(Z + (size_t)(row0 + w * nrw + i) * ZW + ZSV + c8); else zrow[i] = (v4u){0u, 0u, 0u, 0u}; }
#pragma unroll
        for (int i = 0; i < 16; ++i) { if (i < nrw) { const int rr = w * nrw + i;
            const v4u zv = zrow[i];
            float x[8] = {bflo(zv.x), bfhi(zv.x), bflo(zv.y), bfhi(zv.y), bflo(zv.z), bfhi(zv.z), bflo(zv.w), bfhi(zv.w)};
            const float s = ((x[0] + x[1]) + (x[2] + x[3])) + ((x[4] + x[5]) + (x[6] + x[7]));
            const float mean = wave_sum(s) * (1.0f / DC); float q = 0.f;
#pragma unroll
            for (int e = 0; e < 8; ++e) { x[e] -= mean; q += x[e] * x[e]; }
            const float rstd = 1.0f / sqrtf(wave_sum(q) * (1.0f / DC) + EPS);
            float y[8];
            y[0] = x[0] * rstd * lg0.x + lb0.x; y[1] = x[1] * rstd * lg0.y + lb0.y; y[2] = x[2] * rstd * lg0.z + lb0.z; y[3] = x[3] * rstd * lg0.w + lb0.w;
            y[4] = x[4] * rstd * lg1.x + lb1.x; y[5] = x[5] * rstd * lg1.y + lb1.y; y[6] = x[6] * rstd * lg1.z + lb1.z; y[7] = x[7] * rstd * lg1.w + lb1.w;
            *(LAS v4u*)(vbase + sg_off((unsigned)rr, (unsigned)(lane & 15))) = (v4u){pk2(y[0], y[1]), pk2(y[2], y[3]), pk2(y[4], y[5]), pk2(y[6], y[7])};
            if (sample) { float* so = F.out + O_SGV + (((size_t)layer * NBS + (ci - MP / 128)) * TS + rr) * DC + c8;
                *(GAS f32x4*)so = (f32x4){y[0], y[1], y[2], y[3]}; *(GAS f32x4*)(so + 4) = (f32x4){y[4], y[5], y[6], y[7]}; }
        } }
    }
    __syncthreads();
    {
        const int g = w >> 1;
        const GAS bf16* Wg = (const GAS bf16*)((const bf16*)(lw(F, layer) + LW_SGW) + (size_t)g * 128 * 128 + (size_t)l31 * 128 + 8 * hh); asm volatile("" : "+v"(Wg));
        LAS unsigned char* vg = VN + g * 32768;
        const int nib = L / 32;
        const unsigned blk = (lane >> 4) & 1, q = (lane & 15) >> 2, p4 = lane & 3;
        bf16x8 Bf[4][8];
#pragma unroll
        for (int ib = 0; ib < 4; ++ib)
#pragma unroll
            for (int s = 0; s < 8; ++s) { if (s < 2 * (ib + 1)) { if (ib < nib) Bf[ib][s] = *(const GAS bf16x8*)(Wg + (32 * ib) * 128 + 16 * s); else Bf[ib][s] = (bf16x8){0, 0, 0, 0, 0, 0, 0, 0}; } }
#pragma unroll
        for (int cbb = 0; cbb < 2; ++cbb) { const int cb = 2 * (w & 1) + cbb;
            f32x16 acc[4];
#pragma unroll
            for (int ib = 0; ib < 4; ++ib)
#pragma unroll
                for (int r = 0; r < 16; ++r) acc[ib][r] = 0.f;
#pragma unroll
            for (int s = 0; s < 8; ++s) { if (s < 2 * nib) {
                const v2u a0 = lds_tr_read(vg + sg_off(16u * s + 8u * hh + q, 4u * cb + 2u * blk + (p4 >> 1)) + 8u * (p4 & 1));
                const v2u a1 = lds_tr_read(vg + sg_off(16u * s + 8u * hh + 4u + q, 4u * cb + 2u * blk + (p4 >> 1)) + 8u * (p4 & 1));
                const v4u af = (v4u){a0.x, a0.y, a1.x, a1.y};
#pragma unroll
                for (int ib = 0; ib < 4; ++ib) { if (s < 2 * (ib + 1)) { if (ib < nib) acc[ib] = MFMA32(__builtin_bit_cast(bf16x8, af), Bf[ib][s], acc[ib]); } }
            } }
#pragma unroll
            for (int ib = 0; ib < 4; ++ib) { if (ib < nib) {
                    const int i = 32 * ib + l31, row = row0 + i; const float bias = INP(I_SGBIAS)[((size_t)layer * 4 + g) * 128 + i];
#pragma unroll
                    for (int rg = 0; rg < 4; ++rg) { const int c4 = 32 * cb + 8 * rg + 4 * hh;
                        const v2u zu = *(const GAS v2u*)(Z + (size_t)row * ZW + ZSU + 128 * g + c4);
                        v2u o; o.x = pk2(bflo(zu.x) * (acc[ib][4 * rg] + bias), bfhi(zu.x) * (acc[ib][4 * rg + 1] + bias)); o.y = pk2(bflo(zu.y) * (acc[ib][4 * rg + 2] + bias), bfhi(zu.y) * (acc[ib][4 * rg + 3] + bias));
                        *(GAS v2u*)(MIX + (size_t)row * MIXW + MIX_D + 128 * g + c4) = o; } } }
        }
    }
    __syncthreads();
}
struct ConvCtx { const GAS unsigned char* zb; const GAS unsigned char* hist; GAS unsigned char* cst; bool sample, first, keep; };
template <int E> __device__ __forceinline__ void conv_load(unsigned (&ex)[62], const ConvCtx& X) {
    if constexpr (E < 30) { if (X.sample) { const f32x2 hv = *(const GAS f32x2*)(X.hist + (size_t)E * DC * 4); ex[E] = pk2(hv.x, hv.y); }
                            else if (X.first) ex[E] = 0u;
                            else ex[E] = *(const GAS unsigned*)(X.zb + (size_t)E * ZW * 2); }
    else ex[E] = *(const GAS unsigned*)(X.zb + (size_t)E * ZW * 2);
}
template <int... Es> __device__ __forceinline__ void conv_loads(unsigned (&ex)[62], const ConvCtx& X, std::integer_sequence<int, Es...>) { (conv_load<Es>(ex, X), ...); }
template <int E> __device__ __forceinline__ void conv_row(f32x2 (&acc)[32], const f32x2 (&wt)[31], const unsigned (&ex)[62], const ConvCtx& X) {
    const f32x2 v = (f32x2){bflo(ex[E]), bfhi(ex[E])};
    constexpr int T0 = E > 30 ? E - 30 : 0, T1 = E < 31 ? E : 31;
#pragma unroll
    for (int t = T0; t <= T1; ++t) acc[t] = wt[E - t] * v + acc[t];
    if constexpr (E >= 32) { if (X.keep) *(GAS f32x2*)(X.cst + (size_t)(E - 32) * DC * 4) = v; }
}
template <int... Es> __device__ __forceinline__ void conv_rows(f32x2 (&acc)[32], const f32x2 (&wt)[31], const unsigned (&ex)[62], const ConvCtx& X, std::integer_sequence<int, Es...>) { (conv_row<Es>(acc, wt, ex, X), ...); }
__device__ __forceinline__ void conv_unit(Frame& F, int layer, int tb, int cq, const bf16* Z, bf16* CA, int ca_pitch) {
    const int c = 128 * cq + 2 * F.lane; const bool sample = tb >= MP / 32; const int sb = tb - MP / 32;
    const int r0 = sample ? MP + 32 * sb : 32 * tb; const bool first = !sample && ((r0 & (SEQ - 1)) == 0);
    ConvCtx X; X.sample = sample; X.first = first; X.keep = sample || ((r0 & (SEQ - 1)) == SEQ - 32);
    X.zb = (const GAS unsigned char*)(Z + ((long)r0 - 30) * ZW + ZU + c); asm volatile("" : "+v"(X.zb));
    const GAS unsigned char* wb = (const GAS unsigned char*)(INP(I_CONVW) + (size_t)layer * 31 * DC + c); asm volatile("" : "+v"(wb));
    f32x2 wt[31];
#pragma unroll
    for (int j = 0; j < 31; ++j) wt[j] = *(const GAS f32x2*)(wb + (size_t)j * DC * 4);
    const f32x2 cbias = *(const GAS f32x2*)(INP(I_CONVB) + layer * DC + c), gg = *(const GAS f32x2*)(INP(I_GNG) + layer * DC + c), gb = *(const GAS f32x2*)(INP(I_GNB) + layer * DC + c);
    f32x2 acc[32];
#pragma unroll
    for (int t = 0; t < 32; ++t) acc[t] = cbias;
    X.hist = (const GAS unsigned char*)(INP(I_CCONV) + ((size_t)layer * NBS + (sample ? sb : 0)) * 30 * DC + c); asm volatile("" : "+v"(X.hist));
    X.cst = (GAS unsigned char*)(sample ? F.out + O_CONVS + ((size_t)layer * NBS + sb) * 30 * DC + c : F.out + O_CONVP + ((size_t)layer * NBP + (r0 >> 13)) * 30 * DC + c); asm volatile("" : "+v"(X.cst));
    GAS unsigned char* cab = (GAS unsigned char*)(CA + (size_t)r0 * ca_pitch + c); asm volatile("" : "+v"(cab));
    unsigned ex[62];
    conv_loads(ex, X, std::make_integer_sequence<int, 62>{});
    conv_rows(acc, wt, ex, X, std::make_integer_sequence<int, 62>{});
#pragma unroll
    for (int t = 0; t < 32; ++t) {
        const f32x2 y = acc[t];
        const float s = half32_sum(y.x + y.y), q = half32_sum(y.x * y.x + y.y * y.y);
        const float mean = s * (1.0f / 64.0f), var = fmaxf(q * (1.0f / 64.0f) - mean * mean, 0.f), rstd = 1.0f / sqrtf(var + EPS);
        const f32x2 n = (y - mean) * rstd * gg + gb;
        *(GAS unsigned*)(cab + (size_t)t * ca_pitch * 2) = pk2(siluf_(n.x), siluf_(n.y));
    }
}
template <int W>
__device__ __forceinline__ void pool_body(Frame& F, int layer, int tb, int cq, const bf16* Z, bf16* PM, int pm_pitch) {
    const int c = 128 * cq + 2 * F.lane; const bool sample = tb >= MP / 32; const int sb = tb - MP / 32;
    const int r0 = sample ? MP + 32 * sb : 32 * tb; const bool first = !sample && ((r0 & (SEQ - 1)) == 0);
    const GAS unsigned char* hist = (const GAS unsigned char*)(INP(I_CPOOL) + ((size_t)layer * NBS + (sample ? sb : 0)) * 15 * DC + c); asm volatile("" : "+v"(hist));
    const bool last_blk = !sample && ((r0 & (SEQ - 1)) == SEQ - 32);
    GAS unsigned char* pst = (GAS unsigned char*)(sample ? F.out + O_POOLS + ((size_t)layer * NBS + sb) * 15 * DC + c : F.out + O_POOLP + ((size_t)layer * NBP + (r0 >> 13)) * 15 * DC + c); asm volatile("" : "+v"(pst));
    const GAS unsigned char* zb = (const GAS unsigned char*)(Z + ((long)r0 - 15) * ZW + ZP + c); asm volatile("" : "+v"(zb));
    GAS unsigned char* pmb = (GAS unsigned char*)(PM + (size_t)r0 * pm_pitch + c); asm volatile("" : "+v"(pmb));
    f32x2 ext[47];
#pragma unroll
    for (int e = 0; e < 47; ++e) {
        if (e < 15) { if (sample) ext[e] = *(const GAS f32x2*)(hist + (size_t)e * DC * 4);
                      else if (first) ext[e] = (f32x2){0.f, 0.f};
                      else { const unsigned u = *(const GAS unsigned*)(zb + (size_t)e * ZW * 2); ext[e] = (f32x2){bflo(u), bfhi(u)}; } }
        else { const unsigned u = *(const GAS unsigned*)(zb + (size_t)e * ZW * 2); ext[e] = (f32x2){bflo(u), bfhi(u)}; }
    }
#pragma unroll
    for (int t = 0; t < 32; ++t) {
        f32x2 win = (f32x2){0.f, 0.f};
#pragma unroll
        for (int i = W - 1; i >= 0; --i) win += ext[15 + t - i];
        const float rc = 1.0f / (float)((first && t + 1 < W) ? t + 1 : W);
        const f32x2 m = win * rc - ext[15 + t];
        *(GAS unsigned*)(pmb + (size_t)t * pm_pitch * 2) = pk2(m.x, m.y);
        if (t >= 17 && (sample || last_blk)) *(GAS f32x2*)(pst + (size_t)(t - 17) * DC * 4) = ext[15 + t];
    }
}
#define MIX_FENCE() do { int t_ = F.tid; asm volatile("" : "+v"(t_)); F.tid = t_; F.lane = t_ & 63; } while (0)
__device__ __forceinline__ void mixer_phase(Frame& F, int layer) {
    const bf16* Z = (const bf16*)(F.ws + WS_Z); bf16* MIX = (bf16*)(F.ws + WS_MIX); bf16* CA = MIX + MIX_A; bf16* PM = MIX + MIX_C;
#ifndef PROBE_MIX
#define PROBE_MIX 0
#endif
#define MDUP(k) _Pragma("unroll") for (int mrep_ = 0; mrep_ < 1 + ((PROBE_MIX >> (k)) & 1); ++mrep_)
    MDUP(0) { for (int id = F.vcu; id < NBP * 8 * 32; id += F.G) attn_unit(F, layer, false, id >> 8, (id >> 5) & 7, id & 31, Z, MIX);
    for (int id = F.vcu - 192; id >= 0 && id < NBS * 8; id += F.G) attn_unit(F, layer, true, id >> 3, id & 7, 0, Z, MIX); }
    MIX_FENCE();
    MDUP(1) { for (int id = F.vcu; id < MP / 128; id += F.G) sg_unit(F, layer, id, Z, MIX);
    for (int id = F.vcu - 96; id >= 0 && id < NBS; id += F.G) sg_unit(F, layer, MP / 128 + id, Z, MIX); }
    const int gw = F.vcu * NWAVES + F.wave, NGW = F.G * NWAVES;
    MIX_FENCE();
    MDUP(2) { for (int id = gw; id < (MP / 32) * 4; id += NGW) conv_unit(F, layer, id >> 2, id & 3, Z, CA, MIXW);
    if (F.wave == 0 && F.vcu >= 128 && F.vcu < 160) { const int id = (MP / 32) * 4 + F.vcu - 128; conv_unit(F, layer, id >> 2, id & 3, Z, CA, MIXW); } }
    MIX_FENCE();
    MDUP(3) for (int it = 0; it < 3; ++it) { int id = gw + it * NGW;
        if (it == 2) { if (F.wave == 0 && F.vcu >= 160 && F.vcu < 192) id = (MP / 32) * 4 + F.vcu - 160; else break; }
        const int tb = id >> 2, cq = id & 3;
        switch (cq) { case 0: pool_body<2>(F, layer, tb, cq, Z, PM, MIXW); break; case 1: pool_body<4>(F, layer, tb, cq, Z, PM, MIXW); break;
                      case 2: pool_body<8>(F, layer, tb, cq, Z, PM, MIXW); break; default: pool_body<16>(F, layer, tb, cq, Z, PM, MIXW); break; } }
    MIX_FENCE();
    const int gt = F.vcu * (NWAVES * 64) + F.tid, NGT = F.G * NWAVES * 64;
    for (int i = gt; i < (NBP * 512 + NBS * TS) * 128; i += NGT) {
        const int rr = i >> 7, kv = (i >> 6) & 1, ch = i & 63;
        int zrow; size_t o;
        if (rr < NBP * 512) { const int b = rr >> 9, t = rr & 511; zrow = b * SEQ + SEQ - 512 + t; o = (kv ? O_VP : O_KP) + (((size_t)layer * NBP + b) * 512 + t) * 512 + 8 * ch; }
        else { const int r2 = rr - NBP * 512, b = r2 >> 5, t = r2 & 31; zrow = MP + r2; o = (kv ? O_VS : O_KS) + (((size_t)layer * NBS + b) * TS + t) * 512 + 8 * ch; }
        const v4u z = *(const GAS v4u*)(Z + (size_t)zrow * ZW + (kv ? ZV : ZK) + 8 * ch);
        *(GAS f32x4*)(F.out + o) = (f32x4){bflo(z.x), bfhi(z.x), bflo(z.y), bfhi(z.y)}; *(GAS f32x4*)(F.out + o + 4) = (f32x4){bflo(z.z), bfhi(z.z), bflo(z.w), bfhi(z.w)};
    }
}

enum { SK_Z = 0, SK_MIX2 = 1, SK_RES = 2, SK_SWI = 3 };
struct SkUnit { int row0, nb0, nb1, ocol0, ocol1; bool pair; float scale; };
template <int KIND, int NTB, int U>
__device__ __forceinline__ void sk_unit(Frame& F, const bf16* A, const bf16* Bt, int K, const SkUnit& u, bf16* obf, int opitch, float* X, const float* gate) {
    const int lane = F.lane, w = F.wave, l31 = lane & 31, hh = lane >> 5;
    const int kw = K >> 3, nch = kw >> 6;
    constexpr int NR = 32 * NTB + 64, NLD = NR / 8;
    LAS unsigned char* stg = F.lds + w * 16384;
    const int lr = lane >> 3, lc = lane & 7;
    const GAS unsigned char* src[NLD];
#pragma unroll
    for (int i = 0; i < NLD; ++i) { const int r = 8 * i + lr;
        const bf16* base = (r < 32 * NTB) ? A + (size_t)(u.row0 + r) * K : (r < 32 * NTB + 32) ? Bt + (size_t)(u.nb0 + r - 32 * NTB) * K : Bt + (size_t)(u.nb1 + r - 32 * NTB - 32) * K;
        src[i] = (const GAS unsigned char*)(base + w * kw + 8 * lc); }
    f32x16 acc[NTB][2];
#pragma unroll
    for (int tb = 0; tb < NTB; ++tb)
#pragma unroll
        for (int c = 0; c < 2; ++c)
#pragma unroll
            for (int r = 0; r < 16; ++r) acc[tb][c][r] = 0.f;
    v4u R[NLD];
#pragma unroll
    for (int i = 0; i < NLD; ++i) R[i] = *(const GAS v4u*)(src[i]);
    for (int ch = 0; ch < nch; ++ch) {
#pragma unroll
        for (int i = 0; i < NLD; ++i) { const int r = 8 * i + lr; *(LAS v4u*)(stg + r * 128 + 16 * (lc ^ (r & 7))) = R[i]; }
        if (ch + 1 < nch) {
#pragma unroll
            for (int i = 0; i < NLD; ++i) R[i] = *(const GAS v4u*)(src[i] + (size_t)(ch + 1) * 128); }
#pragma unroll
        for (int s = 0; s < 4; ++s) { const int cx = 16 * ((2 * s + hh) ^ (l31 & 7));
            bf16x8 xf[NTB];
#pragma unroll
            for (int tb = 0; tb < NTB; ++tb) xf[tb] = *(const LAS bf16x8*)(stg + (32 * tb + l31) * 128 + cx);
            const bf16x8 w0 = *(const LAS bf16x8*)(stg + (32 * NTB + l31) * 128 + cx), w1 = *(const LAS bf16x8*)(stg + (32 * NTB + 32 + l31) * 128 + cx);
#pragma unroll
            for (int tb = 0; tb < NTB; ++tb) { acc[tb][0] = MFMA32(w0, xf[tb], acc[tb][0]); acc[tb][1] = MFMA32(w1, xf[tb], acc[tb][1]); }
        }
    }
    __syncthreads();
    LAS f32x4* red = (LAS f32x4*)F.lds;
#pragma unroll
    for (int tb = 0; tb < NTB; ++tb)
#pragma unroll
        for (int c = 0; c < 2; ++c)
#pragma unroll
            for (int rg = 0; rg < 4; ++rg) red[((((w * NTB + tb) * 2 + c) * 4 + rg) << 6) + lane] = (f32x4){acc[tb][c][4 * rg], acc[tb][c][4 * rg + 1], acc[tb][c][4 * rg + 2], acc[tb][c][4 * rg + 3]};
    __syncthreads();
    {
        const int rg = w & 3, tb = (NTB == 2) ? (w >> 2) : 0, c_lo = (NTB == 2) ? 0 : (w >> 2), c_hi = (NTB == 2) ? 2 : (w >> 2) + 1;
        f32x4 v[2] = {(f32x4){0.f, 0.f, 0.f, 0.f}, (f32x4){0.f, 0.f, 0.f, 0.f}};
#pragma unroll
        for (int c = 0; c < 2; ++c) { if (c >= c_lo && c < c_hi) {
#pragma unroll
                for (int w2 = 0; w2 < 8; ++w2) v[c] += red[((((w2 * NTB + tb) * 2 + c) * 4 + rg) << 6) + lane]; } }
        const int row = u.row0 + 32 * tb + l31, co = 8 * rg + 4 * hh;
        if (KIND == SK_Z) {
            if (u.pair) { v2u o; o.x = pk2(v[0][0] * sigmoidf_(v[1][0]), v[0][1] * sigmoidf_(v[1][1])); o.y = pk2(v[0][2] * sigmoidf_(v[1][2]), v[0][3] * sigmoidf_(v[1][3]));
                *(GAS v2u*)(obf + (size_t)row * opitch + u.ocol0 + co) = o; }
            else {
#pragma unroll
                for (int c = 0; c < 2; ++c) { const f32x4 y = v[c] * u.scale; v2u o; o.x = pk2(y[0], y[1]); o.y = pk2(y[2], y[3]); *(GAS v2u*)(obf + (size_t)row * opitch + (c ? u.ocol1 : u.ocol0) + co) = o; } }
        } else if (KIND == SK_MIX2) {
#pragma unroll
            for (int c = 0; c < 2; ++c) { v2u o; o.x = pk2(v[c][0], v[c][1]); o.y = pk2(v[c][2], v[c][3]); *(GAS v2u*)(obf + (size_t)row * opitch + (c ? u.ocol1 : u.ocol0) + co) = o; }
        } else if (KIND == SK_SWI) {
            v2u o; o.x = pk2(siluf_(v[0][0]) * v[1][0], siluf_(v[0][1]) * v[1][1]); o.y = pk2(siluf_(v[0][2]) * v[1][2], siluf_(v[0][3]) * v[1][3]);
            *(GAS v2u*)(obf + (size_t)row * opitch + u.ocol0 + co) = o;
        } else {
            const int c = w >> 2, col = (c ? u.ocol1 : u.ocol0) + co;
            const f32x4 g = *(const GAS f32x4*)(gate + (size_t)batch_of_row(row) * NMOD + col); GAS v2u* xp = (GAS v2u*)(obf + (size_t)row * opitch + col); const v2u xo = *xp;
            const f32x4 y = g * v[c] + (f32x4){bflo(xo.x), bfhi(xo.x), bflo(xo.y), bfhi(xo.y)};
            v2u o; o.x = pk2(y[0], y[1]); o.y = pk2(y[2], y[3]); *xp = o;
        }
    }
    __syncthreads();
}
constexpr int NPL = 7, N_PHASES = 2 + NPL * NL + 1;

__global__ void __launch_bounds__(NWAVES * 64, 2) enc_fwd(Args args) {
    extern __shared__ __attribute__((aligned(16))) unsigned char lds[];
    Frame F;
    F.lds = (LAS unsigned char*)lds;
    F.tid = threadIdx.x; F.lane = F.tid & 63; F.wave = __builtin_amdgcn_readfirstlane(F.tid >> 6);
    F.G = gridDim.x; { const int bx = blockIdx.x; F.vcu = (F.G % 8 == 0) ? (bx % 8) * (F.G / 8) + bx / 8 : bx; }
    F.ka = (KArgs)__builtin_amdgcn_kernarg_segment_ptr();
    F.out = args.out; F.ws = args.ws;
    volatile LAS unsigned* MISC = (volatile LAS unsigned*)(F.lds + MISC_OFF);
    for (int u = F.tid; u < (LDS_BYTES - LDSCTL_OFF) / 4; u += NWAVES * 64) ((LAS unsigned*)(F.lds + LDSCTL_OFF))[u] = 0u;
    __syncthreads();
    const int lo = args.ph_lo, hi = args.ph_hi;
#define REFRESH() do { int t_ = threadIdx.x; asm volatile("" : "+v"(t_)); F.tid = t_; F.lane = t_ & 63; F.wave = __builtin_amdgcn_readfirstlane(t_ >> 6); \
        unsigned long long w_ = (unsigned long long)args.ws, o_ = (unsigned long long)args.out, k_ = (unsigned long long)__builtin_amdgcn_kernarg_segment_ptr(); \
        asm volatile("" : "+s"(w_), "+s"(o_), "+s"(k_)); F.ws = (unsigned char*)(GAS unsigned char*)w_; F.out = (float*)(GAS float*)o_; F.ka = (KArgs)k_; \
        unsigned l_ = (unsigned)(unsigned long long)(LAS unsigned char*)lds; asm volatile("" : "+s"(l_)); F.lds = (LAS unsigned char*)(unsigned long long)l_; } while (0)
    XcdBarrier bar; bar.bar = (unsigned*)(F.ws + WS_CTL) + CW_BAR; bar.x = 0; bar.st = nullptr;
    if (hi - lo > 1) bar = xcd_barrier_post((unsigned*)(F.ws + WS_CTL) + CW_BAR, MISC + 8);
#ifdef ONLY_PHASE
#define IN(k) ((((k) < 2 || (k) == N_PHASES - 1) ? (k) : 2 + ((k) - 2) % NPL) == ONLY_PHASE && lo <= (k) && (k) < hi)
#else
#define IN(k) (lo <= (k) && (k) < hi)
#endif
#ifndef PROBE_DUP
#define PROBE_DUP 0
#endif
#define DUP(k) _Pragma("unroll") for (int rep_ = 0; rep_ < 1 + ((PROBE_DUP >> (k)) & 1); ++rep_)
#ifndef STAGGER_TICKS
#define STAGGER_TICKS 0
#endif
#define STAGGER(ticks) do { if ((ticks) > 0 && (blockIdx.x & 8)) { const unsigned long long t0_ = __builtin_amdgcn_s_memrealtime(); while (__builtin_amdgcn_s_memrealtime() - t0_ < (unsigned long long)(ticks)) __builtin_amdgcn_s_sleep(8); } } while (0)
#define SEAM(k) do { if (IN(k) && IN((k) + 1)) { XcdBarrier b_ = bar; unsigned long long p_ = (unsigned long long)b_.bar; asm volatile("" : "+s"(p_)); b_.bar = (unsigned*)p_; xcd_barrier(b_); } } while (0)

    if (IN(0)) DUP(8) { REFRESH(); p0a_phase(F); } SEAM(0);
    if (IN(1)) { REFRESH(); p0b_phase(F);
        pg8::Gemm g{(const bf16*)(F.ws + WS_TA), (const bf16*)(F.ws + WS_FB), NL * 2 * DM, NL * 2 * DC, DC}; pg8::FoldOrder S{F.G, (int)blockIdx.x}; pg8::EpiFold E{F.ws + WS_W, LW, LW_WOUT};
        pg8::gemm_phase<pg8::EpiFold, pg8::FoldOrder, true, true>(F.lds, g, S, E); } SEAM(1);
    for (int l = 0; l < NL; ++l) {
        const int pb = 2 + NPL * l;
        if (IN(pb + 0)) DUP(0) { REFRESH(); bf16* H = (bf16*)(F.ws + WS_H); bf16* Zb = (bf16*)(F.ws + WS_Z); bf16* MIX = (bf16*)(F.ws + WS_MIX); bf16* HID = (bf16*)(F.ws + WS_HID); bf16* CAPM = (bf16*)(F.ws + WS_CAPM); bf16* XB = (bf16*)(F.ws + WS_XB); (void)XB; (void)H; (void)Zb; (void)MIX; (void)HID; (void)CAPM; const float* mod_l = modp(F, l); unsigned char* wl = lw(F, l); (void)mod_l; (void)wl; if (l == 0) norm_phase<true>(F, INP(I_N1) + l * DM, mod_l, 0, H, XB); else norm_phase<false>(F, INP(I_N1) + l * DM, mod_l, 0, H, XB); } SEAM(pb + 0);
        if (IN(pb + 1)) DUP(1) { REFRESH(); bf16* H = (bf16*)(F.ws + WS_H); bf16* Zb = (bf16*)(F.ws + WS_Z); bf16* MIX = (bf16*)(F.ws + WS_MIX); bf16* HID = (bf16*)(F.ws + WS_HID); bf16* CAPM = (bf16*)(F.ws + WS_CAPM); bf16* XB = (bf16*)(F.ws + WS_XB); (void)XB; (void)H; (void)Zb; (void)MIX; (void)HID; (void)CAPM; const float* mod_l = modp(F, l); unsigned char* wl = lw(F, l); (void)mod_l; (void)wl; pg8::Gemm g{H, (const bf16*)(wl + LW_WIN), MP, DIN, DM}; pg8::StaticOrder S; S.init(MP, DIN, F.G, (int)blockIdx.x); int dry_ = (PROBE_DRY != 0) && (rep_ == 1); asm volatile("" : "+s"(dry_)); pg8::EpiZ E{Zb, dry_};
            pg8::gemm_phase<pg8::EpiZ, pg8::StaticOrder, true, true>(F.lds, g, S, E);
            for (int su = F.vcu; su < 4 * 64; su += F.G) { const int rt = su & 3, cb = su >> 2; SkUnit u; u.row0 = MP + 64 * rt;
                if (cb < 16) { const int tt = cb >> 2, x0 = 32 * (cb & 3); u.nb0 = 256 * tt + x0; u.nb1 = u.nb0 + 128; u.ocol0 = 128 * tt + x0; u.ocol1 = 0; u.pair = true; u.scale = 1.f; }
                else { const int pbk = cb - 16; u.nb0 = 1024 + 64 * pbk; u.nb1 = u.nb0 + 32; u.ocol0 = 512 + 64 * pbk; u.ocol1 = u.ocol0 + 32; u.pair = false; u.scale = (u.nb0 < 1536) ? QSCALE : 1.f; }
                sk_unit<SK_Z, 2, 8>(F, H, (const bf16*)(wl + LW_WIN), DM, u, Zb, ZW, nullptr, nullptr); } } SEAM(pb + 1);
        if (IN(pb + 2)) DUP(2) { REFRESH(); bf16* H = (bf16*)(F.ws + WS_H); bf16* Zb = (bf16*)(F.ws + WS_Z); bf16* MIX = (bf16*)(F.ws + WS_MIX); bf16* HID = (bf16*)(F.ws + WS_HID); bf16* CAPM = (bf16*)(F.ws + WS_CAPM); bf16* XB = (bf16*)(F.ws + WS_XB); (void)XB; (void)H; (void)Zb; (void)MIX; (void)HID; (void)CAPM; const float* mod_l = modp(F, l); unsigned char* wl = lw(F, l); (void)mod_l; (void)wl; mixer_phase(F, l); } SEAM(pb + 2);
        if (IN(pb + 3)) DUP(3) { REFRESH(); bf16* H = (bf16*)(F.ws + WS_H); bf16* Zb = (bf16*)(F.ws + WS_Z); bf16* MIX = (bf16*)(F.ws + WS_MIX); bf16* HID = (bf16*)(F.ws + WS_HID); bf16* CAPM = (bf16*)(F.ws + WS_CAPM); bf16* XB = (bf16*)(F.ws + WS_XB); (void)XB; (void)H; (void)Zb; (void)MIX; (void)HID; (void)CAPM; const float* mod_l = modp(F, l); unsigned char* wl = lw(F, l); (void)mod_l; (void)wl; STAGGER(STAGGER_G3); pg8::Gemm g{MIX, (const bf16*)(wl + LW_WOUT), MP, DM, DM}; pg8::StaticOrder S; S.init(MP, DM, F.G, (int)blockIdx.x); int dry_ = (PROBE_DRY != 0) && (rep_ == 1); asm volatile("" : "+s"(dry_)); pg8::EpiResB E{XB, mod_l + 2 * DM, dry_};
            pg8::gemm_phase<pg8::EpiResB, pg8::StaticOrder, true, true>(F.lds, g, S, E);
            if (!dry_) for (int su = F.vcu; su < 8 * 32; su += F.G) { const int rt = su & 7, cb = su >> 3; SkUnit u; u.row0 = MP + 32 * rt; u.nb0 = 64 * cb; u.nb1 = u.nb0 + 32; u.ocol0 = u.nb0; u.ocol1 = u.nb1; u.pair = false; u.scale = 1.f;
                sk_unit<SK_RES, 1, 8>(F, MIX, (const bf16*)(wl + LW_WOUT), DM, u, XB, DM, nullptr, mod_l + 2 * DM); } } SEAM(pb + 3);
        if (IN(pb + 4)) DUP(4) { REFRESH(); bf16* H = (bf16*)(F.ws + WS_H); bf16* Zb = (bf16*)(F.ws + WS_Z); bf16* MIX = (bf16*)(F.ws + WS_MIX); bf16* HID = (bf16*)(F.ws + WS_HID); bf16* CAPM = (bf16*)(F.ws + WS_CAPM); bf16* XB = (bf16*)(F.ws + WS_XB); (void)XB; (void)H; (void)Zb; (void)MIX; (void)HID; (void)CAPM; const float* mod_l = modp(F, l); unsigned char* wl = lw(F, l); (void)mod_l; (void)wl; norm_phase<false>(F, INP(I_N2) + l * DM, mod_l, 3, H, XB); } SEAM(pb + 4);
        if (IN(pb + 5)) DUP(5) { REFRESH(); bf16* H = (bf16*)(F.ws + WS_H); bf16* Zb = (bf16*)(F.ws + WS_Z); bf16* MIX = (bf16*)(F.ws + WS_MIX); bf16* HID = (bf16*)(F.ws + WS_HID); bf16* CAPM = (bf16*)(F.ws + WS_CAPM); bf16* XB = (bf16*)(F.ws + WS_XB); (void)XB; (void)H; (void)Zb; (void)MIX; (void)HID; (void)CAPM; const float* mod_l = modp(F, l); unsigned char* wl = lw(F, l); (void)mod_l; (void)wl; pg8::Gemm g{H, (const bf16*)(wl + LW_WGU), MP, 2 * DFF, DM}; pg8::StaticOrder S; S.init(MP, 2 * DFF, F.G, (int)blockIdx.x); pg8::EpiSwi E{HID};
            pg8::gemm_phase<pg8::EpiSwi, pg8::StaticOrder, true, true>(F.lds, g, S, E);
            for (int su = F.vcu; su < 4 * 176; su += F.G) { const int rt = su & 3, cb = su >> 2, tt = cb >> 2, x0 = 32 * (cb & 3); SkUnit u; u.row0 = MP + 64 * rt; u.nb0 = 256 * tt + x0; u.nb1 = u.nb0 + 128;
                u.ocol0 = 128 * tt + x0; u.ocol1 = 0; u.pair = true; u.scale = 1.f;
                sk_unit<SK_SWI, 2, 8>(F, H, (const bf16*)(wl + LW_WGU), DM, u, HID, DFF, nullptr, nullptr); } } SEAM(pb + 5);
        if (IN(pb + 6)) DUP(6) { REFRESH(); bf16* H = (bf16*)(F.ws + WS_H); bf16* Zb = (bf16*)(F.ws + WS_Z); bf16* MIX = (bf16*)(F.ws + WS_MIX); bf16* HID = (bf16*)(F.ws + WS_HID); bf16* CAPM = (bf16*)(F.ws + WS_CAPM); bf16* XB = (bf16*)(F.ws + WS_XB); (void)XB; (void)H; (void)Zb; (void)MIX; (void)HID; (void)CAPM; const float* mod_l = modp(F, l); unsigned char* wl = lw(F, l); (void)mod_l; (void)wl; STAGGER(STAGGER_G5); pg8::Gemm g{HID, (const bf16*)(wl + LW_WD), MP, DM, DFF}; pg8::StaticOrder S; S.init(MP, DM, F.G, (int)blockIdx.x); int dry_ = (PROBE_DRY != 0) && (rep_ == 1); asm volatile("" : "+s"(dry_)); pg8::EpiResB E{XB, mod_l + 5 * DM, dry_};
            pg8::gemm_phase<pg8::EpiResB, pg8::StaticOrder, true, true>(F.lds, g, S, E);
            if (!dry_) for (int su = F.vcu; su < 8 * 32; su += F.G) { const int rt = su & 7, cb = su >> 3; SkUnit u; u.row0 = MP + 32 * rt; u.nb0 = 64 * cb; u.nb1 = u.nb0 + 32; u.ocol0 = u.nb0; u.ocol1 = u.nb1; u.pair = false; u.scale = 1.f;
                sk_unit<SK_RES, 1, 11>(F, HID, (const bf16*)(wl + LW_WD), DFF, u, XB, DM, nullptr, mod_l + 5 * DM); } } SEAM(pb + 6);
    }
    if (IN(N_PHASES - 1)) { REFRESH(); final_norm_phase(F, (const bf16*)(F.ws + WS_XB)); }
#undef IN
#undef SEAM
}

extern "C" void kernel_launch(void* const* d_in, const int* in_sizes, int n_in, void* d_out, int out_size, void* d_ws, size_t ws_size, hipStream_t stream) {
    static int grid = 0;
    if (grid == 0) {
        if (n_in != N_IN || in_sizes[0] != MP * DM || (size_t)out_size != O_END || ws_size < WS_END) {
            fprintf(stderr, "kernel_launch: unexpected shapes: n_in %d in0 %d out %d ws %zu (need %zu); nothing launched\n", n_in, n_in > 0 ? in_sizes[0] : -1, out_size, ws_size, (size_t)WS_END); grid = -1; return; }
        int dev = 0, cus = 0;
        if (hipGetDevice(&dev) != hipSuccess || hipDeviceGetAttribute(&cus, hipDeviceAttributeMultiprocessorCount, dev) != hipSuccess) { grid = -1; return; }
        if (hipFuncSetAttribute((const void*)enc_fwd, hipFuncAttributeMaxDynamicSharedMemorySize, LDS_BYTES) != hipSuccess) { fprintf(stderr, "kernel_launch: hipFuncSetAttribute failed\n"); grid = -1; return; }
        int per_cu = 0;
        if (hipOccupancyMaxActiveBlocksPerMultiprocessor(&per_cu, (const void*)enc_fwd, NWAVES * 64, LDS_BYTES) != hipSuccess || per_cu < 1)
            fprintf(stderr, "kernel_launch: note: occupancy query reports %d workgroups per CU\n", per_cu);
        (void)hipGetLastError();
        grid = cus;
    }
    if (grid < 0) return;
    if (hipMemsetAsync((char*)d_ws + WS_CTL, 0, CTL_ZERO_BYTES, stream) != hipSuccess) return;
    Args a{};
    for (int i = 0; i < N_IN; ++i) a.in[i] = (const float*)d_in[i];
    a.out = (float*)d_out; a.ws = (unsigned char*)d_ws; a.pad0 = 0; a.pad1 = 0;
#if MK_ONE_LAUNCH
    a.ph_lo = 0; a.ph_hi = N_PHASES;
    hipLaunchKernelGGL(enc_fwd, dim3(grid), dim3(NWAVES * 64), LDS_BYTES, stream, a);
#else
    for (int ph = 0; ph < N_PHASES; ++ph) { a.ph_lo = ph; a.ph_hi = ph + 1;
        hipLaunchKernelGGL(enc_fwd, dim3(grid), dim3(NWAVES * 64), LDS_BYTES, stream, a); }
#endif
}
```

```cpp
#include <hip/hip_runtime.h>
#include <cstdio>
#include <cstdint>
#include <utility>

#ifndef MK_ONE_LAUNCH
#define MK_ONE_LAUNCH 1
#endif
#ifndef PROBE_DUP
#define PROBE_DUP 0
#endif
#ifndef PROBE_DRY
#define PROBE_DRY 0
#endif
#ifndef PROBE_MIX
#define PROBE_MIX 0
#endif
#ifndef PROBE_EPI2
#define PROBE_EPI2 0
#endif
#ifndef STAGGER_TICKS
#define STAGGER_TICKS 0
#endif
#ifndef STAGGER_G3
#define STAGGER_G3 0
#define STAGGER_G5 0
#endif

constexpr int DM = 2048, SEQ = 8192, NBP = 4, MP = NBP * SEQ, NBS = 8, TS = 32, MS = NBS * TS, MT = MP + MS, NPANEL = MT / 256;
constexpr int DIN = 4096, DFF = 5632, DC = 512, NL = 4, NMOD = 6 * DM, NBT = NBP + NBS;
constexpr int ZW = 3584, ZU = 0, ZQ = 512, ZK = 1024, ZV = 1536, ZP = 2048, ZSU = 2560, ZSV = 3072;
constexpr int MIXW = 2048, MIX_A = 0, MIX_B = 512, MIX_C = 1024, MIX_D = 1536;
constexpr float EPS = 1e-6f, LOG2E = 1.4426950408889634f, QSCALE = 0.125f * LOG2E;
constexpr int KSPLIT = 16;
constexpr size_t O_YP = 0, O_YS = O_YP + (size_t)MP * DM, O_CONVP = O_YS + (size_t)MS * DM, O_CONVS = O_CONVP + (size_t)NL * NBP * 30 * DC,
    O_KP = O_CONVS + (size_t)NL * NBS * 30 * DC, O_VP = O_KP + (size_t)NL * NBP * 512 * 512, O_KS = O_VP + (size_t)NL * NBP * 512 * 512,
    O_VS = O_KS + (size_t)NL * NBS * TS * 512, O_POOLP = O_VS + (size_t)NL * NBS * TS * 512, O_POOLS = O_POOLP + (size_t)NL * NBP * 15 * DC,
    O_SGV = O_POOLS + (size_t)NL * NBS * 15 * DC, O_END = O_SGV + (size_t)NL * NBS * TS * DC;
static_assert(O_END == 78700544, "output size");
enum { I_XP = 0, I_XS, I_CP, I_CS, I_CCONV, I_CK, I_CV, I_CPOOL, I_ADAW, I_ADAB, I_N1, I_N2, I_WIN, I_CONVW, I_CONVB, I_GNG, I_GNB, I_CPW, I_RELB,
       I_POOLW, I_POOLS, I_SGG, I_SGB, I_SGW, I_SGBIAS, I_WOUT, I_WG, I_WU, I_WD, I_FING, N_IN };
static_assert(N_IN == 30, "30 inputs");

constexpr size_t MiB = 1u << 20;
constexpr size_t WS_CTL = 0, CTL_ZERO_BYTES = 1 * MiB;
constexpr size_t WS_MOD = 1 * MiB;
constexpr size_t WS_MODP = 4 * MiB;
constexpr size_t WS_W = 40 * MiB;
constexpr size_t LW_WIN = 0, LW_WOUT = 16 * MiB, LW_WGU = 24 * MiB, LW_WD = 68 * MiB, LW_CPW = 90 * MiB, LW_PWD = LW_CPW + 512 * 1024, LW_SGW = 91 * MiB, LW = 91 * MiB + 256 * 1024;
constexpr size_t WS_H = WS_W + NL * LW;
constexpr size_t WS_Z = WS_H + (size_t)MT * DM * 2;
constexpr size_t WS_MIX = WS_Z + (size_t)MT * ZW * 2;
constexpr size_t WS_HID = WS_Z;
constexpr size_t WS_CAPM = WS_MIX + (size_t)MT * MIXW * 2;
constexpr size_t WS_TA = WS_CAPM, WS_FB = WS_CAPM + 16 * MiB;
constexpr size_t WS_XB = WS_CAPM + (size_t)2 * MT * DC * 2;
constexpr size_t WS_END = WS_XB + (size_t)MT * DM * 2;
static_assert(WS_HID + (size_t)MT * DFF * 2 <= WS_CAPM, "HID overlay");
static_assert((size_t)NL * 12 * NMOD * 4 <= 3 * MiB && (size_t)KSPLIT * NL * 12 * NMOD * 4 <= 36 * MiB, "mod buffers");
constexpr int CW_BAR = 4096;

constexpr int RING_BYTES = 131072;
constexpr int LDSCTL_OFF = RING_BYTES, MISC_OFF = LDSCTL_OFF + 320;
constexpr int LDS_BYTES = 147456;
constexpr int NWAVES = 8;

#define GAS __attribute__((address_space(1)))
#define LAS __attribute__((address_space(3)))
typedef unsigned short bf16;
typedef unsigned v4u __attribute__((ext_vector_type(4)));
typedef unsigned v2u __attribute__((ext_vector_type(2)));
typedef float f32x4 __attribute__((ext_vector_type(4)));
typedef float f32x2 __attribute__((ext_vector_type(2)));
typedef float f32x16 __attribute__((ext_vector_type(16)));
typedef short bf16x8 __attribute__((ext_vector_type(8)));
typedef __bf16 bf16x2_t __attribute__((ext_vector_type(2)));
typedef GAS unsigned gu32;
#define RLX_AGENT __ATOMIC_RELAXED, __HIP_MEMORY_SCOPE_AGENT
#define LDS_WAIT() asm volatile("s_waitcnt lgkmcnt(0)" ::: "memory")
#define VM_WAIT() asm volatile("s_waitcnt vmcnt(0)" ::: "memory")

__device__ __forceinline__ unsigned pk2(float lo, float hi) { f32x2 v = {lo, hi}; bf16x2_t b = __builtin_convertvector(v, bf16x2_t); return __builtin_bit_cast(unsigned, b); }
__device__ __forceinline__ float bflo(unsigned u) { return __uint_as_float(u << 16); }
__device__ __forceinline__ float bfhi(unsigned u) { return __uint_as_float(u & 0xffff0000u); }
__device__ __forceinline__ float bf2f(bf16 h) { return __uint_as_float((unsigned)h << 16); }
__device__ __forceinline__ float fast_exp2(float x) { return __builtin_amdgcn_exp2f(x); }
__device__ __forceinline__ float fast_rcp(float x) { return __builtin_amdgcn_rcpf(x); }
__device__ __forceinline__ float sigmoidf_(float x) { return fast_rcp(1.0f + fast_exp2(-x * LOG2E)); }
__device__ __forceinline__ float siluf_(float x) { return x * sigmoidf_(x); }
template <int CTRL> __device__ __forceinline__ float dpp_f(float v) { return __int_as_float(__builtin_amdgcn_update_dpp(0, __float_as_int(v), CTRL, 0xF, 0xF, true)); }
__device__ __forceinline__ float row16_sum(float v) { v += dpp_f<0xB1>(v); v += dpp_f<0x4E>(v); v += dpp_f<0x141>(v); v += dpp_f<0x140>(v); return v; }
__device__ __forceinline__ float half32_sum(float v) { v = row16_sum(v); v += __int_as_float(__builtin_amdgcn_ds_swizzle(__float_as_int(v), 0x401F)); return v; }
__device__ __forceinline__ float wave_sum(float v) { v = half32_sum(v);
    return __int_as_float(__builtin_amdgcn_readlane(__float_as_int(v), 0)) + __int_as_float(__builtin_amdgcn_readlane(__float_as_int(v), 32)); }
__device__ __forceinline__ int batch_of_row(int row) { return row < MP ? (row >> 13) : NBP + ((row - MP) >> 5); }

namespace pg8 {
#define PG8_LAS __attribute__((address_space(3)))
typedef unsigned short bf16_t;
typedef short bf16x8 __attribute__((ext_vector_type(8)));
typedef float f32x4 __attribute__((ext_vector_type(4)));
typedef unsigned u32x4 __attribute__((ext_vector_type(4)));
constexpr int BM = 256, BK = 64, HALF = 128, HTB = HALF * BK * 2  , STAGE_BYTES = 8 * HTB, NXCD = 8, WGM = 8;

__host__ __device__ __forceinline__ int lds_byte(int r, int c) { const int st = (r >> 4) * 2 + (c >> 5), rr = r & 15, cc = c & 31, ob = rr * 64 + cc * 2; return st * 1024 + (ob ^ (((ob >> 9) & 1) << 5)); }
__host__ __device__ __forceinline__ void stage_rc(int b, int& R, int& C) { const int st = b / 1024, sb = b % 1024, swz = sb ^ (((sb >> 9) & 1) << 5); R = (st >> 1) * 16 + swz / 64; C = (st & 1) * 32 + (swz % 64) / 2; }
__host__ __device__ __forceinline__ int perm32(int rho) { const int n = rho >> 4, i = rho & 15; return 8 * (i >> 2) + 4 * n + (i & 3); }

struct Unit { int pm, pn; };
struct Gemm { const bf16_t* A; const bf16_t* Bt; int M, N, K; };

struct StaticOrder {
    int nM, nN, nwg, G, c;
    __host__ __device__ void init(int M, int N, int G_, int c_) { nM = M / BM; nN = N / BM; nwg = nM * nN; G = G_; c = c_; }
    __host__ __device__ bool next(int i, Unit& u) const {
        const long L = (long)i * G + c; if (L >= nwg) return false;
        int wgid = (int)L; { const int q = nwg / NXCD, r = nwg % NXCD, xcd = wgid % NXCD, off = wgid / NXCD; wgid = (xcd < r ? xcd * (q + 1) : r * (q + 1) + (xcd - r) * q) + off; }
        const int nig = WGM * nN, gid = wgid / nig, fm = gid * WGM, gsz = (nM - fm) < WGM ? (nM - fm) : WGM;
        u.pm = fm + ((wgid % nig) % gsz); u.pn = (wgid % nig) / gsz; return true;
    }
    __device__ __forceinline__ void a_ready(const Unit&) const {}
    __device__ __forceinline__ void done(const Unit&) const {}
};
__device__ __forceinline__ unsigned cvt_pk_bf16(float lo, float hi) { return ::pk2(lo, hi); }
struct EpiZ {
    static constexpr bool PERM = true, AFTER_DRAIN = false;
    bf16_t* Z; int dry;
    __device__ __forceinline__ void operator()(const f32x4 (&acc)[2][2][4][2], const Unit& u, int wr, int wc, int fr, int fq) const {
        const int row0 = u.pm * BM + wr * 64 + fr;
        if (dry) return;
        if (u.pn < 4) {
            const int col0 = 128 * u.pn + wc * 32 + 8 * fq;
#pragma unroll
            for (int ai = 0; ai < 2; ++ai)
#pragma unroll
                for (int m = 0; m < 4; ++m) { bf16_t* rowp = Z + (size_t)(row0 + ai * HALF + m * 16) * ::ZW + col0;
                    const f32x4 a0 = acc[ai][0][m][0], a1 = acc[ai][0][m][1], g0 = acc[ai][1][m][0], g1 = acc[ai][1][m][1];
                    u32x4 w; w.x = cvt_pk_bf16(a0[0] * ::sigmoidf_(g0[0]), a0[1] * ::sigmoidf_(g0[1])); w.y = cvt_pk_bf16(a0[2] * ::sigmoidf_(g0[2]), a0[3] * ::sigmoidf_(g0[3]));
                    w.z = cvt_pk_bf16(a1[0] * ::sigmoidf_(g1[0]), a1[1] * ::sigmoidf_(g1[1])); w.w = cvt_pk_bf16(a1[2] * ::sigmoidf_(g1[2]), a1[3] * ::sigmoidf_(g1[3]));
                    *(u32x4*)rowp = w; }
        } else {
            const float sc = (u.pn < 6) ? ::QSCALE : 1.0f;
            const int col0 = 512 + 256 * (u.pn - 4) + wc * 32 + 8 * fq;
#pragma unroll
            for (int ai = 0; ai < 2; ++ai)
#pragma unroll
                for (int m = 0; m < 4; ++m) { bf16_t* rowp = Z + (size_t)(row0 + ai * HALF + m * 16) * ::ZW + col0;
#pragma unroll
                    for (int bj = 0; bj < 2; ++bj) { const f32x4 v0 = acc[ai][bj][m][0] * sc, v1 = acc[ai][bj][m][1] * sc;
                        u32x4 w; w.x = cvt_pk_bf16(v0[0], v0[1]); w.y = cvt_pk_bf16(v0[2], v0[3]); w.z = cvt_pk_bf16(v1[0], v1[1]); w.w = cvt_pk_bf16(v1[2], v1[3]);
                        *(u32x4*)(rowp + bj * HALF) = w; } }
        }
    }
};
struct EpiFold {
    static constexpr bool PERM = true, AFTER_DRAIN = false;
    unsigned char* wbase; size_t lwstride, lwoff;
    __device__ __forceinline__ void operator()(const f32x4 (&acc)[2][2][4][2], const Unit& u, int wr, int wc, int fr, int fq) const {
        const int lwh = u.pn >> 1, layer = lwh >> 1, which = lwh & 1, pm = u.pm - lwh * 8;
        bf16_t* O = (bf16_t*)(wbase + (size_t)layer * lwstride + lwoff);
        const int row0 = pm * BM + wr * 64 + fr, col0 = which * 1024 + (u.pn & 1) * 256 + wc * 32 + 8 * fq;
#pragma unroll
        for (int ai = 0; ai < 2; ++ai)
#pragma unroll
            for (int m = 0; m < 4; ++m) { bf16_t* rowp = O + (size_t)(row0 + ai * HALF + m * 16) * ::DM + col0;
#pragma unroll
                for (int bj = 0; bj < 2; ++bj) { const f32x4 v0 = acc[ai][bj][m][0], v1 = acc[ai][bj][m][1];
                    u32x4 w; w.x = cvt_pk_bf16(v0[0], v0[1]); w.y = cvt_pk_bf16(v0[2], v0[3]); w.z = cvt_pk_bf16(v1[0], v1[1]); w.w = cvt_pk_bf16(v1[2], v1[3]);
                    *(u32x4*)(rowp + bj * HALF) = w; } }
    }
};
struct EpiResB {
    static constexpr bool PERM = true, AFTER_DRAIN = false;
    bf16_t* XB; const float* gate; int dry;
    __device__ __forceinline__ void operator()(const f32x4 (&acc)[2][2][4][2], const Unit& u, int wr, int wc, int fr, int fq) const {
        if (dry) return;
        const int row0 = u.pm * BM + wr * 64 + fr, col0 = u.pn * BM + wc * 32 + 8 * fq;
        const float* gp = gate + (size_t)::batch_of_row(u.pm * BM) * ::NMOD + col0;
        f32x4 gv[2][2];
#pragma unroll
        for (int bj = 0; bj < 2; ++bj)
#pragma unroll
            for (int n = 0; n < 2; ++n) gv[bj][n] = *(const f32x4*)(gp + bj * HALF + 4 * n);
#pragma unroll
        for (int ai = 0; ai < 2; ++ai)
#pragma unroll
            for (int m = 0; m < 4; ++m) { bf16_t* rowp = XB + (size_t)(row0 + ai * HALF + m * 16) * ::DM + col0;
#pragma unroll
                for (int bj = 0; bj < 2; ++bj) { const u32x4 xo = *(const u32x4*)(rowp + bj * HALF);
                    const f32x4 v0 = acc[ai][bj][m][0] * gv[bj][0] + (f32x4){::bflo(xo.x), ::bfhi(xo.x), ::bflo(xo.y), ::bfhi(xo.y)};
                    const f32x4 v1 = acc[ai][bj][m][1] * gv[bj][1] + (f32x4){::bflo(xo.z), ::bfhi(xo.z), ::bflo(xo.w), ::bfhi(xo.w)};
                    u32x4 w; w.x = cvt_pk_bf16(v0[0], v0[1]); w.y = cvt_pk_bf16(v0[2], v0[3]); w.z = cvt_pk_bf16(v1[0], v1[1]); w.w = cvt_pk_bf16(v1[2], v1[3]);
                    *(u32x4*)(rowp + bj * HALF) = w; } }
    }
};
struct EpiSwi {
    static constexpr bool PERM = true, AFTER_DRAIN = false;
    bf16_t* HID;
    __device__ __forceinline__ void operator()(const f32x4 (&acc)[2][2][4][2], const Unit& u, int wr, int wc, int fr, int fq) const {
        const int row0 = u.pm * BM + wr * 64 + fr, col0 = 128 * u.pn + wc * 32 + 8 * fq;
#pragma unroll
        for (int ai = 0; ai < 2; ++ai)
#pragma unroll
            for (int m = 0; m < 4; ++m) { bf16_t* rowp = HID + (size_t)(row0 + ai * HALF + m * 16) * ::DFF + col0;
                const f32x4 g0 = acc[ai][0][m][0], g1 = acc[ai][0][m][1], u0 = acc[ai][1][m][0], u1 = acc[ai][1][m][1];
                u32x4 w; w.x = cvt_pk_bf16(::siluf_(g0[0]) * u0[0], ::siluf_(g0[1]) * u0[1]); w.y = cvt_pk_bf16(::siluf_(g0[2]) * u0[2], ::siluf_(g0[3]) * u0[3]);
                w.z = cvt_pk_bf16(::siluf_(g1[0]) * u1[0], ::siluf_(g1[1]) * u1[1]); w.w = cvt_pk_bf16(::siluf_(g1[2]) * u1[2], ::siluf_(g1[3]) * u1[3]);
                *(u32x4*)rowp = w; }
    }
};
struct FoldOrder {
    int G, c;
    __device__ __forceinline__ bool next(int i, Unit& u) const {
        const int L = i * G + c; if (L >= ::NL * 32) return false;
        const int lwh = L >> 4, pm = (L >> 1) & 7, pn = L & 1;
        u.pm = lwh * 8 + pm; u.pn = lwh * 2 + pn; return true;
    }
    __device__ __forceinline__ void a_ready(const Unit&) const {}
    __device__ __forceinline__ void done(const Unit&) const {}
};

template <class Epi, class Sched, bool ALIGN_EPI = false, bool SP2 = false>
__device__ __forceinline__ void gemm_phase(PG8_LAS unsigned char* lds, const Gemm g, const Sched& S, const Epi& E) {
    int tid_ = threadIdx.x; asm volatile("" : "+v"(tid_));
    const int tid = tid_, wid = __builtin_amdgcn_readfirstlane(tid >> 6), lane = tid & 63, wr = wid >> 2, wc = wid & 3, fr = lane & 15, fq = lane >> 4;
    const int K = g.K, nt = K / BK;
    unsigned voffA[2], voffB[2];
#pragma unroll
    for (int i = 0; i < 2; ++i) { int R, C; stage_rc(tid * 16 + i * 8192, R, C); const int Rb = Epi::PERM ? ((R & ~31) + perm32(R & 31)) : R;
        voffA[i] = (unsigned)(R * K + C) * 2u; voffB[i] = (unsigned)(Rb * K + C) * 2u; }
    const size_t kstep = (size_t)(BK * 2);
    const size_t hstep = (size_t)HALF * K * 2;
    const size_t tstep = 2 * hstep;
    const unsigned ldsw = (unsigned)wid * 1024u;
    const int aoff = lds_byte(wr * 64 + fr, fq * 8), boff = lds_byte(wc * 32 + fr, fq * 8);
#define PG8_SA(b, h) (((b) * 2 + (h)) * HTB)
#define PG8_SB(b, h) ((4 + (b) * 2 + (h)) * HTB)
#define PG8_STAGE(bufoff, gbase, voff) do { _Pragma("unroll") for (int _i = 0; _i < 2; ++_i) \
        __builtin_amdgcn_global_load_lds((const unsigned*)((const char*)(gbase) + (voff)[_i]), (PG8_LAS unsigned*)(lds + (bufoff) + ldsw + _i * 8192), 16, 0, 0); } while (0)
#define PG8_LDA(dst, b, h) do { _Pragma("unroll") for (int m = 0; m < 4; ++m) _Pragma("unroll") for (int k = 0; k < 2; ++k) dst[m][k] = *(const PG8_LAS bf16x8*)(lds + PG8_SA(b, h) + aoff + m * 2048 + k * 1024); } while (0)
#define PG8_LDB(dst, b, h) do { _Pragma("unroll") for (int n = 0; n < 2; ++n) _Pragma("unroll") for (int k = 0; k < 2; ++k) dst[n][k] = *(const PG8_LAS bf16x8*)(lds + PG8_SB(b, h) + boff + n * 2048 + k * 1024); } while (0)
#define PG8_MMA(ai, bj, At, Bt) do { __builtin_amdgcn_s_setprio(1); _Pragma("unroll") for (int m = 0; m < 4; ++m) _Pragma("unroll") for (int n = 0; n < 2; ++n) _Pragma("unroll") for (int k = 0; k < 2; ++k) \
        acc[ai][bj][m][n] = __builtin_amdgcn_mfma_f32_16x16x32_bf16(Bt[n][k], At[m][k], acc[ai][bj][m][n], 0, 0, 0); __builtin_amdgcn_s_setprio(0); } while (0)
#define PG8_WAIT_V(n) asm volatile("s_waitcnt vmcnt(" #n ")" ::: "memory")
#define PG8_WAIT_L(n) asm volatile("s_waitcnt lgkmcnt(" #n ")" ::: "memory")
#define PG8_BAR __builtin_amdgcn_s_barrier()
#define PG8_SCHED __builtin_amdgcn_sched_barrier(0)
    Unit cur, nxt; int ui = 0;
    if (!S.next(0, cur)) return;
    f32x4 acc[2][2][4][2];
#pragma unroll
    for (int a = 0; a < 2; ++a)
#pragma unroll
        for (int b = 0; b < 2; ++b)
#pragma unroll
            for (int m = 0; m < 4; ++m)
#pragma unroll
                for (int n = 0; n < 2; ++n) acc[a][b][m][n] = (f32x4){0.f, 0.f, 0.f, 0.f};
    bf16x8 At[4][2], B0[2][2], B1[2][2];
    const char* cA = (const char*)g.A + (size_t)cur.pm * tstep; const char* cB = (const char*)g.Bt + (size_t)cur.pn * tstep;
    S.a_ready(cur);
    if constexpr (SP2) {
        PG8_STAGE(PG8_SB(0, 0), cB, voffB); PG8_STAGE(PG8_SB(0, 1), cB + hstep, voffB); PG8_STAGE(PG8_SA(0, 0), cA, voffA); PG8_STAGE(PG8_SA(0, 1), cA + hstep, voffA);
        if (wr == 1) PG8_BAR;
        PG8_WAIT_V(2); PG8_BAR;
        PG8_STAGE(PG8_SB(1, 0), cB + kstep, voffB); PG8_STAGE(PG8_SA(1, 0), cA + kstep, voffA); PG8_STAGE(PG8_SB(1, 1), cB + hstep + kstep, voffB);
        PG8_WAIT_V(6); PG8_BAR;
    } else {
        PG8_STAGE(PG8_SB(0, 0), cB, voffB); PG8_STAGE(PG8_SA(0, 0), cA, voffA); PG8_STAGE(PG8_SB(0, 1), cB + hstep, voffB); PG8_STAGE(PG8_SA(0, 1), cA + hstep, voffA);
        if (wr == 1) PG8_BAR;
        PG8_WAIT_V(4); PG8_BAR;
        PG8_STAGE(PG8_SB(1, 0), cB + kstep, voffB); PG8_STAGE(PG8_SA(1, 0), cA + kstep, voffA); PG8_STAGE(PG8_SB(1, 1), cB + hstep + kstep, voffB);
        PG8_WAIT_V(6); PG8_BAR;
    }
    for (;;) {
        const bool has_next = S.next(ui + 1, nxt);
        const char* nA = has_next ? (const char*)g.A + (size_t)nxt.pm * tstep : cA; const char* nB = has_next ? (const char*)g.Bt + (size_t)nxt.pn * tstep : cB;
        for (int t = 0; t < nt; t += 2) {
            const bool last = (t == nt - 2);
            const char* a1 = cA + (size_t)(t + 1) * kstep;
            const char* a2 = last ? nA : cA + (size_t)(t + 2) * kstep; const char* b2 = last ? nB : cB + (size_t)(t + 2) * kstep;
            const char* a3 = a2 + kstep; const char* b3 = b2 + kstep;
            if (last && has_next) S.a_ready(nxt);
            if constexpr (SP2) {
            PG8_LDB(B0, 0, 0); PG8_LDB(B1, 0, 1); PG8_SCHED; PG8_LDA(At, 0, 0); PG8_STAGE(PG8_SA(1, 1), a1 + hstep, voffA);
            PG8_WAIT_V(8); PG8_WAIT_L(0); PG8_BAR; PG8_MMA(0, 0, At, B0); PG8_MMA(0, 1, At, B1); PG8_BAR; PG8_SCHED;
            PG8_LDA(At, 0, 1); PG8_STAGE(PG8_SB(0, 0), b2, voffB); PG8_STAGE(PG8_SB(0, 1), b2 + hstep, voffB); PG8_STAGE(PG8_SA(0, 0), a2, voffA);
            PG8_WAIT_V(8); PG8_WAIT_L(0); PG8_BAR; PG8_MMA(1, 0, At, B0); PG8_MMA(1, 1, At, B1); PG8_BAR; PG8_SCHED;
            PG8_LDB(B0, 1, 0); PG8_LDB(B1, 1, 1); PG8_SCHED; PG8_LDA(At, 1, 0); PG8_STAGE(PG8_SA(0, 1), a2 + hstep, voffA);
            PG8_WAIT_V(8); PG8_WAIT_L(0); PG8_BAR; PG8_MMA(0, 0, At, B0); PG8_MMA(0, 1, At, B1); PG8_BAR; PG8_SCHED;
            PG8_LDA(At, 1, 1); PG8_STAGE(PG8_SB(1, 0), b3, voffB); PG8_STAGE(PG8_SB(1, 1), b3 + hstep, voffB); PG8_STAGE(PG8_SA(1, 0), a3, voffA);
            PG8_WAIT_V(8); PG8_WAIT_L(0); PG8_BAR; PG8_MMA(1, 0, At, B0); PG8_MMA(1, 1, At, B1); PG8_BAR; PG8_SCHED;
            } else {
            PG8_LDB(B0, 0, 0); PG8_SCHED; PG8_LDA(At, 0, 0); PG8_STAGE(PG8_SA(1, 1), a1 + hstep, voffA);
            PG8_WAIT_L(8); PG8_BAR; PG8_WAIT_L(0); PG8_MMA(0, 0, At, B0); PG8_BAR; PG8_SCHED;
            PG8_LDB(B1, 0, 1); PG8_STAGE(PG8_SB(0, 0), b2, voffB);
            PG8_BAR; PG8_WAIT_L(0); PG8_MMA(0, 1, At, B1); PG8_BAR;
            PG8_LDA(At, 0, 1); PG8_STAGE(PG8_SA(0, 0), a2, voffA);
            PG8_BAR; PG8_WAIT_L(0); PG8_MMA(1, 0, At, B0); PG8_BAR; PG8_SCHED;
            PG8_STAGE(PG8_SB(0, 1), b2 + hstep, voffB);
            PG8_WAIT_V(6); PG8_BAR; PG8_MMA(1, 1, At, B1); PG8_BAR;
            PG8_LDB(B0, 1, 0); PG8_SCHED; PG8_LDA(At, 1, 0); PG8_STAGE(PG8_SA(0, 1), a2 + hstep, voffA);
            PG8_WAIT_L(8); PG8_BAR; PG8_WAIT_L(0); PG8_MMA(0, 0, At, B0); PG8_BAR; PG8_SCHED;
            PG8_LDB(B1, 1, 1); PG8_STAGE(PG8_SB(1, 0), b3, voffB);
            PG8_BAR; PG8_WAIT_L(0); PG8_MMA(0, 1, At, B1); PG8_BAR;
            PG8_LDA(At, 1, 1); PG8_STAGE(PG8_SA(1, 0), a3, voffA);
            PG8_BAR; PG8_WAIT_L(0); PG8_MMA(1, 0, At, B0); PG8_BAR; PG8_SCHED;
            PG8_STAGE(PG8_SB(1, 1), b3 + hstep, voffB);
            PG8_WAIT_V(6); PG8_BAR; PG8_MMA(1, 1, At, B1); PG8_BAR;
            }
        }
        if constexpr (ALIGN_EPI) { if (wr == 0) PG8_BAR; }
        if constexpr (!Epi::AFTER_DRAIN) { E(acc, cur, wr, wc, fr, fq);
#if PROBE_EPI2
            if constexpr (Epi::PERM) { asm volatile("" ::: "memory"); E(acc, cur, wr, wc, fr, fq); }
#endif
            S.done(cur); }
        if (!has_next) break;
#pragma unroll
        for (int a = 0; a < 2; ++a)
#pragma unroll
            for (int b = 0; b < 2; ++b)
#pragma unroll
                for (int m = 0; m < 4; ++m)
#pragma unroll
                    for (int n = 0; n < 2; ++n) acc[a][b][m][n] = (f32x4){0.f, 0.f, 0.f, 0.f};
        cur = nxt; cA = nA; cB = nB; ++ui;
        if constexpr (ALIGN_EPI) { if (wr == 1) PG8_BAR; }
    }
    PG8_WAIT_V(0);
    if constexpr (!ALIGN_EPI) { if (wr == 0) PG8_BAR; }
    PG8_BAR;
    if constexpr (Epi::AFTER_DRAIN) { E.fused(acc, cur, wr, wc, fr, fq, lds, wid, lane); S.done(cur); }
#undef PG8_SA
#undef PG8_SB
#undef PG8_STAGE
#undef PG8_LDA
#undef PG8_LDB
#undef PG8_MMA
#undef PG8_WAIT_V
#undef PG8_WAIT_L
#undef PG8_BAR
#undef PG8_SCHED
}
}
#define XB_TMO      128
#define XB_XCNT(j)  (256  + 64 * (j))
#define XB_XSUB(j)  (1280 + 64 * (j))
#define XB_XGEN(j)  (2304 + 64 * (j))
#define XB_TOP      3328
#define XB_TOPGEN   3392
#define XCD_BAR_WORDS 3456
#define XB_SPIN_CAP (1u << 18)

__device__ __forceinline__ unsigned xb_ld(unsigned* p)              { return __hip_atomic_load(p, __ATOMIC_RELAXED, __HIP_MEMORY_SCOPE_AGENT); }
__device__ __forceinline__ unsigned xb_add(unsigned* p, unsigned v) { return __hip_atomic_fetch_add(p, v, __ATOMIC_RELAXED, __HIP_MEMORY_SCOPE_AGENT); }
__device__ __forceinline__ unsigned xb_xcc_id() { return (unsigned)__builtin_amdgcn_s_getreg((3 << 11) | 20) & 0xFu; }
#define XB_SPIN(cond, bar) do { unsigned _sp = 0; while (cond) { __builtin_amdgcn_s_sleep(1); \
    if ((++_sp & 255u) == 0u) { if (xb_ld(&(bar)[XB_TMO])) break; if (_sp > XB_SPIN_CAP) { atomicAdd(&(bar)[XB_TMO], 1u); break; } } } } while (0)

struct XcdBarrier {
    unsigned* bar; unsigned x;
    volatile LAS unsigned* st;
};

__device__ __forceinline__ XcdBarrier xcd_barrier_post(unsigned* bar, volatile LAS unsigned* st) {
    XcdBarrier b; b.bar = bar; b.x = xb_xcc_id(); b.st = st;
    if (threadIdx.x == 0) (void)xb_add(&bar[XB_XCNT(b.x)], 1u);
    return b;
}
__device__ __forceinline__ void xcd_barrier_complete(unsigned* bar, unsigned x, unsigned& nloc, unsigned& nx) {
    const unsigned G = gridDim.x * gridDim.y * gridDim.z;
    unsigned sum, cnt, mine, sp = 0u;
    for (;;) {
        sum = 0u; cnt = 0u; mine = 0u;
#pragma unroll
        for (unsigned j = 0; j < 16; ++j) { const unsigned c = xb_ld(&bar[XB_XCNT(j)]); sum += c; cnt += (c > 0u) ? 1u : 0u; mine = (j == x) ? c : mine; }
        if (sum == G) break;
        __builtin_amdgcn_s_sleep(1);
        if ((++sp & 255u) == 0u) { if (xb_ld(&bar[XB_TMO])) break; if (sp > XB_SPIN_CAP) { atomicAdd(&bar[XB_TMO], 1u); break; } }
    }
    nloc = mine > 0u ? mine : 1u; nx = cnt > 0u ? cnt : 1u;
}

__device__ __forceinline__ void xcd_barrier(const XcdBarrier& b) {
    asm volatile("s_waitcnt vmcnt(0)" ::: "memory");
    __syncthreads();
    if (threadIdx.x == 0) {
        unsigned* bar = b.bar;
        __builtin_amdgcn_s_waitcnt(0);
        unsigned nloc = b.st[0], nx = b.st[1];
        if (nloc == 0u) { xcd_barrier_complete(bar, b.x, nloc, nx); b.st[0] = nloc; b.st[1] = nx; }
        const unsigned old = xb_add(&bar[XB_XSUB(b.x)], 1u);
        const unsigned gen = old / nloc;
        if (old + 1u == (gen + 1u) * nloc) {
            __builtin_amdgcn_fence(__ATOMIC_RELEASE, "agent");
            asm volatile("s_waitcnt vmcnt(0)" ::: "memory");
            const unsigned og = xb_add(&bar[XB_TOP], 1u);
            const unsigned tg = og / nx;
            if (og + 1u == (tg + 1u) * nx) xb_add(&bar[XB_TOPGEN], 1u);
            else XB_SPIN(xb_ld(&bar[XB_TOPGEN]) == tg, bar);
            __builtin_amdgcn_fence(__ATOMIC_ACQUIRE, "agent");
            xb_add(&bar[XB_XGEN(b.x)], 1u);
            asm volatile("s_waitcnt vmcnt(0)" ::: "memory");
        } else {
            XB_SPIN(xb_ld(&bar[XB_XGEN(b.x)]) == gen, bar);
            __builtin_amdgcn_fence(__ATOMIC_ACQUIRE, "agent");
            asm volatile("s_waitcnt vmcnt(0)" ::: "memory");
        }
    }
    __syncthreads();
}
struct Args { const float* in[N_IN]; float* out; unsigned char* ws; int ph_lo, ph_hi, pad0, pad1; };
static_assert(sizeof(Args) == (N_IN + 2) * 8 + 16, "Args has no padding");
struct DevArgs { const GAS float* in[N_IN]; GAS float* out; GAS unsigned char* ws; int ph_lo, ph_hi, pad0, pad1; };
static_assert(sizeof(DevArgs) == sizeof(Args), "DevArgs mirrors Args");
typedef const __attribute__((address_space(4))) DevArgs* KArgs;
#define INP(i) ((const float*)F.ka->in[i])
struct Frame {
    LAS unsigned char* lds;
    int tid, lane, wave, vcu, G;
    KArgs ka;
    float* out; unsigned char* ws;
};
__device__ __forceinline__ const float* modp(const Frame& F, int layer) { return (const float*)(F.ws + WS_MOD) + (size_t)layer * 12 * NMOD; }
__device__ __forceinline__ unsigned char* lw(const Frame& F, int layer) { return F.ws + WS_W + (size_t)layer * LW; }

__device__ __forceinline__ void transpose_item(const float* W, int N, bf16* WT, int opitch, int ocol0, int k0, int n0, int orow0, LAS float* scr, int lane) {
#pragma unroll 8
    for (int i = 0; i < 32; ++i) { const int kk = 2 * i + (lane >> 5); scr[kk * 33 + (lane & 31)] = W[(size_t)(k0 + kk) * N + n0 + (lane & 31)]; }
    LDS_WAIT(); asm volatile("" ::: "memory");
    const int c = lane & 7;
#pragma unroll
    for (int j = 0; j < 4; ++j) { const int n = (lane >> 3) + 8 * j; const LAS float* s = scr + (8 * c) * 33 + n;
        v4u o; o.x = pk2(s[0 * 33], s[1 * 33]); o.y = pk2(s[2 * 33], s[3 * 33]); o.z = pk2(s[4 * 33], s[5 * 33]); o.w = pk2(s[6 * 33], s[7 * 33]);
        *(GAS v4u*)(WT + (size_t)(orow0 + n) * opitch + ocol0 + 8 * c) = o; }
    LDS_WAIT(); asm volatile("" ::: "memory");
}
__device__ __forceinline__ void p0a_phase(Frame& F) {
    const int gw = F.vcu * NWAVES + F.wave, NGW = F.G * NWAVES, gt = F.vcu * (NWAVES * 64) + F.tid, NGT = F.G * NWAVES * 64;
    {
        LAS float* sil = (LAS float*)F.lds;
        for (int i = F.tid; i < 12 * DM; i += NWAVES * 64) { const int b = i / DM, k = i % DM;
            const float c = b < NBP ? INP(I_CP)[b * DM + k] : INP(I_CS)[(b - NBP) * DM + k]; sil[k * 12 + b] = siluf_(c); }
        __syncthreads();
        constexpr int KC = DM / KSPLIT, NCB = NMOD / 256;
        float* part = (float*)(F.ws + WS_MODP);
        for (int it = gw; it < NL * KSPLIT * NCB; it += NGW) {
            const int l = it / (KSPLIT * NCB), ks = (it / NCB) % KSPLIT, cb = it % NCB, col = cb * 256 + 4 * F.lane;
            const GAS f32x4* wp = (const GAS f32x4*)(INP(I_ADAW) + ((size_t)l * DM + ks * KC) * NMOD + col);
            f32x4 acc[12];
#pragma unroll
            for (int b = 0; b < 12; ++b) acc[b] = (f32x4){0.f, 0.f, 0.f, 0.f};
#pragma unroll 4
            for (int k = 0; k < KC; ++k) { const f32x4 wv = wp[(size_t)k * (NMOD / 4)];
                const LAS f32x4* sp = (const LAS f32x4*)(sil + (ks * KC + k) * 12); const f32x4 s0 = sp[0], s1 = sp[1], s2 = sp[2];
                acc[0] += wv * s0[0]; acc[1] += wv * s0[1]; acc[2] += wv * s0[2]; acc[3] += wv * s0[3];
                acc[4] += wv * s1[0]; acc[5] += wv * s1[1]; acc[6] += wv * s1[2]; acc[7] += wv * s1[3];
                acc[8] += wv * s2[0]; acc[9] += wv * s2[1]; acc[10] += wv * s2[2]; acc[11] += wv * s2[3]; }
#pragma unroll
            for (int b = 0; b < 12; ++b) *(GAS f32x4*)(part + (((size_t)ks * NL + l) * 12 + b) * NMOD + col) = acc[b];
        }
        __syncthreads();
    }
    {
        LAS float* scr = (LAS float*)(F.lds + F.wave * 16384);
        constexpr int I_IN = (DM / 64) * (DIN / 32), I_OUT = (DM / 64) * (DM / 32), I_G = (DM / 64) * (DFF / 32), I_D = (DFF / 64) * (DM / 32), I_C = (DC / 64) * (DC / 32);
        constexpr int PER_L = I_IN + I_OUT + 2 * I_G + I_D; (void)I_C;
        for (int it = gw; it < NL * PER_L; it += NGW) {
            const int l = it / PER_L; int r = it % PER_L; unsigned char* wl = lw(F, l);
            if (r < I_IN) { const int nblk = DIN / 32, k0 = 64 * (r / nblk), n0 = 32 * (r % nblk);
                int orow0 = n0; if (n0 < 512) orow0 = 256 * (n0 >> 7) + (n0 & 127); else if (n0 < 1024) orow0 = 256 * ((n0 - 512) >> 7) + 128 + (n0 & 127);
                transpose_item(INP(I_WIN) + (size_t)l * DM * DIN, DIN, (bf16*)(wl + LW_WIN), DM, k0, k0, n0, orow0, scr, F.lane); continue; } r -= I_IN;
            if (r < I_OUT) { const int nblk = DM / 32, k0 = 64 * (r / nblk), n0 = 32 * (r % nblk);
                if ((k0 & 512) == 0) { const int which = k0 >> 10;
                    transpose_item(INP(I_WOUT) + (size_t)l * DM * DM, DM, (bf16*)(F.ws + WS_TA) + ((size_t)l * 2 + which) * DM * DC, DC, k0 & 511, k0, n0, n0, scr, F.lane); }
                else transpose_item(INP(I_WOUT) + (size_t)l * DM * DM, DM, (bf16*)(wl + LW_WOUT), DM, k0, k0, n0, n0, scr, F.lane);
                continue; } r -= I_OUT;
            if (r < 2 * I_G) { const int up = r >= I_G; if (up) r -= I_G; const int nblk = DFF / 32, k0 = 64 * (r / nblk), n0 = 32 * (r % nblk);
                const int orow0 = 256 * (n0 >> 7) + 128 * up + (n0 & 127);
                transpose_item(INP(up ? I_WU : I_WG) + (size_t)l * DM * DFF, DFF, (bf16*)(wl + LW_WGU), DM, k0, k0, n0, orow0, scr, F.lane); continue; } r -= 2 * I_G;
            { const int nblk = DM / 32, k0 = 64 * (r / nblk), n0 = 32 * (r % nblk);
                transpose_item(INP(I_WD) + (size_t)l * DFF * DM, DM, (bf16*)(wl + LW_WD), DFF, k0, k0, n0, n0, scr, F.lane); }
        }
        for (int i = gt; i < NL * 2 * DC * DC; i += NGT) { const int l = i / (2 * DC * DC), which = (i / (DC * DC)) & 1, c = (i / DC) % DC, d = i % DC; float v;
            if (which == 0) v = INP(I_CPW)[((size_t)l * DC + c) * DC + d];
            else v = ((c >> 7) == (d >> 7)) ? INP(I_POOLW)[(((size_t)l * 4 + (c >> 7)) * 128 + (c & 127)) * 128 + (d & 127)] * INP(I_POOLS)[l * DC + d] : 0.f;
            ((bf16*)(F.ws + WS_FB))[i] = (bf16)(pk2(v, 0.f) & 0xffffu); }
        for (int i = gt; i < NL * 4 * 128 * 128; i += NGT) { const int l = i / 65536, r = i % 65536, ii = (r >> 7) & 127, jj = r & 127;
            const float v = (jj <= ii) ? INP(I_SGW)[i] : 0.f; ((bf16*)(lw(F, l) + LW_SGW))[r] = (bf16)(pk2(v, 0.f) & 0xffffu); }
    }
    __syncthreads();
}
__device__ __forceinline__ void p0b_phase(Frame& F) {
    const int gt = F.vcu * (NWAVES * 64) + F.tid, NGT = F.G * NWAVES * 64;
    const float* part = (const float*)(F.ws + WS_MODP); float* mod = (float*)(F.ws + WS_MOD);
    for (int i = gt; i < NL * 12 * NMOD; i += NGT) { const int l = i / (12 * NMOD), n = i % NMOD; float s = INP(I_ADAB)[l * NMOD + n];
#pragma unroll
        for (int ks = 0; ks < KSPLIT; ++ks) s += part[(size_t)ks * NL * 12 * NMOD + i];
        mod[i] = s; }
}
template <bool COPY> struct NormRow { f32x4 f[COPY ? 8 : 1]; v2u h[COPY ? 1 : 8]; };
template <bool COPY> __device__ __forceinline__ void norm_load(Frame& F, NormRow<COPY>& R, int m, const bf16* XB) {
    if constexpr (COPY) { const float* src = m < MP ? INP(I_XP) + (size_t)m * DM : INP(I_XS) + (size_t)(m - MP) * DM; const GAS f32x4* xr = (const GAS f32x4*)src + F.lane;
#pragma unroll
        for (int j = 0; j < 8; ++j) R.f[j] = xr[64 * j]; }
    else { const GAS v2u* xr = (const GAS v2u*)(XB + (size_t)m * DM) + F.lane;
#pragma unroll
        for (int j = 0; j < 8; ++j) R.h[j] = xr[64 * j]; }
}
template <bool COPY> __device__ __forceinline__ void norm_row(Frame& F, const NormRow<COPY>& R, int m, const f32x4 (&gv)[8], const f32x4 (&sv)[8], bf16* H, bf16* XB) {
    f32x4 v[8]; float s = 0.f;
    if constexpr (COPY) { GAS v2u* xo = (GAS v2u*)(XB + (size_t)m * DM) + F.lane;
#pragma unroll
        for (int j = 0; j < 8; ++j) { const f32x4 t = R.f[j]; v2u w; w.x = pk2(t.x, t.y); w.y = pk2(t.z, t.w); xo[64 * j] = w; v[j] = (f32x4){bflo(w.x), bfhi(w.x), bflo(w.y), bfhi(w.y)}; } }
    else {
#pragma unroll
        for (int j = 0; j < 8; ++j) { const v2u d = R.h[j]; v[j] = (f32x4){bflo(d.x), bfhi(d.x), bflo(d.y), bfhi(d.y)}; } }
#pragma unroll
    for (int j = 0; j < 8; ++j) s += (v[j].x * v[j].x + v[j].y * v[j].y) + (v[j].z * v[j].z + v[j].w * v[j].w);
    const float rstd = 1.0f / sqrtf(wave_sum(s) * (1.0f / DM) + EPS);
    GAS v2u* o8 = (GAS v2u*)(H + (size_t)m * DM) + F.lane;
#pragma unroll
    for (int j = 0; j < 8; ++j) { const f32x4 y = v[j] * rstd * gv[j] + sv[j]; v2u w; w.x = pk2(y.x, y.y); w.y = pk2(y.z, y.w); o8[64 * j] = w; }
}
template <bool COPY>
__device__ __forceinline__ void norm_phase(Frame& F, const float* gain, const float* mod_l, int sh_idx, bf16* H, bf16* XB) {
    const int gw = F.vcu * NWAVES + F.wave, NGW = F.G * NWAVES;
    const GAS f32x4* gp = (const GAS f32x4*)gain + F.lane;
    for (int b = 0; b < NBT; ++b) {
        const int r_lo = b < NBP ? b * SEQ : MP + (b - NBP) * TS, r_hi = b < NBP ? r_lo + SEQ : r_lo + TS;
        int m = r_lo + (b < NBP ? gw : gw - TS * (b - NBP)); if (m < r_lo || m >= r_hi) continue;
        const float* mb = mod_l + (size_t)b * NMOD;
        const GAS f32x4* shp = (const GAS f32x4*)(mb + sh_idx * DM) + F.lane; const GAS f32x4* scp = (const GAS f32x4*)(mb + (sh_idx + 1) * DM) + F.lane;
        f32x4 gv[8], sv[8];
#pragma unroll
        for (int j = 0; j < 8; ++j) { gv[j] = gp[64 * j] * (scp[64 * j] + 1.0f); sv[j] = shp[64 * j]; }
        NormRow<COPY> cur, nxt; norm_load<COPY>(F, cur, m, XB);
        for (;;) { const int mn = m + NGW; const bool more = mn < r_hi;
            if (more) norm_load<COPY>(F, nxt, mn, XB);
            norm_row<COPY>(F, cur, m, gv, sv, H, XB);
            if (!more) break;
            cur = nxt; m = mn; }
    }
}
__device__ __forceinline__ void final_norm_phase(Frame& F, const bf16* XB) {
    const int gw = F.vcu * NWAVES + F.wave, NGW = F.G * NWAVES;
    for (int m = gw; m < MT; m += NGW) {
        GAS f32x4* yr = (GAS f32x4*)(F.out + (size_t)m * DM) + F.lane;
        const GAS v2u* xr = (const GAS v2u*)(XB + (size_t)m * DM) + F.lane;
        f32x4 v[8]; float s = 0.f;
#pragma unroll
        for (int j = 0; j < 8; ++j) { const v2u d = xr[64 * j]; v[j] = (f32x4){bflo(d.x), bfhi(d.x), bflo(d.y), bfhi(d.y)}; s += (v[j].x * v[j].x + v[j].y * v[j].y) + (v[j].z * v[j].z + v[j].w * v[j].w); }
        const float rstd = 1.0f / sqrtf(wave_sum(s) * (1.0f / DM) + EPS);
        const GAS f32x4* gp = (const GAS f32x4*)INP(I_FING) + F.lane;
#pragma unroll
        for (int j = 0; j < 8; ++j) yr[64 * j] = v[j] * rstd * gp[64 * j];
    }
}

__device__ __forceinline__ int crow(int r, int hi) { return (r & 3) + 8 * (r >> 2) + 4 * hi; }
#define MFMA32(a, b, c) __builtin_amdgcn_mfma_f32_32x32x16_bf16((a), (b), (c), 0, 0, 0)
constexpr int AT_KP = 144, AT_VP = 192, AT_KB = 64 * AT_KP, AT_VB = 64 * AT_VP;
constexpr int AT_K0 = 0, AT_V0 = 2 * AT_KB, AT_BT = AT_V0 + 2 * AT_VB;
typedef short v4i16_t __attribute__((ext_vector_type(4)));
__device__ __forceinline__ v2u lds_tr_read(LAS unsigned char* p) { const v4i16_t r = __builtin_amdgcn_ds_read_tr16_b64_v4i16((LAS v4i16_t*)p); return __builtin_bit_cast(v2u, r); }
__device__ __forceinline__ float xhalf_max(float v) { auto rr = __builtin_amdgcn_permlane32_swap(__float_as_uint(v), __float_as_uint(v), false, false); return fmaxf(__uint_as_float(rr[0]), __uint_as_float(rr[1])); }
__device__ __forceinline__ float xhalf_sum(float v) { auto rr = __builtin_amdgcn_permlane32_swap(__float_as_uint(v), __float_as_uint(v), false, false); return __uint_as_float(rr[0]) + __uint_as_float(rr[1]); }
__device__ __forceinline__ void attn_unit(Frame& F, int layer, bool sample, int b, int h, int qg, const bf16* Z, bf16* MIX) {
    const int tid = F.tid, lane = F.lane, w = F.wave, l31 = lane & 31, hh = lane >> 5;
    LAS float* bt = (LAS float*)(F.lds + AT_BT);
    if (tid < 257) bt[tid] = INP(I_RELB)[((size_t)layer * 8 + h) * 257 + tid] * LOG2E;
    const bool wave_on = sample ? (w == 0) : true;
    const int qpos = sample ? l31 : 256 * qg + 32 * w + l31;
    const int qrow = sample ? MP + 32 * b + l31 : b * SEQ + qpos;
    bf16x8 qr[4];
#pragma unroll
    for (int d0 = 0; d0 < 4; ++d0) qr[d0] = *(const GAS bf16x8*)(Z + (size_t)qrow * ZW + ZQ + 64 * h + 16 * d0 + 8 * hh);
    f32x16 o0, o1;
#pragma unroll
    for (int r = 0; r < 16; ++r) { o0[r] = 0.f; o1[r] = 0.f; }
    float mrun = -1e30f, lrun = 0.f;
    const int ntile = sample ? 9 : 12, qc = 4 * qg + (w >> 1);
    const int jstart = sample ? 0 : (4 * qg >= 8 ? 0 : 8 - 4 * qg);
    const int sr = tid >> 3, sch = tid & 7;
    const float* ck = INP(I_CK) + ((size_t)layer * NBS + b) * 512 * 512; const float* cv = INP(I_CV) + ((size_t)layer * NBS + b) * 512 * 512;
    v4u kreg = (v4u){0u, 0u, 0u, 0u}, vreg = (v4u){0u, 0u, 0u, 0u};
#define AT_LOAD(j) do { \
        if (!sample) { const bf16* zr_ = Z + (size_t)(b * SEQ + 64 * (4 * qg - 8 + (j)) + sr) * ZW + 64 * h + 8 * sch; kreg = *(const GAS v4u*)(zr_ + ZK); vreg = *(const GAS v4u*)(zr_ + ZV); } \
        else if ((j) < 8) { const size_t o_ = ((size_t)(64 * (j) + sr) * 8 + h) * 64 + 8 * sch; \
                const f32x4 k0_ = *(const GAS f32x4*)(ck + o_), k1_ = *(const GAS f32x4*)(ck + o_ + 4), v0_ = *(const GAS f32x4*)(cv + o_), v1_ = *(const GAS f32x4*)(cv + o_ + 4); \
                kreg = (v4u){pk2(k0_.x, k0_.y), pk2(k0_.z, k0_.w), pk2(k1_.x, k1_.y), pk2(k1_.z, k1_.w)}; vreg = (v4u){pk2(v0_.x, v0_.y), pk2(v0_.z, v0_.w), pk2(v1_.x, v1_.y), pk2(v1_.z, v1_.w)}; } \
        else if (sr < 32) { const bf16* zr_ = Z + (size_t)(MP + 32 * b + sr) * ZW + 64 * h + 8 * sch; kreg = *(const GAS v4u*)(zr_ + ZK); vreg = *(const GAS v4u*)(zr_ + ZV); } \
        else { kreg = (v4u){0u, 0u, 0u, 0u}; vreg = (v4u){0u, 0u, 0u, 0u}; } } while (0)
#define AT_STORE(bf_) do { *(LAS v4u*)(F.lds + AT_K0 + (bf_) * AT_KB + sr * AT_KP + sch * 16) = kreg; *(LAS v4u*)(F.lds + AT_V0 + (bf_) * AT_VB + sr * AT_VP + sch * 16) = vreg; } while (0)
    AT_LOAD(jstart); AT_STORE(0);
    __syncthreads();
    const int tro = ((lane & 15) >> 2) * AT_VP + (16 * ((lane >> 4) & 1) + 4 * (lane & 3)) * 2 + 4 * hh * AT_VP;
    int buf = 0;
    for (int j = jstart; j < ntile; ++j) {
        const int kc = 4 * qg - 8 + j;
        const bool more = j + 1 < ntile;
        if (more) AT_LOAD(j + 1);
        const bool active = sample ? (w == 0) : (kc >= qc - 8 && kc <= qc);
        if (active) {
            LAS unsigned char* Ks = F.lds + AT_K0 + buf * AT_KB; LAS unsigned char* Vs = F.lds + AT_V0 + buf * AT_VB + tro;
            f32x16 p0, p1;
#pragma unroll
            for (int r = 0; r < 16; ++r) { p0[r] = 0.f; p1[r] = 0.f; }
#pragma unroll
            for (int d0 = 0; d0 < 4; ++d0) {
                const bf16x8 a0 = *(const LAS bf16x8*)(Ks + l31 * AT_KP + (16 * d0 + 8 * hh) * 2);
                const bf16x8 a1 = *(const LAS bf16x8*)(Ks + (32 + l31) * AT_KP + (16 * d0 + 8 * hh) * 2);
                p0 = MFMA32(a0, qr[d0], p0); p1 = MFMA32(a1, qr[d0], p1);
            }
            const int kbase = sample ? 64 * j - 512 : 64 * kc;
            const int relb = kbase - qpos;
            const int qmin = sample ? 0 : 256 * qg + 32 * w;
            float boff = 0.f;
            if (kbase + 63 - qmin <= -128) boff = bt[0];
            else {
#pragma unroll
                for (int r = 0; r < 16; ++r) { const int kv = crow(r, hh); int i0 = relb + kv, i1 = i0 + 32;
                    i0 = (i0 < -128 ? -128 : (i0 > 128 ? 128 : i0)) + 128; i1 = (i1 < -128 ? -128 : (i1 > 128 ? 128 : i1)) + 128;
                    p0[r] += bt[i0]; p1[r] += bt[i1]; }
            }
            if (sample && j == 8) {
#pragma unroll
                for (int r = 0; r < 16; ++r) p1[r] = -1e30f;
            }
            float mx = p0[0];
#pragma unroll
            for (int r = 1; r < 16; ++r) mx = fmaxf(mx, p0[r]);
#pragma unroll
            for (int r = 0; r < 16; ++r) mx = fmaxf(mx, p1[r]);
            mx = xhalf_max(mx) + boff;
            const float mn = fmaxf(mrun, mx), msub = mn - boff;
            if (__builtin_amdgcn_ballot_w64(mn > mrun) != 0ull) {
                const float alpha = fast_exp2(mrun - mn); lrun *= alpha;
#pragma unroll
                for (int r = 0; r < 16; ++r) { o0[r] *= alpha; o1[r] *= alpha; }
            }
            mrun = mn;
            float rs = 0.f;
#pragma unroll
            for (int r = 0; r < 16; ++r) { p0[r] = fast_exp2(p0[r] - msub); p1[r] = fast_exp2(p1[r] - msub); rs += p0[r] + p1[r]; }
            lrun += xhalf_sum(rs);
            bf16x8 pf[4];
            { v4u t;
              t = (v4u){pk2(p0[0], p0[1]), pk2(p0[2], p0[3]), pk2(p0[4], p0[5]), pk2(p0[6], p0[7])}; pf[0] = __builtin_bit_cast(bf16x8, t);
              t = (v4u){pk2(p0[8], p0[9]), pk2(p0[10], p0[11]), pk2(p0[12], p0[13]), pk2(p0[14], p0[15])}; pf[1] = __builtin_bit_cast(bf16x8, t);
              t = (v4u){pk2(p1[0], p1[1]), pk2(p1[2], p1[3]), pk2(p1[4], p1[5]), pk2(p1[6], p1[7])}; pf[2] = __builtin_bit_cast(bf16x8, t);
              t = (v4u){pk2(p1[8], p1[9]), pk2(p1[10], p1[11]), pk2(p1[12], p1[13]), pk2(p1[14], p1[15])}; pf[3] = __builtin_bit_cast(bf16x8, t); }
#pragma unroll
            for (int xt = 0; xt < 2; ++xt)
#pragma unroll
                for (int s = 0; s < 2; ++s) { const int ro = (32 * xt + 16 * s) * AT_VP;
                    const v2u lo0 = lds_tr_read(Vs + ro), hi0 = lds_tr_read(Vs + ro + 8 * AT_VP);
                    const v2u lo1 = lds_tr_read(Vs + ro + 64), hi1 = lds_tr_read(Vs + ro + 8 * AT_VP + 64);
                    const v4u f0 = (v4u){lo0.x, lo0.y, hi0.x, hi0.y}, f1 = (v4u){lo1.x, lo1.y, hi1.x, hi1.y};
                    o0 = MFMA32(__builtin_bit_cast(bf16x8, f0), pf[2 * xt + s], o0); o1 = MFMA32(__builtin_bit_cast(bf16x8, f1), pf[2 * xt + s], o1); }
        }
        if (more) AT_STORE(buf ^ 1);
        __syncthreads();
        buf ^= 1;
    }
#undef AT_LOAD
#undef AT_STORE
    if (wave_on) {
        const float inv = 1.0f / lrun;
        bf16* orow = MIX + (size_t)qrow * MIXW + MIX_B + 64 * h;
#pragma unroll
        for (int g4 = 0; g4 < 4; ++g4) { const int d = 8 * g4 + 4 * hh;
            v2u w0; w0.x = pk2(o0[4 * g4] * inv, o0[4 * g4 + 1] * inv); w0.y = pk2(o0[4 * g4 + 2] * inv, o0[4 * g4 + 3] * inv); *(GAS v2u*)(orow + d) = w0;
            v2u w1; w1.x = pk2(o1[4 * g4] * inv, o1[4 * g4 + 1] * inv); w1.y = pk2(o1[4 * g4 + 2] * inv, o1[4 * g4 + 3] * inv); *(GAS v2u*)(orow + 32 + d) = w1; }
    }
}
__device__ __forceinline__ unsigned sg_off(unsigned row, unsigned ch) { return 256u * row + 16u * (ch ^ (((row & 3u) << 2) | ((row >> 2) & 3u))); }
__device__ __forceinline__ void sg_unit(Frame& F, int layer, int ci, const bf16* Z, bf16* MIX) {
    const int lane = F.lane, w = F.wave, l31 = lane & 31, hh = lane >> 5;
    const bool sample = ci >= MP / 128; const int L = sample ? 32 : 128, row0 = sample ? MP + 32 * (ci - MP / 128) : 128 * ci;
    LAS unsigned char* VN = F.lds;
    {
        const int c8 = 8 * lane;
        const GAS f32x4* lgp = (const GAS f32x4*)(INP(I_SGG) + layer * DC + c8); const GAS f32x4* lbp = (const GAS f32x4*)(INP(I_SGB) + layer * DC + c8);
        const f32x4 lg0 = lgp[0], lg1 = lgp[1], lb0 = lbp[0], lb1 = lbp[1];
        const int nrw = L / 8;
        LAS unsigned char* vbase = VN + (lane >> 4) * 32768;
        v4u zrow[16];
#pragma unroll
        for (int i = 0; i < 16; ++i) { if (i < nrw) zrow[i] = *(const GAS v4u*)(Z + (size_t)(row0 + w * nrw + i) * ZW + ZSV + c8); else zrow[i] = (v4u){0u, 0u, 0u, 0u}; }
#pragma unroll
        for (int i = 0; i < 16; ++i) { if (i < nrw) { const int rr = w * nrw + i;
            const v4u zv = zrow[i];
            float x[8] = {bflo(zv.x), bfhi(zv.x), bflo(zv.y), bfhi(zv.y), bflo(zv.z), bfhi(zv.z), bflo(zv.w), bfhi(zv.w)};
            const float s = ((x[0] + x[1]) + (x[2] + x[3])) + ((x[4] + x[5]) + (x[6] + x[7]));
            const float mean = wave_sum(s) * (1.0f / DC); float q = 0.f;
#pragma unroll
            for (int e = 0; e < 8; ++e) { x[e] -= mean; q += x[e] * x[e]; }
            const float rstd = 1.0f / sqrtf(wave_sum(q) * (1.0f / DC) + EPS);
            float y[8];
            y[0] = x[0] * rstd * lg0.x + lb0.x; y[1] = x[1] * rstd * lg0.y + lb0.y; y[2] = x[2] * rstd * lg0.z + lb0.z; y[3] = x[3] * rstd * lg0.w + lb0.w;
            y[4] = x[4] * rstd * lg1.x + lb1.x; y[5] = x[5] * rstd * lg1.y + lb1.y; y[6] = x[6] * rstd * lg1.z + lb1.z; y[7] = x[7] * rstd * lg1.w + lb1.w;
            *(LAS v4u*)(vbase + sg_off((unsigned)rr, (unsigned)(lane & 15))) = (v4u){pk2(y[0], y[1]), pk2(y[2], y[3]), pk2(y[4], y[5]), pk2(y[6], y[7])};
            if (sample) { float* so = F.out + O_SGV + (((size_t)layer * NBS + (ci - MP / 128)) * TS + rr) * DC + c8;
                *(GAS f32x4*)so = (f32x4){y[0], y[1], y[2], y[3]}; *(GAS f32x4*)(so + 4) = (f32x4){y[4], y[5], y[6], y[7]}; }
        } }
    }
    __syncthreads();
    {
        const int g = w >> 1;
        const GAS bf16* Wg = (const GAS bf16*)((const bf16*)(lw(F, layer) + LW_SGW) + (size_t)g * 128 * 128 + (size_t)l31 * 128 + 8 * hh); asm volatile("" : "+v"(Wg));
        LAS unsigned char* vg = VN + g * 32768;
        const int nib = L / 32;
        const unsigned blk = (lane >> 4) & 1, q = (lane & 15) >> 2, p4 = lane & 3;
        bf16x8 Bf[4][8];
#pragma unroll
        for (int ib = 0; ib < 4; ++ib)
#pragma unroll
            for (int s = 0; s < 8; ++s) { if (s < 2 * (ib + 1)) { if (ib < nib) Bf[ib][s] = *(const GAS bf16x8*)(Wg + (32 * ib) * 128 + 16 * s); else Bf[ib][s] = (bf16x8){0, 0, 0, 0, 0, 0, 0, 0}; } }
#pragma unroll
        for (int cbb = 0; cbb < 2; ++cbb) { const int cb = 2 * (w & 1) + cbb;
            f32x16 acc[4];
#pragma unroll
            for (int ib = 0; ib < 4; ++ib)
#pragma unroll
                for (int r = 0; r < 16; ++r) acc[ib][r] = 0.f;
#pragma unroll
            for (int s = 0; s < 8; ++s) { if (s < 2 * nib) {
                const v2u a0 = lds_tr_read(vg + sg_off(16u * s + 8u * hh + q, 4u * cb + 2u * blk + (p4 >> 1)) + 8u * (p4 & 1));
                const v2u a1 = lds_tr_read(vg + sg_off(16u * s + 8u * hh + 4u + q, 4u * cb + 2u * blk + (p4 >> 1)) + 8u * (p4 & 1));
                const v4u af = (v4u){a0.x, a0.y, a1.x, a1.y};
#pragma unroll
                for (int ib = 0; ib < 4; ++ib) { if (s < 2 * (ib + 1)) { if (ib < nib) acc[ib] = MFMA32(__builtin_bit_cast(bf16x8, af), Bf[ib][s], acc[ib]); } }
            } }
#pragma unroll
            for (int ib = 0; ib < 4; ++ib) { if (ib < nib) {
                    const int i = 32 * ib + l31, row = row0 + i; const float bias = INP(I_SGBIAS)[((size_t)layer * 4 + g) * 128 + i];
#pragma unroll
                    for (int rg = 0; rg < 4; ++rg) { const int c4 = 32 * cb + 8 * rg + 4 * hh;
                        const v2u zu = *(const GAS v2u*)(Z + (size_t)row * ZW + ZSU + 128 * g + c4);
                        v2u o; o.x = pk2(bflo(zu.x) * (acc[ib][4 * rg] + bias), bfhi(zu.x) * (acc[ib][4 * rg + 1] + bias)); o.y = pk2(bflo(zu.y) * (acc[ib][4 * rg + 2] + bias), bfhi(zu.y) * (acc[ib][4 * rg + 3] + bias));
                        *(GAS v2u*)(MIX + (size_t)row * MIXW + MIX_D + 128 * g + c4) = o; } } }
        }
    }
    __syncthreads();
}
struct ConvCtx { const GAS unsigned char* zb; const GAS unsigned char* hist; GAS unsigned char* cst; bool sample, first, keep; };
template <int E> __device__ __forceinline__ void conv_load(unsigned (&ex)[62], const ConvCtx& X) {
    if constexpr (E < 30) { if (X.sample) { const f32x2 hv = *(const GAS f32x2*)(X.hist + (size_t)E * DC * 4); ex[E] = pk2(hv.x, hv.y); }
                            else if (X.first) ex[E] = 0u;
                            else ex[E] = *(const GAS unsigned*)(X.zb + (size_t)E * ZW * 2); }
    else ex[E] = *(const GAS unsigned*)(X.zb + (size_t)E * ZW * 2);
}
template <int... Es> __device__ __forceinline__ void conv_loads(unsigned (&ex)[62], const ConvCtx& X, std::integer_sequence<int, Es...>) { (conv_load<Es>(ex, X), ...); }
template <int E> __device__ __forceinline__ void conv_row(f32x2 (&acc)[32], const f32x2 (&wt)[31], const unsigned (&ex)[62], const ConvCtx& X) {
    const f32x2 v = (f32x2){bflo(ex[E]), bfhi(ex[E])};
    constexpr int T0 = E > 30 ? E - 30 : 0, T1 = E < 31 ? E : 31;
#pragma unroll
    for (int t = T0; t <= T1; ++t) acc[t] = wt[E - t] * v + acc[t];
    if constexpr (E >= 32) { if (X.keep) *(GAS f32x2*)(X.cst + (size_t)(E - 32) * DC * 4) = v; }
}
template <int... Es> __device__ __forceinline__ void conv_rows(f32x2 (&acc)[32], const f32x2 (&wt)[31], const unsigned (&ex)[62], const ConvCtx& X, std::integer_sequence<int, Es...>) { (conv_row<Es>(acc, wt, ex, X), ...); }
__device__ __forceinline__ void conv_unit(Frame& F, int layer, int tb, int cq, const bf16* Z, bf16* CA, int ca_pitch) {
    const int c = 128 * cq + 2 * F.lane; const bool sample = tb >= MP / 32; const int sb = tb - MP / 32;
    const int r0 = sample ? MP + 32 * sb : 32 * tb; const bool first = !sample && ((r0 & (SEQ - 1)) == 0);
    ConvCtx X; X.sample = sample; X.first = first; X.keep = sample || ((r0 & (SEQ - 1)) == SEQ - 32);
    X.zb = (const GAS unsigned char*)(Z + ((long)r0 - 30) * ZW + ZU + c); asm volatile("" : "+v"(X.zb));
    const GAS unsigned char* wb = (const GAS unsigned char*)(INP(I_CONVW) + (size_t)layer * 31 * DC + c); asm volatile("" : "+v"(wb));
    f32x2 wt[31];
#pragma unroll
    for (int j = 0; j < 31; ++j) wt[j] = *(const GAS f32x2*)(wb + (size_t)j * DC * 4);
    const f32x2 cbias = *(const GAS f32x2*)(INP(I_CONVB) + layer * DC + c), gg = *(const GAS f32x2*)(INP(I_GNG) + layer * DC + c), gb = *(const GAS f32x2*)(INP(I_GNB) + layer * DC + c);
    f32x2 acc[32];
#pragma unroll
    for (int t = 0; t < 32; ++t) acc[t] = cbias;
    X.hist = (const GAS unsigned char*)(INP(I_CCONV) + ((size_t)layer * NBS + (sample ? sb : 0)) * 30 * DC + c); asm volatile("" : "+v"(X.hist));
    X.cst = (GAS unsigned char*)(sample ? F.out + O_CONVS + ((size_t)layer * NBS + sb) * 30 * DC + c : F.out + O_CONVP + ((size_t)layer * NBP + (r0 >> 13)) * 30 * DC + c); asm volatile("" : "+v"(X.cst));
    GAS unsigned char* cab = (GAS unsigned char*)(CA + (size_t)r0 * ca_pitch + c); asm volatile("" : "+v"(cab));
    unsigned ex[62];
    conv_loads(ex, X, std::make_integer_sequence<int, 62>{});
    conv_rows(acc, wt, ex, X, std::make_integer_sequence<int, 62>{});
#pragma unroll
    for (int t = 0; t < 32; ++t) {
        const f32x2 y = acc[t];
        const float s = half32_sum(y.x + y.y), q = half32_sum(y.x * y.x + y.y * y.y);
        const float mean = s * (1.0f / 64.0f), var = fmaxf(q * (1.0f / 64.0f) - mean * mean, 0.f), rstd = 1.0f / sqrtf(var + EPS);
        const f32x2 n = (y - mean) * rstd * gg + gb;
        *(GAS unsigned*)(cab + (size_t)t * ca_pitch * 2) = pk2(siluf_(n.x), siluf_(n.y));
    }
}
template <int W>
__device__ __forceinline__ void pool_body(Frame& F, int layer, int tb, int cq, const bf16* Z, bf16* PM, int pm_pitch) {
    const int c = 128 * cq + 2 * F.lane; const bool sample = tb >= MP / 32; const int sb = tb - MP / 32;
    const int r0 = sample ? MP + 32 * sb : 32 * tb; const bool first = !sample && ((r0 & (SEQ - 1)) == 0);
    const GAS unsigned char* hist = (const GAS unsigned char*)(INP(I_CPOOL) + ((size_t)layer * NBS + (sample ? sb : 0)) * 15 * DC + c); asm volatile("" : "+v"(hist));
    const bool last_blk = !sample && ((r0 & (SEQ - 1)) == SEQ - 32);
    GAS unsigned char* pst = (GAS unsigned char*)(sample ? F.out + O_POOLS + ((size_t)layer * NBS + sb) * 15 * DC + c : F.out + O_POOLP + ((size_t)layer * NBP + (r0 >> 13)) * 15 * DC + c); asm volatile("" : "+v"(pst));
    const GAS unsigned char* zb = (const GAS unsigned char*)(Z + ((long)r0 - 15) * ZW + ZP + c); asm volatile("" : "+v"(zb));
    GAS unsigned char* pmb = (GAS unsigned char*)(PM + (size_t)r0 * pm_pitch + c); asm volatile("" : "+v"(pmb));
    f32x2 ext[47];
#pragma unroll
    for (int e = 0; e < 47; ++e) {
        if (e < 15) { if (sample) ext[e] = *(const GAS f32x2*)(hist + (size_t)e * DC * 4);
                      else if (first) ext[e] = (f32x2){0.f, 0.f};
                      else { const unsigned u = *(const GAS unsigned*)(zb + (size_t)e * ZW * 2); ext[e] = (f32x2){bflo(u), bfhi(u)}; } }
        else { const unsigned u = *(const GAS unsigned*)(zb + (size_t)e * ZW * 2); ext[e] = (f32x2){bflo(u), bfhi(u)}; }
    }
#pragma unroll
    for (int t = 0; t < 32; ++t) {
        f32x2 win = (f32x2){0.f, 0.f};
#pragma unroll
        for (int i = W - 1; i >= 0; --i) win += ext[15 + t - i];
        const float rc = 1.0f / (float)((first && t + 1 < W) ? t + 1 : W);
        const f32x2 m = win * rc - ext[15 + t];
        *(GAS unsigned*)(pmb + (size_t)t * pm_pitch * 2) = pk2(m.x, m.y);
        if (t >= 17 && (sample || last_blk)) *(GAS f32x2*)(pst + (size_t)(t - 17) * DC * 4) = ext[15 + t];
    }
}
#define MIX_FENCE() do { int t_ = F.tid; asm volatile("" : "+v"(t_)); F.tid = t_; F.lane = t_ & 63; } while (0)
__device__ __forceinline__ void mixer_phase(Frame& F, int layer) {
    const bf16* Z = (const bf16*)(F.ws + WS_Z); bf16* MIX = (bf16*)(F.ws + WS_MIX); bf16* CA = MIX + MIX_A; bf16* PM = MIX + MIX_C;
#ifndef PROBE_MIX
#define PROBE_MIX 0
#endif
#define MDUP(k) _Pragma("unroll") for (int mrep_ = 0; mrep_ < 1 + ((PROBE_MIX >> (k)) & 1); ++mrep_)
    MDUP(0) { for (int id = F.vcu; id < NBP * 8 * 32; id += F.G) attn_unit(F, layer, false, id >> 8, (id >> 5) & 7, id & 31, Z, MIX);
    for (int id = F.vcu - 192; id >= 0 && id < NBS * 8; id += F.G) attn_unit(F, layer, true, id >> 3, id & 7, 0, Z, MIX); }
    MIX_FENCE();
    MDUP(1) { for (int id = F.vcu; id < MP / 128; id += F.G) sg_unit(F, layer, id, Z, MIX);
    for (int id = F.vcu - 96; id >= 0 && id < NBS; id += F.G) sg_unit(F, layer, MP / 128 + id, Z, MIX); }
    const int gw = F.vcu * NWAVES + F.wave, NGW = F.G * NWAVES;
    MIX_FENCE();
    MDUP(2) { for (int id = gw; id < (MP / 32) * 4; id += NGW) conv_unit(F, layer, id >> 2, id & 3, Z, CA, MIXW);
    if (F.wave == 0 && F.vcu >= 128 && F.vcu < 160) { const int id = (MP / 32) * 4 + F.vcu - 128; conv_unit(F, layer, id >> 2, id & 3, Z, CA, MIXW); } }
    MIX_FENCE();
    MDUP(3) for (int it = 0; it < 3; ++it) { int id = gw + it * NGW;
        if (it == 2) { if (F.wave == 0 && F.vcu >= 160 && F.vcu < 192) id = (MP / 32) * 4 + F.vcu - 160; else break; }
        const int tb = id >> 2, cq = id & 3;
        switch (cq) { case 0: pool_body<2>(F, layer, tb, cq, Z, PM, MIXW); break; case 1: pool_body<4>(F, layer, tb, cq, Z, PM, MIXW); break;
                      case 2: pool_body<8>(F, layer, tb, cq, Z, PM, MIXW); break; default: pool_body<16>(F, layer, tb, cq, Z, PM, MIXW); break; } }
    MIX_FENCE();
    const int gt = F.vcu * (NWAVES * 64) + F.tid, NGT = F.G * NWAVES * 64;
    for (int i = gt; i < (NBP * 512 + NBS * TS) * 128; i += NGT) {
        const int rr = i >> 7, kv = (i >> 6) & 1, ch = i & 63;
        int zrow; size_t o;
        if (rr < NBP * 512) { const int b = rr >> 9, t = rr & 511; zrow = b * SEQ + SEQ - 512 + t; o = (kv ? O_VP : O_KP) + (((size_t)layer * NBP + b) * 512 + t) * 512 + 8 * ch; }
        else { const int r2 = rr - NBP * 512, b = r2 >> 5, t = r2 & 31; zrow = MP + r2; o = (kv ? O_VS : O_KS) + (((size_t)layer * NBS + b) * TS + t) * 512 + 8 * ch; }
        const v4u z = *(const GAS v4u*)(Z + (size_t)zrow * ZW + (kv ? ZV : ZK) + 8 * ch);
        *(GAS f32x4*)(F.out + o) = (f32x4){bflo(z.x), bfhi(z.x), bflo(z.y), bfhi(z.y)}; *(GAS f32x4*)(F.out + o + 4) = (f32x4){bflo(z.z), bfhi(z.z), bflo(z.w), bfhi(z.w)};
    }
}

enum { SK_Z = 0, SK_MIX2 = 1, SK_RES = 2, SK_SWI = 3 };
struct SkUnit { int row0, nb0, nb1, ocol0, ocol1; bool pair; float scale; };
template <int KIND, int NTB, int U>
__device__ __forceinline__ void sk_unit(Frame& F, const bf16* A, const bf16* Bt, int K, const SkUnit& u, bf16* obf, int opitch, float* X, const float* gate) {
    const int lane = F.lane, w = F.wave, l31 = lane & 31, hh = lane >> 5;
    const int kw = K >> 3, nch = kw >> 6;
    constexpr int NR = 32 * NTB + 64, NLD = NR / 8;
    LAS unsigned char* stg = F.lds + w * 16384;
    const int lr = lane >> 3, lc = lane & 7;
    const GAS unsigned char* src[NLD];
#pragma unroll
    for (int i = 0; i < NLD; ++i) { const int r = 8 * i + lr;
        const bf16* base = (r < 32 * NTB) ? A + (size_t)(u.row0 + r) * K : (r < 32 * NTB + 32) ? Bt + (size_t)(u.nb0 + r - 32 * NTB) * K : Bt + (size_t)(u.nb1 + r - 32 * NTB - 32) * K;
        src[i] = (const GAS unsigned char*)(base + w * kw + 8 * lc); }
    f32x16 acc[NTB][2];
#pragma unroll
    for (int tb = 0; tb < NTB; ++tb)
#pragma unroll
        for (int c = 0; c < 2; ++c)
#pragma unroll
            for (int r = 0; r < 16; ++r) acc[tb][c][r] = 0.f;
    v4u R[NLD];
#pragma unroll
    for (int i = 0; i < NLD; ++i) R[i] = *(const GAS v4u*)(src[i]);
    for (int ch = 0; ch < nch; ++ch) {
#pragma unroll
        for (int i = 0; i < NLD; ++i) { const int r = 8 * i + lr; *(LAS v4u*)(stg + r * 128 + 16 * (lc ^ (r & 7))) = R[i]; }
        if (ch + 1 < nch) {
#pragma unroll
            for (int i = 0; i < NLD; ++i) R[i] = *(const GAS v4u*)(src[i] + (size_t)(ch + 1) * 128); }
#pragma unroll
        for (int s = 0; s < 4; ++s) { const int cx = 16 * ((2 * s + hh) ^ (l31 & 7));
            bf16x8 xf[NTB];
#pragma unroll
            for (int tb = 0; tb < NTB; ++tb) xf[tb] = *(const LAS bf16x8*)(stg + (32 * tb + l31) * 128 + cx);
            const bf16x8 w0 = *(const LAS bf16x8*)(stg + (32 * NTB + l31) * 128 + cx), w1 = *(const LAS bf16x8*)(stg + (32 * NTB + 32 + l31) * 128 + cx);
#pragma unroll
            for (int tb = 0; tb < NTB; ++tb) { acc[tb][0] = MFMA32(w0, xf[tb], acc[tb][0]); acc[tb][1] = MFMA32(w1, xf[tb], acc[tb][1]); }
        }
    }
    __syncthreads();
    LAS f32x4* red = (LAS f32x4*)F.lds;
#pragma unroll
    for (int tb = 0; tb < NTB; ++tb)
#pragma unroll
        for (int c = 0; c < 2; ++c)
#pragma unroll
            for (int rg = 0; rg < 4; ++rg) red[((((w * NTB + tb) * 2 + c) * 4 + rg) << 6) + lane] = (f32x4){acc[tb][c][4 * rg], acc[tb][c][4 * rg + 1], acc[tb][c][4 * rg + 2], acc[tb][c][4 * rg + 3]};
    __syncthreads();
    {
        const int rg = w & 3, tb = (NTB == 2) ? (w >> 2) : 0, c_lo = (NTB == 2) ? 0 : (w >> 2), c_hi = (NTB == 2) ? 2 : (w >> 2) + 1;
        f32x4 v[2] = {(f32x4){0.f, 0.f, 0.f, 0.f}, (f32x4){0.f, 0.f, 0.f, 0.f}};
#pragma unroll
        for (int c = 0; c < 2; ++c) { if (c >= c_lo && c < c_hi) {
#pragma unroll
                for (int w2 = 0; w2 < 8; ++w2) v[c] += red[((((w2 * NTB + tb) * 2 + c) * 4 + rg) << 6) + lane]; } }
        const int row = u.row0 + 32 * tb + l31, co = 8 * rg + 4 * hh;
        if (KIND == SK_Z) {
            if (u.pair) { v2u o; o.x = pk2(v[0][0] * sigmoidf_(v[1][0]), v[0][1] * sigmoidf_(v[1][1])); o.y = pk2(v[0][2] * sigmoidf_(v[1][2]), v[0][3] * sigmoidf_(v[1][3]));
                *(GAS v2u*)(obf + (size_t)row * opitch + u.ocol0 + co) = o; }
            else {
#pragma unroll
                for (int c = 0; c < 2; ++c) { const f32x4 y = v[c] * u.scale; v2u o; o.x = pk2(y[0], y[1]); o.y = pk2(y[2], y[3]); *(GAS v2u*)(obf + (size_t)row * opitch + (c ? u.ocol1 : u.ocol0) + co) = o; } }
        } else if (KIND == SK_MIX2) {
#pragma unroll
            for (int c = 0; c < 2; ++c) { v2u o; o.x = pk2(v[c][0], v[c][1]); o.y = pk2(v[c][2], v[c][3]); *(GAS v2u*)(obf + (size_t)row * opitch + (c ? u.ocol1 : u.ocol0) + co) = o; }
        } else if (KIND == SK_SWI) {
            v2u o; o.x = pk2(siluf_(v[0][0]) * v[1][0], siluf_(v[0][1]) * v[1][1]); o.y = pk2(siluf_(v[0][2]) * v[1][2], siluf_(v[0][3]) * v[1][3]);
            *(GAS v2u*)(obf + (size_t)row * opitch + u.ocol0 + co) = o;
        } else {
            const int c = w >> 2, col = (c ? u.ocol1 : u.ocol0) + co;
            const f32x4 g = *(const GAS f32x4*)(gate + (size_t)batch_of_row(row) * NMOD + col); GAS v2u* xp = (GAS v2u*)(obf + (size_t)row * opitch + col); const v2u xo = *xp;
            const f32x4 y = g * v[c] + (f32x4){bflo(xo.x), bfhi(xo.x), bflo(xo.y), bfhi(xo.y)};
            v2u o; o.x = pk2(y[0], y[1]); o.y = pk2(y[2], y[3]); *xp = o;
        }
    }
    __syncthreads();
}
constexpr int NPL = 7, N_PHASES = 2 + NPL * NL + 1;

__global__ void __launch_bounds__(NWAVES * 64, 2) enc_fwd(Args args) {
    extern __shared__ __attribute__((aligned(16))) unsigned char lds[];
    Frame F;
    F.lds = (LAS unsigned char*)lds;
    F.tid = threadIdx.x; F.lane = F.tid & 63; F.wave = __builtin_amdgcn_readfirstlane(F.tid >> 6);
    F.G = gridDim.x; { const int bx = blockIdx.x; F.vcu = (F.G % 8 == 0) ? (bx % 8) * (F.G / 8) + bx / 8 : bx; }
    F.ka = (KArgs)__builtin_amdgcn_kernarg_segment_ptr();
    F.out = args.out; F.ws = args.ws;
    volatile LAS unsigned* MISC = (volatile LAS unsigned*)(F.lds + MISC_OFF);
    for (int u = F.tid; u < (LDS_BYTES - LDSCTL_OFF) / 4; u += NWAVES * 64) ((LAS unsigned*)(F.lds + LDSCTL_OFF))[u] = 0u;
    __syncthreads();
    const int lo = args.ph_lo, hi = args.ph_hi;
#define REFRESH() do { int t_ = threadIdx.x; asm volatile("" : "+v"(t_)); F.tid = t_; F.lane = t_ & 63; F.wave = __builtin_amdgcn_readfirstlane(t_ >> 6); \
        unsigned long long w_ = (unsigned long long)args.ws, o_ = (unsigned long long)args.out, k_ = (unsigned long long)__builtin_amdgcn_kernarg_segment_ptr(); \
        asm volatile("" : "+s"(w_), "+s"(o_), "+s"(k_)); F.ws = (unsigned char*)(GAS unsigned char*)w_; F.out = (float*)(GAS float*)o_; F.ka = (KArgs)k_; \
        unsigned l_ = (unsigned)(unsigned long long)(LAS unsigned char*)lds; asm volatile("" : "+s"(l_)); F.lds = (LAS unsigned char*)(unsigned long long)l_; } while (0)
    XcdBarrier bar; bar.bar = (unsigned*)(F.ws + WS_CTL) + CW_BAR; bar.x = 0; bar.st = nullptr;
    if (hi - lo > 1) bar = xcd_barrier_post((unsigned*)(F.ws + WS_CTL) + CW_BAR, MISC + 8);
#ifdef ONLY_PHASE
#define IN(k) ((((k) < 2 || (k) == N_PHASES - 1) ? (k) : 2 + ((k) - 2) % NPL) == ONLY_PHASE && lo <= (k) && (k) < hi)
#else
#define IN(k) (lo <= (k) && (k) < hi)
#endif
#ifndef PROBE_DUP
#define PROBE_DUP 0
#endif
#define DUP(k) _Pragma("unroll") for (int rep_ = 0; rep_ < 1 + ((PROBE_DUP >> (k)) & 1); ++rep_)
#ifndef STAGGER_TICKS
#define STAGGER_TICKS 0
#endif
#define STAGGER(ticks) do { if ((ticks) > 0 && (blockIdx.x & 8)) { const unsigned long long t0_ = __builtin_amdgcn_s_memrealtime(); while (__builtin_amdgcn_s_memrealtime() - t0_ < (unsigned long long)(ticks)) __builtin_amdgcn_s_sleep(8); } } while (0)
#define SEAM(k) do { if (IN(k) && IN((k) + 1)) { XcdBarrier b_ = bar; unsigned long long p_ = (unsigned long long)b_.bar; asm volatile("" : "+s"(p_)); b_.bar = (unsigned*)p_; xcd_barrier(b_); } } while (0)

    if (IN(0)) DUP(8) { REFRESH(); p0a_phase(F); } SEAM(0);
    if (IN(1)) { REFRESH(); p0b_phase(F);
        pg8::Gemm g{(const bf16*)(F.ws + WS_TA), (const bf16*)(F.ws + WS_FB), NL * 2 * DM, NL * 2 * DC, DC}; pg8::FoldOrder S{F.G, (int)blockIdx.x}; pg8::EpiFold E{F.ws + WS_W, LW, LW_WOUT};
        pg8::gemm_phase<pg8::EpiFold, pg8::FoldOrder, true, true>(F.lds, g, S, E); } SEAM(1);
    for (int l = 0; l < NL; ++l) {
        const int pb = 2 + NPL * l;
        if (IN(pb + 0)) DUP(0) { REFRESH(); bf16* H = (bf16*)(F.ws + WS_H); bf16* Zb = (bf16*)(F.ws + WS_Z); bf16* MIX = (bf16*)(F.ws + WS_MIX); bf16* HID = (bf16*)(F.ws + WS_HID); bf16* CAPM = (bf16*)(F.ws + WS_CAPM); bf16* XB = (bf16*)(F.ws + WS_XB); (void)XB; (void)H; (void)Zb; (void)MIX; (void)HID; (void)CAPM; const float* mod_l = modp(F, l); unsigned char* wl = lw(F, l); (void)mod_l; (void)wl; if (l == 0) norm_phase<true>(F, INP(I_N1) + l * DM, mod_l, 0, H, XB); else norm_phase<false>(F, INP(I_N1) + l * DM, mod_l, 0, H, XB); } SEAM(pb + 0);
        if (IN(pb + 1)) DUP(1) { REFRESH(); bf16* H = (bf16*)(F.ws + WS_H); bf16* Zb = (bf16*)(F.ws + WS_Z); bf16* MIX = (bf16*)(F.ws + WS_MIX); bf16* HID = (bf16*)(F.ws + WS_HID); bf16* CAPM = (bf16*)(F.ws + WS_CAPM); bf16* XB = (bf16*)(F.ws + WS_XB); (void)XB; (void)H; (void)Zb; (void)MIX; (void)HID; (void)CAPM; const float* mod_l = modp(F, l); unsigned char* wl = lw(F, l); (void)mod_l; (void)wl; pg8::Gemm g{H, (const bf16*)(wl + LW_WIN), MP, DIN, DM}; pg8::StaticOrder S; S.init(MP, DIN, F.G, (int)blockIdx.x); int dry_ = (PROBE_DRY != 0) && (rep_ == 1); asm volatile("" : "+s"(dry_)); pg8::EpiZ E{Zb, dry_};
            pg8::gemm_phase<pg8::EpiZ, pg8::StaticOrder, true, true>(F.lds, g, S, E);
            for (int su = F.vcu; su < 4 * 64; su += F.G) { const int rt = su & 3, cb = su >> 2; SkUnit u; u.row0 = MP + 64 * rt;
                if (cb < 16) { const int tt = cb >> 2, x0 = 32 * (cb & 3); u.nb0 = 256 * tt + x0; u.nb1 = u.nb0 + 128; u.ocol0 = 128 * tt + x0; u.ocol1 = 0; u.pair = true; u.scale = 1.f; }
                else { const int pbk = cb - 16; u.nb0 = 1024 + 64 * pbk; u.nb1 = u.nb0 + 32; u.ocol0 = 512 + 64 * pbk; u.ocol1 = u.ocol0 + 32; u.pair = false; u.scale = (u.nb0 < 1536) ? QSCALE : 1.f; }
                sk_unit<SK_Z, 2, 8>(F, H, (const bf16*)(wl + LW_WIN), DM, u, Zb, ZW, nullptr, nullptr); } } SEAM(pb + 1);
        if (IN(pb + 2)) DUP(2) { REFRESH(); bf16* H = (bf16*)(F.ws + WS_H); bf16* Zb = (bf16*)(F.ws + WS_Z); bf16* MIX = (bf16*)(F.ws + WS_MIX); bf16* HID = (bf16*)(F.ws + WS_HID); bf16* CAPM = (bf16*)(F.ws + WS_CAPM); bf16* XB = (bf16*)(F.ws + WS_XB); (void)XB; (void)H; (void)Zb; (void)MIX; (void)HID; (void)CAPM; const float* mod_l = modp(F, l); unsigned char* wl = lw(F, l); (void)mod_l; (void)wl; mixer_phase(F, l); } SEAM(pb + 2);
        if (IN(pb + 3)) DUP(3) { REFRESH(); bf16* H = (bf16*)(F.ws + WS_H); bf16* Zb = (bf16*)(F.ws + WS_Z); bf16* MIX = (bf16*)(F.ws + WS_MIX); bf16* HID = (bf16*)(F.ws + WS_HID); bf16* CAPM = (bf16*)(F.ws + WS_CAPM); bf16* XB = (bf16*)(F.ws + WS_XB); (void)XB; (void)H; (void)Zb; (void)MIX; (void)HID; (void)CAPM; const float* mod_l = modp(F, l); unsigned char* wl = lw(F, l); (void)mod_l; (void)wl; STAGGER(STAGGER_G3); pg8::Gemm g{MIX, (const bf16*)(wl + LW_WOUT), MP, DM, DM}; pg8::StaticOrder S; S.init(MP, DM, F.G, (int)blockIdx.x); int dry_ = (PROBE_DRY != 0) && (rep_ == 1); asm volatile("" : "+s"(dry_)); pg8::EpiResB E{XB, mod_l + 2 * DM, dry_};
            pg8::gemm_phase<pg8::EpiResB, pg8::StaticOrder, true, true>(F.lds, g, S, E);
            if (!dry_) for (int su = F.vcu; su < 8 * 32; su += F.G) { const int rt = su & 7, cb = su >> 3; SkUnit u; u.row0 = MP + 32 * rt; u.nb0 = 64 * cb; u.nb1 = u.nb0 + 32; u.ocol0 = u.nb0; u.ocol1 = u.nb1; u.pair = false; u.scale = 1.f;
                sk_unit<SK_RES, 1, 8>(F, MIX, (const bf16*)(wl + LW_WOUT), DM, u, XB, DM, nullptr, mod_l + 2 * DM); } } SEAM(pb + 3);
        if (IN(pb + 4)) DUP(4) { REFRESH(); bf16* H = (bf16*)(F.ws + WS_H); bf16* Zb = (bf16*)(F.ws + WS_Z); bf16* MIX = (bf16*)(F.ws + WS_MIX); bf16* HID = (bf16*)(F.ws + WS_HID); bf16* CAPM = (bf16*)(F.ws + WS_CAPM); bf16* XB = (bf16*)(F.ws + WS_XB); (void)XB; (void)H; (void)Zb; (void)MIX; (void)HID; (void)CAPM; const float* mod_l = modp(F, l); unsigned char* wl = lw(F, l); (void)mod_l; (void)wl; norm_phase<false>(F, INP(I_N2) + l * DM, mod_l, 3, H, XB); } SEAM(pb + 4);
        if (IN(pb + 5)) DUP(5) { REFRESH(); bf16* H = (bf16*)(F.ws + WS_H); bf16* Zb = (bf16*)(F.ws + WS_Z); bf16* MIX = (bf16*)(F.ws + WS_MIX); bf16* HID = (bf16*)(F.ws + WS_HID); bf16* CAPM = (bf16*)(F.ws + WS_CAPM); bf16* XB = (bf16*)(F.ws + WS_XB); (void)XB; (void)H; (void)Zb; (void)MIX; (void)HID; (void)CAPM; const float* mod_l = modp(F, l); unsigned char* wl = lw(F, l); (void)mod_l; (void)wl; pg8::Gemm g{H, (const bf16*)(wl + LW_WGU), MP, 2 * DFF, DM}; pg8::StaticOrder S; S.init(MP, 2 * DFF, F.G, (int)blockIdx.x); pg8::EpiSwi E{HID};
            pg8::gemm_phase<pg8::EpiSwi, pg8::StaticOrder, true, true>(F.lds, g, S, E);
            for (int su = F.vcu; su < 4 * 176; su += F.G) { const int rt = su & 3, cb = su >> 2, tt = cb >> 2, x0 = 32 * (cb & 3); SkUnit u; u.row0 = MP + 64 * rt; u.nb0 = 256 * tt + x0; u.nb1 = u.nb0 + 128;
                u.ocol0 = 128 * tt + x0; u.ocol1 = 0; u.pair = true; u.scale = 1.f;
                sk_unit<SK_SWI, 2, 8>(F, H, (const bf16*)(wl + LW_WGU), DM, u, HID, DFF, nullptr, nullptr); } } SEAM(pb + 5);
        if (IN(pb + 6)) DUP(6) { REFRESH(); bf16* H = (bf16*)(F.ws + WS_H); bf16* Zb = (bf16*)(F.ws + WS_Z); bf16* MIX = (bf16*)(F.ws + WS_MIX); bf16* HID = (bf16*)(F.ws + WS_HID); bf16* CAPM = (bf16*)(F.ws + WS_CAPM); bf16* XB = (bf16*)(F.ws + WS_XB); (void)XB; (void)H; (void)Zb; (void)MIX; (void)HID; (void)CAPM; const float* mod_l = modp(F, l); unsigned char* wl = lw(F, l); (void)mod_l; (void)wl; STAGGER(STAGGER_G5); pg8::Gemm g{HID, (const bf16*)(wl + LW_WD), MP, DM, DFF}; pg8::StaticOrder S; S.init(MP, DM, F.G, (int)blockIdx.x); int dry_ = (PROBE_DRY != 0) && (rep_ == 1); asm volatile("" : "+s"(dry_)); pg8::EpiResB E{XB, mod_l + 5 * DM, dry_};
            pg8::gemm_phase<pg8::EpiResB, pg8::StaticOrder, true, true>(F.lds, g, S, E);
            if (!dry_) for (int su = F.vcu; su < 8 * 32; su += F.G) { const int rt = su & 7, cb = su >> 3; SkUnit u; u.row0 = MP + 32 * rt; u.nb0 = 64 * cb; u.nb1 = u.nb0 + 32; u.ocol0 = u.nb0; u.ocol1 = u.nb1; u.pair = false; u.scale = 1.f;
                sk_unit<SK_RES, 1, 11>(F, HID, (const bf16*)(wl + LW_WD), DFF, u, XB, DM, nullptr, mod_l + 5 * DM); } } SEAM(pb + 6);
    }
    if (IN(N_PHASES - 1)) { REFRESH(); final_norm_phase(F, (const bf16*)(F.ws + WS_XB)); }
#undef IN
#undef SEAM
}

extern "C" void kernel_launch(void* const* d_in, const int* in_sizes, int n_in, void* d_out, int out_size, void* d_ws, size_t ws_size, hipStream_t stream) {
    static int grid = 0;
    if (grid == 0) {
        if (n_in != N_IN || in_sizes[0] != MP * DM || (size_t)out_size != O_END || ws_size < WS_END) {
            fprintf(stderr, "kernel_launch: unexpected shapes: n_in %d in0 %d out %d ws %zu (need %zu); nothing launched\n", n_in, n_in > 0 ? in_sizes[0] : -1, out_size, ws_size, (size_t)WS_END); grid = -1; return; }
        int dev = 0, cus = 0;
        if (hipGetDevice(&dev) != hipSuccess || hipDeviceGetAttribute(&cus, hipDeviceAttributeMultiprocessorCount, dev) != hipSuccess) { grid = -1; return; }
        if (hipFuncSetAttribute((const void*)enc_fwd, hipFuncAttributeMaxDynamicSharedMemorySize, LDS_BYTES) != hipSuccess) { fprintf(stderr, "kernel_launch: hipFuncSetAttribute failed\n"); grid = -1; return; }
        int per_cu = 0;
        if (hipOccupancyMaxActiveBlocksPerMultiprocessor(&per_cu, (const void*)enc_fwd, NWAVES * 64, LDS_BYTES) != hipSuccess || per_cu < 1)
            fprintf(stderr, "kernel_launch: note: occupancy query reports %d workgroups per CU\n", per_cu);
        (void)hipGetLastError();
        grid = cus;
    }
    if (grid < 0) return;
    if (hipMemsetAsync((char*)d_ws + WS_CTL, 0, CTL_ZERO_BYTES, stream) != hipSuccess) return;
    Args a{};
    for (int i = 0; i < N_IN; ++i) a.in[i] = (const float*)d_in[i];
    a.out = (float*)d_out; a.ws = (unsigned char*)d_ws; a.pad0 = 0; a.pad1 = 0;
#if MK_ONE_LAUNCH
    a.ph_lo = 0; a.ph_hi = N_PHASES;
    hipLaunchKernelGGL(enc_fwd, dim3(grid), dim3(NWAVES * 64), LDS_BYTES, stream, a);
#else
    for (int ph = 0; ph < N_PHASES; ++ph) { a.ph_lo = ph; a.ph_hi = ph + 1;
        hipLaunchKernelGGL(enc_fwd, dim3(grid), dim3(NWAVES * 64), LDS_BYTES, stream, a); }
#endif
}
```

```cpp
#include <hip/hip_runtime.h>
#include <cstdio>
#include <cstdint>
#include <utility>

#ifndef MK_ONE_LAUNCH
#define MK_ONE_LAUNCH 1
#endif
#ifndef PROBE_DUP
#define PROBE_DUP 0
#endif
#ifndef PROBE_DRY
#define PROBE_DRY 0
#endif
#ifndef PROBE_MIX
#define PROBE_MIX 0
#endif
#ifndef PROBE_EPI2
#define PROBE_EPI2 0
#endif
#ifndef STAGGER_TICKS
#define STAGGER_TICKS 0
#endif
#ifndef STAGGER_G3
#define STAGGER_G3 0
#define STAGGER_G5 0
#endif

constexpr int DM = 2048, SEQ = 8192, NBP = 4, MP = NBP * SEQ, NBS = 8, TS = 32, MS = NBS * TS, MT = MP + MS, NPANEL = MT / 256;
constexpr int DIN = 4096, DFF = 5632, DC = 512, NL = 4, NMOD = 6 * DM, NBT = NBP + NBS;
constexpr int ZW = 3584, ZU = 0, ZQ = 512, ZK = 1024, ZV = 1536, ZP = 2048, ZSU = 2560, ZSV = 3072;
constexpr int MIXW = 2048, MIX_A = 0, MIX_B = 512, MIX_C = 1024, MIX_D = 1536;
constexpr float EPS = 1e-6f, LOG2E = 1.4426950408889634f, QSCALE = 0.125f * LOG2E;
constexpr int KSPLIT = 16;
constexpr size_t O_YP = 0, O_YS = O_YP + (size_t)MP * DM, O_CONVP = O_YS + (size_t)MS * DM, O_CONVS = O_CONVP + (size_t)NL * NBP * 30 * DC,
    O_KP = O_CONVS + (size_t)NL * NBS * 30 * DC, O_VP = O_KP + (size_t)NL * NBP * 512 * 512, O_KS = O_VP + (size_t)NL * NBP * 512 * 512,
    O_VS = O_KS + (size_t)NL * NBS * TS * 512, O_POOLP = O_VS + (size_t)NL * NBS * TS * 512, O_POOLS = O_POOLP + (size_t)NL * NBP * 15 * DC,
    O_SGV = O_POOLS + (size_t)NL * NBS * 15 * DC, O_END = O_SGV + (size_t)NL * NBS * TS * DC;
static_assert(O_END == 78700544, "output size");
enum { I_XP = 0, I_XS, I_CP, I_CS, I_CCONV, I_CK, I_CV, I_CPOOL, I_ADAW, I_ADAB, I_N1, I_N2, I_WIN, I_CONVW, I_CONVB, I_GNG, I_GNB, I_CPW, I_RELB,
       I_POOLW, I_POOLS, I_SGG, I_SGB, I_SGW, I_SGBIAS, I_WOUT, I_WG, I_WU, I_WD, I_FING, N_IN };
static_assert(N_IN == 30, "30 inputs");

constexpr size_t MiB = 1u << 20;
constexpr size_t WS_CTL = 0, CTL_ZERO_BYTES = 1 * MiB;
constexpr size_t WS_MOD = 1 * MiB;
constexpr size_t WS_MODP = 4 * MiB;
constexpr size_t WS_W = 40 * MiB;
constexpr size_t LW_WIN = 0, LW_WOUT = 16 * MiB, LW_WGU = 24 * MiB, LW_WD = 68 * MiB, LW_CPW = 90 * MiB, LW_PWD = LW_CPW + 512 * 1024, LW_SGW = 91 * MiB, LW = 91 * MiB + 256 * 1024;
constexpr size_t WS_H = WS_W + NL * LW;
constexpr size_t WS_Z = WS_H + (size_t)MT * DM * 2;
constexpr size_t WS_MIX = WS_Z + (size_t)MT * ZW * 2;
constexpr size_t WS_HID = WS_Z;
constexpr size_t WS_CAPM = WS_MIX + (size_t)MT * MIXW * 2;
constexpr size_t WS_TA = WS_CAPM, WS_FB = WS_CAPM + 16 * MiB;
constexpr size_t WS_XB = WS_CAPM + (size_t)2 * MT * DC * 2;
constexpr size_t WS_END = WS_XB + (size_t)MT * DM * 2;
static_assert(WS_HID + (size_t)MT * DFF * 2 <= WS_CAPM, "HID overlay");
static_assert((size_t)NL * 12 * NMOD * 4 <= 3 * MiB && (size_t)KSPLIT * NL * 12 * NMOD * 4 <= 36 * MiB, "mod buffers");
constexpr int CW_BAR = 4096;

constexpr int RING_BYTES = 131072;
constexpr int LDSCTL_OFF = RING_BYTES, MISC_OFF = LDSCTL_OFF + 320;
constexpr int LDS_BYTES = 147456;
constexpr int NWAVES = 8;

#define GAS __attribute__((address_space(1)))
#define LAS __attribute__((address_space(3)))
typedef unsigned short bf16;
typedef unsigned v4u __attribute__((ext_vector_type(4)));
typedef unsigned v2u __attribute__((ext_vector_type(2)));
typedef float f32x4 __attribute__((ext_vector_type(4)));
typedef float f32x2 __attribute__((ext_vector_type(2)));
typedef float f32x16 __attribute__((ext_vector_type(16)));
typedef short bf16x8 __attribute__((ext_vector_type(8)));
typedef __bf16 bf16x2_t __attribute__((ext_vector_type(2)));
typedef GAS unsigned gu32;
#define RLX_AGENT __ATOMIC_RELAXED, __HIP_MEMORY_SCOPE_AGENT
#define LDS_WAIT() asm volatile("s_waitcnt lgkmcnt(0)" ::: "memory")
#define VM_WAIT() asm volatile("s_waitcnt vmcnt(0)" ::: "memory")

__device__ __forceinline__ unsigned pk2(float lo, float hi) { f32x2 v = {lo, hi}; bf16x2_t b = __builtin_convertvector(v, bf16x2_t); return __builtin_bit_cast(unsigned, b); }
__device__ __forceinline__ float bflo(unsigned u) { return __uint_as_float(u << 16); }
__device__ __forceinline__ float bfhi(unsigned u) { return __uint_as_float(u & 0xffff0000u); }
__device__ __forceinline__ float bf2f(bf16 h) { return __uint_as_float((unsigned)h << 16); }
__device__ __forceinline__ float fast_exp2(float x) { return __builtin_amdgcn_exp2f(x); }
__device__ __forceinline__ float fast_rcp(float x) { return __builtin_amdgcn_rcpf(x); }
__device__ __forceinline__ float sigmoidf_(float x) { return fast_rcp(1.0f + fast_exp2(-x * LOG2E)); }
__device__ __forceinline__ float siluf_(float x) { return x * sigmoidf_(x); }
template <int CTRL> __device__ __forceinline__ float dpp_f(float v) { return __int_as_float(__builtin_amdgcn_update_dpp(0, __float_as_int(v), CTRL, 0xF, 0xF, true)); }
__device__ __forceinline__ float row16_sum(float v) { v += dpp_f<0xB1>(v); v += dpp_f<0x4E>(v); v += dpp_f<0x141>(v); v += dpp_f<0x140>(v); return v; }
__device__ __forceinline__ float half32_sum(float v) { v = row16_sum(v); v += __int_as_float(__builtin_amdgcn_ds_swizzle(__float_as_int(v), 0x401F)); return v; }
__device__ __forceinline__ float wave_sum(float v) { v = half32_sum(v);
    return __int_as_float(__builtin_amdgcn_readlane(__float_as_int(v), 0)) + __int_as_float(__builtin_amdgcn_readlane(__float_as_int(v), 32)); }
__device__ __forceinline__ int batch_of_row(int row) { return row < MP ? (row >> 13) : NBP + ((row - MP) >> 5); }

namespace pg8 {
#define PG8_LAS __attribute__((address_space(3)))
typedef unsigned short bf16_t;
typedef short bf16x8 __attribute__((ext_vector_type(8)));
typedef float f32x4 __attribute__((ext_vector_type(4)));
typedef unsigned u32x4 __attribute__((ext_vector_type(4)));
constexpr int BM = 256, BK = 64, HALF = 128, HTB = HALF * BK * 2  , STAGE_BYTES = 8 * HTB, NXCD = 8, WGM = 8;

__host__ __device__ __forceinline__ int lds_byte(int r, int c) { const int st = (r >> 4) * 2 + (c >> 5), rr = r & 15, cc = c & 31, ob = rr * 64 + cc * 2; return st * 1024 + (ob ^ (((ob >> 9) & 1) << 5)); }
__host__ __device__ __forceinline__ void stage_rc(int b, int& R, int& C) { const int st = b / 1024, sb = b % 1024, swz = sb ^ (((sb >> 9) & 1) << 5); R = (st >> 1) * 16 + swz / 64; C = (st & 1) * 32 + (swz % 64) / 2; }
__host__ __device__ __forceinline__ int perm32(int rho) { const int n = rho >> 4, i = rho & 15; return 8 * (i >> 2) + 4 * n + (i & 3); }

struct Unit { int pm, pn; };
struct Gemm { const bf16_t* A; const bf16_t* Bt; int M, N, K; };

struct StaticOrder {
    int nM, nN, nwg, G, c;
    __host__ __device__ void init(int M, int N, int G_, int c_) { nM = M / BM; nN = N / BM; nwg = nM * nN; G = G_; c = c_; }
    __host__ __device__ bool next(int i, Unit& u) const {
        const long L = (long)i * G + c; if (L >= nwg) return false;
        int wgid = (int)L; { const int q = nwg / NXCD, r = nwg % NXCD, xcd = wgid % NXCD, off = wgid / NXCD; wgid = (xcd < r ? xcd * (q + 1) : r * (q + 1) + (xcd - r) * q) + off; }
        const int nig = WGM * nN, gid = wgid / nig, fm = gid * WGM, gsz = (nM - fm) < WGM ? (nM - fm) : WGM;
        u.pm = fm + ((wgid % nig) % gsz); u.pn = (wgid % nig) / gsz; return true;
    }
    __device__ __forceinline__ void a_ready(const Unit&) const {}
    __device__ __forceinline__ void done(const Unit&) const {}
};
__device__ __forceinline__ unsigned cvt_pk_bf16(float lo, float hi) { return ::pk2(lo, hi); }
struct EpiZ {
    static constexpr bool PERM = true, AFTER_DRAIN = false;
    bf16_t* Z; int dry;
    __device__ __forceinline__ void operator()(const f32x4 (&acc)[2][2][4][2], const Unit& u, int wr, int wc, int fr, int fq) const {
        const int row0 = u.pm * BM + wr * 64 + fr;
        if (dry) return;
        if (u.pn < 4) {
            const int col0 = 128 * u.pn + wc * 32 + 8 * fq;
#pragma unroll
            for (int ai = 0; ai < 2; ++ai)
#pragma unroll
                for (int m = 0; m < 4; ++m) { bf16_t* rowp = Z + (size_t)(row0 + ai * HALF + m * 16) * ::ZW + col0;
                    const f32x4 a0 = acc[ai][0][m][0], a1 = acc[ai][0][m][1], g0 = acc[ai][1][m][0], g1 = acc[ai][1][m][1];
                    u32x4 w; w.x = cvt_pk_bf16(a0[0] * ::sigmoidf_(g0[0]), a0[1] * ::sigmoidf_(g0[1])); w.y = cvt_pk_bf16(a0[2] * ::sigmoidf_(g0[2]), a0[3] * ::sigmoidf_(g0[3]));
                    w.z = cvt_pk_bf16(a1[0] * ::sigmoidf_(g1[0]), a1[1] * ::sigmoidf_(g1[1])); w.w = cvt_pk_bf16(a1[2] * ::sigmoidf_(g1[2]), a1[3] * ::sigmoidf_(g1[3]));
                    *(u32x4*)rowp = w; }
        } else {
            const float sc = (u.pn < 6) ? ::QSCALE : 1.0f;
            const int col0 = 512 + 256 * (u.pn - 4) + wc * 32 + 8 * fq;
#pragma unroll
            for (int ai = 0; ai < 2; ++ai)
#pragma unroll
                for (int m = 0; m < 4; ++m) { bf16_t* rowp = Z + (size_t)(row0 + ai * HALF + m * 16) * ::ZW + col0;
#pragma unroll
                    for (int bj = 0; bj < 2; ++bj) { const f32x4 v0 = acc[ai][bj][m][0] * sc, v1 = acc[ai][bj][m][1] * sc;
                        u32x4 w; w.x = cvt_pk_bf16(v0[0], v0[1]); w.y = cvt_pk_bf16(v0[2], v0[3]); w.z = cvt_pk_bf16(v1[0], v1[1]); w.w = cvt_pk_bf16(v1[2], v1[3]);
                        *(u32x4*)(rowp + bj * HALF) = w; } }
        }
    }
};
struct EpiFold {
    static constexpr bool PERM = true, AFTER_DRAIN = false;
    unsigned char* wbase; size_t lwstride, lwoff;
    __device__ __forceinline__ void operator()(const f32x4 (&acc)[2][2][4][2], const Unit& u, int wr, int wc, int fr, int fq) const {
        const int lwh = u.pn >> 1, layer = lwh >> 1, which = lwh & 1, pm = u.pm - lwh * 8;
        bf16_t* O = (bf16_t*)(wbase + (size_t)layer * lwstride + lwoff);
        const int row0 = pm * BM + wr * 64 + fr, col0 = which * 1024 + (u.pn & 1) * 256 + wc * 32 + 8 * fq;
#pragma unroll
        for (int ai = 0; ai < 2; ++ai)
#pragma unroll
            for (int m = 0; m < 4; ++m) { bf16_t* rowp = O + (size_t)(row0 + ai * HALF + m * 16) * ::DM + col0;
#pragma unroll
                for (int bj = 0; bj < 2; ++bj) { const f32x4 v0 = acc[ai][bj][m][0], v1 = acc[ai][bj][m][1];
                    u32x4 w; w.x = cvt_pk_bf16(v0[0], v0[1]); w.y = cvt_pk_bf16(v0[2], v0[3]); w.z = cvt_pk_bf16(v1[0], v1[1]); w.w = cvt_pk_bf16(v1[2], v1[3]);
                    *(u32x4*)(rowp + bj * HALF) = w; } }
    }
};
struct EpiResB {
    static constexpr bool PERM = true, AFTER_DRAIN = false;
    bf16_t* XB; const float* gate; int dry;
    __device__ __forceinline__ void operator()(const f32x4 (&acc)[2][2][4][2], const Unit& u, int wr, int wc, int fr, int fq) const {
        if (dry) return;
        const int row0 = u.pm * BM + wr * 64 + fr, col0 = u.pn * BM + wc * 32 + 8 * fq;
        const float* gp = gate + (size_t)::batch_of_row(u.pm * BM) * ::NMOD + col0;
        f32x4 gv[2][2];
#pragma unroll
        for (int bj = 0; bj < 2; ++bj)
#pragma unroll
            for (int n = 0; n < 2; ++n) gv[bj][n] = *(const f32x4*)(gp + bj * HALF + 4 * n);
#pragma unroll
        for (int ai = 0; ai < 2; ++ai) {
            u32x4 xold[4][2];
#pragma unroll
            for (int m = 0; m < 4; ++m)
#pragma unroll
                for (int bj = 0; bj < 2; ++bj) xold[m][bj] = *(const u32x4*)(XB + (size_t)(row0 + ai * HALF + m * 16) * ::DM + col0 + bj * HALF);
#pragma unroll
            for (int m = 0; m < 4; ++m) { bf16_t* rowp = XB + (size_t)(row0 + ai * HALF + m * 16) * ::DM + col0;
#pragma unroll
                for (int bj = 0; bj < 2; ++bj) { const u32x4 xo = xold[m][bj];
                    const f32x4 v0 = acc[ai][bj][m][0] * gv[bj][0] + (f32x4){::bflo(xo.x), ::bfhi(xo.x), ::bflo(xo.y), ::bfhi(xo.y)};
                    const f32x4 v1 = acc[ai][bj][m][1] * gv[bj][1] + (f32x4){::bflo(xo.z), ::bfhi(xo.z), ::bflo(xo.w), ::bfhi(xo.w)};
                    u32x4 w; w.x = cvt_pk_bf16(v0[0], v0[1]); w.y = cvt_pk_bf16(v0[2], v0[3]); w.z = cvt_pk_bf16(v1[0], v1[1]); w.w = cvt_pk_bf16(v1[2], v1[3]);
                    *(u32x4*)(rowp + bj * HALF) = w; } } }
    }
};
struct EpiSwi {
    static constexpr bool PERM = true, AFTER_DRAIN = false;
    bf16_t* HID;
    __device__ __forceinline__ void operator()(const f32x4 (&acc)[2][2][4][2], const Unit& u, int wr, int wc, int fr, int fq) const {
        const int row0 = u.pm * BM + wr * 64 + fr, col0 = 128 * u.pn + wc * 32 + 8 * fq;
#pragma unroll
        for (int ai = 0; ai < 2; ++ai)
#pragma unroll
            for (int m = 0; m < 4; ++m) { bf16_t* rowp = HID + (size_t)(row0 + ai * HALF + m * 16) * ::DFF + col0;
                const f32x4 g0 = acc[ai][0][m][0], g1 = acc[ai][0][m][1], u0 = acc[ai][1][m][0], u1 = acc[ai][1][m][1];
                u32x4 w; w.x = cvt_pk_bf16(::siluf_(g0[0]) * u0[0], ::siluf_(g0[1]) * u0[1]); w.y = cvt_pk_bf16(::siluf_(g0[2]) * u0[2], ::siluf_(g0[3]) * u0[3]);
                w.z = cvt_pk_bf16(::siluf_(g1[0]) * u1[0], ::siluf_(g1[1]) * u1[1]); w.w = cvt_pk_bf16(::siluf_(g1[2]) * u1[2], ::siluf_(g1[3]) * u1[3]);
                *(u32x4*)rowp = w; }
    }
};
struct FoldOrder {
    int G, c;
    __device__ __forceinline__ bool next(int i, Unit& u) const {
        const int L = i * G + c; if (L >= ::NL * 32) return false;
        const int lwh = L >> 4, pm = (L >> 1) & 7, pn = L & 1;
        u.pm = lwh * 8 + pm; u.pn = lwh * 2 + pn; return true;
    }
    __device__ __forceinline__ void a_ready(const Unit&) const {}
    __device__ __forceinline__ void done(const Unit&) const {}
};

template <class Epi, class Sched, bool ALIGN_EPI = false, bool SP2 = false>
__device__ __forceinline__ void gemm_phase(PG8_LAS unsigned char* lds, const Gemm g, const Sched& S, const Epi& E) {
    int tid_ = threadIdx.x; asm volatile("" : "+v"(tid_));
    const int tid = tid_, wid = __builtin_amdgcn_readfirstlane(tid >> 6), lane = tid & 63, wr = wid >> 2, wc = wid & 3, fr = lane & 15, fq = lane >> 4;
    const int K = g.K, nt = K / BK;
    unsigned voffA[2], voffB[2];
#pragma unroll
    for (int i = 0; i < 2; ++i) { int R, C; stage_rc(tid * 16 + i * 8192, R, C); const int Rb = Epi::PERM ? ((R & ~31) + perm32(R & 31)) : R;
        voffA[i] = (unsigned)(R * K + C) * 2u; voffB[i] = (unsigned)(Rb * K + C) * 2u; }
    const size_t kstep = (size_t)(BK * 2);
    const size_t hstep = (size_t)HALF * K * 2;
    const size_t tstep = 2 * hstep;
    const unsigned ldsw = (unsigned)wid * 1024u;
    const int aoff = lds_byte(wr * 64 + fr, fq * 8), boff = lds_byte(wc * 32 + fr, fq * 8);
#define PG8_SA(b, h) (((b) * 2 + (h)) * HTB)
#define PG8_SB(b, h) ((4 + (b) * 2 + (h)) * HTB)
#define PG8_STAGE(bufoff, gbase, voff) do { _Pragma("unroll") for (int _i = 0; _i < 2; ++_i) \
        __builtin_amdgcn_global_load_lds((const unsigned*)((const char*)(gbase) + (voff)[_i]), (PG8_LAS unsigned*)(lds + (bufoff) + ldsw + _i * 8192), 16, 0, 0); } while (0)
#define PG8_LDA(dst, b, h) do { _Pragma("unroll") for (int m = 0; m < 4; ++m) _Pragma("unroll") for (int k = 0; k < 2; ++k) dst[m][k] = *(const PG8_LAS bf16x8*)(lds + PG8_SA(b, h) + aoff + m * 2048 + k * 1024); } while (0)
#define PG8_LDB(dst, b, h) do { _Pragma("unroll") for (int n = 0; n < 2; ++n) _Pragma("unroll") for (int k = 0; k < 2; ++k) dst[n][k] = *(const PG8_LAS bf16x8*)(lds + PG8_SB(b, h) + boff + n * 2048 + k * 1024); } while (0)
#define PG8_MMA(ai, bj, At, Bt) do { __builtin_amdgcn_s_setprio(1); _Pragma("unroll") for (int m = 0; m < 4; ++m) _Pragma("unroll") for (int n = 0; n < 2; ++n) _Pragma("unroll") for (int k = 0; k < 2; ++k) \
        acc[ai][bj][m][n] = __builtin_amdgcn_mfma_f32_16x16x32_bf16(Bt[n][k], At[m][k], acc[ai][bj][m][n], 0, 0, 0); __builtin_amdgcn_s_setprio(0); } while (0)
#define PG8_WAIT_V(n) asm volatile("s_waitcnt vmcnt(" #n ")" ::: "memory")
#define PG8_WAIT_L(n) asm volatile("s_waitcnt lgkmcnt(" #n ")" ::: "memory")
#define PG8_BAR __builtin_amdgcn_s_barrier()
#define PG8_SCHED __builtin_amdgcn_sched_barrier(0)
    Unit cur, nxt; int ui = 0;
    if (!S.next(0, cur)) return;
    f32x4 acc[2][2][4][2];
#pragma unroll
    for (int a = 0; a < 2; ++a)
#pragma unroll
        for (int b = 0; b < 2; ++b)
#pragma unroll
            for (int m = 0; m < 4; ++m)
#pragma unroll
                for (int n = 0; n < 2; ++n) acc[a][b][m][n] = (f32x4){0.f, 0.f, 0.f, 0.f};
    bf16x8 At[4][2], B0[2][2], B1[2][2];
    const char* cA = (const char*)g.A + (size_t)cur.pm * tstep; const char* cB = (const char*)g.Bt + (size_t)cur.pn * tstep;
    S.a_ready(cur);
    if constexpr (SP2) {
        PG8_STAGE(PG8_SB(0, 0), cB, voffB); PG8_STAGE(PG8_SB(0, 1), cB + hstep, voffB); PG8_STAGE(PG8_SA(0, 0), cA, voffA); PG8_STAGE(PG8_SA(0, 1), cA + hstep, voffA);
        if (wr == 1) PG8_BAR;
        PG8_WAIT_V(2); PG8_BAR;
        PG8_STAGE(PG8_SB(1, 0), cB + kstep, voffB); PG8_STAGE(PG8_SA(1, 0), cA + kstep, voffA); PG8_STAGE(PG8_SB(1, 1), cB + hstep + kstep, voffB);
        PG8_WAIT_V(6); PG8_BAR;
    } else {
        PG8_STAGE(PG8_SB(0, 0), cB, voffB); PG8_STAGE(PG8_SA(0, 0), cA, voffA); PG8_STAGE(PG8_SB(0, 1), cB + hstep, voffB); PG8_STAGE(PG8_SA(0, 1), cA + hstep, voffA);
        if (wr == 1) PG8_BAR;
        PG8_WAIT_V(4); PG8_BAR;
        PG8_STAGE(PG8_SB(1, 0), cB + kstep, voffB); PG8_STAGE(PG8_SA(1, 0), cA + kstep, voffA); PG8_STAGE(PG8_SB(1, 1), cB + hstep + kstep, voffB);
        PG8_WAIT_V(6); PG8_BAR;
    }
    for (;;) {
        const bool has_next = S.next(ui + 1, nxt);
        const char* nA = has_next ? (const char*)g.A + (size_t)nxt.pm * tstep : cA; const char* nB = has_next ? (const char*)g.Bt + (size_t)nxt.pn * tstep : cB;
        for (int t = 0; t < nt; t += 2) {
            const bool last = (t == nt - 2);
            const char* a1 = cA + (size_t)(t + 1) * kstep;
            const char* a2 = last ? nA : cA + (size_t)(t + 2) * kstep; const char* b2 = last ? nB : cB + (size_t)(t + 2) * kstep;
            const char* a3 = a2 + kstep; const char* b3 = b2 + kstep;
            if (last && has_next) S.a_ready(nxt);
            if constexpr (SP2) {
            PG8_LDB(B0, 0, 0); PG8_LDB(B1, 0, 1); PG8_SCHED; PG8_LDA(At, 0, 0); PG8_STAGE(PG8_SA(1, 1), a1 + hstep, voffA);
            PG8_WAIT_V(8); PG8_WAIT_L(0); PG8_BAR; PG8_MMA(0, 0, At, B0); PG8_MMA(0, 1, At, B1); PG8_BAR; PG8_SCHED;
            PG8_LDA(At, 0, 1); PG8_STAGE(PG8_SB(0, 0), b2, voffB); PG8_STAGE(PG8_SB(0, 1), b2 + hstep, voffB); PG8_STAGE(PG8_SA(0, 0), a2, voffA);
            PG8_WAIT_V(8); PG8_WAIT_L(0); PG8_BAR; PG8_MMA(1, 0, At, B0); PG8_MMA(1, 1, At, B1); PG8_BAR; PG8_SCHED;
            PG8_LDB(B0, 1, 0); PG8_LDB(B1, 1, 1); PG8_SCHED; PG8_LDA(At, 1, 0); PG8_STAGE(PG8_SA(0, 1), a2 + hstep, voffA);
            PG8_WAIT_V(8); PG8_WAIT_L(0); PG8_BAR; PG8_MMA(0, 0, At, B0); PG8_MMA(0, 1, At, B1); PG8_BAR; PG8_SCHED;
            PG8_LDA(At, 1, 1); PG8_STAGE(PG8_SB(1, 0), b3, voffB); PG8_STAGE(PG8_SB(1, 1), b3 + hstep, voffB); PG8_STAGE(PG8_SA(1, 0), a3, voffA);
            PG8_WAIT_V(8); PG8_WAIT_L(0); PG8_BAR; PG8_MMA(1, 0, At, B0); PG8_MMA(1, 1, At, B1); PG8_BAR; PG8_SCHED;
            } else {
            PG8_LDB(B0, 0, 0); PG8_SCHED; PG8_LDA(At, 0, 0); PG8_STAGE(PG8_SA(1, 1), a1 + hstep, voffA);
            PG8_WAIT_L(8); PG8_BAR; PG8_WAIT_L(0); PG8_MMA(0, 0, At, B0); PG8_BAR; PG8_SCHED;
            PG8_LDB(B1, 0, 1); PG8_STAGE(PG8_SB(0, 0), b2, voffB);
            PG8_BAR; PG8_WAIT_L(0); PG8_MMA(0, 1, At, B1); PG8_BAR;
            PG8_LDA(At, 0, 1); PG8_STAGE(PG8_SA(0, 0), a2, voffA);
            PG8_BAR; PG8_WAIT_L(0); PG8_MMA(1, 0, At, B0); PG8_BAR; PG8_SCHED;
            PG8_STAGE(PG8_SB(0, 1), b2 + hstep, voffB);
            PG8_WAIT_V(6); PG8_BAR; PG8_MMA(1, 1, At, B1); PG8_BAR;
            PG8_LDB(B0, 1, 0); PG8_SCHED; PG8_LDA(At, 1, 0); PG8_STAGE(PG8_SA(0, 1), a2 + hstep, voffA);
            PG8_WAIT_L(8); PG8_BAR; PG8_WAIT_L(0); PG8_MMA(0, 0, At, B0); PG8_BAR; PG8_SCHED;
            PG8_LDB(B1, 1, 1); PG8_STAGE(PG8_SB(1, 0), b3, voffB);
            PG8_BAR; PG8_WAIT_L(0); PG8_MMA(0, 1, At, B1); PG8_BAR;
            PG8_LDA(At, 1, 1); PG8_STAGE(PG8_SA(1, 0), a3, voffA);
            PG8_BAR; PG8_WAIT_L(0); PG8_MMA(1, 0, At, B0); PG8_BAR; PG8_SCHED;
            PG8_STAGE(PG8_SB(1, 1), b3 + hstep, voffB);
            PG8_WAIT_V(6); PG8_BAR; PG8_MMA(1, 1, At, B1); PG8_BAR;
            }
        }
        if constexpr (ALIGN_EPI) { if (wr == 0) PG8_BAR; }
        if constexpr (!Epi::AFTER_DRAIN) { E(acc, cur, wr, wc, fr, fq);
#if PROBE_EPI2
            if constexpr (Epi::PERM) { asm volatile("" ::: "memory"); E(acc, cur, wr, wc, fr, fq); }
#endif
            S.done(cur); }
        if (!has_next) break;
#pragma unroll
        for (int a = 0; a < 2; ++a)
#pragma unroll
            for (int b = 0; b < 2; ++b)
#pragma unroll
                for (int m = 0; m < 4; ++m)
#pragma unroll
                    for (int n = 0; n < 2; ++n) acc[a][b][m][n] = (f32x4){0.f, 0.f, 0.f, 0.f};
        cur = nxt; cA = nA; cB = nB; ++ui;
        if constexpr (ALIGN_EPI) { if (wr == 1) PG8_BAR; }
    }
    PG8_WAIT_V(0);
    if constexpr (!ALIGN_EPI) { if (wr == 0) PG8_BAR; }
    PG8_BAR;
    if constexpr (Epi::AFTER_DRAIN) { E.fused(acc, cur, wr, wc, fr, fq, lds, wid, lane); S.done(cur); }
#undef PG8_SA
#undef PG8_SB
#undef PG8_STAGE
#undef PG8_LDA
#undef PG8_LDB
#undef PG8_MMA
#undef PG8_WAIT_V
#undef PG8_WAIT_L
#undef PG8_BAR
#undef PG8_SCHED
}
}
#define XB_TMO      128
#define XB_XCNT(j)  (256  + 64 * (j))
#define XB_XSUB(j)  (1280 + 64 * (j))
#define XB_XGEN(j)  (2304 + 64 * (j))
#define XB_TOP      3328
#define XB_TOPGEN   3392
#define XCD_BAR_WORDS 3456
#define XB_SPIN_CAP (1u << 18)

__device__ __forceinline__ unsigned xb_ld(unsigned* p)              { return __hip_atomic_load(p, __ATOMIC_RELAXED, __HIP_MEMORY_SCOPE_AGENT); }
__device__ __forceinline__ unsigned xb_add(unsigned* p, unsigned v) { return __hip_atomic_fetch_add(p, v, __ATOMIC_RELAXED, __HIP_MEMORY_SCOPE_AGENT); }
__device__ __forceinline__ unsigned xb_xcc_id() { return (unsigned)__builtin_amdgcn_s_getreg((3 << 11) | 20) & 0xFu; }
#define XB_SPIN(cond, bar) do { unsigned _sp = 0; while (cond) { __builtin_amdgcn_s_sleep(1); \
    if ((++_sp & 255u) == 0u) { if (xb_ld(&(bar)[XB_TMO])) break; if (_sp > XB_SPIN_CAP) { atomicAdd(&(bar)[XB_TMO], 1u); break; } } } } while (0)

struct XcdBarrier {
    unsigned* bar; unsigned x;
    volatile LAS unsigned* st;
};

__device__ __forceinline__ XcdBarrier xcd_barrier_post(unsigned* bar, volatile LAS unsigned* st) {
    XcdBarrier b; b.bar = bar; b.x = xb_xcc_id(); b.st = st;
    if (threadIdx.x == 0) (void)xb_add(&bar[XB_XCNT(b.x)], 1u);
    return b;
}
__device__ __forceinline__ void xcd_barrier_complete(unsigned* bar, unsigned x, unsigned& nloc, unsigned& nx) {
    const unsigned G = gridDim.x * gridDim.y * gridDim.z;
    unsigned sum, cnt, mine, sp = 0u;
    for (;;) {
        sum = 0u; cnt = 0u; mine = 0u;
#pragma unroll
        for (unsigned j = 0; j < 16; ++j) { const unsigned c = xb_ld(&bar[XB_XCNT(j)]); sum += c; cnt += (c > 0u) ? 1u : 0u; mine = (j == x) ? c : mine; }
        if (sum == G) break;
        __builtin_amdgcn_s_sleep(1);
        if ((++sp & 255u) == 0u) { if (xb_ld(&bar[XB_TMO])) break; if (sp > XB_SPIN_CAP) { atomicAdd(&bar[XB_TMO], 1u); break; } }
    }
    nloc = mine > 0u ? mine : 1u; nx = cnt > 0u ? cnt : 1u;
}

__device__ __forceinline__ void xcd_barrier(const XcdBarrier& b) {
    asm volatile("s_waitcnt vmcnt(0)" ::: "memory");
    __syncthreads();
    if (threadIdx.x == 0) {
        unsigned* bar = b.bar;
        __builtin_amdgcn_s_waitcnt(0);
        unsigned nloc = b.st[0], nx = b.st[1];
        if (nloc == 0u) { xcd_barrier_complete(bar, b.x, nloc, nx); b.st[0] = nloc; b.st[1] = nx; }
        const unsigned old = xb_add(&bar[XB_XSUB(b.x)], 1u);
        const unsigned gen = old / nloc;
        if (old + 1u == (gen + 1u) * nloc) {
            __builtin_amdgcn_fence(__ATOMIC_RELEASE, "agent");
            asm volatile("s_waitcnt vmcnt(0)" ::: "memory");
            const unsigned og = xb_add(&bar[XB_TOP], 1u);
            const unsigned tg = og / nx;
            if (og + 1u == (tg + 1u) * nx) xb_add(&bar[XB_TOPGEN], 1u);
            else XB_SPIN(xb_ld(&bar[XB_TOPGEN]) == tg, bar);
            __builtin_amdgcn_fence(__ATOMIC_ACQUIRE, "agent");
            xb_add(&bar[XB_XGEN(b.x)], 1u);
            asm volatile("s_waitcnt vmcnt(0)" ::: "memory");
        } else {
            XB_SPIN(xb_ld(&bar[XB_XGEN(b.x)]) == gen, bar);
            __builtin_amdgcn_fence(__ATOMIC_ACQUIRE, "agent");
            asm volatile("s_waitcnt vmcnt(0)" ::: "memory");
        }
    }
    __syncthreads();
}
struct Args { const float* in[N_IN]; float* out; unsigned char* ws; int ph_lo, ph_hi, pad0, pad1; };
static_assert(sizeof(Args) == (N_IN + 2) * 8 + 16, "Args has no padding");
struct DevArgs { const GAS float* in[N_IN]; GAS float* out; GAS unsigned char* ws; int ph_lo, ph_hi, pad0, pad1; };
static_assert(sizeof(DevArgs) == sizeof(Args), "DevArgs mirrors Args");
typedef const __attribute__((address_space(4))) DevArgs* KArgs;
#define INP(i) ((const float*)F.ka->in[i])
struct Frame {
    LAS unsigned char* lds;
    int tid, lane, wave, vcu, G;
    KArgs ka;
    float* out; unsigned char* ws;
};
__device__ __forceinline__ const float* modp(const Frame& F, int layer) { return (const float*)(F.ws + WS_MOD) + (size_t)layer * 12 * NMOD; }
__device__ __forceinline__ unsigned char* lw(const Frame& F, int layer) { return F.ws + WS_W + (size_t)layer * LW; }

__device__ __forceinline__ void transpose_item(const float* W, int N, bf16* WT, int opitch, int ocol0, int k0, int n0, int orow0, LAS float* scr, int lane) {
#pragma unroll 8
    for (int i = 0; i < 32; ++i) { const int kk = 2 * i + (lane >> 5); scr[kk * 33 + (lane & 31)] = W[(size_t)(k0 + kk) * N + n0 + (lane & 31)]; }
    LDS_WAIT(); asm volatile("" ::: "memory");
    const int c = lane & 7;
#pragma unroll
    for (int j = 0; j < 4; ++j) { const int n = (lane >> 3) + 8 * j; const LAS float* s = scr + (8 * c) * 33 + n;
        v4u o; o.x = pk2(s[0 * 33], s[1 * 33]); o.y = pk2(s[2 * 33], s[3 * 33]); o.z = pk2(s[4 * 33], s[5 * 33]); o.w = pk2(s[6 * 33], s[7 * 33]);
        *(GAS v4u*)(WT + (size_t)(orow0 + n) * opitch + ocol0 + 8 * c) = o; }
    LDS_WAIT(); asm volatile("" ::: "memory");
}
__device__ __forceinline__ void p0a_phase(Frame& F) {
    const int gw = F.vcu * NWAVES + F.wave, NGW = F.G * NWAVES, gt = F.vcu * (NWAVES * 64) + F.tid, NGT = F.G * NWAVES * 64;
    {
        LAS float* sil = (LAS float*)F.lds;
        for (int i = F.tid; i < 12 * DM; i += NWAVES * 64) { const int b = i / DM, k = i % DM;
            const float c = b < NBP ? INP(I_CP)[b * DM + k] : INP(I_CS)[(b - NBP) * DM + k]; sil[k * 12 + b] = siluf_(c); }
        __syncthreads();
        constexpr int KC = DM / KSPLIT, NCB = NMOD / 256;
        float* part = (float*)(F.ws + WS_MODP);
        for (int it = gw; it < NL * KSPLIT * NCB; it += NGW) {
            const int l = it / (KSPLIT * NCB), ks = (it / NCB) % KSPLIT, cb = it % NCB, col = cb * 256 + 4 * F.lane;
            const GAS f32x4* wp = (const GAS f32x4*)(INP(I_ADAW) + ((size_t)l * DM + ks * KC) * NMOD + col);
            f32x4 acc[12];
#pragma unroll
            for (int b = 0; b < 12; ++b) acc[b] = (f32x4){0.f, 0.f, 0.f, 0.f};
#pragma unroll 4
            for (int k = 0; k < KC; ++k) { const f32x4 wv = wp[(size_t)k * (NMOD / 4)];
                const LAS f32x4* sp = (const LAS f32x4*)(sil + (ks * KC + k) * 12); const f32x4 s0 = sp[0], s1 = sp[1], s2 = sp[2];
                acc[0] += wv * s0[0]; acc[1] += wv * s0[1]; acc[2] += wv * s0[2]; acc[3] += wv * s0[3];
                acc[4] += wv * s1[0]; acc[5] += wv * s1[1]; acc[6] += wv * s1[2]; acc[7] += wv * s1[3];
                acc[8] += wv * s2[0]; acc[9] += wv * s2[1]; acc[10] += wv * s2[2]; acc[11] += wv * s2[3]; }
#pragma unroll
            for (int b = 0; b < 12; ++b) *(GAS f32x4*)(part + (((size_t)ks * NL + l) * 12 + b) * NMOD + col) = acc[b];
        }
        __syncthreads();
    }
    {
        LAS float* scr = (LAS float*)(F.lds + F.wave * 16384);
        constexpr int I_IN = (DM / 64) * (DIN / 32), I_OUT = (DM / 64) * (DM / 32), I_G = (DM / 64) * (DFF / 32), I_D = (DFF / 64) * (DM / 32), I_C = (DC / 64) * (DC / 32);
        constexpr int PER_L = I_IN + I_OUT + 2 * I_G + I_D; (void)I_C;
        for (int it = gw; it < NL * PER_L; it += NGW) {
            const int l = it / PER_L; int r = it % PER_L; unsigned char* wl = lw(F, l);
            if (r < I_IN) { const int nblk = DIN / 32, k0 = 64 * (r / nblk), n0 = 32 * (r % nblk);
                int orow0 = n0; if (n0 < 512) orow0 = 256 * (n0 >> 7) + (n0 & 127); else if (n0 < 1024) orow0 = 256 * ((n0 - 512) >> 7) + 128 + (n0 & 127);
                transpose_item(INP(I_WIN) + (size_t)l * DM * DIN, DIN, (bf16*)(wl + LW_WIN), DM, k0, k0, n0, orow0, scr, F.lane); continue; } r -= I_IN;
            if (r < I_OUT) { const int nblk = DM / 32, k0 = 64 * (r / nblk), n0 = 32 * (r % nblk);
                if ((k0 & 512) == 0) { const int which = k0 >> 10;
                    transpose_item(INP(I_WOUT) + (size_t)l * DM * DM, DM, (bf16*)(F.ws + WS_TA) + ((size_t)l * 2 + which) * DM * DC, DC, k0 & 511, k0, n0, n0, scr, F.lane); }
                else transpose_item(INP(I_WOUT) + (size_t)l * DM * DM, DM, (bf16*)(wl + LW_WOUT), DM, k0, k0, n0, n0, scr, F.lane);
                continue; } r -= I_OUT;
            if (r < 2 * I_G) { const int up = r >= I_G; if (up) r -= I_G; const int nblk = DFF / 32, k0 = 64 * (r / nblk), n0 = 32 * (r % nblk);
                const int orow0 = 256 * (n0 >> 7) + 128 * up + (n0 & 127);
                transpose_item(INP(up ? I_WU : I_WG) + (size_t)l * DM * DFF, DFF, (bf16*)(wl + LW_WGU), DM, k0, k0, n0, orow0, scr, F.lane); continue; } r -= 2 * I_G;
            { const int nblk = DM / 32, k0 = 64 * (r / nblk), n0 = 32 * (r % nblk);
                transpose_item(INP(I_WD) + (size_t)l * DFF * DM, DM, (bf16*)(wl + LW_WD), DFF, k0, k0, n0, n0, scr, F.lane); }
        }
        for (int i = gt; i < NL * 2 * DC * DC; i += NGT) { const int l = i / (2 * DC * DC), which = (i / (DC * DC)) & 1, c = (i / DC) % DC, d = i % DC; float v;
            if (which == 0) v = INP(I_CPW)[((size_t)l * DC + c) * DC + d];
            else v = ((c >> 7) == (d >> 7)) ? INP(I_POOLW)[(((size_t)l * 4 + (c >> 7)) * 128 + (c & 127)) * 128 + (d & 127)] * INP(I_POOLS)[l * DC + d] : 0.f;
            ((bf16*)(F.ws + WS_FB))[i] = (bf16)(pk2(v, 0.f) & 0xffffu); }
        for (int i = gt; i < NL * 4 * 128 * 128; i += NGT) { const int l = i / 65536, r = i % 65536, ii = (r >> 7) & 127, jj = r & 127;
            const float v = (jj <= ii) ? INP(I_SGW)[i] : 0.f; ((bf16*)(lw(F, l) + LW_SGW))[r] = (bf16)(pk2(v, 0.f) & 0xffffu); }
    }
    __syncthreads();
}
__device__ __forceinline__ void p0b_phase(Frame& F) {
    const int gt = F.vcu * (NWAVES * 64) + F.tid, NGT = F.G * NWAVES * 64;
    const float* part = (const float*)(F.ws + WS_MODP); float* mod = (float*)(F.ws + WS_MOD);
    for (int i = gt; i < NL * 12 * NMOD; i += NGT) { const int l = i / (12 * NMOD), n = i % NMOD; float s = INP(I_ADAB)[l * NMOD + n];
#pragma unroll
        for (int ks = 0; ks < KSPLIT; ++ks) s += part[(size_t)ks * NL * 12 * NMOD + i];
        mod[i] = s; }
}
template <bool COPY> struct NormRow { f32x4 f[COPY ? 8 : 1]; v2u h[COPY ? 1 : 8]; };
template <bool COPY> __device__ __forceinline__ void norm_load(Frame& F, NormRow<COPY>& R, int m, const bf16* XB) {
    if constexpr (COPY) { const float* src = m < MP ? INP(I_XP) + (size_t)m * DM : INP(I_XS) + (size_t)(m - MP) * DM; const GAS f32x4* xr = (const GAS f32x4*)src + F.lane;
#pragma unroll
        for (int j = 0; j < 8; ++j) R.f[j] = xr[64 * j]; }
    else { const GAS v2u* xr = (const GAS v2u*)(XB + (size_t)m * DM) + F.lane;
#pragma unroll
        for (int j = 0; j < 8; ++j) R.h[j] = xr[64 * j]; }
}
template <bool COPY> __device__ __forceinline__ void norm_row(Frame& F, const NormRow<COPY>& R, int m, const f32x4 (&gv)[8], const f32x4 (&sv)[8], bf16* H, bf16* XB) {
    f32x4 v[8]; float s = 0.f;
    if constexpr (COPY) { GAS v2u* xo = (GAS v2u*)(XB + (size_t)m * DM) + F.lane;
#pragma unroll
        for (int j = 0; j < 8; ++j) { const f32x4 t = R.f[j]; v2u w; w.x = pk2(t.x, t.y); w.y = pk2(t.z, t.w); xo[64 * j] = w; v[j] = (f32x4){bflo(w.x), bfhi(w.x), bflo(w.y), bfhi(w.y)}; } }
    else {
#pragma unroll
        for (int j = 0; j < 8; ++j) { const v2u d = R.h[j]; v[j] = (f32x4){bflo(d.x), bfhi(d.x), bflo(d.y), bfhi(d.y)}; } }
#pragma unroll
    for (int j = 0; j < 8; ++j) s += (v[j].x * v[j].x + v[j].y * v[j].y) + (v[j].z * v[j].z + v[j].w * v[j].w);
    const float rstd = 1.0f / sqrtf(wave_sum(s) * (1.0f / DM) + EPS);
    GAS v2u* o8 = (GAS v2u*)(H + (size_t)m * DM) + F.lane;
#pragma unroll
    for (int j = 0; j < 8; ++j) { const f32x4 y = v[j] * rstd * gv[j] + sv[j]; v2u w; w.x = pk2(y.x, y.y); w.y = pk2(y.z, y.w); o8[64 * j] = w; }
}
template <bool COPY>
__device__ __forceinline__ void norm_phase(Frame& F, const float* gain, const float* mod_l, int sh_idx, bf16* H, bf16* XB) {
    const int gw = F.vcu * NWAVES + F.wave, NGW = F.G * NWAVES;
    const GAS f32x4* gp = (const GAS f32x4*)gain + F.lane;
    for (int b = 0; b < NBT; ++b) {
        const int r_lo = b < NBP ? b * SEQ : MP + (b - NBP) * TS, r_hi = b < NBP ? r_lo + SEQ : r_lo + TS;
        int m = r_lo + (b < NBP ? gw : gw - TS * (b - NBP)); if (m < r_lo || m >= r_hi) continue;
        const float* mb = mod_l + (size_t)b * NMOD;
        const GAS f32x4* shp = (const GAS f32x4*)(mb + sh_idx * DM) + F.lane; const GAS f32x4* scp = (const GAS f32x4*)(mb + (sh_idx + 1) * DM) + F.lane;
        f32x4 gv[8], sv[8], sc[8];
#pragma unroll
        for (int j = 0; j < 8; ++j) { gv[j] = gp[64 * j]; sc[j] = scp[64 * j]; sv[j] = shp[64 * j]; }
        asm volatile("" ::: "memory");
#pragma unroll
        for (int j = 0; j < 8; ++j) gv[j] = gv[j] * (sc[j] + 1.0f);
        NormRow<COPY> cur, nxt; norm_load<COPY>(F, cur, m, XB);
        for (;;) { const int mn = m + NGW; const bool more = mn < r_hi;
            if (more) norm_load<COPY>(F, nxt, mn, XB);
            norm_row<COPY>(F, cur, m, gv, sv, H, XB);
            if (!more) break;
            cur = nxt; m = mn; }
    }
}
__device__ __forceinline__ void final_norm_phase(Frame& F, const bf16* XB) {
    const int gw = F.vcu * NWAVES + F.wave, NGW = F.G * NWAVES;
    const GAS f32x4* gp = (const GAS f32x4*)INP(I_FING) + F.lane;
    f32x4 gv[8];
#pragma unroll
    for (int j = 0; j < 8; ++j) gv[j] = gp[64 * j];
    int m = gw; if (m >= MT) return;
    v2u cur[8], nxt[8];
    { const GAS v2u* xr = (const GAS v2u*)(XB + (size_t)m * DM) + F.lane;
#pragma unroll
      for (int j = 0; j < 8; ++j) cur[j] = xr[64 * j]; }
    for (;;) { const int mn = m + NGW; const bool more = mn < MT;
        if (more) { const GAS v2u* xr = (const GAS v2u*)(XB + (size_t)mn * DM) + F.lane;
#pragma unroll
            for (int j = 0; j < 8; ++j) nxt[j] = xr[64 * j]; }
        f32x4 v[8]; float s = 0.f;
#pragma unroll
        for (int j = 0; j < 8; ++j) { const v2u d = cur[j]; v[j] = (f32x4){bflo(d.x), bfhi(d.x), bflo(d.y), bfhi(d.y)}; s += (v[j].x * v[j].x + v[j].y * v[j].y) + (v[j].z * v[j].z + v[j].w * v[j].w); }
        const float rstd = 1.0f / sqrtf(wave_sum(s) * (1.0f / DM) + EPS);
        GAS f32x4* yr = (GAS f32x4*)(F.out + (size_t)m * DM) + F.lane;
#pragma unroll
        for (int j = 0; j < 8; ++j) yr[64 * j] = v[j] * rstd * gv[j];
        if (!more) break;
#pragma unroll
        for (int j = 0; j < 8; ++j) cur[j] = nxt[j];
        m = mn; }
}

__device__ __forceinline__ int crow(int r, int hi) { return (r & 3) + 8 * (r >> 2) + 4 * hi; }
#define MFMA32(a, b, c) __builtin_amdgcn_mfma_f32_32x32x16_bf16((a), (b), (c), 0, 0, 0)
constexpr int AT_KP = 144, AT_VP = 192, AT_KB = 64 * AT_KP, AT_VB = 64 * AT_VP;
constexpr int AT_K0 = 0, AT_V0 = 2 * AT_KB, AT_BT = AT_V0 + 2 * AT_VB;
typedef short v4i16_t __attribute__((ext_vector_type(4)));
__device__ __forceinline__ v2u lds_tr_read(LAS unsigned char* p) { const v4i16_t r = __builtin_amdgcn_ds_read_tr16_b64_v4i16((LAS v4i16_t*)p); return __builtin_bit_cast(v2u, r); }
__device__ __forceinline__ float xhalf_max(float v) { auto rr = __builtin_amdgcn_permlane32_swap(__float_as_uint(v), __float_as_uint(v), false, false); return fmaxf(__uint_as_float(rr[0]), __uint_as_float(rr[1])); }
__device__ __forceinline__ float xhalf_sum(float v) { auto rr = __builtin_amdgcn_permlane32_swap(__float_as_uint(v), __float_as_uint(v), false, false); return __uint_as_float(rr[0]) + __uint_as_float(rr[1]); }
__device__ __forceinline__ void attn_unit(Frame& F, int layer, bool sample, int b, int h, int qg, const bf16* Z, bf16* MIX) {
    const int tid = F.tid, lane = F.lane, w = F.wave, l31 = lane & 31, hh = lane >> 5;
    LAS float* bt = (LAS float*)(F.lds + AT_BT);
    if (tid < 257) bt[tid] = INP(I_RELB)[((size_t)layer * 8 + h) * 257 + tid] * LOG2E;
    const bool wave_on = sample ? (w == 0) : true;
    const int qpos = sample ? l31 : 256 * qg + 32 * w + l31;
    const int qrow = sample ? MP + 32 * b + l31 : b * SEQ + qpos;
    bf16x8 qr[4];
#pragma unroll
    for (int d0 = 0; d0 < 4; ++d0) qr[d0] = *(const GAS bf16x8*)(Z + (size_t)qrow * ZW + ZQ + 64 * h + 16 * d0 + 8 * hh);
    f32x16 o0, o1;
#pragma unroll
    for (int r = 0; r < 16; ++r) { o0[r] = 0.f; o1[r] = 0.f; }
    float mrun = -1e30f, lrun = 0.f;
    const int ntile = sample ? 9 : 12, qc = 4 * qg + (w >> 1);
    const int jstart = sample ? 0 : (4 * qg >= 8 ? 0 : 8 - 4 * qg);
    const int sr = tid >> 3, sch = tid & 7;
    const float* ck = INP(I_CK) + ((size_t)layer * NBS + b) * 512 * 512; const float* cv = INP(I_CV) + ((size_t)layer * NBS + b) * 512 * 512;
    v4u kreg = (v4u){0u, 0u, 0u, 0u}, vreg = (v4u){0u, 0u, 0u, 0u};
#define AT_LOAD(j) do { \
        if (!sample) { const bf16* zr_ = Z + (size_t)(b * SEQ + 64 * (4 * qg - 8 + (j)) + sr) * ZW + 64 * h + 8 * sch; kreg = *(const GAS v4u*)(zr_ + ZK); vreg = *(const GAS v4u*)(zr_ + ZV); } \
        else if ((j) < 8) { const size_t o_ = ((size_t)(64 * (j) + sr) * 8 + h) * 64 + 8 * sch; \
                const f32x4 k0_ = *(const GAS f32x4*)(ck + o_), k1_ = *(const GAS f32x4*)(ck + o_ + 4), v0_ = *(const GAS f32x4*)(cv + o_), v1_ = *(const GAS f32x4*)(cv + o_ + 4); \
                kreg = (v4u){pk2(k0_.x, k0_.y), pk2(k0_.z, k0_.w), pk2(k1_.x, k1_.y), pk2(k1_.z, k1_.w)}; vreg = (v4u){pk2(v0_.x, v0_.y), pk2(v0_.z, v0_.w), pk2(v1_.x, v1_.y), pk2(v1_.z, v1_.w)}; } \
        else if (sr < 32) { const bf16* zr_ = Z + (size_t)(MP + 32 * b + sr) * ZW + 64 * h + 8 * sch; kreg = *(const GAS v4u*)(zr_ + ZK); vreg = *(const GAS v4u*)(zr_ + ZV); } \
        else { kreg = (v4u){0u, 0u, 0u, 0u}; vreg = (v4u){0u, 0u, 0u, 0u}; } } while (0)
#define AT_STORE(bf_) do { *(LAS v4u*)(F.lds + AT_K0 + (bf_) * AT_KB + sr * AT_KP + sch * 16) = kreg; *(LAS v4u*)(F.lds + AT_V0 + (bf_) * AT_VB + sr * AT_VP + sch * 16) = vreg; } while (0)
    AT_LOAD(jstart); AT_STORE(0);
    __syncthreads();
    const int tro = ((lane & 15) >> 2) * AT_VP + (16 * ((lane >> 4) & 1) + 4 * (lane & 3)) * 2 + 4 * hh * AT_VP;
    int buf = 0;
    for (int j = jstart; j < ntile; ++j) {
        const int kc = 4 * qg - 8 + j;
        const bool more = j + 1 < ntile;
        if (more) AT_LOAD(j + 1);
        const bool active = sample ? (w == 0) : (kc >= qc - 8 && kc <= qc);
        if (active) {
            LAS unsigned char* Ks = F.lds + AT_K0 + buf * AT_KB; LAS unsigned char* Vs = F.lds + AT_V0 + buf * AT_VB + tro;
            f32x16 p0, p1;
#pragma unroll
            for (int r = 0; r < 16; ++r) { p0[r] = 0.f; p1[r] = 0.f; }
#pragma unroll
            for (int d0 = 0; d0 < 4; ++d0) {
                const bf16x8 a0 = *(const LAS bf16x8*)(Ks + l31 * AT_KP + (16 * d0 + 8 * hh) * 2);
                const bf16x8 a1 = *(const LAS bf16x8*)(Ks + (32 + l31) * AT_KP + (16 * d0 + 8 * hh) * 2);
                p0 = MFMA32(a0, qr[d0], p0); p1 = MFMA32(a1, qr[d0], p1);
            }
            const int kbase = sample ? 64 * j - 512 : 64 * kc;
            const int relb = kbase - qpos;
            const int qmin = sample ? 0 : 256 * qg + 32 * w;
            float boff = 0.f;
            if (kbase + 63 - qmin <= -128) boff = bt[0];
            else {
#pragma unroll
                for (int r = 0; r < 16; ++r) { const int kv = crow(r, hh); int i0 = relb + kv, i1 = i0 + 32;
                    i0 = (i0 < -128 ? -128 : (i0 > 128 ? 128 : i0)) + 128; i1 = (i1 < -128 ? -128 : (i1 > 128 ? 128 : i1)) + 128;
                    p0[r] += bt[i0]; p1[r] += bt[i1]; }
            }
            if (sample && j == 8) {
#pragma unroll
                for (int r = 0; r < 16; ++r) p1[r] = -1e30f;
            }
            float mx = p0[0];
#pragma unroll
            for (int r = 1; r < 16; ++r) mx = fmaxf(mx, p0[r]);
#pragma unroll
            for (int r = 0; r < 16; ++r) mx = fmaxf(mx, p1[r]);
            mx = xhalf_max(mx) + boff;
            const float mn = fmaxf(mrun, mx), msub = mn - boff;
            if (__builtin_amdgcn_ballot_w64(mn > mrun) != 0ull) {
                const float alpha = fast_exp2(mrun - mn); lrun *= alpha;
#pragma unroll
                for (int r = 0; r < 16; ++r) { o0[r] *= alpha; o1[r] *= alpha; }
            }
            mrun = mn;
            float rs = 0.f;
#pragma unroll
            for (int r = 0; r < 16; ++r) { p0[r] = fast_exp2(p0[r] - msub); p1[r] = fast_exp2(p1[r] - msub); rs += p0[r] + p1[r]; }
            lrun += xhalf_sum(rs);
            bf16x8 pf[4];
            { v4u t;
              t = (v4u){pk2(p0[0], p0[1]), pk2(p0[2], p0[3]), pk2(p0[4], p0[5]), pk2(p0[6], p0[7])}; pf[0] = __builtin_bit_cast(bf16x8, t);
              t = (v4u){pk2(p0[8], p0[9]), pk2(p0[10], p0[11]), pk2(p0[12], p0[13]), pk2(p0[14], p0[15])}; pf[1] = __builtin_bit_cast(bf16x8, t);
              t = (v4u){pk2(p1[0], p1[1]), pk2(p1[2], p1[3]), pk2(p1[4], p1[5]), pk2(p1[6], p1[7])}; pf[2] = __builtin_bit_cast(bf16x8, t);
              t = (v4u){pk2(p1[8], p1[9]), pk2(p1[10], p1[11]), pk2(p1[12], p1[13]), pk2(p1[14], p1[15])}; pf[3] = __builtin_bit_cast(bf16x8, t); }
#pragma unroll
            for (int xt = 0; xt < 2; ++xt)
#pragma unroll
                for (int s = 0; s < 2; ++s) { const int ro = (32 * xt + 16 * s) * AT_VP;
                    const v2u lo0 = lds_tr_read(Vs + ro), hi0 = lds_tr_read(Vs + ro + 8 * AT_VP);
                    const v2u lo1 = lds_tr_read(Vs + ro + 64), hi1 = lds_tr_read(Vs + ro + 8 * AT_VP + 64);
                    const v4u f0 = (v4u){lo0.x, lo0.y, hi0.x, hi0.y}, f1 = (v4u){lo1.x, lo1.y, hi1.x, hi1.y};
                    o0 = MFMA32(__builtin_bit_cast(bf16x8, f0), pf[2 * xt + s], o0); o1 = MFMA32(__builtin_bit_cast(bf16x8, f1), pf[2 * xt + s], o1); }
        }
        if (more) AT_STORE(buf ^ 1);
        __syncthreads();
        buf ^= 1;
    }
#undef AT_LOAD
#undef AT_STORE
    if (wave_on) {
        const float inv = 1.0f / lrun;
        bf16* orow = MIX + (size_t)qrow * MIXW + MIX_B + 64 * h;
#pragma unroll
        for (int g4 = 0; g4 < 4; ++g4) { const int d = 8 * g4 + 4 * hh;
            v2u w0; w0.x = pk2(o0[4 * g4] * inv, o0[4 * g4 + 1] * inv); w0.y = pk2(o0[4 * g4 + 2] * inv, o0[4 * g4 + 3] * inv); *(GAS v2u*)(orow + d) = w0;
            v2u w1; w1.x = pk2(o1[4 * g4] * inv, o1[4 * g4 + 1] * inv); w1.y = pk2(o1[4 * g4 + 2] * inv, o1[4 * g4 + 3] * inv); *(GAS v2u*)(orow + 32 + d) = w1; }
    }
}
__device__ __forceinline__ unsigned sg_off(unsigned row, unsigned ch) { return 256u * row + 16u * (ch ^ (((row & 3u) << 2) | ((row >> 2) & 3u))); }
__device__ __forceinline__ void sg_unit(Frame& F, int layer, int ci, const bf16* Z, bf16* MIX) {
    const int lane = F.lane, w = F.wave, l31 = lane & 31, hh = lane >> 5;
    const bool sample = ci >= MP / 128; const int L = sample ? 32 : 128, row0 = sample ? MP + 32 * (ci - MP / 128) : 128 * ci;
    LAS unsigned char* VN = F.lds;
    {
        const int c8 = 8 * lane;
        const GAS f32x4* lgp = (const GAS f32x4*)(INP(I_SGG) + layer * DC + c8); const GAS f32x4* lbp = (const GAS f32x4*)(INP(I_SGB) + layer * DC + c8);
        const f32x4 lg0 = lgp[0], lg1 = lgp[1], lb0 = lbp[0], lb1 = lbp[1];
        const int nrw = L / 8;
        LAS unsigned char* vbase = VN + (lane >> 4) * 32768;
        v4u zrow[16];
#pragma unroll
        for (int i = 0; i < 16; ++i) { if (i < nrw) zrow[i] = *(const GAS v4u*)(Z + (size_t)(row0 + w * nrw + i) * ZW + ZSV + c8); else zrow[i] = (v4u){0u, 0u, 0u, 0u}; }
#pragma unroll
        for (int i = 0; i < 16; ++i) { if (i < nrw) { const int rr = w * nrw + i;
            const v4u zv = zrow[i];
            float x[8] = {bflo(zv.x), bfhi(zv.x), bflo(zv.y), bfhi(zv.y), bflo(zv.z), bfhi(zv.z), bflo(zv.w), bfhi(zv.w)};
            const float s = ((x[0] + x[1]) + (x[2] + x[3])) + ((x[4] + x[5]) + (x[6] + x[7]));
            const float mean = wave_sum(s) * (1.0f / DC); float q = 0.f;
#pragma unroll
            for (int e = 0; e < 8; ++e) { x[e] -= mean; q += x[e] * x[e]; }
            const float rstd = 1.0f / sqrtf(wave_sum(q) * (1.0f / DC) + EPS);
            float y[8];
            y[0] = x[0] * rstd * lg0.x + lb0.x; y[1] = x[1] * rstd * lg0.y + lb0.y; y[2] = x[2] * rstd * lg0.z + lb0.z; y[3] = x[3] * rstd * lg0.w + lb0.w;
            y[4] = x[4] * rstd * lg1.x + lb1.x; y[5] = x[5] * rstd * lg1.y + lb1.y; y[6] = x[6] * rstd * lg1.z + lb1.z; y[7] = x[7] * rstd * lg1.w + lb1.w;
            *(LAS v4u*)(vbase + sg_off((unsigned)rr, (unsigned)(lane & 15))) = (v4u){pk2(y[0], y[1]), pk2(y[2], y[3]), pk2(y[4], y[5]), pk2(y[6], y[7])};
            if (sample) { float* so = F.out + O_SGV + (((size_t)layer * NBS + (ci - MP / 128)) * TS + rr) * DC + c8;
                *(GAS f32x4*)so = (f32x4){y[0], y[1], y[2], y[3]}; *(GAS f32x4*)(so + 4) = (f32x4){y[4], y[5], y[6], y[7]}; }
        } }
    }
    __syncthreads();
    {
        const int g = w >> 1;
        const GAS bf16* Wg = (const GAS bf16*)((const bf16*)(lw(F, layer) + LW_SGW) + (size_t)g * 128 * 128 + (size_t)l31 * 128 + 8 * hh); asm volatile("" : "+v"(Wg));
        LAS unsigned char* vg = VN + g * 32768;
        const int nib = L / 32;
        const unsigned blk = (lane >> 4) & 1, q = (lane & 15) >> 2, p4 = lane & 3;
        bf16x8 Bf[4][8];
#pragma unroll
        for (int ib = 0; ib < 4; ++ib)
#pragma unroll
            for (int s = 0; s < 8; ++s) { if (s < 2 * (ib + 1)) { if (ib < nib) Bf[ib][s] = *(const GAS bf16x8*)(Wg + (32 * ib) * 128 + 16 * s); else Bf[ib][s] = (bf16x8){0, 0, 0, 0, 0, 0, 0, 0}; } }
#pragma unroll
        for (int cbb = 0; cbb < 2; ++cbb) { const int cb = 2 * (w & 1) + cbb;
            f32x16 acc[4];
#pragma unroll
            for (int ib = 0; ib < 4; ++ib)
#pragma unroll
                for (int r = 0; r < 16; ++r) acc[ib][r] = 0.f;
#pragma unroll
            for (int s = 0; s < 8; ++s) { if (s < 2 * nib) {
                const v2u a0 = lds_tr_read(vg + sg_off(16u * s + 8u * hh + q, 4u * cb + 2u * blk + (p4 >> 1)) + 8u * (p4 & 1));
                const v2u a1 = lds_tr_read(vg + sg_off(16u * s + 8u * hh + 4u + q, 4u * cb + 2u * blk + (p4 >> 1)) + 8u * (p4 & 1));
                const v4u af = (v4u){a0.x, a0.y, a1.x, a1.y};
#pragma unroll
                for (int ib = 0; ib < 4; ++ib) { if (s < 2 * (ib + 1)) { if (ib < nib) acc[ib] = MFMA32(__builtin_bit_cast(bf16x8, af), Bf[ib][s], acc[ib]); } }
            } }
#pragma unroll
            for (int ib = 0; ib < 4; ++ib) { if (ib < nib) {
                    const int i = 32 * ib + l31, row = row0 + i; const float bias = INP(I_SGBIAS)[((size_t)layer * 4 + g) * 128 + i];
                    v2u zuv[4];
#pragma unroll
                    for (int rg = 0; rg < 4; ++rg) zuv[rg] = *(const GAS v2u*)(Z + (size_t)row * ZW + ZSU + 128 * g + 32 * cb + 8 * rg + 4 * hh);
#pragma unroll
                    for (int rg = 0; rg < 4; ++rg) { const int c4 = 32 * cb + 8 * rg + 4 * hh;
                        const v2u zu = zuv[rg];
                        v2u o; o.x = pk2(bflo(zu.x) * (acc[ib][4 * rg] + bias), bfhi(zu.x) * (acc[ib][4 * rg + 1] + bias)); o.y = pk2(bflo(zu.y) * (acc[ib][4 * rg + 2] + bias), bfhi(zu.y) * (acc[ib][4 * rg + 3] + bias));
                        *(GAS v2u*)(MIX + (size_t)row * MIXW + MIX_D + 128 * g + c4) = o; } } }
        }
    }
    __syncthreads();
}
struct ConvCtx { const GAS unsigned char* zb; const GAS unsigned char* hist; GAS unsigned char* cst; bool sample, first, keep; };
template <int E> __device__ __forceinline__ void conv_load(unsigned (&ex)[62], const ConvCtx& X) {
    if constexpr (E < 30) { if (X.sample) { const f32x2 hv = *(const GAS f32x2*)(X.hist + (size_t)E * DC * 4); ex[E] = pk2(hv.x, hv.y); }
                            else if (X.first) ex[E] = 0u;
                            else ex[E] = *(const GAS unsigned*)(X.zb + (size_t)E * ZW * 2); }
    else ex[E] = *(const GAS unsigned*)(X.zb + (size_t)E * ZW * 2);
}
template <int... Es> __device__ __forceinline__ void conv_loads(unsigned (&ex)[62], const ConvCtx& X, std::integer_sequence<int, Es...>) { (conv_load<Es>(ex, X), ...); }
template <int E> __device__ __forceinline__ void conv_row(f32x2 (&acc)[32], const f32x2 (&wt)[31], const unsigned (&ex)[62], const ConvCtx& X) {
    const f32x2 v = (f32x2){bflo(ex[E]), bfhi(ex[E])};
    constexpr int T0 = E > 30 ? E - 30 : 0, T1 = E < 31 ? E : 31;
#pragma unroll
    for (int t = T0; t <= T1; ++t) acc[t] = wt[E - t] * v + acc[t];
    if constexpr (E >= 32) { if (X.keep) *(GAS f32x2*)(X.cst + (size_t)(E - 32) * DC * 4) = v; }
}
template <int... Es> __device__ __forceinline__ void conv_rows(f32x2 (&acc)[32], const f32x2 (&wt)[31], const unsigned (&ex)[62], const ConvCtx& X, std::integer_sequence<int, Es...>) { (conv_row<Es>(acc, wt, ex, X), ...); }
__device__ __forceinline__ void conv_unit(Frame& F, int layer, int tb, int cq, const bf16* Z, bf16* CA, int ca_pitch) {
    const int c = 128 * cq + 2 * F.lane; const bool sample = tb >= MP / 32; const int sb = tb - MP / 32;
    const int r0 = sample ? MP + 32 * sb : 32 * tb; const bool first = !sample && ((r0 & (SEQ - 1)) == 0);
    ConvCtx X; X.sample = sample; X.first = first; X.keep = sample || ((r0 & (SEQ - 1)) == SEQ - 32);
    X.zb = (const GAS unsigned char*)(Z + ((long)r0 - 30) * ZW + ZU + c); asm volatile("" : "+v"(X.zb));
    const GAS unsigned char* wb = (const GAS unsigned char*)(INP(I_CONVW) + (size_t)layer * 31 * DC + c); asm volatile("" : "+v"(wb));
    f32x2 wt[31];
#pragma unroll
    for (int j = 0; j < 31; ++j) wt[j] = *(const GAS f32x2*)(wb + (size_t)j * DC * 4);
    const f32x2 cbias = *(const GAS f32x2*)(INP(I_CONVB) + layer * DC + c), gg = *(const GAS f32x2*)(INP(I_GNG) + layer * DC + c), gb = *(const GAS f32x2*)(INP(I_GNB) + layer * DC + c);
    f32x2 acc[32];
#pragma unroll
    for (int t = 0; t < 32; ++t) acc[t] = cbias;
    X.hist = (const GAS unsigned char*)(INP(I_CCONV) + ((size_t)layer * NBS + (sample ? sb : 0)) * 30 * DC + c); asm volatile("" : "+v"(X.hist));
    X.cst = (GAS unsigned char*)(sample ? F.out + O_CONVS + ((size_t)layer * NBS + sb) * 30 * DC + c : F.out + O_CONVP + ((size_t)layer * NBP + (r0 >> 13)) * 30 * DC + c); asm volatile("" : "+v"(X.cst));
    GAS unsigned char* cab = (GAS unsigned char*)(CA + (size_t)r0 * ca_pitch + c); asm volatile("" : "+v"(cab));
    unsigned ex[62];
    conv_loads(ex, X, std::make_integer_sequence<int, 62>{});
    asm volatile("" ::: "memory");
    conv_rows(acc, wt, ex, X, std::make_integer_sequence<int, 62>{});
#pragma unroll
    for (int t = 0; t < 32; ++t) {
        const f32x2 y = acc[t];
        const float s = half32_sum(y.x + y.y), q = half32_sum(y.x * y.x + y.y * y.y);
        const float mean = s * (1.0f / 64.0f), var = fmaxf(q * (1.0f / 64.0f) - mean * mean, 0.f), rstd = 1.0f / sqrtf(var + EPS);
        const f32x2 n = (y - mean) * rstd * gg + gb;
        *(GAS unsigned*)(cab + (size_t)t * ca_pitch * 2) = pk2(siluf_(n.x), siluf_(n.y));
    }
}
template <int W>
__device__ __forceinline__ void pool_body(Frame& F, int layer, int tb, int cq, const bf16* Z, bf16* PM, int pm_pitch) {
    const int c = 128 * cq + 2 * F.lane; const bool sample = tb >= MP / 32; const int sb = tb - MP / 32;
    const int r0 = sample ? MP + 32 * sb : 32 * tb; const bool first = !sample && ((r0 & (SEQ - 1)) == 0);
    const GAS unsigned char* hist = (const GAS unsigned char*)(INP(I_CPOOL) + ((size_t)layer * NBS + (sample ? sb : 0)) * 15 * DC + c); asm volatile("" : "+v"(hist));
    const bool last_blk = !sample && ((r0 & (SEQ - 1)) == SEQ - 32);
    GAS unsigned char* pst = (GAS unsigned char*)(sample ? F.out + O_POOLS + ((size_t)layer * NBS + sb) * 15 * DC + c : F.out + O_POOLP + ((size_t)layer * NBP + (r0 >> 13)) * 15 * DC + c); asm volatile("" : "+v"(pst));
    const GAS unsigned char* zb = (const GAS unsigned char*)(Z + ((long)r0 - 15) * ZW + ZP + c); asm volatile("" : "+v"(zb));
    GAS unsigned char* pmb = (GAS unsigned char*)(PM + (size_t)r0 * pm_pitch + c); asm volatile("" : "+v"(pmb));
    unsigned raw[47];
#pragma unroll
    for (int e = 0; e < 47; ++e) {
        if (e < 15) { if (sample) { const f32x2 hv = *(const GAS f32x2*)(hist + (size_t)e * DC * 4); raw[e] = pk2(hv.x, hv.y); }
                      else if (first) raw[e] = 0u;
                      else raw[e] = *(const GAS unsigned*)(zb + (size_t)e * ZW * 2); }
        else raw[e] = *(const GAS unsigned*)(zb + (size_t)e * ZW * 2);
    }
    asm volatile("" ::: "memory");
    f32x2 ext[47];
#pragma unroll
    for (int e = 0; e < 47; ++e) ext[e] = (f32x2){bflo(raw[e]), bfhi(raw[e])};
#pragma unroll
    for (int t = 0; t < 32; ++t) {
        f32x2 win = (f32x2){0.f, 0.f};
#pragma unroll
        for (int i = W - 1; i >= 0; --i) win += ext[15 + t - i];
        const float rc = 1.0f / (float)((first && t + 1 < W) ? t + 1 : W);
        const f32x2 m = win * rc - ext[15 + t];
        *(GAS unsigned*)(pmb + (size_t)t * pm_pitch * 2) = pk2(m.x, m.y);
        if (t >= 17 && (sample || last_blk)) *(GAS f32x2*)(pst + (size_t)(t - 17) * DC * 4) = ext[15 + t];
    }
}
#define MIX_FENCE() do { int t_ = F.tid; asm volatile("" : "+v"(t_)); F.tid = t_; F.lane = t_ & 63; } while (0)
__device__ __forceinline__ void mixer_phase(Frame& F, int layer) {
    const bf16* Z = (const bf16*)(F.ws + WS_Z); bf16* MIX = (bf16*)(F.ws + WS_MIX); bf16* CA = MIX + MIX_A; bf16* PM = MIX + MIX_C;
#ifndef PROBE_MIX
#define PROBE_MIX 0
#endif
#define MDUP(k) _Pragma("unroll") for (int mrep_ = 0; mrep_ < 1 + ((PROBE_MIX >> (k)) & 1); ++mrep_)
    MDUP(0) { for (int id = F.vcu; id < NBP * 8 * 32; id += F.G) attn_unit(F, layer, false, id >> 8, (id >> 5) & 7, id & 31, Z, MIX);
    for (int id = F.vcu - 192; id >= 0 && id < NBS * 8; id += F.G) attn_unit(F, layer, true, id >> 3, id & 7, 0, Z, MIX); }
    MIX_FENCE();
    MDUP(1) { for (int id = F.vcu; id < MP / 128; id += F.G) sg_unit(F, layer, id, Z, MIX);
    for (int id = F.vcu - 96; id >= 0 && id < NBS; id += F.G) sg_unit(F, layer, MP / 128 + id, Z, MIX); }
    const int gw = F.vcu * NWAVES + F.wave, NGW = F.G * NWAVES;
    MIX_FENCE();
    MDUP(2) { for (int id = gw; id < (MP / 32) * 4; id += NGW) conv_unit(F, layer, id >> 2, id & 3, Z, CA, MIXW);
    if (F.wave == 0 && F.vcu >= 128 && F.vcu < 160) { const int id = (MP / 32) * 4 + F.vcu - 128; conv_unit(F, layer, id >> 2, id & 3, Z, CA, MIXW); } }
    MIX_FENCE();
    MDUP(3) for (int it = 0; it < 3; ++it) { int id = gw + it * NGW;
        if (it == 2) { if (F.wave == 0 && F.vcu >= 160 && F.vcu < 192) id = (MP / 32) * 4 + F.vcu - 160; else break; }
        const int tb = id >> 2, cq = id & 3;
        switch (cq) { case 0: pool_body<2>(F, layer, tb, cq, Z, PM, MIXW); break; case 1: pool_body<4>(F, layer, tb, cq, Z, PM, MIXW); break;
                      case 2: pool_body<8>(F, layer, tb, cq, Z, PM, MIXW); break; default: pool_body<16>(F, layer, tb, cq, Z, PM, MIXW); break; } }
    MIX_FENCE();
    const int gt = F.vcu * (NWAVES * 64) + F.tid, NGT = F.G * NWAVES * 64;
    for (int i = gt; i < (NBP * 512 + NBS * TS) * 128; i += NGT) {
        const int rr = i >> 7, kv = (i >> 6) & 1, ch = i & 63;
        int zrow; size_t o;
        if (rr < NBP * 512) { const int b = rr >> 9, t = rr & 511; zrow = b * SEQ + SEQ - 512 + t; o = (kv ? O_VP : O_KP) + (((size_t)layer * NBP + b) * 512 + t) * 512 + 8 * ch; }
        else { const int r2 = rr - NBP * 512, b = r2 >> 5, t = r2 & 31; zrow = MP + r2; o = (kv ? O_VS : O_KS) + (((size_t)layer * NBS + b) * TS + t) * 512 + 8 * ch; }
        const v4u z = *(const GAS v4u*)(Z + (size_t)zrow * ZW + (kv ? ZV : ZK) + 8 * ch);
        *(GAS f32x4*)(F.out + o) = (f32x4){bflo(z.x), bfhi(z.x), bflo(z.y), bfhi(z.y)}; *(GAS f32x4*)(F.out + o + 4) = (f32x4){bflo(z.z), bfhi(z.z), bflo(z.w), bfhi(z.w)};
    }
}

enum { SK_Z = 0, SK_MIX2 = 1, SK_RES = 2, SK_SWI = 3 };
struct SkUnit { int row0, nb0, nb1, ocol0, ocol1; bool pair; float scale; };
template <int KIND, int NTB, int U>
__device__ __forceinline__ void sk_unit(Frame& F, const bf16* A, const bf16* Bt, int K, const SkUnit& u, bf16* obf, int opitch, float* X, const float* gate) {
    const int lane = F.lane, w = F.wave, l31 = lane & 31, hh = lane >> 5;
    const int kw = K >> 3, nch = kw >> 6;
    constexpr int NR = 32 * NTB + 64, NLD = NR / 8;
    LAS unsigned char* stg = F.lds + w * 16384;
    const int lr = lane >> 3, lc = lane & 7;
    const GAS unsigned char* src[NLD];
#pragma unroll
    for (int i = 0; i < NLD; ++i) { const int r = 8 * i + lr;
        const bf16* base = (r < 32 * NTB) ? A + (size_t)(u.row0 + r) * K : (r < 32 * NTB + 32) ? Bt + (size_t)(u.nb0 + r - 32 * NTB) * K : Bt + (size_t)(u.nb1 + r - 32 * NTB - 32) * K;
        src[i] = (const GAS unsigned char*)(base + w * kw + 8 * lc); }
    f32x16 acc[NTB][2];
#pragma unroll
    for (int tb = 0; tb < NTB; ++tb)
#pragma unroll
        for (int c = 0; c < 2; ++c)
#pragma unroll
            for (int r = 0; r < 16; ++r) acc[tb][c][r] = 0.f;
    v4u R[NLD];
#pragma unroll
    for (int i = 0; i < NLD; ++i) R[i] = *(const GAS v4u*)(src[i]);
    for (int ch = 0; ch < nch; ++ch) {
#pragma unroll
        for (int i = 0; i < NLD; ++i) { const int r = 8 * i + lr; *(LAS v4u*)(stg + r * 128 + 16 * (lc ^ (r & 7))) = R[i]; }
        if (ch + 1 < nch) {
#pragma unroll
            for (int i = 0; i < NLD; ++i) R[i] = *(const GAS v4u*)(src[i] + (size_t)(ch + 1) * 128); }
#pragma unroll
        for (int s = 0; s < 4; ++s) { const int cx = 16 * ((2 * s + hh) ^ (l31 & 7));
            bf16x8 xf[NTB];
#pragma unroll
            for (int tb = 0; tb < NTB; ++tb) xf[tb] = *(const LAS bf16x8*)(stg + (32 * tb + l31) * 128 + cx);
            const bf16x8 w0 = *(const LAS bf16x8*)(stg + (32 * NTB + l31) * 128 + cx), w1 = *(const LAS bf16x8*)(stg + (32 * NTB + 32 + l31) * 128 + cx);
#pragma unroll
            for (int tb = 0; tb < NTB; ++tb) { acc[tb][0] = MFMA32(w0, xf[tb], acc[tb][0]); acc[tb][1] = MFMA32(w1, xf[tb], acc[tb][1]); }
        }
    }
    __syncthreads();
    LAS f32x4* red = (LAS f32x4*)F.lds;
#pragma unroll
    for (int tb = 0; tb < NTB; ++tb)
#pragma unroll
        for (int c = 0; c < 2; ++c)
#pragma unroll
            for (int rg = 0; rg < 4; ++rg) red[((((w * NTB + tb) * 2 + c) * 4 + rg) << 6) + lane] = (f32x4){acc[tb][c][4 * rg], acc[tb][c][4 * rg + 1], acc[tb][c][4 * rg + 2], acc[tb][c][4 * rg + 3]};
    __syncthreads();
    {
        const int rg = w & 3, tb = (NTB == 2) ? (w >> 2) : 0, c_lo = (NTB == 2) ? 0 : (w >> 2), c_hi = (NTB == 2) ? 2 : (w >> 2) + 1;
        f32x4 v[2] = {(f32x4){0.f, 0.f, 0.f, 0.f}, (f32x4){0.f, 0.f, 0.f, 0.f}};
#pragma unroll
        for (int c = 0; c < 2; ++c) { if (c >= c_lo && c < c_hi) {
#pragma unroll
                for (int w2 = 0; w2 < 8; ++w2) v[c] += red[((((w2 * NTB + tb) * 2 + c) * 4 + rg) << 6) + lane]; } }
        const int row = u.row0 + 32 * tb + l31, co = 8 * rg + 4 * hh;
        if (KIND == SK_Z) {
            if (u.pair) { v2u o; o.x = pk2(v[0][0] * sigmoidf_(v[1][0]), v[0][1] * sigmoidf_(v[1][1])); o.y = pk2(v[0][2] * sigmoidf_(v[1][2]), v[0][3] * sigmoidf_(v[1][3]));
                *(GAS v2u*)(obf + (size_t)row * opitch + u.ocol0 + co) = o; }
            else {
#pragma unroll
                for (int c = 0; c < 2; ++c) { const f32x4 y = v[c] * u.scale; v2u o; o.x = pk2(y[0], y[1]); o.y = pk2(y[2], y[3]); *(GAS v2u*)(obf + (size_t)row * opitch + (c ? u.ocol1 : u.ocol0) + co) = o; } }
        } else if (KIND == SK_MIX2) {
#pragma unroll
            for (int c = 0; c < 2; ++c) { v2u o; o.x = pk2(v[c][0], v[c][1]); o.y = pk2(v[c][2], v[c][3]); *(GAS v2u*)(obf + (size_t)row * opitch + (c ? u.ocol1 : u.ocol0) + co) = o; }
        } else if (KIND == SK_SWI) {
            v2u o; o.x = pk2(siluf_(v[0][0]) * v[1][0], siluf_(v[0][1]) * v[1][1]); o.y = pk2(siluf_(v[0][2]) * v[1][2], siluf_(v[0][3]) * v[1][3]);
            *(GAS v2u*)(obf + (size_t)row * opitch + u.ocol0 + co) = o;
        } else {
            const int c = w >> 2, col = (c ? u.ocol1 : u.ocol0) + co;
            const f32x4 g = *(const GAS f32x4*)(gate + (size_t)batch_of_row(row) * NMOD + col); GAS v2u* xp = (GAS v2u*)(obf + (size_t)row * opitch + col); const v2u xo = *xp;
            const f32x4 y = g * v[c] + (f32x4){bflo(xo.x), bfhi(xo.x), bflo(xo.y), bfhi(xo.y)};
            v2u o; o.x = pk2(y[0], y[1]); o.y = pk2(y[2], y[3]); *xp = o;
        }
    }
    __syncthreads();
}
constexpr int NPL = 7, N_PHASES = 2 + NPL * NL + 1;

__global__ void __launch_bounds__(NWAVES * 64, 2) enc_fwd(Args args) {
    extern __shared__ __attribute__((aligned(16))) unsigned char lds[];
    Frame F;
    F.lds = (LAS unsigned char*)lds;
    F.tid = threadIdx.x; F.lane = F.tid & 63; F.wave = __builtin_amdgcn_readfirstlane(F.tid >> 6);
    F.G = gridDim.x; { const int bx = blockIdx.x; F.vcu = (F.G % 8 == 0) ? (bx % 8) * (F.G / 8) + bx / 8 : bx; }
    F.ka = (KArgs)__builtin_amdgcn_kernarg_segment_ptr();
    F.out = args.out; F.ws = args.ws;
    volatile LAS unsigned* MISC = (volatile LAS unsigned*)(F.lds + MISC_OFF);
    for (int u = F.tid; u < (LDS_BYTES - LDSCTL_OFF) / 4; u += NWAVES * 64) ((LAS unsigned*)(F.lds + LDSCTL_OFF))[u] = 0u;
    __syncthreads();
    const int lo = args.ph_lo, hi = args.ph_hi;
#define REFRESH() do { int t_ = threadIdx.x; asm volatile("" : "+v"(t_)); F.tid = t_; F.lane = t_ & 63; F.wave = __builtin_amdgcn_readfirstlane(t_ >> 6); \
        unsigned long long w_ = (unsigned long long)args.ws, o_ = (unsigned long long)args.out, k_ = (unsigned long long)__builtin_amdgcn_kernarg_segment_ptr(); \
        asm volatile("" : "+s"(w_), "+s"(o_), "+s"(k_)); F.ws = (unsigned char*)(GAS unsigned char*)w_; F.out = (float*)(GAS float*)o_; F.ka = (KArgs)k_; \
        unsigned l_ = (unsigned)(unsigned long long)(LAS unsigned char*)lds; asm volatile("" : "+s"(l_)); F.lds = (LAS unsigned char*)(unsigned long long)l_; } while (0)
    XcdBarrier bar; bar.bar = (unsigned*)(F.ws + WS_CTL) + CW_BAR; bar.x = 0; bar.st = nullptr;
    if (hi - lo > 1) bar = xcd_barrier_post((unsigned*)(F.ws + WS_CTL) + CW_BAR, MISC + 8);
#ifdef ONLY_PHASE
#define IN(k) ((((k) < 2 || (k) == N_PHASES - 1) ? (k) : 2 + ((k) - 2) % NPL) == ONLY_PHASE && lo <= (k) && (k) < hi)
#else
#define IN(k) (lo <= (k) && (k) < hi)
#endif
#ifndef PROBE_DUP
#define PROBE_DUP 0
#endif
#define DUP(k) _Pragma("unroll") for (int rep_ = 0; rep_ < 1 + ((PROBE_DUP >> (k)) & 1); ++rep_)
#ifndef STAGGER_TICKS
#define STAGGER_TICKS 0
#endif
#define STAGGER(ticks) do { if ((ticks) > 0 && (blockIdx.x & 8)) { const unsigned long long t0_ = __builtin_amdgcn_s_memrealtime(); while (__builtin_amdgcn_s_memrealtime() - t0_ < (unsigned long long)(ticks)) __builtin_amdgcn_s_sleep(8); } } while (0)
#define SEAM(k) do { if (IN(k) && IN((k) + 1)) { XcdBarrier b_ = bar; unsigned long long p_ = (unsigned long long)b_.bar; asm volatile("" : "+s"(p_)); b_.bar = (unsigned*)p_; xcd_barrier(b_); } } while (0)

    if (IN(0)) DUP(8) { REFRESH(); p0a_phase(F); } SEAM(0);
    if (IN(1)) { REFRESH(); p0b_phase(F);
        pg8::Gemm g{(const bf16*)(F.ws + WS_TA), (const bf16*)(F.ws + WS_FB), NL * 2 * DM, NL * 2 * DC, DC}; pg8::FoldOrder S{F.G, (int)blockIdx.x}; pg8::EpiFold E{F.ws + WS_W, LW, LW_WOUT};
        pg8::gemm_phase<pg8::EpiFold, pg8::FoldOrder, true, true>(F.lds, g, S, E); } SEAM(1);
    for (int l = 0; l < NL; ++l) {
        const int pb = 2 + NPL * l;
        if (IN(pb + 0)) DUP(0) { REFRESH(); bf16* H = (bf16*)(F.ws + WS_H); bf16* Zb = (bf16*)(F.ws + WS_Z); bf16* MIX = (bf16*)(F.ws + WS_MIX); bf16* HID = (bf16*)(F.ws + WS_HID); bf16* CAPM = (bf16*)(F.ws + WS_CAPM); bf16* XB = (bf16*)(F.ws + WS_XB); (void)XB; (void)H; (void)Zb; (void)MIX; (void)HID; (void)CAPM; const float* mod_l = modp(F, l); unsigned char* wl = lw(F, l); (void)mod_l; (void)wl; if (l == 0) norm_phase<true>(F, INP(I_N1) + l * DM, mod_l, 0, H, XB); else norm_phase<false>(F, INP(I_N1) + l * DM, mod_l, 0, H, XB); } SEAM(pb + 0);
        if (IN(pb + 1)) DUP(1) { REFRESH(); bf16* H = (bf16*)(F.ws + WS_H); bf16* Zb = (bf16*)(F.ws + WS_Z); bf16* MIX = (bf16*)(F.ws + WS_MIX); bf16* HID = (bf16*)(F.ws + WS_HID); bf16* CAPM = (bf16*)(F.ws + WS_CAPM); bf16* XB = (bf16*)(F.ws + WS_XB); (void)XB; (void)H; (void)Zb; (void)MIX; (void)HID; (void)CAPM; const float* mod_l = modp(F, l); unsigned char* wl = lw(F, l); (void)mod_l; (void)wl; pg8::Gemm g{H, (const bf16*)(wl + LW_WIN), MP, DIN, DM}; pg8::StaticOrder S; S.init(MP, DIN, F.G, (int)blockIdx.x); int dry_ = (PROBE_DRY != 0) && (rep_ == 1); asm volatile("" : "+s"(dry_)); pg8::EpiZ E{Zb, dry_};
            pg8::gemm_phase<pg8::EpiZ, pg8::StaticOrder, true, true>(F.lds, g, S, E);
            for (int su = F.vcu; su < 4 * 64; su += F.G) { const int rt = su & 3, cb = su >> 2; SkUnit u; u.row0 = MP + 64 * rt;
                if (cb < 16) { const int tt = cb >> 2, x0 = 32 * (cb & 3); u.nb0 = 256 * tt + x0; u.nb1 = u.nb0 + 128; u.ocol0 = 128 * tt + x0; u.ocol1 = 0; u.pair = true; u.scale = 1.f; }
                else { const int pbk = cb - 16; u.nb0 = 1024 + 64 * pbk; u.nb1 = u.nb0 + 32; u.ocol0 = 512 + 64 * pbk; u.ocol1 = u.ocol0 + 32; u.pair = false; u.scale = (u.nb0 < 1536) ? QSCALE : 1.f; }
                sk_unit<SK_Z, 2, 8>(F, H, (const bf16*)(wl + LW_WIN), DM, u, Zb, ZW, nullptr, nullptr); } } SEAM(pb + 1);
        if (IN(pb + 2)) DUP(2) { REFRESH(); bf16* H = (bf16*)(F.ws + WS_H); bf16* Zb = (bf16*)(F.ws + WS_Z); bf16* MIX = (bf16*)(F.ws + WS_MIX); bf16* HID = (bf16*)(F.ws + WS_HID); bf16* CAPM = (bf16*)(F.ws + WS_CAPM); bf16* XB = (bf16*)(F.ws + WS_XB); (void)XB; (void)H; (void)Zb; (void)MIX; (void)HID; (void)CAPM; const float* mod_l = modp(F, l); unsigned char* wl = lw(F, l); (void)mod_l; (void)wl; mixer_phase(F, l); } SEAM(pb + 2);
        if (IN(pb + 3)) DUP(3) { REFRESH(); bf16* H = (bf16*)(F.ws + WS_H); bf16* Zb = (bf16*)(F.ws + WS_Z); bf16* MIX = (bf16*)(F.ws + WS_MIX); bf16* HID = (bf16*)(F.ws + WS_HID); bf16* CAPM = (bf16*)(F.ws + WS_CAPM); bf16* XB = (bf16*)(F.ws + WS_XB); (void)XB; (void)H; (void)Zb; (void)MIX; (void)HID; (void)CAPM; const float* mod_l = modp(F, l); unsigned char* wl = lw(F, l); (void)mod_l; (void)wl; STAGGER(STAGGER_G3); pg8::Gemm g{MIX, (const bf16*)(wl + LW_WOUT), MP, DM, DM}; pg8::StaticOrder S; S.init(MP, DM, F.G, (int)blockIdx.x); int dry_ = (PROBE_DRY != 0) && (rep_ == 1); asm volatile("" : "+s"(dry_)); pg8::EpiResB E{XB, mod_l + 2 * DM, dry_};
            pg8::gemm_phase<pg8::EpiResB, pg8::StaticOrder, true, true>(F.lds, g, S, E);
            if (!dry_) for (int su = F.vcu; su < 8 * 32; su += F.G) { const int rt = su & 7, cb = su >> 3; SkUnit u; u.row0 = MP + 32 * rt; u.nb0 = 64 * cb; u.nb1 = u.nb0 + 32; u.ocol0 = u.nb0; u.ocol1 = u.nb1; u.pair = false; u.scale = 1.f;
                sk_unit<SK_RES, 1, 8>(F, MIX, (const bf16*)(wl + LW_WOUT), DM, u, XB, DM, nullptr, mod_l + 2 * DM); } } SEAM(pb + 3);
        if (IN(pb + 4)) DUP(4) { REFRESH(); bf16* H = (bf16*)(F.ws + WS_H); bf16* Zb = (bf16*)(F.ws + WS_Z); bf16* MIX = (bf16*)(F.ws + WS_MIX); bf16* HID = (bf16*)(F.ws + WS_HID); bf16* CAPM = (bf16*)(F.ws + WS_CAPM); bf16* XB = (bf16*)(F.ws + WS_XB); (void)XB; (void)H; (void)Zb; (void)MIX; (void)HID; (void)CAPM; const float* mod_l = modp(F, l); unsigned char* wl = lw(F, l); (void)mod_l; (void)wl; norm_phase<false>(F, INP(I_N2) + l * DM, mod_l, 3, H, XB); } SEAM(pb + 4);
        if (IN(pb + 5)) DUP(5) { REFRESH(); bf16* H = (bf16*)(F.ws + WS_H); bf16* Zb = (bf16*)(F.ws + WS_Z); bf16* MIX = (bf16*)(F.ws + WS_MIX); bf16* HID = (bf16*)(F.ws + WS_HID); bf16* CAPM = (bf16*)(F.ws + WS_CAPM); bf16* XB = (bf16*)(F.ws + WS_XB); (void)XB; (void)H; (void)Zb; (void)MIX; (void)HID; (void)CAPM; const float* mod_l = modp(F, l); unsigned char* wl = lw(F, l); (void)mod_l; (void)wl; pg8::Gemm g{H, (const bf16*)(wl + LW_WGU), MP, 2 * DFF, DM}; pg8::StaticOrder S; S.init(MP, 2 * DFF, F.G, (int)blockIdx.x); pg8::EpiSwi E{HID};
            pg8::gemm_phase<pg8::EpiSwi, pg8::StaticOrder, true, true>(F.lds, g, S, E);
            for (int su = F.vcu; su < 4 * 176; su += F.G) { const int rt = su & 3, cb = su >> 2, tt = cb >> 2, x0 = 32 * (cb & 3); SkUnit u; u.row0 = MP + 64 * rt; u.nb0 = 256 * tt + x0; u.nb1 = u.nb0 + 128;
                u.ocol0 = 128 * tt + x0; u.ocol1 = 0; u.pair = true; u.scale = 1.f;
                sk_unit<SK_SWI, 2, 8>(F, H, (const bf16*)(wl + LW_WGU), DM, u, HID, DFF, nullptr, nullptr); } } SEAM(pb + 5);
        if (IN(pb + 6)) DUP(6) { REFRESH(); bf16* H = (bf16*)(F.ws + WS_H); bf16* Zb = (bf16*)(F.ws + WS_Z); bf16* MIX = (bf16*)(F.ws + WS_MIX); bf16* HID = (bf16*)(F.ws + WS_HID); bf16* CAPM = (bf16*)(F.ws + WS_CAPM); bf16* XB = (bf16*)(F.ws + WS_XB); (void)XB; (void)H; (void)Zb; (void)MIX; (void)HID; (void)CAPM; const float* mod_l = modp(F, l); unsigned char* wl = lw(F, l); (void)mod_l; (void)wl; STAGGER(STAGGER_G5); pg8::Gemm g{HID, (const bf16*)(wl + LW_WD), MP, DM, DFF}; pg8::StaticOrder S; S.init(MP, DM, F.G, (int)blockIdx.x); int dry_ = (PROBE_DRY != 0) && (rep_ == 1); asm volatile("" : "+s"(dry_)); pg8::EpiResB E{XB, mod_l + 5 * DM, dry_};
            pg8::gemm_phase<pg8::EpiResB, pg8::StaticOrder, true, true>(F.lds, g, S, E);
            if (!dry_) for (int su = F.vcu; su < 8 * 32; su += F.G) { const int rt = su & 7, cb = su >> 3; SkUnit u; u.row0 = MP + 32 * rt; u.nb0 = 64 * cb; u.nb1 = u.nb0 + 32; u.ocol0 = u.nb0; u.ocol1 = u.nb1; u.pair = false; u.scale = 1.f;
                sk_unit<SK_RES, 1, 11>(F, HID, (const bf16*)(wl + LW_WD), DFF, u, XB, DM, nullptr, mod_l + 5 * DM); } } SEAM(pb + 6);
    }
    if (IN(N_PHASES - 1)) { REFRESH(); final_norm_phase(F, (const bf16*)(F.ws + WS_XB)); }
#undef IN
#undef SEAM
}

extern "C" void kernel_launch(void* const* d_in, const int* in_sizes, int n_in, void* d_out, int out_size, void* d_ws, size_t ws_size, hipStream_t stream) {
    static int grid = 0;
    if (grid == 0) {
        if (n_in != N_IN || in_sizes[0] != MP * DM || (size_t)out_size != O_END || ws_size < WS_END) {
            fprintf(stderr, "kernel_launch: unexpected shapes: n_in %d in0 %d out %d ws %zu (need %zu); nothing launched\n", n_in, n_in > 0 ? in_sizes[0] : -1, out_size, ws_size, (size_t)WS_END); grid = -1; return; }
        int dev = 0, cus = 0;
        if (hipGetDevice(&dev) != hipSuccess || hipDeviceGetAttribute(&cus, hipDeviceAttributeMultiprocessorCount, dev) != hipSuccess) { grid = -1; return; }
        if (hipFuncSetAttribute((const void*)enc_fwd, hipFuncAttributeMaxDynamicSharedMemorySize, LDS_BYTES) != hipSuccess) { fprintf(stderr, "kernel_launch: hipFuncSetAttribute failed\n"); grid = -1; return; }
        int per_cu = 0;
        if (hipOccupancyMaxActiveBlocksPerMultiprocessor(&per_cu, (const void*)enc_fwd, NWAVES * 64, LDS_BYTES) != hipSuccess || per_cu < 1)
            fprintf(stderr, "kernel_launch: note: occupancy query reports %d workgroups per CU\n", per_cu);
        (void)hipGetLastError();
        grid = cus;
    }
    if (grid < 0) return;
    if (hipMemsetAsync((char*)d_ws + WS_CTL, 0, CTL_ZERO_BYTES, stream) != hipSuccess) return;
    Args a{};
    for (int i = 0; i < N_IN; ++i) a.in[i] = (const float*)d_in[i];
    a.out = (float*)d_out; a.ws = (unsigned char*)d_ws; a.pad0 = 0; a.pad1 = 0;
#if MK_ONE_LAUNCH
    a.ph_lo = 0; a.ph_hi = N_PHASES;
    hipLaunchKernelGGL(enc_fwd, dim3(grid), dim3(NWAVES * 64), LDS_BYTES, stream, a);
#else
    for (int ph = 0; ph < N_PHASES; ++ph) { a.ph_lo = ph; a.ph_hi = ph + 1;
        hipLaunchKernelGGL(enc_fwd, dim3(grid), dim3(NWAVES * 64), LDS_BYTES, stream, a); }
#endif
}
```
